# Optimizing an MI355X kernel written in HIP

```python
import jax, jax.numpy as jnp
from jax import lax
import numpy as np

D_MODEL = 2048
BATCH = 2
SEQ = 4096
DEPTH = 2
DEC_BATCH = 32
DEC_SEQ = 32
PAST_LEN = 2048

CHUNK = 64
N_MIXERS = 2
N_A_LAYERS = (DEPTH + 1) // 2
N_B_LAYERS = DEPTH // 2
HGRN_HEADS = 16
HGRN_DK = D_MODEL // HGRN_HEADS
HGRN_DV = D_MODEL // HGRN_HEADS
HGRN_QW = HGRN_HEADS * HGRN_DK
HGRN_VW = HGRN_HEADS * HGRN_DV
ATT_HEADS = 16
ATT_HEAD_DIM = D_MODEL // ATT_HEADS
N_PREV_CHUNKS = 8
BAND = N_PREV_CHUNKS * CHUNK
MAX_BACK = 2 * CHUNK
REL_ROWS = MAX_BACK + CHUNK
D_FF = 5632
CONV_W = 3
EPS = 1e-6

kernel_name = "hybrid_stream_hgrn2_bandattn_convffn_step"


def rms_norm(x, g):
    xf = x.astype(jnp.float32)
    y = xf * lax.rsqrt(jnp.mean(xf * xf, axis=-1, keepdims=True) + EPS)
    return (y * g.astype(jnp.float32)).astype(x.dtype)


def gla_scan(q, k, v, log_f, S0):
    B, L, H, _ = q.shape
    blk = min(CHUNK, L)
    nb = L // blk

    def to_blocks(t):
        return t.astype(jnp.float32).reshape(B, nb, blk, H, t.shape[-1]).transpose(1, 0, 3, 2, 4)

    causal = jnp.tril(jnp.ones((blk, blk), dtype=bool))

    def step(S, inp):
        qc, kc, vc, gc = inp
        b = jnp.cumsum(gc, axis=2)
        diff = b[:, :, :, None, :] - b[:, :, None, :, :]
        decay = jnp.exp(jnp.where(causal[:, :, None], diff, -jnp.inf))
        scores = jnp.einsum('bhtsk,bhsk->bhts', qc[:, :, :, None, :] * decay, kc)
        o = (jnp.einsum('bhts,bhsv->bhtv', scores, vc)
             + jnp.einsum('bhtk,bhkv->bhtv', qc * jnp.exp(b), S))
        b_end = b[:, :, -1:, :]
        S = (jnp.exp(b_end[:, :, 0, :])[..., None] * S
             + jnp.einsum('bhsk,bhsv->bhkv', kc * jnp.exp(b_end - b), vc))
        return S, o

    S, o = lax.scan(step, S0.astype(jnp.float32), (to_blocks(q), to_blocks(k), to_blocks(v), to_blocks(log_f)))
    o = o.transpose(1, 0, 3, 2, 4).reshape(B, L, H, v.shape[-1])
    return o.astype(q.dtype), S.astype(S0.dtype)


def hgrn2_mixer(h, S0, w_in, lb, norm_o, w_o):
    B, L, _ = h.shape
    proj = h @ w_in
    q = proj[..., :HGRN_QW].reshape(B, L, HGRN_HEADS, HGRN_DK)
    fz = proj[..., HGRN_QW:2 * HGRN_QW].reshape(B, L, HGRN_HEADS, HGRN_DK).astype(jnp.float32)
    iv = proj[..., 2 * HGRN_QW:2 * HGRN_QW + HGRN_VW].reshape(B, L, HGRN_HEADS, HGRN_DV)
    g = proj[..., 2 * HGRN_QW + HGRN_VW:].reshape(B, L, HGRN_HEADS, HGRN_DV)
    lbh = lb.reshape(HGRN_HEADS, HGRN_DK)
    log_f = jnp.log(lbh + (1.0 - lbh) * jax.nn.sigmoid(fz))
    k = (1.0 - lbh) * jax.nn.sigmoid(-fz)
    o, S = gla_scan(q, k, iv, log_f, S0)
    o = rms_norm(o, norm_o) * jax.nn.silu(g)
    return o.reshape(B, L, HGRN_VW) @ w_o, S


def attn_project(h, w_qkv, q_norm, k_norm):
    B, L, _ = h.shape
    proj = h @ w_qkv
    q = proj[..., :D_MODEL].reshape(B, L, ATT_HEADS, ATT_HEAD_DIM)
    k = proj[..., D_MODEL:2 * D_MODEL].reshape(B, L, ATT_HEADS, ATT_HEAD_DIM)
    v = proj[..., 2 * D_MODEL:].reshape(B, L, ATT_HEADS, ATT_HEAD_DIM)
    return rms_norm(q, q_norm), rms_norm(k, k_norm), v


def band_attend(q, k, v, q_pos, k_pos, rel_bias):
    s = jnp.einsum('bnqhd,bnkhd->bnhqk', q, k).astype(jnp.float32) * (ATT_HEAD_DIM ** -0.5)
    rel = k_pos[:, None, :] - q_pos[:, :, None]
    idx = jnp.clip(rel, -MAX_BACK, CHUNK - 1) + MAX_BACK
    bias = jnp.transpose(rel_bias.astype(jnp.float32)[idx], (0, 3, 1, 2))
    q_chunk = (q_pos // CHUNK)[:, :, None]
    k_chunk = (k_pos // CHUNK)[:, None, :]
    valid = (k_pos[:, None, :] >= 0) & (k_chunk <= q_chunk) & (k_chunk >= q_chunk - N_PREV_CHUNKS)
    s = jnp.where(valid[None, :, None], s + bias[None], -jnp.inf)
    p = jax.nn.softmax(s, axis=-1).astype(v.dtype)
    return jnp.einsum('bnhqk,bnkhd->bnqhd', p, v)


def band_attn_prompt(h, w_qkv, q_norm, k_norm, rel_bias, w_o):
    B, L, _ = h.shape
    q, k, v = attn_project(h, w_qkv, q_norm, k_norm)
    nc = L // CHUNK
    pad = ((0, 0), (BAND, 0), (0, 0), (0, 0))
    idx = (jnp.arange(nc) * CHUNK)[:, None] + jnp.arange(BAND + CHUNK)[None, :]
    kb = jnp.pad(k, pad)[:, idx]
    vb = jnp.pad(v, pad)[:, idx]
    q_pos = jnp.arange(L).reshape(nc, CHUNK)
    o = band_attend(q.reshape(B, nc, CHUNK, ATT_HEADS, ATT_HEAD_DIM), kb, vb, q_pos, idx - BAND, rel_bias)
    keep = min(BAND, L)
    return o.reshape(B, L, D_MODEL) @ w_o, k[:, L - keep:], v[:, L - keep:]


def band_attn_sample(h, cache_k, cache_v, w_qkv, q_norm, k_norm, rel_bias, w_o):
    B, L, _ = h.shape
    q, k, v = attn_project(h, w_qkv, q_norm, k_norm)
    r = cache_k.shape[1]
    k_all = jnp.concatenate([cache_k.astype(k.dtype), k], axis=1)[:, None]
    v_all = jnp.concatenate([cache_v.astype(v.dtype), v], axis=1)[:, None]
    k_pos = jnp.arange(PAST_LEN - r, PAST_LEN + L)[None]
    q_pos = (PAST_LEN + jnp.arange(L))[None]
    o = band_attend(q[:, None], k_all, v_all, q_pos, k_pos, rel_bias)
    return o.reshape(B, L, D_MODEL) @ w_o, k, v


def conv_ffn(h, conv_state, w_in, conv_w, conv_b, w_down):
    L = h.shape[1]
    up = h @ w_in
    u = up[..., :D_FF]
    gate = up[..., D_FF:]
    u_ext = jnp.concatenate([conv_state.astype(u.dtype), u], axis=1)
    c = conv_b
    for j in range(CONV_W):
        c = c + u_ext[:, j:j + L] * conv_w[j]
    return (jax.nn.silu(c) * gate) @ w_down, u_ext[:, -(CONV_W - 1):]


def setup_inputs(seed: int = 0) -> dict:
    key = jax.random.key(seed)
    ks = jax.random.split(key, 24)

    def nrm(k, shape, scale):
        return jax.random.normal(k, shape, jnp.float32) * scale

    band_rows = min(BAND, PAST_LEN)
    return {
        "x_prompt": nrm(ks[0], (BATCH, SEQ, D_MODEL), 1.0),
        "x_sample": nrm(ks[1], (DEC_BATCH, DEC_SEQ, D_MODEL), 1.0),
        "state_a_S": nrm(ks[2], (N_A_LAYERS, DEC_BATCH, HGRN_HEADS, HGRN_DK, HGRN_DV), 0.5),
        "cache_b_k": nrm(ks[3], (N_B_LAYERS, DEC_BATCH, band_rows, ATT_HEADS, ATT_HEAD_DIM), 1.0),
        "cache_b_v": nrm(ks[4], (N_B_LAYERS, DEC_BATCH, band_rows, ATT_HEADS, ATT_HEAD_DIM), 1.0),
        "state_ffn_conv": nrm(ks[5], (DEPTH, DEC_BATCH, CONV_W - 1, D_FF), 1.0),
        "norm_mix": 1.0 + nrm(ks[6], (DEPTH, D_MODEL), 0.02),
        "norm_ffn": 1.0 + nrm(ks[7], (DEPTH, D_MODEL), 0.02),
        "a_w_in": nrm(ks[8], (N_A_LAYERS, D_MODEL, 2 * HGRN_QW + 2 * HGRN_VW), D_MODEL ** -0.5),
        "a_gamma_lb": nrm(ks[9], (DEPTH + 1, HGRN_QW), 1.0),
        "a_norm_o": 1.0 + nrm(ks[10], (N_A_LAYERS, HGRN_DV), 0.02),
        "a_w_o": nrm(ks[11], (N_A_LAYERS, HGRN_VW, D_MODEL), HGRN_VW ** -0.5),
        "b_w_qkv": nrm(ks[12], (N_B_LAYERS, D_MODEL, 3 * D_MODEL), D_MODEL ** -0.5),
        "b_q_norm": 1.0 + nrm(ks[13], (N_B_LAYERS, ATT_HEAD_DIM), 0.02),
        "b_k_norm": 1.0 + nrm(ks[14], (N_B_LAYERS, ATT_HEAD_DIM), 0.02),
        "b_rel_bias": nrm(ks[15], (N_B_LAYERS, REL_ROWS, ATT_HEADS), 0.1),
        "b_w_o": nrm(ks[16], (N_B_LAYERS, D_MODEL, D_MODEL), D_MODEL ** -0.5),
        "f_w_in": nrm(ks[17], (DEPTH, D_MODEL, 2 * D_FF), D_MODEL ** -0.5),
        "f_conv_w": nrm(ks[18], (DEPTH, CONV_W, D_FF), CONV_W ** -0.5),
        "f_conv_b": nrm(ks[19], (DEPTH, D_FF), 0.02),
        "f_w_down": nrm(ks[20], (DEPTH, D_FF, D_MODEL), D_FF ** -0.5),
    }


def reference(x_prompt, x_sample, state_a_S, cache_b_k, cache_b_v, state_ffn_conv,
              norm_mix, norm_ffn, a_w_in, a_gamma_lb, a_norm_o, a_w_o,
              b_w_qkv, b_q_norm, b_k_norm, b_rel_bias, b_w_o,
              f_w_in, f_conv_w, f_conv_b, f_w_down):
    lb_all = jnp.cumsum(jax.nn.softmax(a_gamma_lb.astype(jnp.float32), axis=0), axis=0)
    xp, xs = x_prompt, x_sample
    B = x_prompt.shape[0]
    a_Sp, a_Ss, b_kp, b_vp, b_ks, b_vs, f_cp, f_cs = [], [], [], [], [], [], [], []
    for i in range(DEPTH):
        j = i // N_MIXERS
        hp = rms_norm(xp, norm_mix[i])
        hs = rms_norm(xs, norm_mix[i])
        if i % N_MIXERS == 0:
            S_zero = jnp.zeros((B, HGRN_HEADS, HGRN_DK, HGRN_DV), jnp.float32)
            yp, Sp = hgrn2_mixer(hp, S_zero, a_w_in[j], lb_all[i], a_norm_o[j], a_w_o[j])
            ys, Ss = hgrn2_mixer(hs, state_a_S[j], a_w_in[j], lb_all[i], a_norm_o[j], a_w_o[j])
            a_Sp.append(Sp)
            a_Ss.append(Ss)
        else:
            yp, kp, vp = band_attn_prompt(hp, b_w_qkv[j], b_q_norm[j], b_k_norm[j], b_rel_bias[j], b_w_o[j])
            ys, ks_, vs_ = band_attn_sample(hs, cache_b_k[j], cache_b_v[j], b_w_qkv[j], b_q_norm[j],
                                            b_k_norm[j], b_rel_bias[j], b_w_o[j])
            b_kp.append(kp)
            b_vp.append(vp)
            b_ks.append(ks_)
            b_vs.append(vs_)
        xp = xp + yp
        xs = xs + ys
        conv_zero = jnp.zeros((B, CONV_W - 1, D_FF), xp.dtype)
        fp, cp = conv_ffn(rms_norm(xp, norm_ffn[i]), conv_zero, f_w_in[i], f_conv_w[i], f_conv_b[i], f_w_down[i])
        fs, cs = conv_ffn(rms_norm(xs, norm_ffn[i]), state_ffn_conv[i], f_w_in[i], f_conv_w[i], f_conv_b[i], f_w_down[i])
        xp = xp + fp
        xs = xs + fs
        f_cp.append(cp)
        f_cs.append(cs)
    return (xp, xs, jnp.stack(a_Sp), jnp.stack(a_Ss), jnp.stack(b_kp), jnp.stack(b_vp),
            jnp.stack(b_ks), jnp.stack(b_vs), jnp.stack(f_cp), jnp.stack(f_cs))
```

```cpp
#include <hip/hip_runtime.h>
#include <hip/hip_cooperative_groups.h>
#include <cstdio>
#include <cstdint>
namespace cg = cooperative_groups;

#define DI __device__ __forceinline__
#define LAS __attribute__((address_space(3)))
#define GAS __attribute__((address_space(1)))
typedef unsigned short bf16;
typedef short bf16x8 __attribute__((ext_vector_type(8)));
typedef float f32x2 __attribute__((ext_vector_type(2)));
typedef float f32x4 __attribute__((ext_vector_type(4)));
typedef float f32x16 __attribute__((ext_vector_type(16)));
typedef unsigned u32x2 __attribute__((ext_vector_type(2)));
typedef unsigned u32x4 __attribute__((ext_vector_type(4)));
typedef __bf16 bf16x2_t __attribute__((ext_vector_type(2)));

#ifndef EN_MASK
#define EN_MASK 0xffffu
#endif
#ifndef MK_N_LAUNCHES
#define MK_N_LAUNCHES 1
#endif

constexpr int D = 2048, TP = 8192, TS = 1024, T = TP + TS, SEQ = 4096, NH = 16, HD = 128, FF = 5632;
constexpr int NQKV = 3 * D, NWIN = 4 * D, NUP = 2 * FF;
constexpr int SROWS = 544;
constexpr float EPS = 1e-6f;
constexpr int NWAVES = 8, NTHR = 512;
constexpr int LDS_BYTES = 147456;

constexpr size_t MiB = 1u << 20;
constexpr size_t WS_WINA = 0, WS_WOA = 32 * MiB, WS_WQKV = 40 * MiB, WS_WOB = 64 * MiB, WS_FIN0 = 72 * MiB, WS_FIN1 = 116 * MiB, WS_FDN0 = 160 * MiB, WS_FDN1 = 182 * MiB;
constexpr size_t WS_LB = 204 * MiB, WS_HB = 205 * MiB, WS_QB = 241 * MiB, WS_MIX = 277 * MiB;
constexpr size_t WS_LOGF = WS_MIX, WS_VB = WS_MIX + 72 * MiB, WS_SG = WS_MIX + 108 * MiB, WS_OI = WS_MIX + 144 * MiB, WS_LOCAL = WS_MIX + 216 * MiB, WS_DEC = WS_MIX + 376 * MiB;
constexpr size_t WS_QKV = WS_MIX, WS_KN = WS_MIX + 108 * MiB, WS_KS = WS_MIX + 140 * MiB, WS_VT = WS_MIX + 208 * MiB, WS_VTS = WS_MIX + 240 * MiB;
constexpr size_t WS_UP = WS_MIX, WS_ACT = WS_MIX + 198 * MiB;
constexpr size_t WS_END = WS_MIX + 378 * MiB;

constexpr size_t O_YP = 0, O_YS = O_YP + (size_t)TP * D, O_SP = O_YS + (size_t)TS * D, O_SS = O_SP + 2 * 16 * 128 * 128, O_KP = O_SS + 32 * 16 * 128 * 128,
                 O_VP = O_KP + 2 * 512 * 2048, O_KSM = O_VP + 2 * 512 * 2048, O_VSM = O_KSM + 32 * 32 * 2048, O_CP = O_VSM + 32 * 32 * 2048, O_CS = O_CP + 2 * 2 * 2 * FF,
                 O_END = O_CS + 2 * 32 * 2 * FF;

struct Params {
    const float* x_prompt; const float* x_sample; const float* state_a_S; const float* cache_k; const float* cache_v; const float* conv_state;
    const float* norm_mix; const float* norm_ffn; const float* a_w_in; const float* a_gamma; const float* a_norm_o; const float* a_w_o;
    const float* b_w_qkv; const float* b_q_norm; const float* b_k_norm; const float* b_rel_bias; const float* b_w_o;
    const float* f_w_in; const float* f_conv_w; const float* f_conv_b; const float* f_w_down;
    float* out; unsigned char* ws; int ph_lo, ph_hi;
};

DI unsigned pk2(float lo, float hi) { f32x2 v = {lo, hi}; return __builtin_bit_cast(unsigned, __builtin_convertvector(v, bf16x2_t)); }
DI bf16 f2bf(float f) { return (bf16)(pk2(f, 0.f) & 0xffffu); }
DI float bflo(unsigned p) { return __uint_as_float(p << 16); }
DI float bfhi(unsigned p) { return __uint_as_float(p & 0xffff0000u); }
DI float wave_sum(float v) {
#pragma unroll
    for (int o = 1; o < 64; o <<= 1) v += __shfl_xor(v, o);
    return v;
}
DI float fsigmoid(float z) { return 1.f / (1.f + __expf(-z)); }
DI float fsilu(float z) { return z / (1.f + __expf(-z)); }
DI int crow(int reg, int h) { return (reg & 3) + 8 * (reg >> 2) + 4 * h; }
#define MFMA32(a, b, c) __builtin_amdgcn_mfma_f32_32x32x16_bf16((a), (b), (c), 0, 0, 0)

namespace pg8 {
constexpr int BM = 256, BK = 64, HALF = 128, HTB = HALF * BK * 2, STAGE_BYTES = 8 * HTB, NXCD = 8, WGM = 8;
DI int lds_byte(int r, int c) { const int st = (r >> 4) * 2 + (c >> 5), rr = r & 15, cc = c & 31, ob = rr * 64 + cc * 2; return st * 1024 + (ob ^ (((ob >> 9) & 1) << 5)); }
DI void stage_rc(int b, int& R, int& C) { const int st = b / 1024, sb = b % 1024, swz = sb ^ (((sb >> 9) & 1) << 5); R = (st >> 1) * 16 + swz / 64; C = (st & 1) * 32 + (swz % 64) / 2; }
DI int perm32(int rho) { const int n = rho >> 4, i = rho & 15; return 8 * (i >> 2) + 4 * n + (i & 3); }
struct Unit { int pm, pn; };
struct Gemm { const bf16* A; const bf16* Bt; int M, N, K; };
struct StaticOrder {
    int nM, nN, nwg, G, c;
    DI void init(int M, int N, int G_, int c_) { nM = M / BM; nN = N / BM; nwg = nM * nN; G = G_; c = c_; }
    DI bool next(int i, Unit& u) const {
        const long L = (long)i * G + c; if (L >= nwg) return false;
        int wgid = (int)L; { const int q = nwg / NXCD, r = nwg % NXCD, xcd = wgid % NXCD, off = wgid / NXCD; wgid = (xcd < r ? xcd * (q + 1) : r * (q + 1) + (xcd - r) * q) + off; }
        const int nig = WGM * nN, gid = wgid / nig, fm = gid * WGM, gsz = (nM - fm) < WGM ? (nM - fm) : WGM;
        u.pm = fm + ((wgid % nig) % gsz); u.pn = (wgid % nig) / gsz; return true;
    }
};

struct Epi {
    int mode;
    int ldo;
    bf16* ob;
    float* of; const float* resP; const float* resS;
    const float* lb; float* logf; unsigned char* wsb;
    DI bool perm() const { return mode != 2; }
    DI void operator()(const f32x4 (&acc)[2][2][4][2], const Unit& u, int wr, int wc, int fr, int fq) const {
        const int row0 = u.pm * BM + wr * 64 + fr;
        if (mode == 2) {
            const int col0 = u.pn * BM + wc * 32 + 4 * fq;
#pragma unroll
            for (int ai = 0; ai < 2; ++ai)
#pragma unroll
                for (int m = 0; m < 4; ++m) {
                    const int row = row0 + ai * HALF + m * 16;
                    const float* rp = (row < TP ? resP + (size_t)row * D : resS + (size_t)(row - TP) * D) + col0;
                    float* op = of + (size_t)row * D + col0;
#pragma unroll
                    for (int bj = 0; bj < 2; ++bj)
#pragma unroll
                        for (int n = 0; n < 2; ++n) { const f32x4 r = *(const f32x4*)(rp + bj * HALF + n * 16); *(f32x4*)(op + bj * HALF + n * 16) = r + acc[ai][bj][m][n]; }
                }
        } else if (mode == 1) {
            const int col0 = u.pn * BM + wc * 32 + 8 * fq;
#pragma unroll
            for (int ai = 0; ai < 2; ++ai)
#pragma unroll
                for (int m = 0; m < 4; ++m) {
                    bf16* op = ob + (size_t)(row0 + ai * HALF + m * 16) * ldo + col0;
#pragma unroll
                    for (int bj = 0; bj < 2; ++bj) { const f32x4 v0 = acc[ai][bj][m][0], v1 = acc[ai][bj][m][1];
                        u32x4 o; o.x = pk2(v0.x, v0.y); o.y = pk2(v0.z, v0.w); o.z = pk2(v1.x, v1.y); o.w = pk2(v1.z, v1.w);
                        *(u32x4*)(op + bj * HALF) = o; }
                }
        } else {
            const int type = u.pn >> 3, col0 = (u.pn & 7) * BM + wc * 32 + 8 * fq;
#pragma unroll
            for (int bj = 0; bj < 2; ++bj) {
                const int col = col0 + bj * HALF;
                f32x4 l0 = {0.f, 0.f, 0.f, 0.f}, l1 = l0;
                if (type == 1) { l0 = *(const f32x4*)(lb + col); l1 = *(const f32x4*)(lb + col + 4); }
#pragma unroll
                for (int ai = 0; ai < 2; ++ai)
#pragma unroll
                    for (int m = 0; m < 4; ++m) {
                        const size_t off = (size_t)(row0 + ai * HALF + m * 16) * D + col;
                        f32x4 v0 = acc[ai][bj][m][0], v1 = acc[ai][bj][m][1];
                        if (type == 1) {
#pragma unroll
                            for (int e = 0; e < 4; ++e) { v0[e] = __logf(l0[e] + (1.f - l0[e]) * fsigmoid(v0[e])); v1[e] = __logf(l1[e] + (1.f - l1[e]) * fsigmoid(v1[e])); }
                            *(f32x4*)(logf + off) = v0; *(f32x4*)(logf + off + 4) = v1;
                        } else {
                            if (type == 3) {
#pragma unroll
                                for (int e = 0; e < 4; ++e) { v0[e] = fsilu(v0[e]); v1[e] = fsilu(v1[e]); }
                            }
                            u32x4 o; o.x = pk2(v0.x, v0.y); o.y = pk2(v0.z, v0.w); o.z = pk2(v1.x, v1.y); o.w = pk2(v1.z, v1.w);
                            bf16* dst = (bf16*)(wsb + (type == 0 ? WS_QB : (type == 2 ? WS_VB : WS_SG)));
                            *(u32x4*)(dst + off) = o;
                        }
                    }
            }
        }
    }
};

DI void gemm_phase(LAS unsigned char* lds, const Gemm g, const StaticOrder& S, const Epi& E, const int tid) {
    const int wid = __builtin_amdgcn_readfirstlane(tid >> 6), lane = tid & 63, wr = wid >> 2, wc = wid & 3, fr = lane & 15, fq = lane >> 4;
    const int K = g.K, nt = K / BK;
    const bool PERM = E.perm();
    unsigned voffA[2], voffB[2];
#pragma unroll
    for (int i = 0; i < 2; ++i) { int R, C; stage_rc(tid * 16 + i * 8192, R, C); const int Rb = PERM ? ((R & ~31) + perm32(R & 31)) : R;
        voffA[i] = (unsigned)(R * K + C) * 2u; voffB[i] = (unsigned)(Rb * K + C) * 2u; }
    const size_t kstep = (size_t)(BK * 2);
    const size_t hstep = (size_t)HALF * K * 2;
    const size_t tstep = 2 * hstep;
    const unsigned ldsw = (unsigned)wid * 1024u;
    const int aoff = lds_byte(wr * 64 + fr, fq * 8), boff = lds_byte(wc * 32 + fr, fq * 8);
#define PG8_SA(b, h) (((b) * 2 + (h)) * HTB)
#define PG8_SB(b, h) ((4 + (b) * 2 + (h)) * HTB)
#define PG8_STAGE(bufoff, gbase, voff) do { _Pragma("unroll") for (int _i = 0; _i < 2; ++_i) \
        __builtin_amdgcn_global_load_lds((const unsigned*)((const char*)(gbase) + (voff)[_i]), (LAS unsigned*)(lds + (bufoff) + ldsw + _i * 8192), 16, 0, 0); } while (0)
#define PG8_LDA(dst, b, h) do { _Pragma("unroll") for (int m = 0; m < 4; ++m) _Pragma("unroll") for (int k = 0; k < 2; ++k) dst[m][k] = *(const LAS bf16x8*)(lds + PG8_SA(b, h) + aoff + m * 2048 + k * 1024); } while (0)
#define PG8_LDB(dst, b, h) do { _Pragma("unroll") for (int n = 0; n < 2; ++n) _Pragma("unroll") for (int k = 0; k < 2; ++k) dst[n][k] = *(const LAS bf16x8*)(lds + PG8_SB(b, h) + boff + n * 2048 + k * 1024); } while (0)
#define PG8_MMA(ai, bj, At, Bt) do { __builtin_amdgcn_s_setprio(1); _Pragma("unroll") for (int m = 0; m < 4; ++m) _Pragma("unroll") for (int n = 0; n < 2; ++n) _Pragma("unroll") for (int k = 0; k < 2; ++k) \
        acc[ai][bj][m][n] = __builtin_amdgcn_mfma_f32_16x16x32_bf16(Bt[n][k], At[m][k], acc[ai][bj][m][n], 0, 0, 0); __builtin_amdgcn_s_setprio(0); } while (0)
#define PG8_WAIT_V(n) asm volatile("s_waitcnt vmcnt(" #n ")" ::: "memory")
#define PG8_WAIT_L(n) asm volatile("s_waitcnt lgkmcnt(" #n ")" ::: "memory")
#define PG8_BAR __builtin_amdgcn_s_barrier()
#define PG8_SCHED __builtin_amdgcn_sched_barrier(0)
    Unit cur, nxt; int ui = 0;
    if (!S.next(0, cur)) return;
    f32x4 acc[2][2][4][2];
#pragma unroll
    for (int a = 0; a < 2; ++a)
#pragma unroll
        for (int b = 0; b < 2; ++b)
#pragma unroll
            for (int m = 0; m < 4; ++m)
#pragma unroll
                for (int n = 0; n < 2; ++n) acc[a][b][m][n] = (f32x4){0.f, 0.f, 0.f, 0.f};
    bf16x8 At[4][2], B0[2][2], B1[2][2];
    const char* cA = (const char*)g.A + (size_t)cur.pm * tstep; const char* cB = (const char*)g.Bt + (size_t)cur.pn * tstep;
    PG8_STAGE(PG8_SB(0, 0), cB, voffB); PG8_STAGE(PG8_SA(0, 0), cA, voffA); PG8_STAGE(PG8_SB(0, 1), cB + hstep, voffB); PG8_STAGE(PG8_SA(0, 1), cA + hstep, voffA);
    if (wr == 1) PG8_BAR;
    PG8_WAIT_V(4); PG8_BAR;
    PG8_STAGE(PG8_SB(1, 0), cB + kstep, voffB); PG8_STAGE(PG8_SA(1, 0), cA + kstep, voffA); PG8_STAGE(PG8_SB(1, 1), cB + hstep + kstep, voffB);
    PG8_WAIT_V(6); PG8_BAR;
    for (;;) {
        const bool has_next = S.next(ui + 1, nxt);
        const char* nA = has_next ? (const char*)g.A + (size_t)nxt.pm * tstep : cA; const char* nB = has_next ? (const char*)g.Bt + (size_t)nxt.pn * tstep : cB;
        for (int t = 0; t < nt; t += 2) {
            const bool last = (t == nt - 2);
            const char* a1 = cA + (size_t)(t + 1) * kstep;
            const char* a2 = last ? nA : cA + (size_t)(t + 2) * kstep; const char* b2 = last ? nB : cB + (size_t)(t + 2) * kstep;
            const char* a3 = a2 + kstep; const char* b3 = b2 + kstep;
            PG8_LDB(B0, 0, 0); PG8_SCHED; PG8_LDA(At, 0, 0); PG8_STAGE(PG8_SA(1, 1), a1 + hstep, voffA);
            PG8_WAIT_L(8); PG8_BAR; PG8_WAIT_L(0); PG8_MMA(0, 0, At, B0); PG8_BAR; PG8_SCHED;
            PG8_LDB(B1, 0, 1); PG8_STAGE(PG8_SB(0, 0), b2, voffB);
            PG8_BAR; PG8_WAIT_L(0); PG8_MMA(0, 1, At, B1); PG8_BAR;
            PG8_LDA(At, 0, 1); PG8_STAGE(PG8_SA(0, 0), a2, voffA);
            PG8_BAR; PG8_WAIT_L(0); PG8_MMA(1, 0, At, B0); PG8_BAR; PG8_SCHED;
            PG8_STAGE(PG8_SB(0, 1), b2 + hstep, voffB);
            PG8_WAIT_V(6); PG8_BAR; PG8_MMA(1, 1, At, B1); PG8_BAR;
            PG8_LDB(B0, 1, 0); PG8_SCHED; PG8_LDA(At, 1, 0); PG8_STAGE(PG8_SA(0, 1), a2 + hstep, voffA);
            PG8_WAIT_L(8); PG8_BAR; PG8_WAIT_L(0); PG8_MMA(0, 0, At, B0); PG8_BAR; PG8_SCHED;
            PG8_LDB(B1, 1, 1); PG8_STAGE(PG8_SB(1, 0), b3, voffB);
            PG8_BAR; PG8_WAIT_L(0); PG8_MMA(0, 1, At, B1); PG8_BAR;
            PG8_LDA(At, 1, 1); PG8_STAGE(PG8_SA(1, 0), a3, voffA);
            PG8_BAR; PG8_WAIT_L(0); PG8_MMA(1, 0, At, B0); PG8_BAR; PG8_SCHED;
            PG8_STAGE(PG8_SB(1, 1), b3 + hstep, voffB);
            PG8_WAIT_V(6); PG8_BAR; PG8_MMA(1, 1, At, B1); PG8_BAR;
        }
        E(acc, cur, wr, wc, fr, fq);
        if (!has_next) break;
#pragma unroll
        for (int a = 0; a < 2; ++a)
#pragma unroll
            for (int b = 0; b < 2; ++b)
#pragma unroll
                for (int m = 0; m < 4; ++m)
#pragma unroll
                    for (int n = 0; n < 2; ++n) acc[a][b][m][n] = (f32x4){0.f, 0.f, 0.f, 0.f};
        cur = nxt; cA = nA; cB = nB; ++ui;
    }
    PG8_WAIT_V(0);
    if (wr == 0) PG8_BAR;
    PG8_BAR;
#undef PG8_SA
#undef PG8_SB
#undef PG8_STAGE
#undef PG8_LDA
#undef PG8_LDB
#undef PG8_MMA
#undef PG8_WAIT_V
#undef PG8_WAIT_L
#undef PG8_BAR
#undef PG8_SCHED
}
}

struct Frame {
    Params p; LAS unsigned char* lds; int tid, lane, wave, G, bid;
    bf16 *WinA, *WoA, *Wqkv, *WoB, *Fin0, *Fin1, *Fdn0, *Fdn1;
    float* LB; bf16 *HB, *QB;
    float* LOGF; bf16 *VB, *SG; float *OI, *LOCAL, *DEC;
    bf16 *QKV, *KN, *KS, *VT, *VTS, *UP, *ACT;
};

DI void transpose_item(const float* __restrict__ W, int K, int N, bf16* __restrict__ WT, LAS float* scr, int item, int lane) {
    const int nblk = N / 64, kb = item / nblk, nb = item % nblk, k0 = 64 * kb, n0 = 64 * nb;
#pragma unroll 8
    for (int i = 0; i < 64; ++i) scr[i * 65 + lane] = W[(size_t)(k0 + i) * N + n0 + lane];
    asm volatile("s_waitcnt lgkmcnt(0)" ::: "memory");
    const int c = lane & 7;
#pragma unroll
    for (int j = 0; j < 8; ++j) { const int n = (lane >> 3) + 8 * j; const LAS float* s = scr + (8 * c) * 65 + n;
        u32x4 o; o.x = pk2(s[0 * 65], s[1 * 65]); o.y = pk2(s[2 * 65], s[3 * 65]); o.z = pk2(s[4 * 65], s[5 * 65]); o.w = pk2(s[6 * 65], s[7 * 65]);
        *(u32x4*)(WT + (size_t)(n0 + n) * K + k0 + 8 * c) = o; }
    asm volatile("s_waitcnt lgkmcnt(0)" ::: "memory");
}
DI void rms_row(const float* __restrict__ xrow, const float* __restrict__ g, bf16* __restrict__ orow, int lane) {
    const f32x4* xr = (const f32x4*)xrow + lane; const f32x4* gr = (const f32x4*)g + lane;
    f32x4 v[8]; float s = 0.f;
#pragma unroll
    for (int j = 0; j < 8; ++j) { v[j] = xr[64 * j]; s += (v[j].x * v[j].x + v[j].y * v[j].y) + (v[j].z * v[j].z + v[j].w * v[j].w); }
    const float rstd = rsqrtf(wave_sum(s) * (1.f / D) + EPS);
    u32x2* o8 = (u32x2*)orow + lane;
#pragma unroll
    for (int j = 0; j < 8; ++j) { const f32x4 gg = gr[64 * j]; u32x2 o; o.x = pk2(v[j].x * rstd * gg.x, v[j].y * rstd * gg.y); o.y = pk2(v[j].z * rstd * gg.z, v[j].w * rstd * gg.w); o8[64 * j] = o; }
}
DI void rms_phase(Frame& F, const float* srcP, const float* srcS, const float* g) {
    const int gw = F.bid * NWAVES + F.wave, NGW = F.G * NWAVES;
    for (int m = gw; m < T; m += NGW) {
        const float* src = m < TP ? srcP + (size_t)m * D : srcS + (size_t)(m - TP) * D;
        rms_row(src, g, F.HB + (size_t)m * D, F.lane);
    }
}
DI void p0_phase(Frame& F) {
    const Params& p = F.p;
    LAS float* scr = (LAS float*)(F.lds + F.wave * 16640);
    const int gw = F.bid * NWAVES + F.wave, NGW = F.G * NWAVES;
    constexpr int I_WINA = (D / 64) * (NWIN / 64), I_WO = (D / 64) * (D / 64), I_QKV = (D / 64) * (NQKV / 64), I_FIN = (D / 64) * (NUP / 64), I_FDN = (FF / 64) * (D / 64);
    constexpr int NITEMS = I_WINA + 2 * I_WO + I_QKV + 2 * I_FIN + 2 * I_FDN;
    for (int it = gw; it < NITEMS; it += NGW) {
        int r = it;
        if (r < I_WINA) { transpose_item(p.a_w_in, D, NWIN, F.WinA, scr, r, F.lane); continue; } r -= I_WINA;
        if (r < I_WO) { transpose_item(p.a_w_o, D, D, F.WoA, scr, r, F.lane); continue; } r -= I_WO;
        if (r < I_QKV) { transpose_item(p.b_w_qkv, D, NQKV, F.Wqkv, scr, r, F.lane); continue; } r -= I_QKV;
        if (r < I_WO) { transpose_item(p.b_w_o, D, D, F.WoB, scr, r, F.lane); continue; } r -= I_WO;
        if (r < I_FIN) { transpose_item(p.f_w_in, D, NUP, F.Fin0, scr, r, F.lane); continue; } r -= I_FIN;
        if (r < I_FIN) { transpose_item(p.f_w_in + (size_t)D * NUP, D, NUP, F.Fin1, scr, r, F.lane); continue; } r -= I_FIN;
        if (r < I_FDN) { transpose_item(p.f_w_down, FF, D, F.Fdn0, scr, r, F.lane); continue; } r -= I_FDN;
        transpose_item(p.f_w_down + (size_t)FF * D, FF, D, F.Fdn1, scr, r, F.lane);
    }
    for (int c = F.bid * NTHR + F.tid; c < D; c += F.G * NTHR) {
        const float g0 = p.a_gamma[c], g1 = p.a_gamma[D + c], g2 = p.a_gamma[2 * D + c];
        const float mx = fmaxf(g0, fmaxf(g1, g2));
        const float e0 = __expf(g0 - mx), e1 = __expf(g1 - mx), e2 = __expf(g2 - mx);
        F.LB[c] = e0 / (e0 + e1 + e2);
    }
    rms_phase(F, p.x_prompt, p.x_sample, p.norm_mix);
}

constexpr int GLA_UNITS = 2048 + 512;
constexpr int QT_STRIDE = 136, TT_STRIDE = 72;
constexpr int L_BCUM = 0, L_QT = 32768, L_KT = L_QT + 64 * QT_STRIDE * 2, L_KHT = L_KT + 64 * QT_STRIDE * 2, L_VT = L_KHT + 128 * TT_STRIDE * 2, L_PM = L_VT + 128 * TT_STRIDE * 2, L_GLA_END = L_PM + 64 * TT_STRIDE * 2;
static_assert(L_GLA_END <= LDS_BYTES, "gla lds");

DI f32x16 mma_lds(const LAS bf16* A, int astride, int arow0, const LAS bf16* B, int bstride, int brow0, int nks, int lane) {
    f32x16 acc; for (int i = 0; i < 16; ++i) acc[i] = 0.f;
    const int r = lane & 31, hf = lane >> 5;
    const LAS bf16* ap = A + (arow0 + r) * astride + 8 * hf; const LAS bf16* bp = B + (brow0 + r) * bstride + 8 * hf;
    for (int ks = 0; ks < nks; ++ks) { const bf16x8 a = *(const LAS bf16x8*)(ap + 16 * ks), b = *(const LAS bf16x8*)(bp + 16 * ks); acc = MFMA32(a, b, acc); }
    return acc;
}

template <int BLK>
DI void gla_a_unit(Frame& F, int u, int row0, int h) {
    LAS float* bcum = (LAS float*)(F.lds + L_BCUM);
    LAS bf16* qt = (LAS bf16*)(F.lds + L_QT); LAS bf16* kt = (LAS bf16*)(F.lds + L_KT); LAS bf16* khT = (LAS bf16*)(F.lds + L_KHT);
    LAS bf16* vT = (LAS bf16*)(F.lds + L_VT); LAS bf16* Pm = (LAS bf16*)(F.lds + L_PM);
    const int tid = F.tid, lane = F.lane, w = F.wave;
    const size_t hoff = (size_t)h * HD;
    constexpr int SEG = BLK / 4;
    { const int seg = tid >> 7, kc = tid & 127; float a = 0.f;
      const float* lp = F.LOGF + (size_t)(row0 + seg * SEG) * D + hoff + kc;
#pragma unroll
      for (int t = 0; t < SEG; ++t) { a += lp[(size_t)t * D]; bcum[(seg * SEG + t) * 128 + kc] = a; }
      __syncthreads();
      float off = 0.f;
      for (int s = 0; s < seg; ++s) off += bcum[(s * SEG + SEG - 1) * 128 + kc];
      __syncthreads();
      if (seg > 0) {
#pragma unroll
          for (int t = 0; t < SEG; ++t) bcum[(seg * SEG + t) * 128 + kc] += off;
      }
      __syncthreads(); }
    for (int i = tid; i < BLK * 16; i += NTHR) {
        const int t = i >> 4, c0 = (i & 15) * 8;
        const size_t goff = (size_t)(row0 + t) * D + hoff + c0;
        const u32x4 qv = *(const u32x4*)(F.QB + goff);
        const u32x4 vv = *(const u32x4*)(F.VB + goff);
        const f32x4 lf0 = *(const f32x4*)(F.LOGF + goff), lf1 = *(const f32x4*)(F.LOGF + goff + 4);
        float q[8] = {bflo(qv.x), bfhi(qv.x), bflo(qv.y), bfhi(qv.y), bflo(qv.z), bfhi(qv.z), bflo(qv.w), bfhi(qv.w)};
        float lf[8] = {lf0.x, lf0.y, lf0.z, lf0.w, lf1.x, lf1.y, lf1.z, lf1.w};
        float qtv[8], ktv[8], qhv[8], khv[8];
#pragma unroll
        for (int e = 0; e < 8; ++e) {
            const float b = bcum[t * 128 + c0 + e], bmid = bcum[(BLK / 2 - 1) * 128 + c0 + e], bend = bcum[(BLK - 1) * 128 + c0 + e];
            const float kk = 1.f - __expf(lf[e]);
            qtv[e] = q[e] * __expf(b - bmid); ktv[e] = kk * __expf(bmid - b); qhv[e] = q[e] * __expf(b); khv[e] = kk * __expf(bend - b);
            if (t == BLK - 1) F.DEC[(size_t)u * 128 + c0 + e] = __expf(bend);
        }
        u32x4 o; o.x = pk2(qtv[0], qtv[1]); o.y = pk2(qtv[2], qtv[3]); o.z = pk2(qtv[4], qtv[5]); o.w = pk2(qtv[6], qtv[7]);
        *(LAS u32x4*)(qt + t * QT_STRIDE + c0) = o;
        o.x = pk2(ktv[0], ktv[1]); o.y = pk2(ktv[2], ktv[3]); o.z = pk2(ktv[4], ktv[5]); o.w = pk2(ktv[6], ktv[7]);
        *(LAS u32x4*)(kt + t * QT_STRIDE + c0) = o;
        o.x = pk2(qhv[0], qhv[1]); o.y = pk2(qhv[2], qhv[3]); o.z = pk2(qhv[4], qhv[5]); o.w = pk2(qhv[6], qhv[7]);
        *(u32x4*)(F.QB + goff) = o;
        const unsigned vw[4] = {vv.x, vv.y, vv.z, vv.w};
#pragma unroll
        for (int e = 0; e < 8; ++e) {
            khT[(c0 + e) * TT_STRIDE + t] = f2bf(khv[e]);
            vT[(c0 + e) * TT_STRIDE + t] = (bf16)((e & 1) ? (vw[e >> 1] >> 16) : (vw[e >> 1] & 0xffffu));
        }
    }
    __syncthreads();
    const int r = lane & 31, hf = lane >> 5;
#pragma unroll
    for (int q2 = 0; q2 < 2; ++q2) {
        const int tl = w * 2 + q2, mt = tl >> 2, nt = tl & 3;
        const f32x16 acc = mma_lds(khT, TT_STRIDE, 32 * mt, vT, TT_STRIDE, 32 * nt, BLK / 16, lane);
        float* lp = F.LOCAL + (size_t)u * 16384 + 32 * nt + r;
#pragma unroll
        for (int i = 0; i < 16; ++i) lp[(size_t)(32 * mt + crow(i, hf)) * 128] = acc[i];
    }
    constexpr int NT2 = BLK / 32;
    if (w < NT2 * NT2) {
        const int mt = w / NT2, nt = w % NT2;
        if (nt > mt) {
#pragma unroll
            for (int i = 0; i < 16; ++i) Pm[(32 * mt + crow(i, hf)) * TT_STRIDE + 32 * nt + r] = 0;
        } else {
            const f32x16 acc = mma_lds(qt, QT_STRIDE, 32 * mt, kt, QT_STRIDE, 32 * nt, 8, lane);
#pragma unroll
            for (int i = 0; i < 16; ++i) { const int t = 32 * mt + crow(i, hf), s = 32 * nt + r; Pm[t * TT_STRIDE + s] = (s <= t) ? f2bf(acc[i]) : (bf16)0; }
        }
    }
    __syncthreads();
    if (w < NT2 * 4) {
        const int mt = w >> 2, nt = w & 3;
        const f32x16 acc = mma_lds(Pm, TT_STRIDE, 32 * mt, vT, TT_STRIDE, 32 * nt, BLK / 16, lane);
        float* op = F.OI + (size_t)(row0 + 32 * mt) * D + hoff + 32 * nt + r;
#pragma unroll
        for (int i = 0; i < 16; ++i) op[(size_t)crow(i, hf) * D] = acc[i];
    }
    __syncthreads();
}
DI void gla_a_phase(Frame& F) {
    for (int u = F.bid; u < GLA_UNITS; u += F.G) {
        if (u < 2048) { const int b = u >> 10, h = (u >> 6) & 15, c = u & 63; gla_a_unit<64>(F, u, b * SEQ + c * 64, h); }
        else { const int su = u - 2048, b = su >> 4, h = su & 15; gla_a_unit<32>(F, u, TP + b * 32, h); }
    }
}
DI void scan_phase(Frame& F) {
    const int gt = F.bid * NTHR + F.tid, NGT = F.G * NTHR;
    for (int it = gt; it < 32 * 4096; it += NGT) {
        const int bh = it >> 12, e = (it & 4095) * 4, kc = e >> 7;
        f32x4 S = {0.f, 0.f, 0.f, 0.f};
        float* lp = F.LOCAL + (size_t)(bh * 64) * 16384 + e; const float* dp = F.DEC + (size_t)(bh * 64) * 128 + kc;
#pragma unroll 8
        for (int c = 0; c < 64; ++c) { const f32x4 loc = *(const f32x4*)(lp + (size_t)c * 16384); const float d = dp[c * 128]; *(f32x4*)(lp + (size_t)c * 16384) = S; S = S * d + loc; }
        *(f32x4*)(F.p.out + O_SP + (size_t)bh * 16384 + e) = S;
    }
    for (int it = gt; it < 512 * 4096; it += NGT) {
        const int bh = it >> 12, e = (it & 4095) * 4, kc = e >> 7;
        const f32x4 S0 = *(const f32x4*)(F.p.state_a_S + (size_t)bh * 16384 + e);
        const f32x4 loc = *(const f32x4*)(F.LOCAL + (size_t)(2048 + bh) * 16384 + e);
        const float d = F.DEC[(size_t)(2048 + bh) * 128 + kc];
        *(f32x4*)(F.p.out + O_SS + (size_t)bh * 16384 + e) = S0 * d + loc;
    }
}
constexpr int OB_STRIDE = 132;
template <int BLK>
DI void gla_c_unit(Frame& F, const float* __restrict__ S, int row0, int h) {
    LAS float* ob = (LAS float*)F.lds;
    const int tid = F.tid, lane = F.lane, w = F.wave, r = lane & 31, hf = lane >> 5;
    const size_t hoff = (size_t)h * HD;
    if (w < (BLK / 32) * 4) {
        const int mt = w >> 2, nt = w & 3;
        f32x16 acc; for (int i = 0; i < 16; ++i) acc[i] = 0.f;
        const bf16* ap = F.QB + (size_t)(row0 + 32 * mt + r) * D + hoff + 8 * hf;
        const float* sp = S + (size_t)(8 * hf) * 128 + 32 * nt + r;
#pragma unroll 2
        for (int ks = 0; ks < 8; ++ks) {
            const bf16x8 a = *(const bf16x8*)(ap + 16 * ks);
            float sv[8];
#pragma unroll
            for (int e = 0; e < 8; ++e) sv[e] = sp[(size_t)(16 * ks + e) * 128];
            u32x4 bb; bb.x = pk2(sv[0], sv[1]); bb.y = pk2(sv[2], sv[3]); bb.z = pk2(sv[4], sv[5]); bb.w = pk2(sv[6], sv[7]);
            acc = MFMA32(a, __builtin_bit_cast(bf16x8, bb), acc);
        }
        const float* oi = F.OI + (size_t)(row0 + 32 * mt) * D + hoff + 32 * nt + r;
#pragma unroll
        for (int i = 0; i < 16; ++i) { const int t = crow(i, hf); ob[(32 * mt + t) * OB_STRIDE + 32 * nt + r] = acc[i] + oi[(size_t)t * D]; }
    }
    __syncthreads();
    {
        constexpr int TPR = NTHR / BLK;
        constexpr int CPT = 128 / TPR;
        const int t = tid / TPR, j = tid % TPR, c0 = j * CPT;
        float v[CPT]; float ss = 0.f;
#pragma unroll
        for (int e = 0; e < CPT; ++e) { v[e] = ob[t * OB_STRIDE + c0 + e]; ss += v[e] * v[e]; }
#pragma unroll
        for (int o = 1; o < TPR; o <<= 1) ss += __shfl_xor(ss, o);
        const float rstd = rsqrtf(ss * (1.f / HD) + EPS);
        const size_t goff = (size_t)(row0 + t) * D + hoff + c0;
#pragma unroll
        for (int e8 = 0; e8 < CPT / 8; ++e8) {
            const u32x4 sg = *(const u32x4*)(F.SG + goff + 8 * e8);
            const f32x4 n0 = *(const f32x4*)(F.p.a_norm_o + c0 + 8 * e8), n1 = *(const f32x4*)(F.p.a_norm_o + c0 + 8 * e8 + 4);
            const float* vv = v + 8 * e8;
            u32x4 o;
            o.x = pk2(vv[0] * rstd * n0.x * bflo(sg.x), vv[1] * rstd * n0.y * bfhi(sg.x));
            o.y = pk2(vv[2] * rstd * n0.z * bflo(sg.y), vv[3] * rstd * n0.w * bfhi(sg.y));
            o.z = pk2(vv[4] * rstd * n1.x * bflo(sg.z), vv[5] * rstd * n1.y * bfhi(sg.z));
            o.w = pk2(vv[6] * rstd * n1.z * bflo(sg.w), vv[7] * rstd * n1.w * bfhi(sg.w));
            *(u32x4*)(F.HB + goff + 8 * e8) = o;
        }
    }
    __syncthreads();
}
DI void gla_c_phase(Frame& F) {
    for (int u = F.bid; u < GLA_UNITS; u += F.G) {
        if (u < 2048) { const int b = u >> 10, h = (u >> 6) & 15, c = u & 63; gla_c_unit<64>(F, F.LOCAL + (size_t)u * 16384, b * SEQ + c * 64, h); }
        else { const int su = u - 2048, b = su >> 4, h = su & 15; gla_c_unit<32>(F, F.p.state_a_S + (size_t)su * 16384, TP + b * 32, h); }
    }
}
DI void conv_phase(Frame& F, int layer) {
    const Params& p = F.p;
    const int gt = F.bid * NTHR + F.tid, NGT = F.G * NTHR;
    constexpr int NCG = FF / 8, NSEG = T / 32;
    const float* cw = p.f_conv_w + (size_t)layer * 3 * FF; const float* cb = p.f_conv_b + (size_t)layer * FF;
    for (int it = gt; it < NSEG * NCG; it += NGT) {
        const int seg = it / NCG, c0 = (it % NCG) * 8;
        const bool smp = seg >= 256; const int r0 = seg * 32;
        const bool first = smp || ((seg & 127) == 0), lastseg = smp || ((seg & 127) == 127);
        float w0[8], w1[8], w2[8], bb[8], um2[8], um1[8];
#pragma unroll
        for (int e = 0; e < 8; ++e) { w0[e] = cw[c0 + e]; w1[e] = cw[FF + c0 + e]; w2[e] = cw[2 * FF + c0 + e]; bb[e] = cb[c0 + e]; um2[e] = 0.f; um1[e] = 0.f; }
        if (first) {
            if (smp) { const float* st = p.conv_state + ((size_t)(layer * 32 + (seg - 256)) * 2) * FF + c0;
#pragma unroll
                for (int e = 0; e < 8; ++e) { um2[e] = st[e]; um1[e] = st[FF + e]; } }
        } else {
            const u32x4 a = *(const u32x4*)(F.UP + (size_t)(r0 - 2) * NUP + c0), b = *(const u32x4*)(F.UP + (size_t)(r0 - 1) * NUP + c0);
            um2[0] = bflo(a.x); um2[1] = bfhi(a.x); um2[2] = bflo(a.y); um2[3] = bfhi(a.y); um2[4] = bflo(a.z); um2[5] = bfhi(a.z); um2[6] = bflo(a.w); um2[7] = bfhi(a.w);
            um1[0] = bflo(b.x); um1[1] = bfhi(b.x); um1[2] = bflo(b.y); um1[3] = bfhi(b.y); um1[4] = bflo(b.z); um1[5] = bfhi(b.z); um1[6] = bflo(b.w); um1[7] = bfhi(b.w);
        }
#pragma unroll 4
        for (int t = 0; t < 32; ++t) {
            const size_t ro = (size_t)(r0 + t) * NUP + c0;
            const u32x4 uu = *(const u32x4*)(F.UP + ro), gg = *(const u32x4*)(F.UP + ro + FF);
            const float uc[8] = {bflo(uu.x), bfhi(uu.x), bflo(uu.y), bfhi(uu.y), bflo(uu.z), bfhi(uu.z), bflo(uu.w), bfhi(uu.w)};
            const float gc[8] = {bflo(gg.x), bfhi(gg.x), bflo(gg.y), bfhi(gg.y), bflo(gg.z), bfhi(gg.z), bflo(gg.w), bfhi(gg.w)};
            float a[8];
#pragma unroll
            for (int e = 0; e < 8; ++e) { const float c = bb[e] + um2[e] * w0[e] + um1[e] * w1[e] + uc[e] * w2[e]; a[e] = fsilu(c) * gc[e]; um2[e] = um1[e]; um1[e] = uc[e]; }
            u32x4 o; o.x = pk2(a[0], a[1]); o.y = pk2(a[2], a[3]); o.z = pk2(a[4], a[5]); o.w = pk2(a[6], a[7]);
            *(u32x4*)(F.ACT + (size_t)(r0 + t) * FF + c0) = o;
        }
        if (lastseg) {
            float* dst = smp ? p.out + O_CS + ((size_t)(layer * 32 + (seg - 256)) * 2) * FF + c0 : p.out + O_CP + ((size_t)(layer * 2 + (seg >> 7)) * 2) * FF + c0;
#pragma unroll
            for (int e = 0; e < 8; ++e) { dst[e] = um2[e]; dst[FF + e] = um1[e]; }
        }
    }
}
DI void prep_phase(Frame& F) {
    const Params& p = F.p;
    const int gw = F.bid * NWAVES + F.wave, NGW = F.G * NWAVES, lane = F.lane;
    const float qscale = 0.08838834764831845f * 1.4426950408889634f;
    for (int m = gw; m < T; m += NGW) {
        const bf16* src = F.QKV + (size_t)m * NQKV + lane * 32;
        const bool smp = m >= TP; const int b = smp ? (m - TP) >> 5 : m >> 12, t = smp ? (m - TP) & 31 : m & 4095;
        const int hc = (lane & 3) * 32;
        { float v[32]; float ss = 0.f;
#pragma unroll
          for (int j = 0; j < 4; ++j) { const u32x4 x = *(const u32x4*)(src + 8 * j); const unsigned xw[4] = {x.x, x.y, x.z, x.w};
#pragma unroll
              for (int e = 0; e < 4; ++e) { v[8 * j + 2 * e] = bflo(xw[e]); v[8 * j + 2 * e + 1] = bfhi(xw[e]); } }
#pragma unroll
          for (int e = 0; e < 32; ++e) ss += v[e] * v[e];
          ss += __shfl_xor(ss, 1); ss += __shfl_xor(ss, 2);
          const float rstd = rsqrtf(ss * (1.f / HD) + EPS) * qscale;
          bf16* dst = F.QB + (size_t)m * D + lane * 32;
#pragma unroll
          for (int j = 0; j < 4; ++j) { const f32x4 g0 = *(const f32x4*)(p.b_q_norm + hc + 8 * j), g1 = *(const f32x4*)(p.b_q_norm + hc + 8 * j + 4);
              u32x4 o; o.x = pk2(v[8 * j] * rstd * g0.x, v[8 * j + 1] * rstd * g0.y); o.y = pk2(v[8 * j + 2] * rstd * g0.z, v[8 * j + 3] * rstd * g0.w);
              o.z = pk2(v[8 * j + 4] * rstd * g1.x, v[8 * j + 5] * rstd * g1.y); o.w = pk2(v[8 * j + 6] * rstd * g1.z, v[8 * j + 7] * rstd * g1.w);
              *(u32x4*)(dst + 8 * j) = o; } }
        float* ko = nullptr; float* vo = nullptr;
        if (smp) { ko = p.out + O_KSM + (size_t)(m - TP) * D + lane * 32; vo = p.out + O_VSM + (size_t)(m - TP) * D + lane * 32; }
        else if (t >= SEQ - 512) { ko = p.out + O_KP + ((size_t)b * 512 + (t - (SEQ - 512))) * D + lane * 32; vo = p.out + O_VP + ((size_t)b * 512 + (t - (SEQ - 512))) * D + lane * 32; }
        { float v[32]; float ss = 0.f;
#pragma unroll
          for (int j = 0; j < 4; ++j) { const u32x4 x = *(const u32x4*)(src + D + 8 * j); const unsigned xw[4] = {x.x, x.y, x.z, x.w};
#pragma unroll
              for (int e = 0; e < 4; ++e) { v[8 * j + 2 * e] = bflo(xw[e]); v[8 * j + 2 * e + 1] = bfhi(xw[e]); } }
#pragma unroll
          for (int e = 0; e < 32; ++e) ss += v[e] * v[e];
          ss += __shfl_xor(ss, 1); ss += __shfl_xor(ss, 2);
          const float rstd = rsqrtf(ss * (1.f / HD) + EPS);
          bf16* dst = smp ? F.KS + ((size_t)b * SROWS + 512 + t) * D + lane * 32 : F.KN + (size_t)m * D + lane * 32;
#pragma unroll
          for (int j = 0; j < 4; ++j) { const f32x4 g0 = *(const f32x4*)(p.b_k_norm + hc + 8 * j), g1 = *(const f32x4*)(p.b_k_norm + hc + 8 * j + 4);
              f32x4 a = {v[8 * j] * rstd * g0.x, v[8 * j + 1] * rstd * g0.y, v[8 * j + 2] * rstd * g0.z, v[8 * j + 3] * rstd * g0.w};
              f32x4 c = {v[8 * j + 4] * rstd * g1.x, v[8 * j + 5] * rstd * g1.y, v[8 * j + 6] * rstd * g1.z, v[8 * j + 7] * rstd * g1.w};
              u32x4 o; o.x = pk2(a.x, a.y); o.y = pk2(a.z, a.w); o.z = pk2(c.x, c.y); o.w = pk2(c.z, c.w);
              *(u32x4*)(dst + 8 * j) = o;
              if (ko) { *(f32x4*)(ko + 8 * j) = a; *(f32x4*)(ko + 8 * j + 4) = c; } } }
        if (vo) {
#pragma unroll
            for (int j = 0; j < 4; ++j) { const u32x4 x = *(const u32x4*)(src + 2 * D + 8 * j);
                f32x4 a = {bflo(x.x), bfhi(x.x), bflo(x.y), bfhi(x.y)}, c = {bflo(x.z), bfhi(x.z), bflo(x.w), bfhi(x.w)};
                *(f32x4*)(vo + 8 * j) = a; *(f32x4*)(vo + 8 * j + 4) = c; }
        }
    }
    { const int gt = F.bid * NTHR + F.tid, NGT = F.G * NTHR;
      for (int it = gt; it < 32 * 512 * (D / 8); it += NGT) {
          const int row = it >> 8, c0 = (it & 255) * 8, b = row >> 9, j = row & 511;
          const f32x4 a = *(const f32x4*)(p.cache_k + (size_t)row * D + c0), c = *(const f32x4*)(p.cache_k + (size_t)row * D + c0 + 4);
          u32x4 o; o.x = pk2(a.x, a.y); o.y = pk2(a.z, a.w); o.z = pk2(c.x, c.y); o.w = pk2(c.z, c.w);
          *(u32x4*)(F.KS + ((size_t)b * SROWS + j) * D + c0) = o;
      } }
    { LAS bf16* tile = (LAS bf16*)(F.lds + F.wave * 16640);
      constexpr int NP = 2 * 64 * 16, NS = 32 * 16 * 9;
      for (int it = gw; it < NP + NS; it += NGW) {
          int nrows = 64; bf16* dst; int dstride;
          if (it < NP) {
              const int h = it & 15, tb = (it >> 4) & 63, b = it >> 10;
              const bf16* src = F.QKV + (size_t)(b * SEQ + tb * 64) * NQKV + 2 * D + h * HD + 2 * lane;
#pragma unroll 8
              for (int i = 0; i < 64; ++i) *(LAS unsigned*)(tile + i * 130 + 2 * lane) = *(const unsigned*)(src + (size_t)i * NQKV);
              dst = F.VT + ((size_t)(b * 16 + h) * HD) * SEQ + tb * 64; dstride = SEQ;
          } else {
              const int r = it - NP, h = r & 15, jb = (r >> 4) % 9, b = r / 144;
              if (jb < 8) {
                  const float* src = p.cache_v + ((size_t)(b * 512 + jb * 64) * NH + h) * HD + 2 * lane;
#pragma unroll 8
                  for (int i = 0; i < 64; ++i) { const f32x2 x = *(const f32x2*)(src + (size_t)i * D); *(LAS unsigned*)(tile + i * 130 + 2 * lane) = pk2(x.x, x.y); }
              } else {
                  nrows = 32;
                  const bf16* src = F.QKV + (size_t)(TP + b * 32) * NQKV + 2 * D + h * HD + 2 * lane;
#pragma unroll 8
                  for (int i = 0; i < 32; ++i) *(LAS unsigned*)(tile + i * 130 + 2 * lane) = *(const unsigned*)(src + (size_t)i * NQKV);
              }
              dst = F.VTS + ((size_t)(b * 16 + h) * HD) * SROWS + jb * 64; dstride = SROWS;
          }
          asm volatile("s_waitcnt lgkmcnt(0)" ::: "memory");
          const int tp = lane & 31, dh = lane >> 5;
          if (2 * tp < nrows) {
#pragma unroll 8
              for (int pp = 0; pp < 64; ++pp) { const int dv = 2 * pp + dh;
                  const unsigned lo = tile[(2 * tp) * 130 + dv], hi = tile[(2 * tp + 1) * 130 + dv];
                  *(unsigned*)(dst + (size_t)dv * dstride + 2 * tp) = lo | (hi << 16); }
          }
          asm volatile("s_waitcnt lgkmcnt(0)" ::: "memory");
      } }
}
DI void attn_phase(Frame& F) {
    const Params& p = F.p;
    const int gw = F.bid * NWAVES + F.wave, NGW = F.G * NWAVES, lane = F.lane, r = lane & 31, hf = lane >> 5;
    constexpr float L2E = 1.4426950408889634f;
    for (int unit = gw; unit < 4096 + 512; unit += NGW) {
        int h, qrow0, nkt, rel0; const bf16* kbase; const bf16* vbase; int vstride;
        if (unit < 4096) {
            const int half = unit & 1, c = (unit >> 1) & 63, b = unit >> 11; h = (unit >> 7) & 15;
            const int c0 = c > 8 ? c - 8 : 0;
            qrow0 = b * SEQ + c * 64 + half * 32; nkt = 2 * (c - c0 + 1); rel0 = c0 * 64 - (c * 64 + half * 32);
            kbase = F.KN + (size_t)(b * SEQ + c0 * 64) * D + h * HD; vbase = F.VT + ((size_t)(b * 16 + h) * HD) * SEQ + c0 * 64; vstride = SEQ;
        } else {
            const int su = unit - 4096, b = su >> 4; h = su & 15;
            qrow0 = TP + b * 32; nkt = 17; rel0 = -512;
            kbase = F.KS + (size_t)(b * SROWS) * D + h * HD; vbase = F.VTS + ((size_t)(b * 16 + h) * HD) * SROWS; vstride = SROWS;
        }
        const float* bias = p.b_rel_bias + h;
        const float bias0 = bias[0] * L2E;
        bf16x8 qf[8];
        { const bf16* qp = F.QB + (size_t)(qrow0 + r) * D + h * HD + 8 * hf;
#pragma unroll
          for (int kk = 0; kk < 8; ++kk) qf[kk] = *(const bf16x8*)(qp + 16 * kk); }
        f32x16 oacc[4];
#pragma unroll
        for (int bl = 0; bl < 4; ++bl) for (int i = 0; i < 16; ++i) oacc[bl][i] = 0.f;
        float mrun = -1e30f, lsum = 0.f;
        for (int kt = 0; kt < nkt; ++kt) {
            f32x16 s; for (int i = 0; i < 16; ++i) s[i] = 0.f;
            { const bf16* kp = kbase + (size_t)(32 * kt + r) * D + 8 * hf;
#pragma unroll
              for (int kk = 0; kk < 8; ++kk) { const bf16x8 kf = *(const bf16x8*)(kp + 16 * kk); s = MFMA32(kf, qf[kk], s); } }
            const int relb = rel0 + 32 * kt - r;
            if (relb + 31 <= -128) {
#pragma unroll
                for (int i = 0; i < 16; ++i) s[i] += bias0;
            } else {
#pragma unroll
                for (int i = 0; i < 16; ++i) { int rel = relb + crow(i, hf); rel = rel < -128 ? -128 : (rel > 63 ? 63 : rel); s[i] += bias[(rel + 128) * NH] * L2E; }
            }
            float mt = s[0];
#pragma unroll
            for (int i = 1; i < 16; ++i) mt = fmaxf(mt, s[i]);
            mt = fmaxf(mt, __shfl_xor(mt, 32));
            const float mnew = fmaxf(mrun, mt), alpha = exp2f(mrun - mnew);
            mrun = mnew;
            float ps = 0.f; float pv[16];
#pragma unroll
            for (int i = 0; i < 16; ++i) { pv[i] = exp2f(s[i] - mnew); ps += pv[i]; }
            lsum = lsum * alpha + ps;
#pragma unroll
            for (int bl = 0; bl < 4; ++bl)
#pragma unroll
                for (int i = 0; i < 16; ++i) oacc[bl][i] *= alpha;
#pragma unroll
            for (int kb = 0; kb < 2; ++kb) {
                u32x4 pb; pb.x = pk2(pv[8 * kb], pv[8 * kb + 1]); pb.y = pk2(pv[8 * kb + 2], pv[8 * kb + 3]); pb.z = pk2(pv[8 * kb + 4], pv[8 * kb + 5]); pb.w = pk2(pv[8 * kb + 6], pv[8 * kb + 7]);
                const bf16x8 pfr = __builtin_bit_cast(bf16x8, pb);
#pragma unroll
                for (int bl = 0; bl < 4; ++bl) {
                    const bf16* vp = vbase + (size_t)(32 * bl + r) * vstride + 32 * kt + 16 * kb + 4 * hf;
                    const u32x2 v0 = *(const u32x2*)vp, v1 = *(const u32x2*)(vp + 8);
                    u32x4 vv; vv.x = v0.x; vv.y = v0.y; vv.z = v1.x; vv.w = v1.y;
                    oacc[bl] = MFMA32(__builtin_bit_cast(bf16x8, vv), pfr, oacc[bl]);
                }
            }
        }
        lsum += __shfl_xor(lsum, 32);
        const float inv = 1.f / lsum;
        bf16* op = F.HB + (size_t)(qrow0 + r) * D + h * HD;
#pragma unroll
        for (int bl = 0; bl < 4; ++bl)
#pragma unroll
            for (int g4 = 0; g4 < 4; ++g4) {
                u32x2 o; o.x = pk2(oacc[bl][4 * g4] * inv, oacc[bl][4 * g4 + 1] * inv); o.y = pk2(oacc[bl][4 * g4 + 2] * inv, oacc[bl][4 * g4 + 3] * inv);
                *(u32x2*)(op + 32 * bl + 8 * g4 + 4 * hf) = o;
            }
    }
}

enum { PH_P0, PH_G1, PH_GLA_A, PH_SCAN, PH_GLA_C, PH_G2, PH_RMS_F0, PH_G3_0, PH_CONV0, PH_G4_0, PH_RMS_M1, PH_G5, PH_PREP, PH_ATTN, PH_G6, PH_RMS_F1, PH_G3_1, PH_CONV1, PH_G4_1, NPH };

__global__ void __launch_bounds__(NTHR, 2) fwd_megakernel(Params prm) {
    extern __shared__ __attribute__((aligned(16))) unsigned char lds_raw[];
    cg::grid_group grid = cg::this_grid();
    float* const X0 = prm.out;
    for (int ph = prm.ph_lo; ph < prm.ph_hi; ++ph) {
        int tid_ = threadIdx.x; asm volatile("" : "+v"(tid_));
        unsigned char* ws_ = prm.ws; asm volatile("" : "+s"(ws_));
        float* X_ = X0; asm volatile("" : "+s"(X_));
        unsigned char* ws = (unsigned char*)(GAS unsigned char*)ws_;
        float* X = (float*)(GAS float*)X_;
        Frame F;
        F.p = prm; F.lds = (LAS unsigned char*)lds_raw;
        F.tid = tid_; F.lane = F.tid & 63; F.wave = __builtin_amdgcn_readfirstlane(F.tid >> 6); F.G = gridDim.x; F.bid = blockIdx.x;
        F.WinA = (bf16*)(ws + WS_WINA); F.WoA = (bf16*)(ws + WS_WOA); F.Wqkv = (bf16*)(ws + WS_WQKV); F.WoB = (bf16*)(ws + WS_WOB);
        F.Fin0 = (bf16*)(ws + WS_FIN0); F.Fin1 = (bf16*)(ws + WS_FIN1); F.Fdn0 = (bf16*)(ws + WS_FDN0); F.Fdn1 = (bf16*)(ws + WS_FDN1);
        F.LB = (float*)(ws + WS_LB); F.HB = (bf16*)(ws + WS_HB); F.QB = (bf16*)(ws + WS_QB);
        F.LOGF = (float*)(ws + WS_LOGF); F.VB = (bf16*)(ws + WS_VB); F.SG = (bf16*)(ws + WS_SG); F.OI = (float*)(ws + WS_OI); F.LOCAL = (float*)(ws + WS_LOCAL); F.DEC = (float*)(ws + WS_DEC);
        F.QKV = (bf16*)(ws + WS_QKV); F.KN = (bf16*)(ws + WS_KN); F.KS = (bf16*)(ws + WS_KS); F.VT = (bf16*)(ws + WS_VT); F.VTS = (bf16*)(ws + WS_VTS);
        F.UP = (bf16*)(ws + WS_UP); F.ACT = (bf16*)(ws + WS_ACT);
        switch (ph) {
        case PH_P0: if (EN_MASK & 1) p0_phase(F); break;
        case PH_GLA_A: if (EN_MASK & 2) gla_a_phase(F); break;
        case PH_SCAN: if (EN_MASK & 4) scan_phase(F); break;
        case PH_GLA_C: if (EN_MASK & 8) gla_c_phase(F); break;
        case PH_RMS_F0: if (EN_MASK & 16) rms_phase(F, X, X + (size_t)TP * D, prm.norm_ffn); break;
        case PH_RMS_M1: if (EN_MASK & 16) rms_phase(F, X, X + (size_t)TP * D, prm.norm_mix + D); break;
        case PH_RMS_F1: if (EN_MASK & 16) rms_phase(F, X, X + (size_t)TP * D, prm.norm_ffn + D); break;
        case PH_CONV0: if (EN_MASK & 32) conv_phase(F, 0); break;
        case PH_CONV1: if (EN_MASK & 32) conv_phase(F, 1); break;
        case PH_PREP: if (EN_MASK & 64) prep_phase(F); break;
        case PH_ATTN: if (EN_MASK & 128) attn_phase(F); break;
        default: if (EN_MASK & 256) {
            pg8::Gemm g; pg8::Epi E; E.mode = 2; E.ldo = D; E.ob = nullptr; E.of = X; E.resP = X; E.resS = X + (size_t)TP * D;
            E.lb = F.LB; E.logf = F.LOGF; E.wsb = ws;
            g.A = F.HB; g.M = T; g.K = D; g.N = D; g.Bt = F.WoA;
            if (ph == PH_G1) { g.Bt = F.WinA; g.N = NWIN; E.mode = 0; }
            else if (ph == PH_G2) { g.Bt = F.WoA; E.resP = prm.x_prompt; E.resS = prm.x_sample; }
            else if (ph == PH_G3_0 || ph == PH_G3_1) { g.Bt = (ph == PH_G3_1) ? F.Fin1 : F.Fin0; g.N = NUP; E.mode = 1; E.ob = F.UP; E.ldo = NUP; }
            else if (ph == PH_G4_0 || ph == PH_G4_1) { g.A = F.ACT; g.Bt = (ph == PH_G4_1) ? F.Fdn1 : F.Fdn0; g.K = FF; }
            else if (ph == PH_G5) { g.Bt = F.Wqkv; g.N = NQKV; E.mode = 1; E.ob = F.QKV; E.ldo = NQKV; }
            else { g.Bt = F.WoB; }
            pg8::StaticOrder S; S.init(g.M, g.N, F.G, F.bid);
            pg8::gemm_phase(F.lds, g, S, E, F.tid);
        } break;
        }
        if (ph + 1 < prm.ph_hi) grid.sync();
    }
}

extern "C" void kernel_launch(void* const* d_in, const int* in_sizes, int n_in, void* d_out, int out_size, void* d_ws, size_t ws_size, hipStream_t stream) {
    static int grid_blocks = 0;
    if (!grid_blocks) {
        int dev = 0, cus = 0, per_cu = 0;
        hipGetDevice(&dev);
        hipDeviceGetAttribute(&cus, hipDeviceAttributeMultiprocessorCount, dev);
        if (hipFuncSetAttribute((const void*)fwd_megakernel, hipFuncAttributeMaxDynamicSharedMemorySize, LDS_BYTES) != hipSuccess) fprintf(stderr, "kernel_launch: hipFuncSetAttribute failed\n");
        hipOccupancyMaxActiveBlocksPerMultiprocessor(&per_cu, (const void*)fwd_megakernel, NTHR, LDS_BYTES);
        if (per_cu < 1) per_cu = 1;
        if (per_cu > 1) per_cu = 1;
        grid_blocks = cus * per_cu;
        if (n_in != 21 || (size_t)out_size != O_END || ws_size < WS_END) fprintf(stderr, "kernel_launch: unexpected sizes n_in %d out %d ws %zu (need %zu)\n", n_in, out_size, ws_size, (size_t)WS_END);
    }
    Params p{};
    p.x_prompt = (const float*)d_in[0]; p.x_sample = (const float*)d_in[1]; p.state_a_S = (const float*)d_in[2]; p.cache_k = (const float*)d_in[3]; p.cache_v = (const float*)d_in[4];
    p.conv_state = (const float*)d_in[5]; p.norm_mix = (const float*)d_in[6]; p.norm_ffn = (const float*)d_in[7]; p.a_w_in = (const float*)d_in[8]; p.a_gamma = (const float*)d_in[9];
    p.a_norm_o = (const float*)d_in[10]; p.a_w_o = (const float*)d_in[11]; p.b_w_qkv = (const float*)d_in[12]; p.b_q_norm = (const float*)d_in[13]; p.b_k_norm = (const float*)d_in[14];
    p.b_rel_bias = (const float*)d_in[15]; p.b_w_o = (const float*)d_in[16]; p.f_w_in = (const float*)d_in[17]; p.f_conv_w = (const float*)d_in[18]; p.f_conv_b = (const float*)d_in[19];
    p.f_w_down = (const float*)d_in[20];
    p.out = (float*)d_out; p.ws = (unsigned char*)d_ws;
#if MK_N_LAUNCHES == 1
    p.ph_lo = 0; p.ph_hi = NPH;
    void* args[] = {&p};
    hipError_t e = hipLaunchCooperativeKernel((const void*)fwd_megakernel, dim3(grid_blocks), dim3(NTHR), args, LDS_BYTES, stream);
    if (e != hipSuccess) fprintf(stderr, "cooperative launch failed: %s (grid %d)\n", hipGetErrorString(e), grid_blocks);
#else
    for (int ph = 0; ph < NPH; ++ph) {
        p.ph_lo = ph; p.ph_hi = ph + 1;
        hipLaunchKernelGGL(fwd_megakernel, dim3(grid_blocks), dim3(NTHR), LDS_BYTES, stream, p);
    }
#endif
}
```

```cpp
#include <hip/hip_runtime.h>
#include <hip/hip_cooperative_groups.h>
#include <cstdio>
#include <cstdint>
namespace cg = cooperative_groups;

#define DI __device__ __forceinline__
#define LAS __attribute__((address_space(3)))
#define GAS __attribute__((address_space(1)))
typedef unsigned short bf16;
typedef short bf16x8 __attribute__((ext_vector_type(8)));
typedef float f32x2 __attribute__((ext_vector_type(2)));
typedef float f32x4 __attribute__((ext_vector_type(4)));
typedef float f32x16 __attribute__((ext_vector_type(16)));
typedef unsigned u32x2 __attribute__((ext_vector_type(2)));
typedef unsigned u32x4 __attribute__((ext_vector_type(4)));
typedef __bf16 bf16x2_t __attribute__((ext_vector_type(2)));

#ifndef EN_MASK
#define EN_MASK 0xffffu
#endif
#ifndef REP_MASK
#define REP_MASK 0
#endif
#ifndef MK_N_LAUNCHES
#define MK_N_LAUNCHES 1
#endif

constexpr int D = 2048, TP = 8192, TS = 1024, T = TP + TS, SEQ = 4096, NH = 16, HD = 128, FF = 5632;
constexpr int NQKV = 3 * D, NWIN = 4 * D, NUP = 2 * FF;
constexpr int SROWS = 544;
constexpr float EPS = 1e-6f;
constexpr int NWAVES = 8, NTHR = 512;
constexpr int LDS_BYTES = 147456;

constexpr size_t MiB = 1u << 20;
constexpr size_t WS_WINA = 0, WS_WOA = 32 * MiB, WS_WQKV = 40 * MiB, WS_WOB = 64 * MiB, WS_FIN0 = 72 * MiB, WS_FIN1 = 116 * MiB, WS_FDN0 = 160 * MiB, WS_FDN1 = 182 * MiB;
constexpr size_t WS_LB = 204 * MiB, WS_HB = 205 * MiB, WS_QB = 241 * MiB, WS_MIX = 277 * MiB;
constexpr size_t WS_LOGF = WS_MIX, WS_VB = WS_MIX + 72 * MiB, WS_SG = WS_MIX + 108 * MiB, WS_OI = WS_MIX + 144 * MiB, WS_LOCAL = WS_MIX + 216 * MiB, WS_DEC = WS_MIX + 376 * MiB;
constexpr size_t WS_QKV = WS_MIX, WS_KN = WS_MIX + 108 * MiB, WS_KS = WS_MIX + 140 * MiB, WS_VT = WS_MIX + 208 * MiB, WS_VTS = WS_MIX + 240 * MiB;
constexpr size_t WS_UP = WS_MIX, WS_ACT = WS_MIX + 198 * MiB;
constexpr size_t WS_PART = WS_MIX + 300 * MiB;
constexpr size_t WS_BAR = WS_LB + 64 * 1024;
constexpr size_t WS_END = WS_MIX + 378 * MiB;

constexpr size_t O_YP = 0, O_YS = O_YP + (size_t)TP * D, O_SP = O_YS + (size_t)TS * D, O_SS = O_SP + 2 * 16 * 128 * 128, O_KP = O_SS + 32 * 16 * 128 * 128,
                 O_VP = O_KP + 2 * 512 * 2048, O_KSM = O_VP + 2 * 512 * 2048, O_VSM = O_KSM + 32 * 32 * 2048, O_CP = O_VSM + 32 * 32 * 2048, O_CS = O_CP + 2 * 2 * 2 * FF,
                 O_END = O_CS + 2 * 32 * 2 * FF;

struct Params {
    const float* x_prompt; const float* x_sample; const float* state_a_S; const float* cache_k; const float* cache_v; const float* conv_state;
    const float* norm_mix; const float* norm_ffn; const float* a_w_in; const float* a_gamma; const float* a_norm_o; const float* a_w_o;
    const float* b_w_qkv; const float* b_q_norm; const float* b_k_norm; const float* b_rel_bias; const float* b_w_o;
    const float* f_w_in; const float* f_conv_w; const float* f_conv_b; const float* f_w_down;
    float* out; unsigned char* ws; int ph_lo, ph_hi;
};

DI unsigned pk2(float lo, float hi) { f32x2 v = {lo, hi}; return __builtin_bit_cast(unsigned, __builtin_convertvector(v, bf16x2_t)); }
DI bf16 f2bf(float f) { return (bf16)(pk2(f, 0.f) & 0xffffu); }
DI float bflo(unsigned p) { return __uint_as_float(p << 16); }
DI float bfhi(unsigned p) { return __uint_as_float(p & 0xffff0000u); }
DI float wave_sum(float v) {
#pragma unroll
    for (int o = 1; o < 64; o <<= 1) v += __shfl_xor(v, o);
    return v;
}
DI float fsigmoid(float z) { return 1.f / (1.f + __expf(-z)); }
DI float fsilu(float z) { return z / (1.f + __expf(-z)); }
DI int crow(int reg, int h) { return (reg & 3) + 8 * (reg >> 2) + 4 * h; }
#define MFMA32(a, b, c) __builtin_amdgcn_mfma_f32_32x32x16_bf16((a), (b), (c), 0, 0, 0)

namespace pg8 {
constexpr int BM = 256, BK = 64, HALF = 128, HTB = HALF * BK * 2, STAGE_BYTES = 8 * HTB, NXCD = 8, WGM = 8;
DI int lds_byte(int r, int c) { const int st = (r >> 4) * 2 + (c >> 5), rr = r & 15, cc = c & 31, ob = rr * 64 + cc * 2; return st * 1024 + (ob ^ (((ob >> 9) & 1) << 5)); }
DI void stage_rc(int b, int& R, int& C) { const int st = b / 1024, sb = b % 1024, swz = sb ^ (((sb >> 9) & 1) << 5); R = (st >> 1) * 16 + swz / 64; C = (st & 1) * 32 + (swz % 64) / 2; }
DI int perm32(int rho) { const int n = rho >> 4, i = rho & 15; return 8 * (i >> 2) + 4 * n + (i & 3); }
struct Unit { int pm, pn, kb0, nkt, slice; };
struct Gemm { const bf16* A; const bf16* Bt; int M, N, K; };
struct StaticOrder {
    int nM, nN, nwg, G, c, tail, nblk, nitems;
    DI void init(int M, int N, int K, int G_, int c_, int tail_) { tail = tail_; nM = tail ? TP / BM : M / BM; nN = N / BM; nwg = nM * nN; G = G_; c = c_; nblk = K / 128; nitems = nwg + (tail ? 256 : 0); }
    DI bool next(int i, Unit& u) const {
        const long L = (long)i * G + c; if (L >= nitems) return false;
        u.slice = -1; u.kb0 = 0; u.nkt = nblk * 2;
        if (L >= nwg) { const int j = (int)L - nwg, uu = j & 31; u.slice = j >> 5; u.pm = TP / BM + (uu >> 3); u.pn = uu & 7;
            const int base = nblk / 8, rem = nblk % 8; u.kb0 = u.slice * base + (u.slice < rem ? u.slice : rem); u.nkt = 2 * (base + (u.slice < rem ? 1 : 0)); return true; }
        int wgid = (int)L; { const int q = nwg / NXCD, r = nwg % NXCD, xcd = wgid % NXCD, off = wgid / NXCD; wgid = (xcd < r ? xcd * (q + 1) : r * (q + 1) + (xcd - r) * q) + off; }
        const int nig = WGM * nN, gid = wgid / nig, fm = gid * WGM, gsz = (nM - fm) < WGM ? (nM - fm) : WGM;
        u.pm = fm + ((wgid % nig) % gsz); u.pn = (wgid % nig) / gsz; return true;
    }
};

struct Epi {
    int mode;
    int ldo;
    bf16* ob;
    float* of; const float* resP; const float* resS;
    const float* lb; float* logf; unsigned char* wsb;
    float* part;
    DI bool perm() const { return mode != 2; }
    DI void operator()(const f32x4 (&acc)[2][2][4][2], const Unit& u, int wr, int wc, int fr, int fq) const {
        const int row0 = u.pm * BM + wr * 64 + fr;
        if (mode == 2 && u.slice >= 0) {
            const int col0 = u.pn * BM + wc * 32 + 4 * fq;
#pragma unroll
            for (int ai = 0; ai < 2; ++ai)
#pragma unroll
                for (int m = 0; m < 4; ++m) {
                    float* op = part + ((size_t)u.slice * TS + (row0 + ai * HALF + m * 16 - TP)) * D + col0;
#pragma unroll
                    for (int bj = 0; bj < 2; ++bj)
#pragma unroll
                        for (int n = 0; n < 2; ++n) *(f32x4*)(op + bj * HALF + n * 16) = acc[ai][bj][m][n];
                }
        } else if (mode == 2) {
            const int col0 = u.pn * BM + wc * 32 + 4 * fq;
#pragma unroll
            for (int ai = 0; ai < 2; ++ai) {
                f32x4 rr[4][2][2];
#pragma unroll
                for (int m = 0; m < 4; ++m) {
                    const int row = row0 + ai * HALF + m * 16;
                    const float* rp = (row < TP ? resP + (size_t)row * D : resS + (size_t)(row - TP) * D) + col0;
#pragma unroll
                    for (int bj = 0; bj < 2; ++bj)
#pragma unroll
                        for (int n = 0; n < 2; ++n) rr[m][bj][n] = *(const f32x4*)(rp + bj * HALF + n * 16);
                }
#pragma unroll
                for (int m = 0; m < 4; ++m) {
                    float* op = of + (size_t)(row0 + ai * HALF + m * 16) * D + col0;
#pragma unroll
                    for (int bj = 0; bj < 2; ++bj)
#pragma unroll
                        for (int n = 0; n < 2; ++n) *(f32x4*)(op + bj * HALF + n * 16) = rr[m][bj][n] + acc[ai][bj][m][n];
                }
            }
        } else if (mode == 1) {
            const int col0 = u.pn * BM + wc * 32 + 8 * fq;
#pragma unroll
            for (int ai = 0; ai < 2; ++ai)
#pragma unroll
                for (int m = 0; m < 4; ++m) {
                    bf16* op = ob + (size_t)(row0 + ai * HALF + m * 16) * ldo + col0;
#pragma unroll
                    for (int bj = 0; bj < 2; ++bj) { const f32x4 v0 = acc[ai][bj][m][0], v1 = acc[ai][bj][m][1];
                        u32x4 o; o.x = pk2(v0.x, v0.y); o.y = pk2(v0.z, v0.w); o.z = pk2(v1.x, v1.y); o.w = pk2(v1.z, v1.w);
                        *(u32x4*)(op + bj * HALF) = o; }
                }
        } else {
            const int type = u.pn >> 3, col0 = (u.pn & 7) * BM + wc * 32 + 8 * fq;
#pragma unroll
            for (int bj = 0; bj < 2; ++bj) {
                const int col = col0 + bj * HALF;
                f32x4 l0 = {0.f, 0.f, 0.f, 0.f}, l1 = l0;
                if (type == 1) { l0 = *(const f32x4*)(lb + col); l1 = *(const f32x4*)(lb + col + 4); }
#pragma unroll
                for (int ai = 0; ai < 2; ++ai)
#pragma unroll
                    for (int m = 0; m < 4; ++m) {
                        const size_t off = (size_t)(row0 + ai * HALF + m * 16) * D + col;
                        f32x4 v0 = acc[ai][bj][m][0], v1 = acc[ai][bj][m][1];
                        if (type == 1) {
#pragma unroll
                            for (int e = 0; e < 4; ++e) { v0[e] = __logf(l0[e] + (1.f - l0[e]) * fsigmoid(v0[e])); v1[e] = __logf(l1[e] + (1.f - l1[e]) * fsigmoid(v1[e])); }
                            *(f32x4*)(logf + off) = v0; *(f32x4*)(logf + off + 4) = v1;
                        } else {
                            if (type == 3) {
#pragma unroll
                                for (int e = 0; e < 4; ++e) { v0[e] = fsilu(v0[e]); v1[e] = fsilu(v1[e]); }
                            }
                            u32x4 o; o.x = pk2(v0.x, v0.y); o.y = pk2(v0.z, v0.w); o.z = pk2(v1.x, v1.y); o.w = pk2(v1.z, v1.w);
                            bf16* dst = (bf16*)(wsb + (type == 0 ? WS_QB : (type == 2 ? WS_VB : WS_SG)));
                            *(u32x4*)(dst + off) = o;
                        }
                    }
            }
        }
    }
};

DI void gemm_phase(LAS unsigned char* lds, const Gemm g, const StaticOrder& S, const Epi& E, const int tid) {
    const int wid = __builtin_amdgcn_readfirstlane(tid >> 6), lane = tid & 63, wr = wid >> 2, wc = wid & 3, fr = lane & 15, fq = lane >> 4;
    const int K = g.K;
    const bool PERM = E.perm();
    unsigned voffA[2], voffB[2];
#pragma unroll
    for (int i = 0; i < 2; ++i) { int R, C; stage_rc(tid * 16 + i * 8192, R, C); const int Rb = PERM ? ((R & ~31) + perm32(R & 31)) : R;
        voffA[i] = (unsigned)(R * K + C) * 2u; voffB[i] = (unsigned)(Rb * K + C) * 2u; }
    const size_t kstep = (size_t)(BK * 2);
    const size_t hstep = (size_t)HALF * K * 2;
    const size_t tstep = 2 * hstep;
    const unsigned ldsw = (unsigned)wid * 1024u;
    const int aoff = lds_byte(wr * 64 + fr, fq * 8), boff = lds_byte(wc * 32 + fr, fq * 8);
#define PG8_SA(b, h) (((b) * 2 + (h)) * HTB)
#define PG8_SB(b, h) ((4 + (b) * 2 + (h)) * HTB)
#define PG8_STAGE(bufoff, gbase, voff) do { _Pragma("unroll") for (int _i = 0; _i < 2; ++_i) \
        __builtin_amdgcn_global_load_lds((const unsigned*)((const char*)(gbase) + (voff)[_i]), (LAS unsigned*)(lds + (bufoff) + ldsw + _i * 8192), 16, 0, 0); } while (0)
#define PG8_LDA(dst, b, h) do { _Pragma("unroll") for (int m = 0; m < 4; ++m) _Pragma("unroll") for (int k = 0; k < 2; ++k) dst[m][k] = *(const LAS bf16x8*)(lds + PG8_SA(b, h) + aoff + m * 2048 + k * 1024); } while (0)
#define PG8_LDB(dst, b, h) do { _Pragma("unroll") for (int n = 0; n < 2; ++n) _Pragma("unroll") for (int k = 0; k < 2; ++k) dst[n][k] = *(const LAS bf16x8*)(lds + PG8_SB(b, h) + boff + n * 2048 + k * 1024); } while (0)
#define PG8_MMA(ai, bj, At, Bt) do { __builtin_amdgcn_s_setprio(1); _Pragma("unroll") for (int m = 0; m < 4; ++m) _Pragma("unroll") for (int n = 0; n < 2; ++n) _Pragma("unroll") for (int k = 0; k < 2; ++k) \
        acc[ai][bj][m][n] = __builtin_amdgcn_mfma_f32_16x16x32_bf16(Bt[n][k], At[m][k], acc[ai][bj][m][n], 0, 0, 0); __builtin_amdgcn_s_setprio(0); } while (0)
#define PG8_WAIT_V(n) asm volatile("s_waitcnt vmcnt(" #n ")" ::: "memory")
#define PG8_WAIT_L(n) asm volatile("s_waitcnt lgkmcnt(" #n ")" ::: "memory")
#define PG8_BAR __builtin_amdgcn_s_barrier()
#define PG8_SCHED __builtin_amdgcn_sched_barrier(0)
    Unit cur, nxt; int ui = 0;
    if (!S.next(0, cur)) return;
    f32x4 acc[2][2][4][2];
#pragma unroll
    for (int a = 0; a < 2; ++a)
#pragma unroll
        for (int b = 0; b < 2; ++b)
#pragma unroll
            for (int m = 0; m < 4; ++m)
#pragma unroll
                for (int n = 0; n < 2; ++n) acc[a][b][m][n] = (f32x4){0.f, 0.f, 0.f, 0.f};
    bf16x8 At[4][2], B0[2][2], B1[2][2];
    const char* cA = (const char*)g.A + (size_t)cur.pm * tstep + (size_t)cur.kb0 * 256; const char* cB = (const char*)g.Bt + (size_t)cur.pn * tstep + (size_t)cur.kb0 * 256;
    PG8_STAGE(PG8_SB(0, 0), cB, voffB); PG8_STAGE(PG8_SA(0, 0), cA, voffA); PG8_STAGE(PG8_SB(0, 1), cB + hstep, voffB); PG8_STAGE(PG8_SA(0, 1), cA + hstep, voffA);
    if (wr == 1) PG8_BAR;
    PG8_WAIT_V(4); PG8_BAR;
    PG8_STAGE(PG8_SB(1, 0), cB + kstep, voffB); PG8_STAGE(PG8_SA(1, 0), cA + kstep, voffA); PG8_STAGE(PG8_SB(1, 1), cB + hstep + kstep, voffB);
    PG8_WAIT_V(6); PG8_BAR;
    for (;;) {
        const bool has_next = S.next(ui + 1, nxt);
        const char* nA = has_next ? (const char*)g.A + (size_t)nxt.pm * tstep + (size_t)nxt.kb0 * 256 : cA; const char* nB = has_next ? (const char*)g.Bt + (size_t)nxt.pn * tstep + (size_t)nxt.kb0 * 256 : cB;
        const int nt = cur.nkt;
        for (int t = 0; t < nt; t += 2) {
            const bool last = (t == nt - 2);
            const char* a1 = cA + (size_t)(t + 1) * kstep;
            const char* a2 = last ? nA : cA + (size_t)(t + 2) * kstep; const char* b2 = last ? nB : cB + (size_t)(t + 2) * kstep;
            const char* a3 = a2 + kstep; const char* b3 = b2 + kstep;
            PG8_LDB(B0, 0, 0); PG8_SCHED; PG8_LDA(At, 0, 0); PG8_STAGE(PG8_SA(1, 1), a1 + hstep, voffA);
            PG8_WAIT_L(8); PG8_BAR; PG8_WAIT_L(0); PG8_MMA(0, 0, At, B0); PG8_BAR; PG8_SCHED;
            PG8_LDB(B1, 0, 1); PG8_STAGE(PG8_SB(0, 0), b2, voffB);
            PG8_BAR; PG8_WAIT_L(0); PG8_MMA(0, 1, At, B1); PG8_BAR;
            PG8_LDA(At, 0, 1); PG8_STAGE(PG8_SA(0, 0), a2, voffA);
            PG8_BAR; PG8_WAIT_L(0); PG8_MMA(1, 0, At, B0); PG8_BAR; PG8_SCHED;
            PG8_STAGE(PG8_SB(0, 1), b2 + hstep, voffB);
            PG8_WAIT_V(6); PG8_BAR; PG8_MMA(1, 1, At, B1); PG8_BAR;
            PG8_LDB(B0, 1, 0); PG8_SCHED; PG8_LDA(At, 1, 0); PG8_STAGE(PG8_SA(0, 1), a2 + hstep, voffA);
            PG8_WAIT_L(8); PG8_BAR; PG8_WAIT_L(0); PG8_MMA(0, 0, At, B0); PG8_BAR; PG8_SCHED;
            PG8_LDB(B1, 1, 1); PG8_STAGE(PG8_SB(1, 0), b3, voffB);
            PG8_BAR; PG8_WAIT_L(0); PG8_MMA(0, 1, At, B1); PG8_BAR;
            PG8_LDA(At, 1, 1); PG8_STAGE(PG8_SA(1, 0), a3, voffA);
            PG8_BAR; PG8_WAIT_L(0); PG8_MMA(1, 0, At, B0); PG8_BAR; PG8_SCHED;
            PG8_STAGE(PG8_SB(1, 1), b3 + hstep, voffB);
            PG8_WAIT_V(6); PG8_BAR; PG8_MMA(1, 1, At, B1); PG8_BAR;
        }
        E(acc, cur, wr, wc, fr, fq);
        if (!has_next) break;
#pragma unroll
        for (int a = 0; a < 2; ++a)
#pragma unroll
            for (int b = 0; b < 2; ++b)
#pragma unroll
                for (int m = 0; m < 4; ++m)
#pragma unroll
                    for (int n = 0; n < 2; ++n) acc[a][b][m][n] = (f32x4){0.f, 0.f, 0.f, 0.f};
        cur = nxt; cA = nA; cB = nB; ++ui;
    }
    PG8_WAIT_V(0);
    if (wr == 0) PG8_BAR;
    PG8_BAR;
#undef PG8_SA
#undef PG8_SB
#undef PG8_STAGE
#undef PG8_LDA
#undef PG8_LDB
#undef PG8_MMA
#undef PG8_WAIT_V
#undef PG8_WAIT_L
#undef PG8_BAR
#undef PG8_SCHED
}
}

struct Frame {
    Params p; LAS unsigned char* lds; int tid, lane, wave, G, bid;
    bf16 *WinA, *WoA, *Wqkv, *WoB, *Fin0, *Fin1, *Fdn0, *Fdn1;
    float* LB; bf16 *HB, *QB;
    float* LOGF; bf16 *VB, *SG; float *OI, *LOCAL, *DEC;
    bf16 *QKV, *KN, *KS, *VT, *VTS, *UP, *ACT;
};

DI void transpose_item(const float* __restrict__ W, int K, int N, bf16* __restrict__ WT, LAS float* scr, int item, int lane) {
    const int nblk = N / 64, kb = item / nblk, nb = item % nblk, k0 = 64 * kb, n0 = 64 * nb;
    const int lr = lane >> 4, lc = (lane & 15) * 4;
    f32x4 v[16];
    const float* src = W + (size_t)(k0 + lr) * N + n0 + lc;
#pragma unroll
    for (int i = 0; i < 16; ++i) v[i] = *(const f32x4*)(src + (size_t)(4 * i) * N);
#pragma unroll
    for (int i = 0; i < 16; ++i) { LAS float* d = scr + (4 * i + lr) * 65 + lc; d[0] = v[i].x; d[1] = v[i].y; d[2] = v[i].z; d[3] = v[i].w; }
    asm volatile("s_waitcnt lgkmcnt(0)" ::: "memory");
    const int c = lane & 7;
#pragma unroll
    for (int j = 0; j < 8; ++j) { const int n = (lane >> 3) + 8 * j; const LAS float* s = scr + (8 * c) * 65 + n;
        u32x4 o; o.x = pk2(s[0 * 65], s[1 * 65]); o.y = pk2(s[2 * 65], s[3 * 65]); o.z = pk2(s[4 * 65], s[5 * 65]); o.w = pk2(s[6 * 65], s[7 * 65]);
        *(u32x4*)(WT + (size_t)(n0 + n) * K + k0 + 8 * c) = o; }
    asm volatile("s_waitcnt lgkmcnt(0)" ::: "memory");
}
DI void rms_row(const float* __restrict__ xrow, const float* __restrict__ g, bf16* __restrict__ orow, int lane, const float* __restrict__ part, float* __restrict__ xdst) {
    const f32x4* xr = (const f32x4*)xrow + lane; const f32x4* gr = (const f32x4*)g + lane;
    f32x4 v[8]; float s = 0.f;
#pragma unroll
    for (int j = 0; j < 8; ++j) v[j] = xr[64 * j];
    if (part) {
#pragma unroll
        for (int sl = 0; sl < 8; ++sl) { const f32x4* pr = (const f32x4*)(part + (size_t)sl * TS * D) + lane;
#pragma unroll
            for (int j = 0; j < 8; ++j) v[j] += pr[64 * j]; }
#pragma unroll
        for (int j = 0; j < 8; ++j) ((f32x4*)xdst + lane)[64 * j] = v[j];
    }
#pragma unroll
    for (int j = 0; j < 8; ++j) s += (v[j].x * v[j].x + v[j].y * v[j].y) + (v[j].z * v[j].z + v[j].w * v[j].w);
    const float rstd = rsqrtf(wave_sum(s) * (1.f / D) + EPS);
    u32x2* o8 = (u32x2*)orow + lane;
#pragma unroll
    for (int j = 0; j < 8; ++j) { const f32x4 gg = gr[64 * j]; u32x2 o; o.x = pk2(v[j].x * rstd * gg.x, v[j].y * rstd * gg.y); o.y = pk2(v[j].z * rstd * gg.z, v[j].w * rstd * gg.w); o8[64 * j] = o; }
}
DI void rms_phase(Frame& F, const float* srcP, const float* srcS, const float* g, const float* part, float* xs) {
    const int gw = F.bid * NWAVES + F.wave, NGW = F.G * NWAVES;
    for (int m = gw; m < T; m += NGW) {
        if (m < TP) rms_row(srcP + (size_t)m * D, g, F.HB + (size_t)m * D, F.lane, nullptr, nullptr);
        else rms_row(srcS + (size_t)(m - TP) * D, g, F.HB + (size_t)m * D, F.lane, part ? part + (size_t)(m - TP) * D : nullptr, xs + (size_t)(m - TP) * D);
    }
}
DI void fin_phase(Frame& F, float* xs, const float* part) {
    const int gt = F.bid * NTHR + F.tid, NGT = F.G * NTHR;
    for (int it = gt; it < TS * D / 4; it += NGT) {
        f32x4 v = ((const f32x4*)xs)[it];
#pragma unroll
        for (int sl = 0; sl < 8; ++sl) v += ((const f32x4*)(part + (size_t)sl * TS * D))[it];
        ((f32x4*)xs)[it] = v;
    }
}
DI void p0_phase(Frame& F) {
    const Params& p = F.p;
    LAS float* scr = (LAS float*)(F.lds + F.wave * 16640);
    const int gw = F.bid * NWAVES + F.wave, NGW = F.G * NWAVES;
    constexpr int I_WINA = (D / 64) * (NWIN / 64), I_WO = (D / 64) * (D / 64), I_QKV = (D / 64) * (NQKV / 64), I_FIN = (D / 64) * (NUP / 64), I_FDN = (FF / 64) * (D / 64);
    constexpr int NITEMS = I_WINA + 2 * I_WO + I_QKV + 2 * I_FIN + 2 * I_FDN;
    for (int it = gw; it < NITEMS; it += NGW) {
        int r = it;
        if (r < I_WINA) { transpose_item(p.a_w_in, D, NWIN, F.WinA, scr, r, F.lane); continue; } r -= I_WINA;
        if (r < I_WO) { transpose_item(p.a_w_o, D, D, F.WoA, scr, r, F.lane); continue; } r -= I_WO;
        if (r < I_QKV) { transpose_item(p.b_w_qkv, D, NQKV, F.Wqkv, scr, r, F.lane); continue; } r -= I_QKV;
        if (r < I_WO) { transpose_item(p.b_w_o, D, D, F.WoB, scr, r, F.lane); continue; } r -= I_WO;
        if (r < I_FIN) { transpose_item(p.f_w_in, D, NUP, F.Fin0, scr, r, F.lane); continue; } r -= I_FIN;
        if (r < I_FIN) { transpose_item(p.f_w_in + (size_t)D * NUP, D, NUP, F.Fin1, scr, r, F.lane); continue; } r -= I_FIN;
        if (r < I_FDN) { transpose_item(p.f_w_down, FF, D, F.Fdn0, scr, r, F.lane); continue; } r -= I_FDN;
        transpose_item(p.f_w_down + (size_t)FF * D, FF, D, F.Fdn1, scr, r, F.lane);
    }
    for (int c = F.bid * NTHR + F.tid; c < D; c += F.G * NTHR) {
        const float g0 = p.a_gamma[c], g1 = p.a_gamma[D + c], g2 = p.a_gamma[2 * D + c];
        const float mx = fmaxf(g0, fmaxf(g1, g2));
        const float e0 = __expf(g0 - mx), e1 = __expf(g1 - mx), e2 = __expf(g2 - mx);
        F.LB[c] = e0 / (e0 + e1 + e2);
    }
    rms_phase(F, p.x_prompt, p.x_sample, p.norm_mix, nullptr, nullptr);
}

constexpr int GLA_UNITS = 2048 + 512;
constexpr int QT_STRIDE = 136, TT_STRIDE = 72;
constexpr int L_BCUM = 0, L_QT = 32768, L_KT = L_QT + 64 * QT_STRIDE * 2, L_KHT = L_KT + 64 * QT_STRIDE * 2, L_VT = L_KHT + 128 * TT_STRIDE * 2, L_PM = L_VT + 128 * TT_STRIDE * 2, L_GLA_END = L_PM + 64 * TT_STRIDE * 2;
static_assert(L_GLA_END <= LDS_BYTES, "gla lds");

DI f32x16 mma_lds(const LAS bf16* A, int astride, int arow0, const LAS bf16* B, int bstride, int brow0, int nks, int lane) {
    f32x16 acc; for (int i = 0; i < 16; ++i) acc[i] = 0.f;
    const int r = lane & 31, hf = lane >> 5;
    const LAS bf16* ap = A + (arow0 + r) * astride + 8 * hf; const LAS bf16* bp = B + (brow0 + r) * bstride + 8 * hf;
    for (int ks = 0; ks < nks; ++ks) { const bf16x8 a = *(const LAS bf16x8*)(ap + 16 * ks), b = *(const LAS bf16x8*)(bp + 16 * ks); acc = MFMA32(a, b, acc); }
    return acc;
}

template <int BLK>
DI void gla_a_unit(Frame& F, int u, int row0, int h) {
    LAS float* bcum = (LAS float*)(F.lds + L_BCUM);
    LAS bf16* qt = (LAS bf16*)(F.lds + L_QT); LAS bf16* kt = (LAS bf16*)(F.lds + L_KT); LAS bf16* khT = (LAS bf16*)(F.lds + L_KHT);
    LAS bf16* vT = (LAS bf16*)(F.lds + L_VT); LAS bf16* Pm = (LAS bf16*)(F.lds + L_PM);
    const int tid = F.tid, lane = F.lane, w = F.wave;
    const size_t hoff = (size_t)h * HD;
    constexpr int SEG = BLK / 4;
    { const int seg = tid >> 7, kc = tid & 127; float a = 0.f;
      const float* lp = F.LOGF + (size_t)(row0 + seg * SEG) * D + hoff + kc;
#pragma unroll
      for (int t = 0; t < SEG; ++t) { a += lp[(size_t)t * D]; bcum[(seg * SEG + t) * 128 + kc] = a; }
      __syncthreads();
      float off = 0.f;
      for (int s = 0; s < seg; ++s) off += bcum[(s * SEG + SEG - 1) * 128 + kc];
      __syncthreads();
      if (seg > 0) {
#pragma unroll
          for (int t = 0; t < SEG; ++t) bcum[(seg * SEG + t) * 128 + kc] += off;
      }
      __syncthreads(); }
    for (int i = tid; i < BLK * 16; i += NTHR) {
        const int t = i >> 4, c0 = (i & 15) * 8;
        const size_t goff = (size_t)(row0 + t) * D + hoff + c0;
        const u32x4 qv = *(const u32x4*)(F.QB + goff);
        const u32x4 vv = *(const u32x4*)(F.VB + goff);
        const f32x4 lf0 = *(const f32x4*)(F.LOGF + goff), lf1 = *(const f32x4*)(F.LOGF + goff + 4);
        float q[8] = {bflo(qv.x), bfhi(qv.x), bflo(qv.y), bfhi(qv.y), bflo(qv.z), bfhi(qv.z), bflo(qv.w), bfhi(qv.w)};
        float lf[8] = {lf0.x, lf0.y, lf0.z, lf0.w, lf1.x, lf1.y, lf1.z, lf1.w};
        float qtv[8], ktv[8], qhv[8], khv[8];
#pragma unroll
        for (int e = 0; e < 8; ++e) {
            const float b = bcum[t * 128 + c0 + e], bmid = bcum[(BLK / 2 - 1) * 128 + c0 + e], bend = bcum[(BLK - 1) * 128 + c0 + e];
            const float kk = 1.f - __expf(lf[e]);
            qtv[e] = q[e] * __expf(b - bmid); ktv[e] = kk * __expf(bmid - b); qhv[e] = q[e] * __expf(b); khv[e] = kk * __expf(bend - b);
            if (t == BLK - 1) F.DEC[(size_t)u * 128 + c0 + e] = __expf(bend);
        }
        u32x4 o; o.x = pk2(qtv[0], qtv[1]); o.y = pk2(qtv[2], qtv[3]); o.z = pk2(qtv[4], qtv[5]); o.w = pk2(qtv[6], qtv[7]);
        *(LAS u32x4*)(qt + t * QT_STRIDE + c0) = o;
        o.x = pk2(ktv[0], ktv[1]); o.y = pk2(ktv[2], ktv[3]); o.z = pk2(ktv[4], ktv[5]); o.w = pk2(ktv[6], ktv[7]);
        *(LAS u32x4*)(kt + t * QT_STRIDE + c0) = o;
        o.x = pk2(qhv[0], qhv[1]); o.y = pk2(qhv[2], qhv[3]); o.z = pk2(qhv[4], qhv[5]); o.w = pk2(qhv[6], qhv[7]);
        *(u32x4*)(F.QB + goff) = o;
        const unsigned vw[4] = {vv.x, vv.y, vv.z, vv.w};
#pragma unroll
        for (int e = 0; e < 8; ++e) {
            khT[(c0 + e) * TT_STRIDE + t] = f2bf(khv[e]);
            vT[(c0 + e) * TT_STRIDE + t] = (bf16)((e & 1) ? (vw[e >> 1] >> 16) : (vw[e >> 1] & 0xffffu));
        }
    }
    __syncthreads();
    const int r = lane & 31, hf = lane >> 5;
#pragma unroll
    for (int q2 = 0; q2 < 2; ++q2) {
        const int tl = w * 2 + q2, mt = tl >> 2, nt = tl & 3;
        const f32x16 acc = mma_lds(khT, TT_STRIDE, 32 * mt, vT, TT_STRIDE, 32 * nt, BLK / 16, lane);
        float* lp = F.LOCAL + (size_t)u * 16384 + 32 * nt + r;
#pragma unroll
        for (int i = 0; i < 16; ++i) lp[(size_t)(32 * mt + crow(i, hf)) * 128] = acc[i];
    }
    constexpr int NT2 = BLK / 32;
    if (w < NT2 * NT2) {
        const int mt = w / NT2, nt = w % NT2;
        if (nt > mt) {
#pragma unroll
            for (int i = 0; i < 16; ++i) Pm[(32 * mt + crow(i, hf)) * TT_STRIDE + 32 * nt + r] = 0;
        } else {
            const f32x16 acc = mma_lds(qt, QT_STRIDE, 32 * mt, kt, QT_STRIDE, 32 * nt, 8, lane);
#pragma unroll
            for (int i = 0; i < 16; ++i) { const int t = 32 * mt + crow(i, hf), s = 32 * nt + r; Pm[t * TT_STRIDE + s] = (s <= t) ? f2bf(acc[i]) : (bf16)0; }
        }
    }
    __syncthreads();
    if (w < NT2 * 4) {
        const int mt = w >> 2, nt = w & 3;
        const f32x16 acc = mma_lds(Pm, TT_STRIDE, 32 * mt, vT, TT_STRIDE, 32 * nt, BLK / 16, lane);
        float* op = F.OI + (size_t)(row0 + 32 * mt) * D + hoff + 32 * nt + r;
#pragma unroll
        for (int i = 0; i < 16; ++i) op[(size_t)crow(i, hf) * D] = acc[i];
    }
    __syncthreads();
}
DI void gla_a_phase(Frame& F) {
    for (int u = F.bid; u < GLA_UNITS; u += F.G) {
        if (u < 2048) { const int b = u >> 10, h = (u >> 6) & 15, c = u & 63; gla_a_unit<64>(F, u, b * SEQ + c * 64, h); }
        else { const int su = u - 2048, b = su >> 4, h = su & 15; gla_a_unit<32>(F, u, TP + b * 32, h); }
    }
}
DI void scan_phase(Frame& F) {
    const int gt = F.bid * NTHR + F.tid, NGT = F.G * NTHR;
    for (int it = gt; it < 32 * 4096; it += NGT) {
        const int bh = it >> 12, e = (it & 4095) * 4, kc = e >> 7;
        f32x4 S = {0.f, 0.f, 0.f, 0.f};
        float* __restrict__ lp = F.LOCAL + (size_t)(bh * 64) * 16384 + e; const float* __restrict__ dp = F.DEC + (size_t)(bh * 64) * 128 + kc;
        for (int c0 = 0; c0 < 64; c0 += 8) {
            f32x4 loc[8]; float d[8];
#pragma unroll
            for (int j = 0; j < 8; ++j) { loc[j] = *(const f32x4*)(lp + (size_t)(c0 + j) * 16384); d[j] = dp[(c0 + j) * 128]; }
#pragma unroll
            for (int j = 0; j < 8; ++j) { *(f32x4*)(lp + (size_t)(c0 + j) * 16384) = S; S = S * d[j] + loc[j]; }
        }
        *(f32x4*)(F.p.out + O_SP + (size_t)bh * 16384 + e) = S;
    }
    for (int it0 = gt; it0 < 512 * 4096; it0 += 4 * NGT) {
        f32x4 S0[4], loc[4]; float d[4];
#pragma unroll
        for (int j = 0; j < 4; ++j) { const int it = it0 + j * NGT; if (it < 512 * 4096) { const int bh = it >> 12, e = (it & 4095) * 4, kc = e >> 7;
            S0[j] = *(const f32x4*)(F.p.state_a_S + (size_t)bh * 16384 + e); loc[j] = *(const f32x4*)(F.LOCAL + (size_t)(2048 + bh) * 16384 + e); d[j] = F.DEC[(size_t)(2048 + bh) * 128 + kc]; } }
#pragma unroll
        for (int j = 0; j < 4; ++j) { const int it = it0 + j * NGT; if (it < 512 * 4096) { const int bh = it >> 12, e = (it & 4095) * 4;
            *(f32x4*)(F.p.out + O_SS + (size_t)bh * 16384 + e) = S0[j] * d[j] + loc[j]; } }
    }
}
constexpr int OB_STRIDE = 132;
template <int BLK>
DI void gla_c_unit(Frame& F, const float* __restrict__ S, int row0, int h) {
    LAS float* ob = (LAS float*)F.lds;
    const int tid = F.tid, lane = F.lane, w = F.wave, r = lane & 31, hf = lane >> 5;
    const size_t hoff = (size_t)h * HD;
    if (w < (BLK / 32) * 4) {
        const int mt = w >> 2, nt = w & 3;
        f32x16 acc; for (int i = 0; i < 16; ++i) acc[i] = 0.f;
        const bf16* ap = F.QB + (size_t)(row0 + 32 * mt + r) * D + hoff + 8 * hf;
        const float* sp = S + (size_t)(8 * hf) * 128 + 32 * nt + r;
#pragma unroll
        for (int ks = 0; ks < 8; ++ks) {
            const bf16x8 a = *(const bf16x8*)(ap + 16 * ks);
            float sv[8];
#pragma unroll
            for (int e = 0; e < 8; ++e) sv[e] = sp[(size_t)(16 * ks + e) * 128];
            u32x4 bb; bb.x = pk2(sv[0], sv[1]); bb.y = pk2(sv[2], sv[3]); bb.z = pk2(sv[4], sv[5]); bb.w = pk2(sv[6], sv[7]);
            acc = MFMA32(a, __builtin_bit_cast(bf16x8, bb), acc);
        }
        const float* oi = F.OI + (size_t)(row0 + 32 * mt) * D + hoff + 32 * nt + r;
#pragma unroll
        for (int i = 0; i < 16; ++i) { const int t = crow(i, hf); ob[(32 * mt + t) * OB_STRIDE + 32 * nt + r] = acc[i] + oi[(size_t)t * D]; }
    }
    __syncthreads();
    {
        constexpr int TPR = NTHR / BLK;
        constexpr int CPT = 128 / TPR;
        const int t = tid / TPR, j = tid % TPR, c0 = j * CPT;
        float v[CPT]; float ss = 0.f;
#pragma unroll
        for (int e = 0; e < CPT; ++e) { v[e] = ob[t * OB_STRIDE + c0 + e]; ss += v[e] * v[e]; }
#pragma unroll
        for (int o = 1; o < TPR; o <<= 1) ss += __shfl_xor(ss, o);
        const float rstd = rsqrtf(ss * (1.f / HD) + EPS);
        const size_t goff = (size_t)(row0 + t) * D + hoff + c0;
#pragma unroll
        for (int e8 = 0; e8 < CPT / 8; ++e8) {
            const u32x4 sg = *(const u32x4*)(F.SG + goff + 8 * e8);
            const f32x4 n0 = *(const f32x4*)(F.p.a_norm_o + c0 + 8 * e8), n1 = *(const f32x4*)(F.p.a_norm_o + c0 + 8 * e8 + 4);
            const float* vv = v + 8 * e8;
            u32x4 o;
            o.x = pk2(vv[0] * rstd * n0.x * bflo(sg.x), vv[1] * rstd * n0.y * bfhi(sg.x));
            o.y = pk2(vv[2] * rstd * n0.z * bflo(sg.y), vv[3] * rstd * n0.w * bfhi(sg.y));
            o.z = pk2(vv[4] * rstd * n1.x * bflo(sg.z), vv[5] * rstd * n1.y * bfhi(sg.z));
            o.w = pk2(vv[6] * rstd * n1.z * bflo(sg.w), vv[7] * rstd * n1.w * bfhi(sg.w));
            *(u32x4*)(F.HB + goff + 8 * e8) = o;
        }
    }
    __syncthreads();
}
DI void gla_c_phase(Frame& F) {
    for (int u = F.bid; u < GLA_UNITS; u += F.G) {
        if (u < 2048) { const int b = u >> 10, h = (u >> 6) & 15, c = u & 63; gla_c_unit<64>(F, F.LOCAL + (size_t)u * 16384, b * SEQ + c * 64, h); }
        else { const int su = u - 2048, b = su >> 4, h = su & 15; gla_c_unit<32>(F, F.p.state_a_S + (size_t)su * 16384, TP + b * 32, h); }
    }
}
DI void conv_phase(Frame& F, int layer) {
    const Params& p = F.p;
    const int gt = F.bid * NTHR + F.tid, NGT = F.G * NTHR;
    constexpr int NCG = FF / 8, NSEG = T / 32;
    const float* cw = p.f_conv_w + (size_t)layer * 3 * FF; const float* cb = p.f_conv_b + (size_t)layer * FF;
    for (int it = gt; it < NSEG * NCG; it += NGT) {
        const int seg = it / NCG, c0 = (it % NCG) * 8;
        const bool smp = seg >= 256; const int r0 = seg * 32;
        const bool first = smp || ((seg & 127) == 0), lastseg = smp || ((seg & 127) == 127);
        float w0[8], w1[8], w2[8], bb[8], um2[8], um1[8];
#pragma unroll
        for (int e = 0; e < 8; ++e) { w0[e] = cw[c0 + e]; w1[e] = cw[FF + c0 + e]; w2[e] = cw[2 * FF + c0 + e]; bb[e] = cb[c0 + e]; um2[e] = 0.f; um1[e] = 0.f; }
        if (first) {
            if (smp) { const float* st = p.conv_state + ((size_t)(layer * 32 + (seg - 256)) * 2) * FF + c0;
#pragma unroll
                for (int e = 0; e < 8; ++e) { um2[e] = st[e]; um1[e] = st[FF + e]; } }
        } else {
            const u32x4 a = *(const u32x4*)(F.UP + (size_t)(r0 - 2) * NUP + c0), b = *(const u32x4*)(F.UP + (size_t)(r0 - 1) * NUP + c0);
            um2[0] = bflo(a.x); um2[1] = bfhi(a.x); um2[2] = bflo(a.y); um2[3] = bfhi(a.y); um2[4] = bflo(a.z); um2[5] = bfhi(a.z); um2[6] = bflo(a.w); um2[7] = bfhi(a.w);
            um1[0] = bflo(b.x); um1[1] = bfhi(b.x); um1[2] = bflo(b.y); um1[3] = bfhi(b.y); um1[4] = bflo(b.z); um1[5] = bfhi(b.z); um1[6] = bflo(b.w); um1[7] = bfhi(b.w);
        }
        for (int t0 = 0; t0 < 32; t0 += 4) {
            u32x4 uu[4], gg[4];
#pragma unroll
            for (int j = 0; j < 4; ++j) { const size_t ro = (size_t)(r0 + t0 + j) * NUP + c0; uu[j] = *(const u32x4*)(F.UP + ro); gg[j] = *(const u32x4*)(F.UP + ro + FF); }
#pragma unroll
            for (int j = 0; j < 4; ++j) {
                const float uc[8] = {bflo(uu[j].x), bfhi(uu[j].x), bflo(uu[j].y), bfhi(uu[j].y), bflo(uu[j].z), bfhi(uu[j].z), bflo(uu[j].w), bfhi(uu[j].w)};
                const float gc[8] = {bflo(gg[j].x), bfhi(gg[j].x), bflo(gg[j].y), bfhi(gg[j].y), bflo(gg[j].z), bfhi(gg[j].z), bflo(gg[j].w), bfhi(gg[j].w)};
                float a[8];
#pragma unroll
                for (int e = 0; e < 8; ++e) { const float c = bb[e] + um2[e] * w0[e] + um1[e] * w1[e] + uc[e] * w2[e]; a[e] = fsilu(c) * gc[e]; um2[e] = um1[e]; um1[e] = uc[e]; }
                u32x4 o; o.x = pk2(a[0], a[1]); o.y = pk2(a[2], a[3]); o.z = pk2(a[4], a[5]); o.w = pk2(a[6], a[7]);
                *(u32x4*)(F.ACT + (size_t)(r0 + t0 + j) * FF + c0) = o;
            }
        }
        if (lastseg) {
            float* dst = smp ? p.out + O_CS + ((size_t)(layer * 32 + (seg - 256)) * 2) * FF + c0 : p.out + O_CP + ((size_t)(layer * 2 + (seg >> 7)) * 2) * FF + c0;
#pragma unroll
            for (int e = 0; e < 8; ++e) { dst[e] = um2[e]; dst[FF + e] = um1[e]; }
        }
    }
}
DI void prep_phase(Frame& F) {
    const Params& p = F.p;
    const int gw = F.bid * NWAVES + F.wave, NGW = F.G * NWAVES, lane = F.lane;
    const float qscale = 0.08838834764831845f * 1.4426950408889634f;
    for (int m = gw; m < T; m += NGW) {
        const bf16* src = F.QKV + (size_t)m * NQKV + lane * 8;
        const bool smp = m >= TP; const int b = smp ? (m - TP) >> 5 : m >> 12, t = smp ? (m - TP) & 31 : m & 4095;
        const int hc = (lane & 15) * 8;
        u32x4 xq[4], xk[4], xv[4];
#pragma unroll
        for (int j = 0; j < 4; ++j) { xq[j] = *(const u32x4*)(src + j * 512); xk[j] = *(const u32x4*)(src + D + j * 512); xv[j] = *(const u32x4*)(src + 2 * D + j * 512); }
        float* ko = nullptr; float* vo = nullptr;
        if (smp) { ko = p.out + O_KSM + (size_t)(m - TP) * D + lane * 8; vo = p.out + O_VSM + (size_t)(m - TP) * D + lane * 8; }
        else if (t >= SEQ - 512) { ko = p.out + O_KP + ((size_t)b * 512 + (t - (SEQ - 512))) * D + lane * 8; vo = p.out + O_VP + ((size_t)b * 512 + (t - (SEQ - 512))) * D + lane * 8; }
        const f32x4 gq0 = *(const f32x4*)(p.b_q_norm + hc), gq1 = *(const f32x4*)(p.b_q_norm + hc + 4);
        const f32x4 gk0 = *(const f32x4*)(p.b_k_norm + hc), gk1 = *(const f32x4*)(p.b_k_norm + hc + 4);
        bf16* qdst = F.QB + (size_t)m * D + lane * 8;
        bf16* kdst = smp ? F.KS + ((size_t)b * SROWS + 512 + t) * D + lane * 8 : F.KN + (size_t)m * D + lane * 8;
#pragma unroll
        for (int j = 0; j < 4; ++j) {
            { const u32x4 x = xq[j]; const float v[8] = {bflo(x.x), bfhi(x.x), bflo(x.y), bfhi(x.y), bflo(x.z), bfhi(x.z), bflo(x.w), bfhi(x.w)};
              float ss = 0.f;
#pragma unroll
              for (int e = 0; e < 8; ++e) ss += v[e] * v[e];
              ss += __shfl_xor(ss, 1); ss += __shfl_xor(ss, 2); ss += __shfl_xor(ss, 4); ss += __shfl_xor(ss, 8);
              const float rstd = rsqrtf(ss * (1.f / HD) + EPS) * qscale;
              u32x4 o; o.x = pk2(v[0] * rstd * gq0.x, v[1] * rstd * gq0.y); o.y = pk2(v[2] * rstd * gq0.z, v[3] * rstd * gq0.w);
              o.z = pk2(v[4] * rstd * gq1.x, v[5] * rstd * gq1.y); o.w = pk2(v[6] * rstd * gq1.z, v[7] * rstd * gq1.w);
              *(u32x4*)(qdst + j * 512) = o; }
            { const u32x4 x = xk[j]; const float v[8] = {bflo(x.x), bfhi(x.x), bflo(x.y), bfhi(x.y), bflo(x.z), bfhi(x.z), bflo(x.w), bfhi(x.w)};
              float ss = 0.f;
#pragma unroll
              for (int e = 0; e < 8; ++e) ss += v[e] * v[e];
              ss += __shfl_xor(ss, 1); ss += __shfl_xor(ss, 2); ss += __shfl_xor(ss, 4); ss += __shfl_xor(ss, 8);
              const float rstd = rsqrtf(ss * (1.f / HD) + EPS);
              const f32x4 a = {v[0] * rstd * gk0.x, v[1] * rstd * gk0.y, v[2] * rstd * gk0.z, v[3] * rstd * gk0.w};
              const f32x4 c = {v[4] * rstd * gk1.x, v[5] * rstd * gk1.y, v[6] * rstd * gk1.z, v[7] * rstd * gk1.w};
              u32x4 o; o.x = pk2(a.x, a.y); o.y = pk2(a.z, a.w); o.z = pk2(c.x, c.y); o.w = pk2(c.z, c.w);
              *(u32x4*)(kdst + j * 512) = o;
              if (ko) { *(f32x4*)(ko + j * 512) = a; *(f32x4*)(ko + j * 512 + 4) = c; } }
            if (vo) { const u32x4 x = xv[j];
              const f32x4 a = {bflo(x.x), bfhi(x.x), bflo(x.y), bfhi(x.y)}, c = {bflo(x.z), bfhi(x.z), bflo(x.w), bfhi(x.w)};
              *(f32x4*)(vo + j * 512) = a; *(f32x4*)(vo + j * 512 + 4) = c; }
        }
    }
    { const int gt = F.bid * NTHR + F.tid, NGT = F.G * NTHR;
      for (int it0 = gt; it0 < 32 * 512 * (D / 8); it0 += 4 * NGT) {
          f32x4 a[4], c[4];
#pragma unroll
          for (int j = 0; j < 4; ++j) { const int it = it0 + j * NGT; if (it < 32 * 512 * (D / 8)) { const int row = it >> 8, cc = (it & 255) * 8;
              a[j] = *(const f32x4*)(p.cache_k + (size_t)row * D + cc); c[j] = *(const f32x4*)(p.cache_k + (size_t)row * D + cc + 4); } }
#pragma unroll
          for (int j = 0; j < 4; ++j) { const int it = it0 + j * NGT; if (it < 32 * 512 * (D / 8)) { const int row = it >> 8, cc = (it & 255) * 8, b = row >> 9, jj = row & 511;
              u32x4 o; o.x = pk2(a[j].x, a[j].y); o.y = pk2(a[j].z, a[j].w); o.z = pk2(c[j].x, c[j].y); o.w = pk2(c[j].z, c[j].w);
              *(u32x4*)(F.KS + ((size_t)b * SROWS + jj) * D + cc) = o; } }
      } }
    { LAS bf16* tile = (LAS bf16*)(F.lds + F.wave * 16640);
      constexpr int NP = 2 * 64 * 16, NS = 32 * 16 * 9;
      for (int it = gw; it < NP + NS; it += NGW) {
          int nrows = 64; bf16* dst; int dstride;
          if (it < NP) {
              const int h = it & 15, tb = (it >> 4) & 63, b = it >> 10;
              const bf16* src = F.QKV + (size_t)(b * SEQ + tb * 64) * NQKV + 2 * D + h * HD + 2 * lane;
              unsigned u[64];
#pragma unroll
              for (int i = 0; i < 64; ++i) u[i] = *(const unsigned*)(src + (size_t)i * NQKV);
#pragma unroll
              for (int i = 0; i < 64; ++i) *(LAS unsigned*)(tile + i * 130 + 2 * lane) = u[i];
              dst = F.VT + ((size_t)(b * 16 + h) * HD) * SEQ + tb * 64; dstride = SEQ;
          } else {
              const int r = it - NP, h = r & 15, jb = (r >> 4) % 9, b = r / 144;
              if (jb < 8) {
                  const float* src = p.cache_v + ((size_t)(b * 512 + jb * 64) * NH + h) * HD + 2 * lane;
#pragma unroll
                  for (int hh = 0; hh < 2; ++hh) {
                      f32x2 x[32];
#pragma unroll
                      for (int i = 0; i < 32; ++i) x[i] = *(const f32x2*)(src + (size_t)(32 * hh + i) * D);
#pragma unroll
                      for (int i = 0; i < 32; ++i) *(LAS unsigned*)(tile + (32 * hh + i) * 130 + 2 * lane) = pk2(x[i].x, x[i].y);
                  }
              } else {
                  nrows = 32;
                  const bf16* src = F.QKV + (size_t)(TP + b * 32) * NQKV + 2 * D + h * HD + 2 * lane;
                  unsigned u[32];
#pragma unroll
                  for (int i = 0; i < 32; ++i) u[i] = *(const unsigned*)(src + (size_t)i * NQKV);
#pragma unroll
                  for (int i = 0; i < 32; ++i) *(LAS unsigned*)(tile + i * 130 + 2 * lane) = u[i];
              }
              dst = F.VTS + ((size_t)(b * 16 + h) * HD) * SROWS + jb * 64; dstride = SROWS;
          }
          asm volatile("s_waitcnt lgkmcnt(0)" ::: "memory");
          const int tp = lane & 31, dh = lane >> 5;
          if (2 * tp < nrows) {
#pragma unroll 8
              for (int pp = 0; pp < 64; ++pp) { const int dv = 2 * pp + dh;
                  const unsigned lo = tile[(2 * tp) * 130 + dv], hi = tile[(2 * tp + 1) * 130 + dv];
                  *(unsigned*)(dst + (size_t)dv * dstride + 2 * tp) = lo | (hi << 16); }
          }
          asm volatile("s_waitcnt lgkmcnt(0)" ::: "memory");
      } }
}
DI void attn_phase(Frame& F) {
    const Params& p = F.p;
    const int gw = F.bid * NWAVES + F.wave, NGW = F.G * NWAVES, lane = F.lane, r = lane & 31, hf = lane >> 5;
    constexpr float L2E = 1.4426950408889634f;
    for (int unit = gw; unit < 4096 + 512; unit += NGW) {
        int h, qrow0, nkt, rel0; const bf16* kbase; const bf16* vbase; int vstride;
        if (unit < 4096) {
            const int half = unit & 1, c = (unit >> 1) & 63, b = unit >> 11; h = (unit >> 7) & 15;
            const int c0 = c > 8 ? c - 8 : 0;
            qrow0 = b * SEQ + c * 64 + half * 32; nkt = 2 * (c - c0 + 1); rel0 = c0 * 64 - (c * 64 + half * 32);
            kbase = F.KN + (size_t)(b * SEQ + c0 * 64) * D + h * HD; vbase = F.VT + ((size_t)(b * 16 + h) * HD) * SEQ + c0 * 64; vstride = SEQ;
        } else {
            const int su = unit - 4096, b = su >> 4; h = su & 15;
            qrow0 = TP + b * 32; nkt = 17; rel0 = -512;
            kbase = F.KS + (size_t)(b * SROWS) * D + h * HD; vbase = F.VTS + ((size_t)(b * 16 + h) * HD) * SROWS; vstride = SROWS;
        }
        const float* bias = p.b_rel_bias + h;
        const float bias0 = bias[0] * L2E;
        bf16x8 qf[8];
        { const bf16* qp = F.QB + (size_t)(qrow0 + r) * D + h * HD + 8 * hf;
#pragma unroll
          for (int kk = 0; kk < 8; ++kk) qf[kk] = *(const bf16x8*)(qp + 16 * kk); }
        f32x16 oacc[4];
#pragma unroll
        for (int bl = 0; bl < 4; ++bl) for (int i = 0; i < 16; ++i) oacc[bl][i] = 0.f;
        float mrun = -1e30f, lsum = 0.f;
        bf16x8 kfc[8];
        { const bf16* kp = kbase + (size_t)r * D + 8 * hf;
#pragma unroll
          for (int kk = 0; kk < 8; ++kk) kfc[kk] = *(const bf16x8*)(kp + 16 * kk); }
        for (int kt = 0; kt < nkt; ++kt) {
            f32x16 s; for (int i = 0; i < 16; ++i) s[i] = 0.f;
            u32x2 vfr[2][4][2];
#pragma unroll
            for (int kb = 0; kb < 2; ++kb)
#pragma unroll
                for (int bl = 0; bl < 4; ++bl) { const bf16* vp = vbase + (size_t)(32 * bl + r) * vstride + 32 * kt + 16 * kb + 4 * hf;
                    vfr[kb][bl][0] = *(const u32x2*)vp; vfr[kb][bl][1] = *(const u32x2*)(vp + 8); }
            bf16x8 kfn[8];
            { const int ktn = (kt + 1 < nkt) ? kt + 1 : kt;
              const bf16* kp = kbase + (size_t)(32 * ktn + r) * D + 8 * hf;
#pragma unroll
              for (int kk = 0; kk < 8; ++kk) kfn[kk] = *(const bf16x8*)(kp + 16 * kk); }
#pragma unroll
            for (int kk = 0; kk < 8; ++kk) s = MFMA32(kfc[kk], qf[kk], s);
#pragma unroll
            for (int kk = 0; kk < 8; ++kk) kfc[kk] = kfn[kk];
            const int relb = rel0 + 32 * kt - r;
            if (relb + 31 <= -128) {
#pragma unroll
                for (int i = 0; i < 16; ++i) s[i] += bias0;
            } else {
#pragma unroll
                for (int i = 0; i < 16; ++i) { int rel = relb + crow(i, hf); rel = rel < -128 ? -128 : (rel > 63 ? 63 : rel); s[i] += bias[(rel + 128) * NH] * L2E; }
            }
            float mt = s[0];
#pragma unroll
            for (int i = 1; i < 16; ++i) mt = fmaxf(mt, s[i]);
            mt = fmaxf(mt, __shfl_xor(mt, 32));
            const float mnew = fmaxf(mrun, mt), alpha = exp2f(mrun - mnew);
            mrun = mnew;
            float ps = 0.f; float pv[16];
#pragma unroll
            for (int i = 0; i < 16; ++i) { pv[i] = exp2f(s[i] - mnew); ps += pv[i]; }
            lsum = lsum * alpha + ps;
#pragma unroll
            for (int bl = 0; bl < 4; ++bl)
#pragma unroll
                for (int i = 0; i < 16; ++i) oacc[bl][i] *= alpha;
#pragma unroll
            for (int kb = 0; kb < 2; ++kb) {
                u32x4 pb; pb.x = pk2(pv[8 * kb], pv[8 * kb + 1]); pb.y = pk2(pv[8 * kb + 2], pv[8 * kb + 3]); pb.z = pk2(pv[8 * kb + 4], pv[8 * kb + 5]); pb.w = pk2(pv[8 * kb + 6], pv[8 * kb + 7]);
                const bf16x8 pfr = __builtin_bit_cast(bf16x8, pb);
#pragma unroll
                for (int bl = 0; bl < 4; ++bl) {
                    const u32x2 v0 = vfr[kb][bl][0], v1 = vfr[kb][bl][1];
                    u32x4 vv; vv.x = v0.x; vv.y = v0.y; vv.z = v1.x; vv.w = v1.y;
                    oacc[bl] = MFMA32(__builtin_bit_cast(bf16x8, vv), pfr, oacc[bl]);
                }
            }
        }
        lsum += __shfl_xor(lsum, 32);
        const float inv = 1.f / lsum;
        bf16* op = F.HB + (size_t)(qrow0 + r) * D + h * HD;
#pragma unroll
        for (int bl = 0; bl < 4; ++bl)
#pragma unroll
            for (int g4 = 0; g4 < 4; ++g4) {
                u32x2 o; o.x = pk2(oacc[bl][4 * g4] * inv, oacc[bl][4 * g4 + 1] * inv); o.y = pk2(oacc[bl][4 * g4 + 2] * inv, oacc[bl][4 * g4 + 3] * inv);
                *(u32x2*)(op + 32 * bl + 8 * g4 + 4 * hf) = o;
            }
    }
}


#define XB_TMO      128
#define XB_XCNT(j)  (256  + 64 * (j))
#define XB_XSUB(j)  (1280 + 64 * (j))
#define XB_XGEN(j)  (2304 + 64 * (j))
#define XB_TOP      3328
#define XB_TOPGEN   3392
#define XCD_BAR_WORDS 3456
#define XB_SPIN_CAP (1u << 18)
DI unsigned xb_ld(unsigned* p)              { return __hip_atomic_load(p, __ATOMIC_RELAXED, __HIP_MEMORY_SCOPE_AGENT); }
DI unsigned xb_add(unsigned* p, unsigned v) { return __hip_atomic_fetch_add(p, v, __ATOMIC_RELAXED, __HIP_MEMORY_SCOPE_AGENT); }
DI unsigned xb_xcc_id() { return (unsigned)__builtin_amdgcn_s_getreg((3 << 11) | 20) & 0xFu; }
#define XB_SPIN(cond, bar) do { unsigned _sp = 0; while (cond) { __builtin_amdgcn_s_sleep(1); \
    if ((++_sp & 255u) == 0u) { if (xb_ld(&(bar)[XB_TMO])) break; if (_sp > XB_SPIN_CAP) { atomicAdd(&(bar)[XB_TMO], 1u); break; } } } } while (0)
struct XcdBarrier { unsigned* bar; unsigned x; volatile LAS unsigned* st; };
DI XcdBarrier xcd_barrier_post(unsigned* bar, volatile LAS unsigned* st) {
    XcdBarrier b; b.bar = bar; b.x = xb_xcc_id(); b.st = st;
    if (threadIdx.x == 0) (void)xb_add(&bar[XB_XCNT(b.x)], 1u);
    return b;
}
DI void xcd_barrier_complete(unsigned* bar, unsigned x, unsigned& nloc, unsigned& nx) {
    const unsigned G = gridDim.x * gridDim.y * gridDim.z;
    unsigned sum, cnt, mine, sp = 0u;
    for (;;) {
        sum = 0u; cnt = 0u; mine = 0u;
#pragma unroll
        for (unsigned j = 0; j < 16; ++j) { const unsigned c = xb_ld(&bar[XB_XCNT(j)]); sum += c; cnt += (c > 0u) ? 1u : 0u; mine = (j == x) ? c : mine; }
        if (sum == G) break;
        __builtin_amdgcn_s_sleep(1);
        if ((++sp & 255u) == 0u) { if (xb_ld(&bar[XB_TMO])) break; if (sp > XB_SPIN_CAP) { atomicAdd(&bar[XB_TMO], 1u); break; } }
    }
    nloc = mine > 0u ? mine : 1u; nx = cnt > 0u ? cnt : 1u;
}
DI void xcd_barrier(const XcdBarrier& b) {
    asm volatile("s_waitcnt vmcnt(0)" ::: "memory");
    __syncthreads();
    if (threadIdx.x == 0) {
        unsigned* bar = b.bar;
        __builtin_amdgcn_s_waitcnt(0);
        unsigned nloc = b.st[0], nx = b.st[1];
        if (nloc == 0u) { xcd_barrier_complete(bar, b.x, nloc, nx); b.st[0] = nloc; b.st[1] = nx; }
        const unsigned old = xb_add(&bar[XB_XSUB(b.x)], 1u);
        const unsigned gen = old / nloc;
        if (old + 1u == (gen + 1u) * nloc) {
            __builtin_amdgcn_fence(__ATOMIC_RELEASE, "agent");
            asm volatile("s_waitcnt vmcnt(0)" ::: "memory");
            const unsigned og = xb_add(&bar[XB_TOP], 1u);
            const unsigned tg = og / nx;
            if (og + 1u == (tg + 1u) * nx) xb_add(&bar[XB_TOPGEN], 1u);
            else XB_SPIN(xb_ld(&bar[XB_TOPGEN]) == tg, bar);
            __builtin_amdgcn_fence(__ATOMIC_ACQUIRE, "agent");
            xb_add(&bar[XB_XGEN(b.x)], 1u);
            asm volatile("s_waitcnt vmcnt(0)" ::: "memory");
        } else {
            XB_SPIN(xb_ld(&bar[XB_XGEN(b.x)]) == gen, bar);
            __builtin_amdgcn_fence(__ATOMIC_ACQUIRE, "agent");
            asm volatile("s_waitcnt vmcnt(0)" ::: "memory");
        }
    }
    __syncthreads();
}

enum { PH_P0, PH_G1, PH_GLA_A, PH_SCAN, PH_GLA_C, PH_G2, PH_RMS_F0, PH_G3_0, PH_CONV0, PH_G4_0, PH_RMS_M1, PH_G5, PH_PREP, PH_ATTN, PH_G6, PH_RMS_F1, PH_G3_1, PH_CONV1, PH_G4_1, PH_FIN, NPH };

__global__ void __launch_bounds__(NTHR, 2) fwd_megakernel(Params prm) {
    extern __shared__ __attribute__((aligned(16))) unsigned char lds_raw[];
    cg::grid_group grid = cg::this_grid();
    float* const X0 = prm.out;
    volatile LAS unsigned* bst = (volatile LAS unsigned*)((LAS unsigned char*)lds_raw + (LDS_BYTES - 16));
    if (threadIdx.x < 4) bst[threadIdx.x] = 0u;
    __syncthreads();
    XcdBarrier xbar = xcd_barrier_post((unsigned*)(prm.ws + WS_BAR), bst);
    for (int ph = prm.ph_lo; ph < prm.ph_hi; ++ph) {
      for (int rep = 0, nrep = 1 + ((REP_MASK >> ph) & 1); rep < nrep; ++rep) {
        int tid_ = threadIdx.x; asm volatile("" : "+v"(tid_));
        size_t zoff = 0; asm volatile("" : "+s"(zoff));
        unsigned char* ws = prm.ws + zoff;
        float* X = X0 + zoff;
        Frame F;
        F.p = prm; F.lds = (LAS unsigned char*)lds_raw;
        F.tid = tid_; F.lane = F.tid & 63; F.wave = __builtin_amdgcn_readfirstlane(F.tid >> 6); F.G = gridDim.x; F.bid = blockIdx.x;
        F.WinA = (bf16*)(ws + WS_WINA); F.WoA = (bf16*)(ws + WS_WOA); F.Wqkv = (bf16*)(ws + WS_WQKV); F.WoB = (bf16*)(ws + WS_WOB);
        F.Fin0 = (bf16*)(ws + WS_FIN0); F.Fin1 = (bf16*)(ws + WS_FIN1); F.Fdn0 = (bf16*)(ws + WS_FDN0); F.Fdn1 = (bf16*)(ws + WS_FDN1);
        F.LB = (float*)(ws + WS_LB); F.HB = (bf16*)(ws + WS_HB); F.QB = (bf16*)(ws + WS_QB);
        F.LOGF = (float*)(ws + WS_LOGF); F.VB = (bf16*)(ws + WS_VB); F.SG = (bf16*)(ws + WS_SG); F.OI = (float*)(ws + WS_OI); F.LOCAL = (float*)(ws + WS_LOCAL); F.DEC = (float*)(ws + WS_DEC);
        F.QKV = (bf16*)(ws + WS_QKV); F.KN = (bf16*)(ws + WS_KN); F.KS = (bf16*)(ws + WS_KS); F.VT = (bf16*)(ws + WS_VT); F.VTS = (bf16*)(ws + WS_VTS);
        F.UP = (bf16*)(ws + WS_UP); F.ACT = (bf16*)(ws + WS_ACT);
        switch (ph) {
        case PH_P0: if (EN_MASK & 1) p0_phase(F); break;
        case PH_GLA_A: if (EN_MASK & 2) gla_a_phase(F); break;
        case PH_SCAN: if (EN_MASK & 4) scan_phase(F); break;
        case PH_GLA_C: if (EN_MASK & 8) gla_c_phase(F); break;
        case PH_RMS_F0: if (EN_MASK & 16) rms_phase(F, X, prm.x_sample, prm.norm_ffn, (const float*)(ws + WS_PART), X + (size_t)TP * D); break;
        case PH_RMS_M1: if (EN_MASK & 16) rms_phase(F, X, X + (size_t)TP * D, prm.norm_mix + D, (const float*)(ws + WS_PART), X + (size_t)TP * D); break;
        case PH_RMS_F1: if (EN_MASK & 16) rms_phase(F, X, X + (size_t)TP * D, prm.norm_ffn + D, (const float*)(ws + WS_PART), X + (size_t)TP * D); break;
        case PH_FIN: fin_phase(F, X + (size_t)TP * D, (const float*)(ws + WS_PART)); break;
        case PH_CONV0: if (EN_MASK & 32) conv_phase(F, 0); break;
        case PH_CONV1: if (EN_MASK & 32) conv_phase(F, 1); break;
        case PH_PREP: if (EN_MASK & 64) prep_phase(F); break;
        case PH_ATTN: if (EN_MASK & 128) attn_phase(F); break;
        default: if (EN_MASK & 256) {
            pg8::Gemm g; pg8::Epi E; E.mode = 2; E.ldo = D; E.ob = nullptr; E.of = X; E.resP = X; E.resS = X + (size_t)TP * D;
            E.lb = F.LB; E.logf = F.LOGF; E.wsb = ws;
            g.A = F.HB; g.M = T; g.K = D; g.N = D; g.Bt = F.WoA;
            if (ph == PH_G1) { g.Bt = F.WinA; g.N = NWIN; E.mode = 0; }
            else if (ph == PH_G2) { g.Bt = F.WoA; E.resP = prm.x_prompt; E.resS = prm.x_sample; }
            else if (ph == PH_G3_0 || ph == PH_G3_1) { g.Bt = (ph == PH_G3_1) ? F.Fin1 : F.Fin0; g.N = NUP; E.mode = 1; E.ob = F.UP; E.ldo = NUP; }
            else if (ph == PH_G4_0 || ph == PH_G4_1) { g.A = F.ACT; g.Bt = (ph == PH_G4_1) ? F.Fdn1 : F.Fdn0; g.K = FF; }
            else if (ph == PH_G5) { g.Bt = F.Wqkv; g.N = NQKV; E.mode = 1; E.ob = F.QKV; E.ldo = NQKV; }
            else { g.Bt = F.WoB; }
            E.part = (float*)(ws + WS_PART);
            pg8::StaticOrder S; S.init(g.M, g.N, g.K, F.G, F.bid, E.mode == 2);
            pg8::gemm_phase(F.lds, g, S, E, F.tid);
        } break;
        }
      }
        if (prm.ph_hi > 1000) grid.sync();
        if (ph + 1 < prm.ph_hi) xcd_barrier(xbar);
    }
}

extern "C" void kernel_launch(void* const* d_in, const int* in_sizes, int n_in, void* d_out, int out_size, void* d_ws, size_t ws_size, hipStream_t stream) {
    static int grid_blocks = 0;
    if (!grid_blocks) {
        int dev = 0, cus = 0, per_cu = 0;
        hipGetDevice(&dev);
        hipDeviceGetAttribute(&cus, hipDeviceAttributeMultiprocessorCount, dev);
        if (hipFuncSetAttribute((const void*)fwd_megakernel, hipFuncAttributeMaxDynamicSharedMemorySize, LDS_BYTES) != hipSuccess) fprintf(stderr, "kernel_launch: hipFuncSetAttribute failed\n");
        hipOccupancyMaxActiveBlocksPerMultiprocessor(&per_cu, (const void*)fwd_megakernel, NTHR, LDS_BYTES);
        if (per_cu < 1) per_cu = 1;
        if (per_cu > 1) per_cu = 1;
        grid_blocks = cus * per_cu;
        if (n_in != 21 || (size_t)out_size != O_END || ws_size < WS_END) fprintf(stderr, "kernel_launch: unexpected sizes n_in %d out %d ws %zu (need %zu)\n", n_in, out_size, ws_size, (size_t)WS_END);
    }
    Params p{};
    p.x_prompt = (const float*)d_in[0]; p.x_sample = (const float*)d_in[1]; p.state_a_S = (const float*)d_in[2]; p.cache_k = (const float*)d_in[3]; p.cache_v = (const float*)d_in[4];
    p.conv_state = (const float*)d_in[5]; p.norm_mix = (const float*)d_in[6]; p.norm_ffn = (const float*)d_in[7]; p.a_w_in = (const float*)d_in[8]; p.a_gamma = (const float*)d_in[9];
    p.a_norm_o = (const float*)d_in[10]; p.a_w_o = (const float*)d_in[11]; p.b_w_qkv = (const float*)d_in[12]; p.b_q_norm = (const float*)d_in[13]; p.b_k_norm = (const float*)d_in[14];
    p.b_rel_bias = (const float*)d_in[15]; p.b_w_o = (const float*)d_in[16]; p.f_w_in = (const float*)d_in[17]; p.f_conv_w = (const float*)d_in[18]; p.f_conv_b = (const float*)d_in[19];
    p.f_w_down = (const float*)d_in[20];
    p.out = (float*)d_out; p.ws = (unsigned char*)d_ws;
#if MK_N_LAUNCHES == 1
    p.ph_lo = 0; p.ph_hi = NPH;
    if (hipMemsetAsync((char*)d_ws + WS_BAR, 0, 16384, stream) != hipSuccess) fprintf(stderr, "kernel_launch: memset of barrier words failed\n");
    void* args[] = {&p};
    hipError_t e = hipLaunchCooperativeKernel((const void*)fwd_megakernel, dim3(grid_blocks), dim3(NTHR), args, LDS_BYTES, stream);
    if (e != hipSuccess) fprintf(stderr, "cooperative launch failed: %s (grid %d)\n", hipGetErrorString(e), grid_blocks);
#else
    for (int ph = 0; ph < NPH; ++ph) {
        p.ph_lo = ph; p.ph_hi = ph + 1;
        hipLaunchKernelGGL(fwd_megakernel, dim3(grid_blocks), dim3(NTHR), LDS_BYTES, stream, p);
    }
#endif
}
```

```cpp
#include <hip/hip_runtime.h>
#include <hip/hip_cooperative_groups.h>
#include <cstdio>
#include <cstdint>
namespace cg = cooperative_groups;

#define DI __device__ __forceinline__
#define LAS __attribute__((address_space(3)))
#define GAS __attribute__((address_space(1)))
typedef unsigned short bf16;
typedef short bf16x8 __attribute__((ext_vector_type(8)));
typedef float f32x2 __attribute__((ext_vector_type(2)));
typedef float f32x4 __attribute__((ext_vector_type(4)));
typedef float f32x16 __attribute__((ext_vector_type(16)));
typedef unsigned u32x2 __attribute__((ext_vector_type(2)));
typedef unsigned u32x4 __attribute__((ext_vector_type(4)));
typedef __bf16 bf16x2_t __attribute__((ext_vector_type(2)));

#ifndef EN_MASK
#define EN_MASK 0xffffu
#endif
#ifndef REP_MASK
#define REP_MASK 0
#endif
#ifndef MK_N_LAUNCHES
#define MK_N_LAUNCHES 1
#endif

constexpr int D = 2048, TP = 8192, TS = 1024, T = TP + TS, SEQ = 4096, NH = 16, HD = 128, FF = 5632;
constexpr int NQKV = 3 * D, NWIN = 4 * D, NUP = 2 * FF;
constexpr int SROWS = 544;
constexpr float EPS = 1e-6f;
constexpr int NWAVES = 8, NTHR = 512;
constexpr int LDS_BYTES = 147456;

constexpr size_t MiB = 1u << 20;
constexpr size_t WS_WINA = 0, WS_WOA = 32 * MiB, WS_WQKV = 40 * MiB, WS_WOB = 64 * MiB, WS_FIN0 = 72 * MiB, WS_FIN1 = 116 * MiB, WS_FDN0 = 160 * MiB, WS_FDN1 = 182 * MiB;
constexpr size_t WS_LB = 204 * MiB, WS_HB = 205 * MiB, WS_QB = 241 * MiB, WS_MIX = 277 * MiB;
constexpr size_t WS_LOGF = WS_MIX, WS_VB = WS_MIX + 72 * MiB, WS_SG = WS_MIX + 108 * MiB, WS_OI = WS_MIX + 144 * MiB, WS_LOCAL = WS_MIX + 216 * MiB, WS_DEC = WS_MIX + 376 * MiB;
constexpr size_t WS_QKV = WS_MIX, WS_KN = WS_MIX + 108 * MiB, WS_KS = WS_MIX + 140 * MiB, WS_VT = WS_MIX + 208 * MiB, WS_VTS = WS_MIX + 240 * MiB;
constexpr size_t WS_UP = WS_MIX, WS_ACT = WS_MIX + 198 * MiB;
constexpr size_t WS_PART = WS_MIX + 300 * MiB;
constexpr size_t WS_BAR = WS_LB + 64 * 1024;
constexpr size_t WS_END = WS_MIX + 378 * MiB;

constexpr size_t O_YP = 0, O_YS = O_YP + (size_t)TP * D, O_SP = O_YS + (size_t)TS * D, O_SS = O_SP + 2 * 16 * 128 * 128, O_KP = O_SS + 32 * 16 * 128 * 128,
                 O_VP = O_KP + 2 * 512 * 2048, O_KSM = O_VP + 2 * 512 * 2048, O_VSM = O_KSM + 32 * 32 * 2048, O_CP = O_VSM + 32 * 32 * 2048, O_CS = O_CP + 2 * 2 * 2 * FF,
                 O_END = O_CS + 2 * 32 * 2 * FF;

struct Params {
    const float* x_prompt; const float* x_sample; const float* state_a_S; const float* cache_k; const float* cache_v; const float* conv_state;
    const float* norm_mix; const float* norm_ffn; const float* a_w_in; const float* a_gamma; const float* a_norm_o; const float* a_w_o;
    const float* b_w_qkv; const float* b_q_norm; const float* b_k_norm; const float* b_rel_bias; const float* b_w_o;
    const float* f_w_in; const float* f_conv_w; const float* f_conv_b; const float* f_w_down;
    float* out; unsigned char* ws; int ph_lo, ph_hi;
};

DI unsigned pk2(float lo, float hi) { f32x2 v = {lo, hi}; return __builtin_bit_cast(unsigned, __builtin_convertvector(v, bf16x2_t)); }
DI bf16 f2bf(float f) { return (bf16)(pk2(f, 0.f) & 0xffffu); }
DI float bflo(unsigned p) { return __uint_as_float(p << 16); }
DI float bfhi(unsigned p) { return __uint_as_float(p & 0xffff0000u); }
DI float wave_sum(float v) {
#pragma unroll
    for (int o = 1; o < 64; o <<= 1) v += __shfl_xor(v, o);
    return v;
}
DI float fsigmoid(float z) { return 1.f / (1.f + __expf(-z)); }
DI float fsilu(float z) { return z / (1.f + __expf(-z)); }
DI int crow(int reg, int h) { return (reg & 3) + 8 * (reg >> 2) + 4 * h; }
#define MFMA32(a, b, c) __builtin_amdgcn_mfma_f32_32x32x16_bf16((a), (b), (c), 0, 0, 0)

namespace pg8 {
constexpr int BM = 256, BK = 64, HALF = 128, HTB = HALF * BK * 2, STAGE_BYTES = 8 * HTB, NXCD = 8, WGM = 8;
DI int lds_byte(int r, int c) { const int st = (r >> 4) * 2 + (c >> 5), rr = r & 15, cc = c & 31, ob = rr * 64 + cc * 2; return st * 1024 + (ob ^ (((ob >> 9) & 1) << 5)); }
DI void stage_rc(int b, int& R, int& C) { const int st = b / 1024, sb = b % 1024, swz = sb ^ (((sb >> 9) & 1) << 5); R = (st >> 1) * 16 + swz / 64; C = (st & 1) * 32 + (swz % 64) / 2; }
DI int perm32(int rho) { const int n = rho >> 4, i = rho & 15; return 8 * (i >> 2) + 4 * n + (i & 3); }
struct Unit { int pm, pn, kb0, nkt, slice; };
struct Gemm { const bf16* A; const bf16* Bt; int M, N, K; };
struct StaticOrder {
    int nM, nN, nwg, G, c, tail, nblk, nitems;
    DI void init(int M, int N, int K, int G_, int c_, int tail_) { tail = tail_; nM = tail ? TP / BM : M / BM; nN = N / BM; nwg = nM * nN; G = G_; c = c_; nblk = K / 128; nitems = nwg + (tail ? 256 : 0); }
    DI bool next(int i, Unit& u) const {
        const long L = (long)i * G + c; if (L >= nitems) return false;
        u.slice = -1; u.kb0 = 0; u.nkt = nblk * 2;
        if (L >= nwg) { const int j = (int)L - nwg, uu = j & 31; u.slice = j >> 5; u.pm = TP / BM + (uu >> 3); u.pn = uu & 7;
            const int base = nblk / 8, rem = nblk % 8; u.kb0 = u.slice * base + (u.slice < rem ? u.slice : rem); u.nkt = 2 * (base + (u.slice < rem ? 1 : 0)); return true; }
        int wgid = (int)L; { const int q = nwg / NXCD, r = nwg % NXCD, xcd = wgid % NXCD, off = wgid / NXCD; wgid = (xcd < r ? xcd * (q + 1) : r * (q + 1) + (xcd - r) * q) + off; }
        const int nig = WGM * nN, gid = wgid / nig, fm = gid * WGM, gsz = (nM - fm) < WGM ? (nM - fm) : WGM;
        u.pm = fm + ((wgid % nig) % gsz); u.pn = (wgid % nig) / gsz; return true;
    }
};

struct Epi {
    int mode;
    int ldo;
    bf16* ob;
    float* of; const float* resP; const float* resS;
    const float* lb; float* logf; unsigned char* wsb;
    float* part;
    DI bool perm() const { return mode != 2; }
    DI void operator()(const f32x4 (&acc)[2][2][4][2], const Unit& u, int wr, int wc, int fr, int fq) const {
        const int row0 = u.pm * BM + wr * 64 + fr;
        if (mode == 2 && u.slice >= 0) {
            const int col0 = u.pn * BM + wc * 32 + 4 * fq;
#pragma unroll
            for (int ai = 0; ai < 2; ++ai)
#pragma unroll
                for (int m = 0; m < 4; ++m) {
                    float* op = part + ((size_t)u.slice * TS + (row0 + ai * HALF + m * 16 - TP)) * D + col0;
#pragma unroll
                    for (int bj = 0; bj < 2; ++bj)
#pragma unroll
                        for (int n = 0; n < 2; ++n) *(f32x4*)(op + bj * HALF + n * 16) = acc[ai][bj][m][n];
                }
        } else if (mode == 2) {
            const int col0 = u.pn * BM + wc * 32 + 4 * fq;
#pragma unroll
            for (int ai = 0; ai < 2; ++ai) {
                f32x4 rr[4][2][2];
#pragma unroll
                for (int m = 0; m < 4; ++m) {
                    const int row = row0 + ai * HALF + m * 16;
                    const float* rp = (row < TP ? resP + (size_t)row * D : resS + (size_t)(row - TP) * D) + col0;
#pragma unroll
                    for (int bj = 0; bj < 2; ++bj)
#pragma unroll
                        for (int n = 0; n < 2; ++n) rr[m][bj][n] = *(const f32x4*)(rp + bj * HALF + n * 16);
                }
#pragma unroll
                for (int m = 0; m < 4; ++m) {
                    float* op = of + (size_t)(row0 + ai * HALF + m * 16) * D + col0;
#pragma unroll
                    for (int bj = 0; bj < 2; ++bj)
#pragma unroll
                        for (int n = 0; n < 2; ++n) *(f32x4*)(op + bj * HALF + n * 16) = rr[m][bj][n] + acc[ai][bj][m][n];
                }
            }
        } else if (mode == 1) {
            const int col0 = u.pn * BM + wc * 32 + 8 * fq;
#pragma unroll
            for (int ai = 0; ai < 2; ++ai)
#pragma unroll
                for (int m = 0; m < 4; ++m) {
                    bf16* op = ob + (size_t)(row0 + ai * HALF + m * 16) * ldo + col0;
#pragma unroll
                    for (int bj = 0; bj < 2; ++bj) { const f32x4 v0 = acc[ai][bj][m][0], v1 = acc[ai][bj][m][1];
                        u32x4 o; o.x = pk2(v0.x, v0.y); o.y = pk2(v0.z, v0.w); o.z = pk2(v1.x, v1.y); o.w = pk2(v1.z, v1.w);
                        *(u32x4*)(op + bj * HALF) = o; }
                }
        } else {
            const int type = u.pn >> 3, col0 = (u.pn & 7) * BM + wc * 32 + 8 * fq;
#pragma unroll
            for (int bj = 0; bj < 2; ++bj) {
                const int col = col0 + bj * HALF;
                f32x4 l0 = {0.f, 0.f, 0.f, 0.f}, l1 = l0;
                if (type == 1) { l0 = *(const f32x4*)(lb + col); l1 = *(const f32x4*)(lb + col + 4); }
#pragma unroll
                for (int ai = 0; ai < 2; ++ai)
#pragma unroll
                    for (int m = 0; m < 4; ++m) {
                        const size_t off = (size_t)(row0 + ai * HALF + m * 16) * D + col;
                        f32x4 v0 = acc[ai][bj][m][0], v1 = acc[ai][bj][m][1];
                        if (type == 1) {
#pragma unroll
                            for (int e = 0; e < 4; ++e) { v0[e] = __logf(l0[e] + (1.f - l0[e]) * fsigmoid(v0[e])); v1[e] = __logf(l1[e] + (1.f - l1[e]) * fsigmoid(v1[e])); }
                            *(f32x4*)(logf + off) = v0; *(f32x4*)(logf + off + 4) = v1;
                        } else {
                            if (type == 3) {
#pragma unroll
                                for (int e = 0; e < 4; ++e) { v0[e] = fsilu(v0[e]); v1[e] = fsilu(v1[e]); }
                            }
                            u32x4 o; o.x = pk2(v0.x, v0.y); o.y = pk2(v0.z, v0.w); o.z = pk2(v1.x, v1.y); o.w = pk2(v1.z, v1.w);
                            bf16* dst = (bf16*)(wsb + (type == 0 ? WS_QB : (type == 2 ? WS_VB : WS_SG)));
                            *(u32x4*)(dst + off) = o;
                        }
                    }
            }
        }
    }
};

DI void gemm_phase(LAS unsigned char* lds, const Gemm g, const StaticOrder& S, const Epi& E, const int tid) {
    const int wid = __builtin_amdgcn_readfirstlane(tid >> 6), lane = tid & 63, wr = wid >> 2, wc = wid & 3, fr = lane & 15, fq = lane >> 4;
    const int K = g.K;
    const bool PERM = E.perm();
    unsigned voffA[2], voffB[2];
#pragma unroll
    for (int i = 0; i < 2; ++i) { int R, C; stage_rc(tid * 16 + i * 8192, R, C); const int Rb = PERM ? ((R & ~31) + perm32(R & 31)) : R;
        voffA[i] = (unsigned)(R * K + C) * 2u; voffB[i] = (unsigned)(Rb * K + C) * 2u; }
    const size_t kstep = (size_t)(BK * 2);
    const size_t hstep = (size_t)HALF * K * 2;
    const size_t tstep = 2 * hstep;
    const unsigned ldsw = (unsigned)wid * 1024u;
    const int aoff = lds_byte(wr * 64 + fr, fq * 8), boff = lds_byte(wc * 32 + fr, fq * 8);
#define PG8_SA(b, h) (((b) * 2 + (h)) * HTB)
#define PG8_SB(b, h) ((4 + (b) * 2 + (h)) * HTB)
#define PG8_STAGE(bufoff, gbase, voff) do { _Pragma("unroll") for (int _i = 0; _i < 2; ++_i) \
        __builtin_amdgcn_global_load_lds((const unsigned*)((const char*)(gbase) + (voff)[_i]), (LAS unsigned*)(lds + (bufoff) + ldsw + _i * 8192), 16, 0, 0); } while (0)
#define PG8_LDA(dst, b, h) do { _Pragma("unroll") for (int m = 0; m < 4; ++m) _Pragma("unroll") for (int k = 0; k < 2; ++k) dst[m][k] = *(const LAS bf16x8*)(lds + PG8_SA(b, h) + aoff + m * 2048 + k * 1024); } while (0)
#define PG8_LDB(dst, b, h) do { _Pragma("unroll") for (int n = 0; n < 2; ++n) _Pragma("unroll") for (int k = 0; k < 2; ++k) dst[n][k] = *(const LAS bf16x8*)(lds + PG8_SB(b, h) + boff + n * 2048 + k * 1024); } while (0)
#define PG8_MMA(ai, bj, At, Bt) do { __builtin_amdgcn_s_setprio(1); _Pragma("unroll") for (int m = 0; m < 4; ++m) _Pragma("unroll") for (int n = 0; n < 2; ++n) _Pragma("unroll") for (int k = 0; k < 2; ++k) \
        acc[ai][bj][m][n] = __builtin_amdgcn_mfma_f32_16x16x32_bf16(Bt[n][k], At[m][k], acc[ai][bj][m][n], 0, 0, 0); __builtin_amdgcn_s_setprio(0); } while (0)
#define PG8_WAIT_V(n) asm volatile("s_waitcnt vmcnt(" #n ")" ::: "memory")
#define PG8_WAIT_L(n) asm volatile("s_waitcnt lgkmcnt(" #n ")" ::: "memory")
#define PG8_BAR __builtin_amdgcn_s_barrier()
#define PG8_SCHED __builtin_amdgcn_sched_barrier(0)
    Unit cur, nxt; int ui = 0;
    if (!S.next(0, cur)) return;
    f32x4 acc[2][2][4][2];
#pragma unroll
    for (int a = 0; a < 2; ++a)
#pragma unroll
        for (int b = 0; b < 2; ++b)
#pragma unroll
            for (int m = 0; m < 4; ++m)
#pragma unroll
                for (int n = 0; n < 2; ++n) acc[a][b][m][n] = (f32x4){0.f, 0.f, 0.f, 0.f};
    bf16x8 At[4][2], B0[2][2], B1[2][2];
    const char* cA = (const char*)g.A + (size_t)cur.pm * tstep + (size_t)cur.kb0 * 256; const char* cB = (const char*)g.Bt + (size_t)cur.pn * tstep + (size_t)cur.kb0 * 256;
    PG8_STAGE(PG8_SB(0, 0), cB, voffB); PG8_STAGE(PG8_SA(0, 0), cA, voffA); PG8_STAGE(PG8_SB(0, 1), cB + hstep, voffB); PG8_STAGE(PG8_SA(0, 1), cA + hstep, voffA);
    if (wr == 1) PG8_BAR;
    PG8_WAIT_V(4); PG8_BAR;
    PG8_STAGE(PG8_SB(1, 0), cB + kstep, voffB); PG8_STAGE(PG8_SA(1, 0), cA + kstep, voffA); PG8_STAGE(PG8_SB(1, 1), cB + hstep + kstep, voffB);
    PG8_WAIT_V(6); PG8_BAR;
    for (;;) {
        const bool has_next = S.next(ui + 1, nxt);
        const char* nA = has_next ? (const char*)g.A + (size_t)nxt.pm * tstep + (size_t)nxt.kb0 * 256 : cA; const char* nB = has_next ? (const char*)g.Bt + (size_t)nxt.pn * tstep + (size_t)nxt.kb0 * 256 : cB;
        const int nt = cur.nkt;
        for (int t = 0; t < nt; t += 2) {
            const bool last = (t == nt - 2);
            const char* a1 = cA + (size_t)(t + 1) * kstep;
            const char* a2 = last ? nA : cA + (size_t)(t + 2) * kstep; const char* b2 = last ? nB : cB + (size_t)(t + 2) * kstep;
            const char* a3 = a2 + kstep; const char* b3 = b2 + kstep;
            PG8_LDB(B0, 0, 0); PG8_SCHED; PG8_LDA(At, 0, 0); PG8_STAGE(PG8_SA(1, 1), a1 + hstep, voffA);
            PG8_WAIT_L(8); PG8_BAR; PG8_WAIT_L(0); PG8_MMA(0, 0, At, B0); PG8_BAR; PG8_SCHED;
            PG8_LDB(B1, 0, 1); PG8_STAGE(PG8_SB(0, 0), b2, voffB);
            PG8_BAR; PG8_WAIT_L(0); PG8_MMA(0, 1, At, B1); PG8_BAR;
            PG8_LDA(At, 0, 1); PG8_STAGE(PG8_SA(0, 0), a2, voffA);
            PG8_BAR; PG8_WAIT_L(0); PG8_MMA(1, 0, At, B0); PG8_BAR; PG8_SCHED;
            PG8_STAGE(PG8_SB(0, 1), b2 + hstep, voffB);
            PG8_WAIT_V(6); PG8_BAR; PG8_MMA(1, 1, At, B1); PG8_BAR;
            PG8_LDB(B0, 1, 0); PG8_SCHED; PG8_LDA(At, 1, 0); PG8_STAGE(PG8_SA(0, 1), a2 + hstep, voffA);
            PG8_WAIT_L(8); PG8_BAR; PG8_WAIT_L(0); PG8_MMA(0, 0, At, B0); PG8_BAR; PG8_SCHED;
            PG8_LDB(B1, 1, 1); PG8_STAGE(PG8_SB(1, 0), b3, voffB);
            PG8_BAR; PG8_WAIT_L(0); PG8_MMA(0, 1, At, B1); PG8_BAR;
            PG8_LDA(At, 1, 1); PG8_STAGE(PG8_SA(1, 0), a3, voffA);
            PG8_BAR; PG8_WAIT_L(0); PG8_MMA(1, 0, At, B0); PG8_BAR; PG8_SCHED;
            PG8_STAGE(PG8_SB(1, 1), b3 + hstep, voffB);
            PG8_WAIT_V(6); PG8_BAR; PG8_MMA(1, 1, At, B1); PG8_BAR;
        }
        E(acc, cur, wr, wc, fr, fq);
        if (!has_next) break;
#pragma unroll
        for (int a = 0; a < 2; ++a)
#pragma unroll
            for (int b = 0; b < 2; ++b)
#pragma unroll
                for (int m = 0; m < 4; ++m)
#pragma unroll
                    for (int n = 0; n < 2; ++n) acc[a][b][m][n] = (f32x4){0.f, 0.f, 0.f, 0.f};
        cur = nxt; cA = nA; cB = nB; ++ui;
    }
    PG8_WAIT_V(0);
    if (wr == 0) PG8_BAR;
    PG8_BAR;
#undef PG8_SA
#undef PG8_SB
#undef PG8_STAGE
#undef PG8_LDA
#undef PG8_LDB
#undef PG8_MMA
#undef PG8_WAIT_V
#undef PG8_WAIT_L
#undef PG8_BAR
#undef PG8_SCHED
}
}

struct Frame {
    Params p; LAS unsigned char* lds; int tid, lane, wave, G, bid;
    bf16 *WinA, *WoA, *Wqkv, *WoB, *Fin0, *Fin1, *Fdn0, *Fdn1;
    float* LB; bf16 *HB, *QB;
    float* LOGF; bf16 *VB, *SG; float *OI, *LOCAL, *DEC;
    bf16 *QKV, *KN, *KS, *VT, *VTS, *UP, *ACT;
};

DI void transpose_item(const float* __restrict__ W, int K, int N, bf16* __restrict__ WT, LAS float* scr, int item, int lane) {
    const int nblk = N / 64, kb = item / nblk, nb = item % nblk, k0 = 64 * kb, n0 = 64 * nb;
    const int lr = lane >> 4, lc = (lane & 15) * 4;
    f32x4 v[16];
    const float* src = W + (size_t)(k0 + lr) * N + n0 + lc;
#pragma unroll
    for (int i = 0; i < 16; ++i) v[i] = *(const f32x4*)(src + (size_t)(4 * i) * N);
#pragma unroll
    for (int i = 0; i < 16; ++i) { LAS float* d = scr + (4 * i + lr) * 65 + lc; d[0] = v[i].x; d[1] = v[i].y; d[2] = v[i].z; d[3] = v[i].w; }
    asm volatile("s_waitcnt lgkmcnt(0)" ::: "memory");
    const int c = lane & 7;
#pragma unroll
    for (int j = 0; j < 8; ++j) { const int n = (lane >> 3) + 8 * j; const LAS float* s = scr + (8 * c) * 65 + n;
        u32x4 o; o.x = pk2(s[0 * 65], s[1 * 65]); o.y = pk2(s[2 * 65], s[3 * 65]); o.z = pk2(s[4 * 65], s[5 * 65]); o.w = pk2(s[6 * 65], s[7 * 65]);
        *(u32x4*)(WT + (size_t)(n0 + n) * K + k0 + 8 * c) = o; }
    asm volatile("s_waitcnt lgkmcnt(0)" ::: "memory");
}
DI void rms_row(const float* __restrict__ xrow, const float* __restrict__ g, bf16* __restrict__ orow, int lane, const float* __restrict__ part, float* __restrict__ xdst) {
    const f32x4* xr = (const f32x4*)xrow + lane; const f32x4* gr = (const f32x4*)g + lane;
    f32x4 v[8]; float s = 0.f;
#pragma unroll
    for (int j = 0; j < 8; ++j) v[j] = xr[64 * j];
    if (part) {
#pragma unroll
        for (int sl = 0; sl < 8; ++sl) { const f32x4* pr = (const f32x4*)(part + (size_t)sl * TS * D) + lane;
#pragma unroll
            for (int j = 0; j < 8; ++j) v[j] += pr[64 * j]; }
#pragma unroll
        for (int j = 0; j < 8; ++j) ((f32x4*)xdst + lane)[64 * j] = v[j];
    }
#pragma unroll
    for (int j = 0; j < 8; ++j) s += (v[j].x * v[j].x + v[j].y * v[j].y) + (v[j].z * v[j].z + v[j].w * v[j].w);
    const float rstd = rsqrtf(wave_sum(s) * (1.f / D) + EPS);
    u32x2* o8 = (u32x2*)orow + lane;
#pragma unroll
    for (int j = 0; j < 8; ++j) { const f32x4 gg = gr[64 * j]; u32x2 o; o.x = pk2(v[j].x * rstd * gg.x, v[j].y * rstd * gg.y); o.y = pk2(v[j].z * rstd * gg.z, v[j].w * rstd * gg.w); o8[64 * j] = o; }
}
DI void rms_phase(Frame& F, const float* srcP, const float* srcS, const float* g, const float* part, float* xs) {
    const int gw = F.bid * NWAVES + F.wave, NGW = F.G * NWAVES;
    for (int m = gw; m < T; m += NGW) {
        if (m < TP) rms_row(srcP + (size_t)m * D, g, F.HB + (size_t)m * D, F.lane, nullptr, nullptr);
        else rms_row(srcS + (size_t)(m - TP) * D, g, F.HB + (size_t)m * D, F.lane, part ? part + (size_t)(m - TP) * D : nullptr, xs + (size_t)(m - TP) * D);
    }
}
DI void fin_phase(Frame& F, float* xs, const float* part) {
    const int gt = F.bid * NTHR + F.tid, NGT = F.G * NTHR;
    for (int it = gt; it < TS * D / 4; it += NGT) {
        f32x4 v = ((const f32x4*)xs)[it];
#pragma unroll
        for (int sl = 0; sl < 8; ++sl) v += ((const f32x4*)(part + (size_t)sl * TS * D))[it];
        ((f32x4*)xs)[it] = v;
    }
}
DI void p0_phase(Frame& F) {
    const Params& p = F.p;
    LAS float* scr = (LAS float*)(F.lds + F.wave * 16640);
    const int gw = F.bid * NWAVES + F.wave, NGW = F.G * NWAVES;
    constexpr int I_WINA = (D / 64) * (NWIN / 64), I_WO = (D / 64) * (D / 64), I_QKV = (D / 64) * (NQKV / 64), I_FIN = (D / 64) * (NUP / 64), I_FDN = (FF / 64) * (D / 64);
    constexpr int NITEMS = I_WINA + 2 * I_WO + I_QKV + 2 * I_FIN + 2 * I_FDN;
    for (int it = gw; it < NITEMS; it += NGW) {
        int r = it;
        if (r < I_WINA) { transpose_item(p.a_w_in, D, NWIN, F.WinA, scr, r, F.lane); continue; } r -= I_WINA;
        if (r < I_WO) { transpose_item(p.a_w_o, D, D, F.WoA, scr, r, F.lane); continue; } r -= I_WO;
        if (r < I_QKV) { transpose_item(p.b_w_qkv, D, NQKV, F.Wqkv, scr, r, F.lane); continue; } r -= I_QKV;
        if (r < I_WO) { transpose_item(p.b_w_o, D, D, F.WoB, scr, r, F.lane); continue; } r -= I_WO;
        if (r < I_FIN) { transpose_item(p.f_w_in, D, NUP, F.Fin0, scr, r, F.lane); continue; } r -= I_FIN;
        if (r < I_FIN) { transpose_item(p.f_w_in + (size_t)D * NUP, D, NUP, F.Fin1, scr, r, F.lane); continue; } r -= I_FIN;
        if (r < I_FDN) { transpose_item(p.f_w_down, FF, D, F.Fdn0, scr, r, F.lane); continue; } r -= I_FDN;
        transpose_item(p.f_w_down + (size_t)FF * D, FF, D, F.Fdn1, scr, r, F.lane);
    }
    for (int c = F.bid * NTHR + F.tid; c < D; c += F.G * NTHR) {
        const float g0 = p.a_gamma[c], g1 = p.a_gamma[D + c], g2 = p.a_gamma[2 * D + c];
        const float mx = fmaxf(g0, fmaxf(g1, g2));
        const float e0 = __expf(g0 - mx), e1 = __expf(g1 - mx), e2 = __expf(g2 - mx);
        F.LB[c] = e0 / (e0 + e1 + e2);
    }
    rms_phase(F, p.x_prompt, p.x_sample, p.norm_mix, nullptr, nullptr);
}

constexpr int GLA_UNITS = 2048 + 512;
constexpr int QT_STRIDE = 136, TT_STRIDE = 72;
constexpr int L_BCUM = 0, L_QT = 32768, L_KT = L_QT + 64 * QT_STRIDE * 2, L_KHT = L_KT + 64 * QT_STRIDE * 2, L_VT = L_KHT + 128 * TT_STRIDE * 2, L_PM = L_VT + 128 * TT_STRIDE * 2, L_GLA_END = L_PM + 64 * TT_STRIDE * 2;
static_assert(L_GLA_END <= LDS_BYTES, "gla lds");

DI f32x16 mma_lds(const LAS bf16* A, int astride, int arow0, const LAS bf16* B, int bstride, int brow0, int nks, int lane) {
    f32x16 acc; for (int i = 0; i < 16; ++i) acc[i] = 0.f;
    const int r = lane & 31, hf = lane >> 5;
    const LAS bf16* ap = A + (arow0 + r) * astride + 8 * hf; const LAS bf16* bp = B + (brow0 + r) * bstride + 8 * hf;
    for (int ks = 0; ks < nks; ++ks) { const bf16x8 a = *(const LAS bf16x8*)(ap + 16 * ks), b = *(const LAS bf16x8*)(bp + 16 * ks); acc = MFMA32(a, b, acc); }
    return acc;
}

template <int BLK>
DI void gla_a_unit(Frame& F, int u, int row0, int h) {
    LAS float* bcum = (LAS float*)(F.lds + L_BCUM);
    LAS bf16* qt = (LAS bf16*)(F.lds + L_QT); LAS bf16* kt = (LAS bf16*)(F.lds + L_KT); LAS bf16* khT = (LAS bf16*)(F.lds + L_KHT);
    LAS bf16* vT = (LAS bf16*)(F.lds + L_VT); LAS bf16* Pm = (LAS bf16*)(F.lds + L_PM);
    const int tid = F.tid, lane = F.lane, w = F.wave;
    const size_t hoff = (size_t)h * HD;
    constexpr int SEG = BLK / 4;
    { const int seg = tid >> 7, kc = tid & 127; float a = 0.f;
      const float* lp = F.LOGF + (size_t)(row0 + seg * SEG) * D + hoff + kc;
#pragma unroll
      for (int t = 0; t < SEG; ++t) { a += lp[(size_t)t * D]; bcum[(seg * SEG + t) * 128 + kc] = a; }
      __syncthreads();
      float off = 0.f;
      for (int s = 0; s < seg; ++s) off += bcum[(s * SEG + SEG - 1) * 128 + kc];
      __syncthreads();
      if (seg > 0) {
#pragma unroll
          for (int t = 0; t < SEG; ++t) bcum[(seg * SEG + t) * 128 + kc] += off;
      }
      __syncthreads(); }
    for (int i = tid; i < BLK * 16; i += NTHR) {
        const int t = i >> 4, c0 = (i & 15) * 8;
        const size_t goff = (size_t)(row0 + t) * D + hoff + c0;
        const u32x4 qv = *(const u32x4*)(F.QB + goff);
        const u32x4 vv = *(const u32x4*)(F.VB + goff);
        const f32x4 lf0 = *(const f32x4*)(F.LOGF + goff), lf1 = *(const f32x4*)(F.LOGF + goff + 4);
        float q[8] = {bflo(qv.x), bfhi(qv.x), bflo(qv.y), bfhi(qv.y), bflo(qv.z), bfhi(qv.z), bflo(qv.w), bfhi(qv.w)};
        float lf[8] = {lf0.x, lf0.y, lf0.z, lf0.w, lf1.x, lf1.y, lf1.z, lf1.w};
        float qtv[8], ktv[8], qhv[8], khv[8];
#pragma unroll
        for (int e = 0; e < 8; ++e) {
            const float b = bcum[t * 128 + c0 + e], bmid = bcum[(BLK / 2 - 1) * 128 + c0 + e], bend = bcum[(BLK - 1) * 128 + c0 + e];
            const float kk = 1.f - __expf(lf[e]);
            qtv[e] = q[e] * __expf(b - bmid); ktv[e] = kk * __expf(bmid - b); qhv[e] = q[e] * __expf(b); khv[e] = kk * __expf(bend - b);
            if (t == BLK - 1) F.DEC[(size_t)u * 128 + c0 + e] = __expf(bend);
        }
        u32x4 o; o.x = pk2(qtv[0], qtv[1]); o.y = pk2(qtv[2], qtv[3]); o.z = pk2(qtv[4], qtv[5]); o.w = pk2(qtv[6], qtv[7]);
        *(LAS u32x4*)(qt + t * QT_STRIDE + c0) = o;
        o.x = pk2(ktv[0], ktv[1]); o.y = pk2(ktv[2], ktv[3]); o.z = pk2(ktv[4], ktv[5]); o.w = pk2(ktv[6], ktv[7]);
        *(LAS u32x4*)(kt + t * QT_STRIDE + c0) = o;
        o.x = pk2(qhv[0], qhv[1]); o.y = pk2(qhv[2], qhv[3]); o.z = pk2(qhv[4], qhv[5]); o.w = pk2(qhv[6], qhv[7]);
        *(u32x4*)(F.QB + goff) = o;
        const unsigned vw[4] = {vv.x, vv.y, vv.z, vv.w};
#pragma unroll
        for (int e = 0; e < 8; ++e) {
            khT[(c0 + e) * TT_STRIDE + t] = f2bf(khv[e]);
            vT[(c0 + e) * TT_STRIDE + t] = (bf16)((e & 1) ? (vw[e >> 1] >> 16) : (vw[e >> 1] & 0xffffu));
        }
    }
    __syncthreads();
    const int r = lane & 31, hf = lane >> 5;
#pragma unroll
    for (int q2 = 0; q2 < 2; ++q2) {
        const int tl = w * 2 + q2, mt = tl >> 2, nt = tl & 3;
        const f32x16 acc = mma_lds(khT, TT_STRIDE, 32 * mt, vT, TT_STRIDE, 32 * nt, BLK / 16, lane);
        float* lp = F.LOCAL + (size_t)u * 16384 + 32 * nt + r;
#pragma unroll
        for (int i = 0; i < 16; ++i) lp[(size_t)(32 * mt + crow(i, hf)) * 128] = acc[i];
    }
    constexpr int NT2 = BLK / 32;
    if (w < NT2 * NT2) {
        const int mt = w / NT2, nt = w % NT2;
        if (nt > mt) {
#pragma unroll
            for (int i = 0; i < 16; ++i) Pm[(32 * mt + crow(i, hf)) * TT_STRIDE + 32 * nt + r] = 0;
        } else {
            const f32x16 acc = mma_lds(qt, QT_STRIDE, 32 * mt, kt, QT_STRIDE, 32 * nt, 8, lane);
#pragma unroll
            for (int i = 0; i < 16; ++i) { const int t = 32 * mt + crow(i, hf), s = 32 * nt + r; Pm[t * TT_STRIDE + s] = (s <= t) ? f2bf(acc[i]) : (bf16)0; }
        }
    }
    __syncthreads();
    if (w < NT2 * 4) {
        const int mt = w >> 2, nt = w & 3;
        const f32x16 acc = mma_lds(Pm, TT_STRIDE, 32 * mt, vT, TT_STRIDE, 32 * nt, BLK / 16, lane);
        float* op = F.OI + (size_t)(row0 + 32 * mt) * D + hoff + 32 * nt + r;
#pragma unroll
        for (int i = 0; i < 16; ++i) op[(size_t)crow(i, hf) * D] = acc[i];
    }
    __syncthreads();
}
DI void gla_a_phase(Frame& F) {
    for (int u = F.bid; u < GLA_UNITS; u += F.G) {
        if (u < 2048) { const int b = u >> 10, h = (u >> 6) & 15, c = u & 63; gla_a_unit<64>(F, u, b * SEQ + c * 64, h); }
        else { const int su = u - 2048, b = su >> 4, h = su & 15; gla_a_unit<32>(F, u, TP + b * 32, h); }
    }
}
DI void scan_phase(Frame& F) {
    const int gt = F.bid * NTHR + F.tid, NGT = F.G * NTHR;
    for (int it = gt; it < 32 * 4096; it += NGT) {
        const int bh = it >> 12, e = (it & 4095) * 4, kc = e >> 7;
        f32x4 S = {0.f, 0.f, 0.f, 0.f};
        float* __restrict__ lp = F.LOCAL + (size_t)(bh * 64) * 16384 + e; const float* __restrict__ dp = F.DEC + (size_t)(bh * 64) * 128 + kc;
        for (int c0 = 0; c0 < 64; c0 += 8) {
            f32x4 loc[8]; float d[8];
#pragma unroll
            for (int j = 0; j < 8; ++j) { loc[j] = *(const f32x4*)(lp + (size_t)(c0 + j) * 16384); d[j] = dp[(c0 + j) * 128]; }
#pragma unroll
            for (int j = 0; j < 8; ++j) { *(f32x4*)(lp + (size_t)(c0 + j) * 16384) = S; S = S * d[j] + loc[j]; }
        }
        *(f32x4*)(F.p.out + O_SP + (size_t)bh * 16384 + e) = S;
    }
    for (int it0 = gt; it0 < 512 * 4096; it0 += 4 * NGT) {
        f32x4 S0[4], loc[4]; float d[4];
#pragma unroll
        for (int j = 0; j < 4; ++j) { const int it = it0 + j * NGT; if (it < 512 * 4096) { const int bh = it >> 12, e = (it & 4095) * 4, kc = e >> 7;
            S0[j] = *(const f32x4*)(F.p.state_a_S + (size_t)bh * 16384 + e); loc[j] = *(const f32x4*)(F.LOCAL + (size_t)(2048 + bh) * 16384 + e); d[j] = F.DEC[(size_t)(2048 + bh) * 128 + kc]; } }
#pragma unroll
        for (int j = 0; j < 4; ++j) { const int it = it0 + j * NGT; if (it < 512 * 4096) { const int bh = it >> 12, e = (it & 4095) * 4;
            *(f32x4*)(F.p.out + O_SS + (size_t)bh * 16384 + e) = S0[j] * d[j] + loc[j]; } }
    }
}
constexpr int OB_STRIDE = 132;
template <int BLK>
DI void gla_c_unit(Frame& F, const float* __restrict__ S, int row0, int h) {
    LAS float* ob = (LAS float*)F.lds;
    const int tid = F.tid, lane = F.lane, w = F.wave, r = lane & 31, hf = lane >> 5;
    const size_t hoff = (size_t)h * HD;
    if (w < (BLK / 32) * 4) {
        const int mt = w >> 2, nt = w & 3;
        f32x16 acc; for (int i = 0; i < 16; ++i) acc[i] = 0.f;
        const bf16* ap = F.QB + (size_t)(row0 + 32 * mt + r) * D + hoff + 8 * hf;
        const float* sp = S + (size_t)(8 * hf) * 128 + 32 * nt + r;
#pragma unroll
        for (int ks = 0; ks < 8; ++ks) {
            const bf16x8 a = *(const bf16x8*)(ap + 16 * ks);
            float sv[8];
#pragma unroll
            for (int e = 0; e < 8; ++e) sv[e] = sp[(size_t)(16 * ks + e) * 128];
            u32x4 bb; bb.x = pk2(sv[0], sv[1]); bb.y = pk2(sv[2], sv[3]); bb.z = pk2(sv[4], sv[5]); bb.w = pk2(sv[6], sv[7]);
            acc = MFMA32(a, __builtin_bit_cast(bf16x8, bb), acc);
        }
        const float* oi = F.OI + (size_t)(row0 + 32 * mt) * D + hoff + 32 * nt + r;
#pragma unroll
        for (int i = 0; i < 16; ++i) { const int t = crow(i, hf); ob[(32 * mt + t) * OB_STRIDE + 32 * nt + r] = acc[i] + oi[(size_t)t * D]; }
    }
    __syncthreads();
    {
        constexpr int TPR = NTHR / BLK;
        constexpr int CPT = 128 / TPR;
        const int t = tid / TPR, j = tid % TPR, c0 = j * CPT;
        float v[CPT]; float ss = 0.f;
#pragma unroll
        for (int e = 0; e < CPT; ++e) { v[e] = ob[t * OB_STRIDE + c0 + e]; ss += v[e] * v[e]; }
#pragma unroll
        for (int o = 1; o < TPR; o <<= 1) ss += __shfl_xor(ss, o);
        const float rstd = rsqrtf(ss * (1.f / HD) + EPS);
        const size_t goff = (size_t)(row0 + t) * D + hoff + c0;
#pragma unroll
        for (int e8 = 0; e8 < CPT / 8; ++e8) {
            const u32x4 sg = *(const u32x4*)(F.SG + goff + 8 * e8);
            const f32x4 n0 = *(const f32x4*)(F.p.a_norm_o + c0 + 8 * e8), n1 = *(const f32x4*)(F.p.a_norm_o + c0 + 8 * e8 + 4);
            const float* vv = v + 8 * e8;
            u32x4 o;
            o.x = pk2(vv[0] * rstd * n0.x * bflo(sg.x), vv[1] * rstd * n0.y * bfhi(sg.x));
            o.y = pk2(vv[2] * rstd * n0.z * bflo(sg.y), vv[3] * rstd * n0.w * bfhi(sg.y));
            o.z = pk2(vv[4] * rstd * n1.x * bflo(sg.z), vv[5] * rstd * n1.y * bfhi(sg.z));
            o.w = pk2(vv[6] * rstd * n1.z * bflo(sg.w), vv[7] * rstd * n1.w * bfhi(sg.w));
            *(u32x4*)(F.HB + goff + 8 * e8) = o;
        }
    }
    __syncthreads();
}
DI void gla_c_phase(Frame& F) {
    for (int u = F.bid; u < GLA_UNITS; u += F.G) {
        if (u < 2048) { const int b = u >> 10, h = (u >> 6) & 15, c = u & 63; gla_c_unit<64>(F, F.LOCAL + (size_t)u * 16384, b * SEQ + c * 64, h); }
        else { const int su = u - 2048, b = su >> 4, h = su & 15; gla_c_unit<32>(F, F.p.state_a_S + (size_t)su * 16384, TP + b * 32, h); }
    }
}
DI void conv_phase(Frame& F, int layer) {
    const Params& p = F.p;
    const int gt = F.bid * NTHR + F.tid, NGT = F.G * NTHR;
    constexpr int NCG = FF / 8, NSEG = T / 32;
    const float* cw = p.f_conv_w + (size_t)layer * 3 * FF; const float* cb = p.f_conv_b + (size_t)layer * FF;
    for (int it = gt; it < NSEG * NCG; it += NGT) {
        const int seg = it / NCG, c0 = (it % NCG) * 8;
        const bool smp = seg >= 256; const int r0 = seg * 32;
        const bool first = smp || ((seg & 127) == 0), lastseg = smp || ((seg & 127) == 127);
        float w0[8], w1[8], w2[8], bb[8], um2[8], um1[8];
#pragma unroll
        for (int e = 0; e < 8; ++e) { w0[e] = cw[c0 + e]; w1[e] = cw[FF + c0 + e]; w2[e] = cw[2 * FF + c0 + e]; bb[e] = cb[c0 + e]; um2[e] = 0.f; um1[e] = 0.f; }
        if (first) {
            if (smp) { const float* st = p.conv_state + ((size_t)(layer * 32 + (seg - 256)) * 2) * FF + c0;
#pragma unroll
                for (int e = 0; e < 8; ++e) { um2[e] = st[e]; um1[e] = st[FF + e]; } }
        } else {
            const u32x4 a = *(const u32x4*)(F.UP + (size_t)(r0 - 2) * NUP + c0), b = *(const u32x4*)(F.UP + (size_t)(r0 - 1) * NUP + c0);
            um2[0] = bflo(a.x); um2[1] = bfhi(a.x); um2[2] = bflo(a.y); um2[3] = bfhi(a.y); um2[4] = bflo(a.z); um2[5] = bfhi(a.z); um2[6] = bflo(a.w); um2[7] = bfhi(a.w);
            um1[0] = bflo(b.x); um1[1] = bfhi(b.x); um1[2] = bflo(b.y); um1[3] = bfhi(b.y); um1[4] = bflo(b.z); um1[5] = bfhi(b.z); um1[6] = bflo(b.w); um1[7] = bfhi(b.w);
        }
        for (int t0 = 0; t0 < 32; t0 += 4) {
            u32x4 uu[4], gg[4];
#pragma unroll
            for (int j = 0; j < 4; ++j) { const size_t ro = (size_t)(r0 + t0 + j) * NUP + c0; uu[j] = *(const u32x4*)(F.UP + ro); gg[j] = *(const u32x4*)(F.UP + ro + FF); }
#pragma unroll
            for (int j = 0; j < 4; ++j) {
                const float uc[8] = {bflo(uu[j].x), bfhi(uu[j].x), bflo(uu[j].y), bfhi(uu[j].y), bflo(uu[j].z), bfhi(uu[j].z), bflo(uu[j].w), bfhi(uu[j].w)};
                const float gc[8] = {bflo(gg[j].x), bfhi(gg[j].x), bflo(gg[j].y), bfhi(gg[j].y), bflo(gg[j].z), bfhi(gg[j].z), bflo(gg[j].w), bfhi(gg[j].w)};
                float a[8];
#pragma unroll
                for (int e = 0; e < 8; ++e) { const float c = bb[e] + um2[e] * w0[e] + um1[e] * w1[e] + uc[e] * w2[e]; a[e] = fsilu(c) * gc[e]; um2[e] = um1[e]; um1[e] = uc[e]; }
                u32x4 o; o.x = pk2(a[0], a[1]); o.y = pk2(a[2], a[3]); o.z = pk2(a[4], a[5]); o.w = pk2(a[6], a[7]);
                *(u32x4*)(F.ACT + (size_t)(r0 + t0 + j) * FF + c0) = o;
            }
        }
        if (lastseg) {
            float* dst = smp ? p.out + O_CS + ((size_t)(layer * 32 + (seg - 256)) * 2) * FF + c0 : p.out + O_CP + ((size_t)(layer * 2 + (seg >> 7)) * 2) * FF + c0;
#pragma unroll
            for (int e = 0; e < 8; ++e) { dst[e] = um2[e]; dst[FF + e] = um1[e]; }
        }
    }
}
DI void prep_phase(Frame& F) {
    const Params& p = F.p;
    const int gw = F.bid * NWAVES + F.wave, NGW = F.G * NWAVES, lane = F.lane;
    const float qscale = 0.08838834764831845f * 1.4426950408889634f;
    for (int m = gw; m < T; m += NGW) {
        const bf16* src = F.QKV + (size_t)m * NQKV + lane * 8;
        const bool smp = m >= TP; const int b = smp ? (m - TP) >> 5 : m >> 12, t = smp ? (m - TP) & 31 : m & 4095;
        const int hc = (lane & 15) * 8;
        u32x4 xq[4], xk[4], xv[4];
#pragma unroll
        for (int j = 0; j < 4; ++j) { xq[j] = *(const u32x4*)(src + j * 512); xk[j] = *(const u32x4*)(src + D + j * 512); xv[j] = *(const u32x4*)(src + 2 * D + j * 512); }
        float* ko = nullptr; float* vo = nullptr;
        if (smp) { ko = p.out + O_KSM + (size_t)(m - TP) * D + lane * 8; vo = p.out + O_VSM + (size_t)(m - TP) * D + lane * 8; }
        else if (t >= SEQ - 512) { ko = p.out + O_KP + ((size_t)b * 512 + (t - (SEQ - 512))) * D + lane * 8; vo = p.out + O_VP + ((size_t)b * 512 + (t - (SEQ - 512))) * D + lane * 8; }
        const f32x4 gq0 = *(const f32x4*)(p.b_q_norm + hc), gq1 = *(const f32x4*)(p.b_q_norm + hc + 4);
        const f32x4 gk0 = *(const f32x4*)(p.b_k_norm + hc), gk1 = *(const f32x4*)(p.b_k_norm + hc + 4);
        bf16* qdst = F.QB + (size_t)m * D + lane * 8;
        bf16* kdst = smp ? F.KS + ((size_t)b * SROWS + 512 + t) * D + lane * 8 : F.KN + (size_t)m * D + lane * 8;
#pragma unroll
        for (int j = 0; j < 4; ++j) {
            { const u32x4 x = xq[j]; const float v[8] = {bflo(x.x), bfhi(x.x), bflo(x.y), bfhi(x.y), bflo(x.z), bfhi(x.z), bflo(x.w), bfhi(x.w)};
              float ss = 0.f;
#pragma unroll
              for (int e = 0; e < 8; ++e) ss += v[e] * v[e];
              ss += __shfl_xor(ss, 1); ss += __shfl_xor(ss, 2); ss += __shfl_xor(ss, 4); ss += __shfl_xor(ss, 8);
              const float rstd = rsqrtf(ss * (1.f / HD) + EPS) * qscale;
              u32x4 o; o.x = pk2(v[0] * rstd * gq0.x, v[1] * rstd * gq0.y); o.y = pk2(v[2] * rstd * gq0.z, v[3] * rstd * gq0.w);
              o.z = pk2(v[4] * rstd * gq1.x, v[5] * rstd * gq1.y); o.w = pk2(v[6] * rstd * gq1.z, v[7] * rstd * gq1.w);
              *(u32x4*)(qdst + j * 512) = o; }
            { const u32x4 x = xk[j]; const float v[8] = {bflo(x.x), bfhi(x.x), bflo(x.y), bfhi(x.y), bflo(x.z), bfhi(x.z), bflo(x.w), bfhi(x.w)};
              float ss = 0.f;
#pragma unroll
              for (int e = 0; e < 8; ++e) ss += v[e] * v[e];
              ss += __shfl_xor(ss, 1); ss += __shfl_xor(ss, 2); ss += __shfl_xor(ss, 4); ss += __shfl_xor(ss, 8);
              const float rstd = rsqrtf(ss * (1.f / HD) + EPS);
              const f32x4 a = {v[0] * rstd * gk0.x, v[1] * rstd * gk0.y, v[2] * rstd * gk0.z, v[3] * rstd * gk0.w};
              const f32x4 c = {v[4] * rstd * gk1.x, v[5] * rstd * gk1.y, v[6] * rstd * gk1.z, v[7] * rstd * gk1.w};
              u32x4 o; o.x = pk2(a.x, a.y); o.y = pk2(a.z, a.w); o.z = pk2(c.x, c.y); o.w = pk2(c.z, c.w);
              *(u32x4*)(kdst + j * 512) = o;
              if (ko) { *(f32x4*)(ko + j * 512) = a; *(f32x4*)(ko + j * 512 + 4) = c; } }
            if (vo) { const u32x4 x = xv[j];
              const f32x4 a = {bflo(x.x), bfhi(x.x), bflo(x.y), bfhi(x.y)}, c = {bflo(x.z), bfhi(x.z), bflo(x.w), bfhi(x.w)};
              *(f32x4*)(vo + j * 512) = a; *(f32x4*)(vo + j * 512 + 4) = c; }
        }
    }
    { const int gt = F.bid * NTHR + F.tid, NGT = F.G * NTHR;
      for (int it0 = gt; it0 < 32 * 512 * (D / 8); it0 += 4 * NGT) {
          f32x4 a[4], c[4];
#pragma unroll
          for (int j = 0; j < 4; ++j) { const int it = it0 + j * NGT; if (it < 32 * 512 * (D / 8)) { const int row = it >> 8, cc = (it & 255) * 8;
              a[j] = *(const f32x4*)(p.cache_k + (size_t)row * D + cc); c[j] = *(const f32x4*)(p.cache_k + (size_t)row * D + cc + 4); } }
#pragma unroll
          for (int j = 0; j < 4; ++j) { const int it = it0 + j * NGT; if (it < 32 * 512 * (D / 8)) { const int row = it >> 8, cc = (it & 255) * 8, b = row >> 9, jj = row & 511;
              u32x4 o; o.x = pk2(a[j].x, a[j].y); o.y = pk2(a[j].z, a[j].w); o.z = pk2(c[j].x, c[j].y); o.w = pk2(c[j].z, c[j].w);
              *(u32x4*)(F.KS + ((size_t)b * SROWS + jj) * D + cc) = o; } }
      } }
    { LAS bf16* tile = (LAS bf16*)(F.lds + F.wave * 16640);
      constexpr int NP = 2 * 64 * 16, NS = 32 * 16 * 9;
      for (int it = gw; it < NP + NS; it += NGW) {
          int nrows = 64; bf16* dst; int dstride;
          if (it < NP) {
              const int h = it & 15, tb = (it >> 4) & 63, b = it >> 10;
              const bf16* src = F.QKV + (size_t)(b * SEQ + tb * 64) * NQKV + 2 * D + h * HD + 2 * lane;
              unsigned u[64];
#pragma unroll
              for (int i = 0; i < 64; ++i) u[i] = *(const unsigned*)(src + (size_t)i * NQKV);
#pragma unroll
              for (int i = 0; i < 64; ++i) *(LAS unsigned*)(tile + i * 130 + 2 * lane) = u[i];
              dst = F.VT + ((size_t)(b * 16 + h) * HD) * SEQ + tb * 64; dstride = SEQ;
          } else {
              const int r = it - NP, h = r & 15, jb = (r >> 4) % 9, b = r / 144;
              if (jb < 8) {
                  const float* src = p.cache_v + ((size_t)(b * 512 + jb * 64) * NH + h) * HD + 2 * lane;
#pragma unroll
                  for (int hh = 0; hh < 2; ++hh) {
                      f32x2 x[32];
#pragma unroll
                      for (int i = 0; i < 32; ++i) x[i] = *(const f32x2*)(src + (size_t)(32 * hh + i) * D);
#pragma unroll
                      for (int i = 0; i < 32; ++i) *(LAS unsigned*)(tile + (32 * hh + i) * 130 + 2 * lane) = pk2(x[i].x, x[i].y);
                  }
              } else {
                  nrows = 32;
                  const bf16* src = F.QKV + (size_t)(TP + b * 32) * NQKV + 2 * D + h * HD + 2 * lane;
                  unsigned u[32];
#pragma unroll
                  for (int i = 0; i < 32; ++i) u[i] = *(const unsigned*)(src + (size_t)i * NQKV);
#pragma unroll
                  for (int i = 0; i < 32; ++i) *(LAS unsigned*)(tile + i * 130 + 2 * lane) = u[i];
              }
              dst = F.VTS + ((size_t)(b * 16 + h) * HD) * SROWS + jb * 64; dstride = SROWS;
          }
          asm volatile("s_waitcnt lgkmcnt(0)" ::: "memory");
          const int tp = lane & 31, dh = lane >> 5;
          if (2 * tp < nrows) {
#pragma unroll 8
              for (int pp = 0; pp < 64; ++pp) { const int dv = 2 * pp + dh;
                  const unsigned lo = tile[(2 * tp) * 130 + dv], hi = tile[(2 * tp + 1) * 130 + dv];
                  *(unsigned*)(dst + (size_t)dv * dstride + 2 * tp) = lo | (hi << 16); }
          }
          asm volatile("s_waitcnt lgkmcnt(0)" ::: "memory");
      } }
}
DI void attn_step(f32x16 (&oacc)[4], float& mrun, float& lsum, const bf16x8 (&qf)[8], const bf16x8 (&kf)[8], const bf16x8 (&vf)[2][4], int relb, const float* __restrict__ bias, float bias0, int hf) {
    constexpr float L2E = 1.4426950408889634f;
    f32x16 s; for (int i = 0; i < 16; ++i) s[i] = 0.f;
#pragma unroll
    for (int kk = 0; kk < 8; ++kk) s = MFMA32(kf[kk], qf[kk], s);
    if (relb + 31 <= -128) {
#pragma unroll
        for (int i = 0; i < 16; ++i) s[i] += bias0;
    } else {
#pragma unroll
        for (int i = 0; i < 16; ++i) { int rel = relb + crow(i, hf); rel = rel < -128 ? -128 : (rel > 63 ? 63 : rel); s[i] += bias[(rel + 128) * NH] * L2E; }
    }
    float mt = s[0];
#pragma unroll
    for (int i = 1; i < 16; ++i) mt = fmaxf(mt, s[i]);
    mt = fmaxf(mt, __shfl_xor(mt, 32));
    const float mnew = fmaxf(mrun, mt), alpha = exp2f(mrun - mnew);
    mrun = mnew;
    float ps = 0.f; float pv[16];
#pragma unroll
    for (int i = 0; i < 16; ++i) { pv[i] = exp2f(s[i] - mnew); ps += pv[i]; }
    lsum = lsum * alpha + ps;
#pragma unroll
    for (int bl = 0; bl < 4; ++bl)
#pragma unroll
        for (int i = 0; i < 16; ++i) oacc[bl][i] *= alpha;
#pragma unroll
    for (int kb = 0; kb < 2; ++kb) {
        u32x4 pb; pb.x = pk2(pv[8 * kb], pv[8 * kb + 1]); pb.y = pk2(pv[8 * kb + 2], pv[8 * kb + 3]); pb.z = pk2(pv[8 * kb + 4], pv[8 * kb + 5]); pb.w = pk2(pv[8 * kb + 6], pv[8 * kb + 7]);
        const bf16x8 pfr = __builtin_bit_cast(bf16x8, pb);
#pragma unroll
        for (int bl = 0; bl < 4; ++bl) oacc[bl] = MFMA32(vf[kb][bl], pfr, oacc[bl]);
    }
}
constexpr int AK_STRIDE = 136, AV_STRIDE = 72, A_KBYTES = 64 * AK_STRIDE * 2, A_VBYTES = 128 * AV_STRIDE * 2, A_BUF = A_KBYTES + A_VBYTES;
static_assert(2 * A_BUF <= LDS_BYTES - 16 && 8 * 16384 + 8 * 256 <= LDS_BYTES - 16, "attention lds");

DI void attn_phase(Frame& F) {
    const Params& p = F.p;
    const int lane = F.lane, w = F.wave, tid = F.tid, r = lane & 31, hf = lane >> 5;
    constexpr float L2E = 1.4426950408889634f;
    for (int su = F.bid; su < 512; su += F.G) {
        const int h = su & 15, b = su >> 4, qrow0 = TP + b * 32;
        const bf16* kbase = F.KS + (size_t)(b * SROWS) * D + h * HD; const bf16* vbase = F.VTS + ((size_t)(b * 16 + h) * HD) * SROWS;
        const float* bias = p.b_rel_bias + h; const float bias0 = bias[0] * L2E;
        bf16x8 qf[8];
        { const bf16* qp = F.QB + (size_t)(qrow0 + r) * D + h * HD + 8 * hf;
#pragma unroll
          for (int kk = 0; kk < 8; ++kk) qf[kk] = *(const bf16x8*)(qp + 16 * kk); }
        f32x16 oacc[4];
#pragma unroll
        for (int bl = 0; bl < 4; ++bl) for (int i = 0; i < 16; ++i) oacc[bl][i] = 0.f;
        float mrun = -1e30f, lsum = 0.f;
        for (int kt = w; kt < 17; kt += 8) {
            bf16x8 kf[8], vf[2][4];
            { const bf16* kp = kbase + (size_t)(32 * kt + r) * D + 8 * hf;
#pragma unroll
              for (int kk = 0; kk < 8; ++kk) kf[kk] = *(const bf16x8*)(kp + 16 * kk); }
#pragma unroll
            for (int kb = 0; kb < 2; ++kb)
#pragma unroll
                for (int bl = 0; bl < 4; ++bl) { const bf16* vp = vbase + (size_t)(32 * bl + r) * SROWS + 32 * kt + 16 * kb + 4 * hf;
                    const u32x2 v0 = *(const u32x2*)vp, v1 = *(const u32x2*)(vp + 8); u32x4 vv; vv.x = v0.x; vv.y = v0.y; vv.z = v1.x; vv.w = v1.y; vf[kb][bl] = __builtin_bit_cast(bf16x8, vv); }
            attn_step(oacc, mrun, lsum, qf, kf, vf, -512 + 32 * kt - r, bias, bias0, hf);
        }
        lsum += __shfl_xor(lsum, 32);
        LAS float* op = (LAS float*)(F.lds + w * 16384); LAS float* ml = (LAS float*)(F.lds + 8 * 16384 + w * 256);
#pragma unroll
        for (int bl = 0; bl < 4; ++bl)
#pragma unroll
            for (int i = 0; i < 16; ++i) op[(32 * bl + crow(i, hf)) * 32 + r] = oacc[bl][i];
        if (hf == 0) { ml[2 * r] = mrun; ml[2 * r + 1] = lsum; }
        __syncthreads();
        { const int q = tid & 31, dv0 = (tid >> 5) * 8;
          float mw[8], M = -1e30f;
#pragma unroll
          for (int ww = 0; ww < 8; ++ww) { mw[ww] = ((LAS float*)(F.lds + 8 * 16384 + ww * 256))[2 * q]; M = fmaxf(M, mw[ww]); }
          float o[8] = {0.f, 0.f, 0.f, 0.f, 0.f, 0.f, 0.f, 0.f}, L = 0.f;
#pragma unroll
          for (int ww = 0; ww < 8; ++ww) { const float sc = exp2f(mw[ww] - M); L += sc * ((LAS float*)(F.lds + 8 * 16384 + ww * 256))[2 * q + 1];
              const LAS float* pp = (LAS float*)(F.lds + ww * 16384) + dv0 * 32 + q;
#pragma unroll
              for (int e = 0; e < 8; ++e) o[e] += sc * pp[e * 32]; }
          const float inv = 1.f / L;
          u32x4 ov; ov.x = pk2(o[0] * inv, o[1] * inv); ov.y = pk2(o[2] * inv, o[3] * inv); ov.z = pk2(o[4] * inv, o[5] * inv); ov.w = pk2(o[6] * inv, o[7] * inv);
          *(u32x4*)(F.HB + (size_t)(qrow0 + q) * D + h * HD + dv0) = ov; }
        __syncthreads();
    }
    for (int unit = F.bid; unit < 512; unit += F.G) {
        const int cq = unit & 15, h = (unit >> 4) & 15, b = unit >> 8;
        const int cw = 4 * cq + (w >> 1), qrow0 = b * SEQ + cw * 64 + (w & 1) * 32;
        const int kc_lo = (4 * cq - 8) > 0 ? 4 * cq - 8 : 0, kc_hi = 4 * cq + 3;
        const float* bias = p.b_rel_bias + h; const float bias0 = bias[0] * L2E;
        const bf16* kg = F.KN + (size_t)(b * SEQ) * D + h * HD;
        const bf16* vg = F.VT + ((size_t)(b * 16 + h) * HD) * SEQ;
        const int kr0 = tid >> 4, ks0 = tid & 15, vr0 = tid >> 3, vs0 = tid & 7;
        u32x4 st[4];
#define A_GLOAD(kc) do { st[0] = *(const u32x4*)(kg + (size_t)((kc) * 64 + kr0) * D + ks0 * 8); st[1] = *(const u32x4*)(kg + (size_t)((kc) * 64 + kr0 + 32) * D + ks0 * 8); \
                         st[2] = *(const u32x4*)(vg + (size_t)vr0 * SEQ + (kc) * 64 + vs0 * 8); st[3] = *(const u32x4*)(vg + (size_t)(vr0 + 64) * SEQ + (kc) * 64 + vs0 * 8); } while (0)
#define A_LWRITE(buf) do { LAS bf16* kb_ = (LAS bf16*)(F.lds + (buf) * A_BUF); LAS bf16* vb_ = (LAS bf16*)(F.lds + (buf) * A_BUF + A_KBYTES); \
                         *(LAS u32x4*)(kb_ + kr0 * AK_STRIDE + ks0 * 8) = st[0]; *(LAS u32x4*)(kb_ + (kr0 + 32) * AK_STRIDE + ks0 * 8) = st[1]; \
                         *(LAS u32x4*)(vb_ + vr0 * AV_STRIDE + vs0 * 8) = st[2]; *(LAS u32x4*)(vb_ + (vr0 + 64) * AV_STRIDE + vs0 * 8) = st[3]; } while (0)
        A_GLOAD(kc_lo);
        bf16x8 qf[8];
        { const bf16* qp = F.QB + (size_t)(qrow0 + r) * D + h * HD + 8 * hf;
#pragma unroll
          for (int kk = 0; kk < 8; ++kk) qf[kk] = *(const bf16x8*)(qp + 16 * kk); }
        f32x16 oacc[4];
#pragma unroll
        for (int bl = 0; bl < 4; ++bl) for (int i = 0; i < 16; ++i) oacc[bl][i] = 0.f;
        float mrun = -1e30f, lsum = 0.f;
        A_LWRITE(0);
        __syncthreads();
        for (int kc = kc_lo; kc <= kc_hi; ++kc) {
            const int cur = (kc - kc_lo) & 1;
            if (kc < kc_hi) A_GLOAD(kc + 1);
            if (kc >= cw - 8 && kc <= cw) {
                const LAS bf16* Kb = (const LAS bf16*)(F.lds + cur * A_BUF); const LAS bf16* Vb = (const LAS bf16*)(F.lds + cur * A_BUF + A_KBYTES);
#pragma unroll 1
                for (int t = 0; t < 2; ++t) {
                    bf16x8 kf[8], vf[2][4];
#pragma unroll
                    for (int kk = 0; kk < 8; ++kk) kf[kk] = *(const LAS bf16x8*)(Kb + (32 * t + r) * AK_STRIDE + 16 * kk + 8 * hf);
#pragma unroll
                    for (int kb = 0; kb < 2; ++kb)
#pragma unroll
                        for (int bl = 0; bl < 4; ++bl) { const LAS bf16* vp = Vb + (32 * bl + r) * AV_STRIDE + 32 * t + 16 * kb + 4 * hf;
                            const u32x2 v0 = *(const LAS u32x2*)vp, v1 = *(const LAS u32x2*)(vp + 8); u32x4 vv; vv.x = v0.x; vv.y = v0.y; vv.z = v1.x; vv.w = v1.y; vf[kb][bl] = __builtin_bit_cast(bf16x8, vv); }
                    attn_step(oacc, mrun, lsum, qf, kf, vf, (kc * 64 + 32 * t) - (cw * 64 + (w & 1) * 32) - r, bias, bias0, hf);
                }
            }
            if (kc < kc_hi) A_LWRITE(cur ^ 1);
            __syncthreads();
        }
#undef A_GLOAD
#undef A_LWRITE
        lsum += __shfl_xor(lsum, 32);
        const float inv = 1.f / lsum;
        bf16* op = F.HB + (size_t)(qrow0 + r) * D + h * HD;
#pragma unroll
        for (int bl = 0; bl < 4; ++bl)
#pragma unroll
            for (int g4 = 0; g4 < 4; ++g4) {
                u32x2 o; o.x = pk2(oacc[bl][4 * g4] * inv, oacc[bl][4 * g4 + 1] * inv); o.y = pk2(oacc[bl][4 * g4 + 2] * inv, oacc[bl][4 * g4 + 3] * inv);
                *(u32x2*)(op + 32 * bl + 8 * g4 + 4 * hf) = o;
            }
    }
}

#define XB_TMO      128
#define XB_XCNT(j)  (256  + 64 * (j))
#define XB_XSUB(j)  (1280 + 64 * (j))
#define XB_XGEN(j)  (2304 + 64 * (j))
#define XB_TOP      3328
#define XB_TOPGEN   3392
#define XCD_BAR_WORDS 3456
#define XB_SPIN_CAP (1u << 18)
DI unsigned xb_ld(unsigned* p)              { return __hip_atomic_load(p, __ATOMIC_RELAXED, __HIP_MEMORY_SCOPE_AGENT); }
DI unsigned xb_add(unsigned* p, unsigned v) { return __hip_atomic_fetch_add(p, v, __ATOMIC_RELAXED, __HIP_MEMORY_SCOPE_AGENT); }
DI unsigned xb_xcc_id() { return (unsigned)__builtin_amdgcn_s_getreg((3 << 11) | 20) & 0xFu; }
#define XB_SPIN(cond, bar) do { unsigned _sp = 0; while (cond) { __builtin_amdgcn_s_sleep(1); \
    if ((++_sp & 255u) == 0u) { if (xb_ld(&(bar)[XB_TMO])) break; if (_sp > XB_SPIN_CAP) { atomicAdd(&(bar)[XB_TMO], 1u); break; } } } } while (0)
struct XcdBarrier { unsigned* bar; unsigned x; volatile LAS unsigned* st; };
DI XcdBarrier xcd_barrier_post(unsigned* bar, volatile LAS unsigned* st) {
    XcdBarrier b; b.bar = bar; b.x = xb_xcc_id(); b.st = st;
    if (threadIdx.x == 0) (void)xb_add(&bar[XB_XCNT(b.x)], 1u);
    return b;
}
DI void xcd_barrier_complete(unsigned* bar, unsigned x, unsigned& nloc, unsigned& nx) {
    const unsigned G = gridDim.x * gridDim.y * gridDim.z;
    unsigned sum, cnt, mine, sp = 0u;
    for (;;) {
        sum = 0u; cnt = 0u; mine = 0u;
#pragma unroll
        for (unsigned j = 0; j < 16; ++j) { const unsigned c = xb_ld(&bar[XB_XCNT(j)]); sum += c; cnt += (c > 0u) ? 1u : 0u; mine = (j == x) ? c : mine; }
        if (sum == G) break;
        __builtin_amdgcn_s_sleep(1);
        if ((++sp & 255u) == 0u) { if (xb_ld(&bar[XB_TMO])) break; if (sp > XB_SPIN_CAP) { atomicAdd(&bar[XB_TMO], 1u); break; } }
    }
    nloc = mine > 0u ? mine : 1u; nx = cnt > 0u ? cnt : 1u;
}
DI void xcd_barrier(const XcdBarrier& b) {
    asm volatile("s_waitcnt vmcnt(0)" ::: "memory");
    __syncthreads();
    if (threadIdx.x == 0) {
        unsigned* bar = b.bar;
        __builtin_amdgcn_s_waitcnt(0);
        unsigned nloc = b.st[0], nx = b.st[1];
        if (nloc == 0u) { xcd_barrier_complete(bar, b.x, nloc, nx); b.st[0] = nloc; b.st[1] = nx; }
        const unsigned old = xb_add(&bar[XB_XSUB(b.x)], 1u);
        const unsigned gen = old / nloc;
        if (old + 1u == (gen + 1u) * nloc) {
            __builtin_amdgcn_fence(__ATOMIC_RELEASE, "agent");
            asm volatile("s_waitcnt vmcnt(0)" ::: "memory");
            const unsigned og = xb_add(&bar[XB_TOP], 1u);
            const unsigned tg = og / nx;
            if (og + 1u == (tg + 1u) * nx) xb_add(&bar[XB_TOPGEN], 1u);
            else XB_SPIN(xb_ld(&bar[XB_TOPGEN]) == tg, bar);
            __builtin_amdgcn_fence(__ATOMIC_ACQUIRE, "agent");
            xb_add(&bar[XB_XGEN(b.x)], 1u);
            asm volatile("s_waitcnt vmcnt(0)" ::: "memory");
        } else {
            XB_SPIN(xb_ld(&bar[XB_XGEN(b.x)]) == gen, bar);
            __builtin_amdgcn_fence(__ATOMIC_ACQUIRE, "agent");
            asm volatile("s_waitcnt vmcnt(0)" ::: "memory");
        }
    }
    __syncthreads();
}

enum { PH_P0, PH_G1, PH_GLA_A, PH_SCAN, PH_GLA_C, PH_G2, PH_RMS_F0, PH_G3_0, PH_CONV0, PH_G4_0, PH_RMS_M1, PH_G5, PH_PREP, PH_ATTN, PH_G6, PH_RMS_F1, PH_G3_1, PH_CONV1, PH_G4_1, PH_FIN, NPH };

__global__ void __launch_bounds__(NTHR, 2) fwd_megakernel(Params prm) {
    extern __shared__ __attribute__((aligned(16))) unsigned char lds_raw[];
    cg::grid_group grid = cg::this_grid();
    float* const X0 = prm.out;
    volatile LAS unsigned* bst = (volatile LAS unsigned*)((LAS unsigned char*)lds_raw + (LDS_BYTES - 16));
    if (threadIdx.x < 4) bst[threadIdx.x] = 0u;
    __syncthreads();
    XcdBarrier xbar = xcd_barrier_post((unsigned*)(prm.ws + WS_BAR), bst);
    for (int ph = prm.ph_lo; ph < prm.ph_hi; ++ph) {
      for (int rep = 0, nrep = 1 + ((REP_MASK >> ph) & 1); rep < nrep; ++rep) {
        int tid_ = threadIdx.x; asm volatile("" : "+v"(tid_));
        size_t zoff = 0; asm volatile("" : "+s"(zoff));
        unsigned char* ws = prm.ws + zoff;
        float* X = X0 + zoff;
        Frame F;
        F.p = prm; F.lds = (LAS unsigned char*)lds_raw;
        F.tid = tid_; F.lane = F.tid & 63; F.wave = __builtin_amdgcn_readfirstlane(F.tid >> 6); F.G = gridDim.x; F.bid = blockIdx.x;
        F.WinA = (bf16*)(ws + WS_WINA); F.WoA = (bf16*)(ws + WS_WOA); F.Wqkv = (bf16*)(ws + WS_WQKV); F.WoB = (bf16*)(ws + WS_WOB);
        F.Fin0 = (bf16*)(ws + WS_FIN0); F.Fin1 = (bf16*)(ws + WS_FIN1); F.Fdn0 = (bf16*)(ws + WS_FDN0); F.Fdn1 = (bf16*)(ws + WS_FDN1);
        F.LB = (float*)(ws + WS_LB); F.HB = (bf16*)(ws + WS_HB); F.QB = (bf16*)(ws + WS_QB);
        F.LOGF = (float*)(ws + WS_LOGF); F.VB = (bf16*)(ws + WS_VB); F.SG = (bf16*)(ws + WS_SG); F.OI = (float*)(ws + WS_OI); F.LOCAL = (float*)(ws + WS_LOCAL); F.DEC = (float*)(ws + WS_DEC);
        F.QKV = (bf16*)(ws + WS_QKV); F.KN = (bf16*)(ws + WS_KN); F.KS = (bf16*)(ws + WS_KS); F.VT = (bf16*)(ws + WS_VT); F.VTS = (bf16*)(ws + WS_VTS);
        F.UP = (bf16*)(ws + WS_UP); F.ACT = (bf16*)(ws + WS_ACT);
        switch (ph) {
        case PH_P0: if (EN_MASK & 1) p0_phase(F); break;
        case PH_GLA_A: if (EN_MASK & 2) gla_a_phase(F); break;
        case PH_SCAN: if (EN_MASK & 4) scan_phase(F); break;
        case PH_GLA_C: if (EN_MASK & 8) gla_c_phase(F); break;
        case PH_RMS_F0: if (EN_MASK & 16) rms_phase(F, X, prm.x_sample, prm.norm_ffn, (const float*)(ws + WS_PART), X + (size_t)TP * D); break;
        case PH_RMS_M1: if (EN_MASK & 16) rms_phase(F, X, X + (size_t)TP * D, prm.norm_mix + D, (const float*)(ws + WS_PART), X + (size_t)TP * D); break;
        case PH_RMS_F1: if (EN_MASK & 16) rms_phase(F, X, X + (size_t)TP * D, prm.norm_ffn + D, (const float*)(ws + WS_PART), X + (size_t)TP * D); break;
        case PH_FIN: fin_phase(F, X + (size_t)TP * D, (const float*)(ws + WS_PART)); break;
        case PH_CONV0: if (EN_MASK & 32) conv_phase(F, 0); break;
        case PH_CONV1: if (EN_MASK & 32) conv_phase(F, 1); break;
        case PH_PREP: if (EN_MASK & 64) prep_phase(F); break;
        case PH_ATTN: if (EN_MASK & 128) attn_phase(F); break;
        default: if (EN_MASK & 256) {
            pg8::Gemm g; pg8::Epi E; E.mode = 2; E.ldo = D; E.ob = nullptr; E.of = X; E.resP = X; E.resS = X + (size_t)TP * D;
            E.lb = F.LB; E.logf = F.LOGF; E.wsb = ws;
            g.A = F.HB; g.M = T; g.K = D; g.N = D; g.Bt = F.WoA;
            if (ph == PH_G1) { g.Bt = F.WinA; g.N = NWIN; E.mode = 0; }
            else if (ph == PH_G2) { g.Bt = F.WoA; E.resP = prm.x_prompt; E.resS = prm.x_sample; }
            else if (ph == PH_G3_0 || ph == PH_G3_1) { g.Bt = (ph == PH_G3_1) ? F.Fin1 : F.Fin0; g.N = NUP; E.mode = 1; E.ob = F.UP; E.ldo = NUP; }
            else if (ph == PH_G4_0 || ph == PH_G4_1) { g.A = F.ACT; g.Bt = (ph == PH_G4_1) ? F.Fdn1 : F.Fdn0; g.K = FF; }
            else if (ph == PH_G5) { g.Bt = F.Wqkv; g.N = NQKV; E.mode = 1; E.ob = F.QKV; E.ldo = NQKV; }
            else { g.Bt = F.WoB; }
            E.part = (float*)(ws + WS_PART);
            pg8::StaticOrder S; S.init(g.M, g.N, g.K, F.G, F.bid, E.mode == 2);
            pg8::gemm_phase(F.lds, g, S, E, F.tid);
        } break;
        }
      }
        if (prm.ph_hi > 1000) grid.sync();
        if (ph + 1 < prm.ph_hi) xcd_barrier(xbar);
    }
}

extern "C" void kernel_launch(void* const* d_in, const int* in_sizes, int n_in, void* d_out, int out_size, void* d_ws, size_t ws_size, hipStream_t stream) {
    static int grid_blocks = 0;
    if (!grid_blocks) {
        int dev = 0, cus = 0, per_cu = 0;
        hipGetDevice(&dev);
        hipDeviceGetAttribute(&cus, hipDeviceAttributeMultiprocessorCount, dev);
        if (hipFuncSetAttribute((const void*)fwd_megakernel, hipFuncAttributeMaxDynamicSharedMemorySize, LDS_BYTES) != hipSuccess) fprintf(stderr, "kernel_launch: hipFuncSetAttribute failed\n");
        hipOccupancyMaxActiveBlocksPerMultiprocessor(&per_cu, (const void*)fwd_megakernel, NTHR, LDS_BYTES);
        if (per_cu < 1) per_cu = 1;
        if (per_cu > 1) per_cu = 1;
        grid_blocks = cus * per_cu;
        if (n_in != 21 || (size_t)out_size != O_END || ws_size < WS_END) fprintf(stderr, "kernel_launch: unexpected sizes n_in %d out %d ws %zu (need %zu)\n", n_in, out_size, ws_size, (size_t)WS_END);
    }
    Params p{};
    p.x_prompt = (const float*)d_in[0]; p.x_sample = (const float*)d_in[1]; p.state_a_S = (const float*)d_in[2]; p.cache_k = (const float*)d_in[3]; p.cache_v = (const float*)d_in[4];
    p.conv_state = (const float*)d_in[5]; p.norm_mix = (const float*)d_in[6]; p.norm_ffn = (const float*)d_in[7]; p.a_w_in = (const float*)d_in[8]; p.a_gamma = (const float*)d_in[9];
    p.a_norm_o = (const float*)d_in[10]; p.a_w_o = (const float*)d_in[11]; p.b_w_qkv = (const float*)d_in[12]; p.b_q_norm = (const float*)d_in[13]; p.b_k_norm = (const float*)d_in[14];
    p.b_rel_bias = (const float*)d_in[15]; p.b_w_o = (const float*)d_in[16]; p.f_w_in = (const float*)d_in[17]; p.f_conv_w = (const float*)d_in[18]; p.f_conv_b = (const float*)d_in[19];
    p.f_w_down = (const float*)d_in[20];
    p.out = (float*)d_out; p.ws = (unsigned char*)d_ws;
#if MK_N_LAUNCHES == 1
    p.ph_lo = 0; p.ph_hi = NPH;
    if (hipMemsetAsync((char*)d_ws + WS_BAR, 0, 16384, stream) != hipSuccess) fprintf(stderr, "kernel_launch: memset of barrier words failed\n");
    void* args[] = {&p};
    hipError_t e = hipLaunchCooperativeKernel((const void*)fwd_megakernel, dim3(grid_blocks), dim3(NTHR), args, LDS_BYTES, stream);
    if (e != hipSuccess) fprintf(stderr, "cooperative launch failed: %s (grid %d)\n", hipGetErrorString(e), grid_blocks);
#else
    for (int ph = 0; ph < NPH; ++ph) {
        p.ph_lo = ph; p.ph_hi = ph + 1;
        hipLaunchKernelGGL(fwd_megakernel, dim3(grid_blocks), dim3(NTHR), LDS_BYTES, stream, p);
    }
#endif
}
```

```cpp
#include <hip/hip_runtime.h>
#include <hip/hip_cooperative_groups.h>
#include <cstdio>
#include <cstdint>
namespace cg = cooperative_groups;

#define DI __device__ __forceinline__
#define LAS __attribute__((address_space(3)))
#define GAS __attribute__((address_space(1)))
typedef unsigned short bf16;
typedef short bf16x8 __attribute__((ext_vector_type(8)));
typedef float f32x2 __attribute__((ext_vector_type(2)));
typedef float f32x4 __attribute__((ext_vector_type(4)));
typedef float f32x16 __attribute__((ext_vector_type(16)));
typedef unsigned u32x2 __attribute__((ext_vector_type(2)));
typedef unsigned u32x4 __attribute__((ext_vector_type(4)));
typedef __bf16 bf16x2_t __attribute__((ext_vector_type(2)));

#ifndef EN_MASK
#define EN_MASK 0xffffu
#endif
#ifndef REP_MASK
#define REP_MASK 0
#endif
#ifndef MK_N_LAUNCHES
#define MK_N_LAUNCHES 1
#endif

constexpr int D = 2048, TP = 8192, TS = 1024, T = TP + TS, SEQ = 4096, NH = 16, HD = 128, FF = 5632;
constexpr int NQKV = 3 * D, NWIN = 4 * D, NUP = 2 * FF;
constexpr int SROWS = 544;
constexpr float EPS = 1e-6f;
constexpr int NWAVES = 8, NTHR = 512;
constexpr int LDS_BYTES = 147456;

constexpr size_t MiB = 1u << 20;
constexpr size_t WS_WINA = 0, WS_WOA = 32 * MiB, WS_WQKV = 40 * MiB, WS_WOB = 64 * MiB, WS_FIN0 = 72 * MiB, WS_FIN1 = 116 * MiB, WS_FDN0 = 160 * MiB, WS_FDN1 = 182 * MiB;
constexpr size_t WS_LB = 204 * MiB, WS_HB = 205 * MiB, WS_QB = 241 * MiB, WS_MIX = 277 * MiB;
constexpr size_t WS_LOGF = WS_MIX, WS_VB = WS_MIX + 72 * MiB, WS_SG = WS_MIX + 108 * MiB, WS_OI = WS_MIX + 144 * MiB, WS_LOCAL = WS_MIX + 216 * MiB, WS_DEC = WS_MIX + 376 * MiB;
constexpr size_t WS_QKV = WS_MIX, WS_KN = WS_MIX + 108 * MiB, WS_KS = WS_MIX + 140 * MiB, WS_VT = WS_MIX + 208 * MiB, WS_VTS = WS_MIX + 240 * MiB;
constexpr size_t WS_UP = WS_MIX, WS_ACT = WS_MIX + 198 * MiB;
constexpr size_t WS_PART = WS_MIX + 300 * MiB;
constexpr size_t WS_BAR = WS_LB + 64 * 1024;
constexpr size_t WS_END = WS_MIX + 378 * MiB;

constexpr size_t O_YP = 0, O_YS = O_YP + (size_t)TP * D, O_SP = O_YS + (size_t)TS * D, O_SS = O_SP + 2 * 16 * 128 * 128, O_KP = O_SS + 32 * 16 * 128 * 128,
                 O_VP = O_KP + 2 * 512 * 2048, O_KSM = O_VP + 2 * 512 * 2048, O_VSM = O_KSM + 32 * 32 * 2048, O_CP = O_VSM + 32 * 32 * 2048, O_CS = O_CP + 2 * 2 * 2 * FF,
                 O_END = O_CS + 2 * 32 * 2 * FF;

struct Params {
    const float* x_prompt; const float* x_sample; const float* state_a_S; const float* cache_k; const float* cache_v; const float* conv_state;
    const float* norm_mix; const float* norm_ffn; const float* a_w_in; const float* a_gamma; const float* a_norm_o; const float* a_w_o;
    const float* b_w_qkv; const float* b_q_norm; const float* b_k_norm; const float* b_rel_bias; const float* b_w_o;
    const float* f_w_in; const float* f_conv_w; const float* f_conv_b; const float* f_w_down;
    float* out; unsigned char* ws; int ph_lo, ph_hi;
};

DI unsigned pk2(float lo, float hi) { f32x2 v = {lo, hi}; return __builtin_bit_cast(unsigned, __builtin_convertvector(v, bf16x2_t)); }
DI bf16 f2bf(float f) { return (bf16)(pk2(f, 0.f) & 0xffffu); }
DI float bflo(unsigned p) { return __uint_as_float(p << 16); }
DI float bfhi(unsigned p) { return __uint_as_float(p & 0xffff0000u); }
DI float wave_sum(float v) {
#pragma unroll
    for (int o = 1; o < 64; o <<= 1) v += __shfl_xor(v, o);
    return v;
}
DI float fsigmoid(float z) { return 1.f / (1.f + __expf(-z)); }
DI float fsilu(float z) { return z / (1.f + __expf(-z)); }
DI int crow(int reg, int h) { return (reg & 3) + 8 * (reg >> 2) + 4 * h; }
#define MFMA32(a, b, c) __builtin_amdgcn_mfma_f32_32x32x16_bf16((a), (b), (c), 0, 0, 0)

namespace pg8 {
constexpr int BM = 256, BK = 64, HALF = 128, HTB = HALF * BK * 2, STAGE_BYTES = 8 * HTB, NXCD = 8, WGM = 8;
DI int lds_byte(int r, int c) { const int st = (r >> 4) * 2 + (c >> 5), rr = r & 15, cc = c & 31, ob = rr * 64 + cc * 2; return st * 1024 + (ob ^ (((ob >> 9) & 1) << 5)); }
DI void stage_rc(int b, int& R, int& C) { const int st = b / 1024, sb = b % 1024, swz = sb ^ (((sb >> 9) & 1) << 5); R = (st >> 1) * 16 + swz / 64; C = (st & 1) * 32 + (swz % 64) / 2; }
DI int perm32(int rho) { const int n = rho >> 4, i = rho & 15; return 8 * (i >> 2) + 4 * n + (i & 3); }
struct Unit { int pm, pn, kb0, nkt, slice; };
struct Gemm { const bf16* A; const bf16* Bt; int M, N, K; };
struct StaticOrder {
    int nM, nN, nwg, G, c, tail, nblk, nitems;
    DI void init(int M, int N, int K, int G_, int c_, int tail_) { tail = tail_; nM = tail ? TP / BM : M / BM; nN = N / BM; nwg = nM * nN; G = G_; c = c_; nblk = K / 128; nitems = nwg + (tail ? 256 : 0); }
    DI bool next(int i, Unit& u) const {
        const long L = (long)i * G + c; if (L >= nitems) return false;
        u.slice = -1; u.kb0 = 0; u.nkt = nblk * 2;
        if (L >= nwg) { const int j = (int)L - nwg, uu = j & 31; u.slice = j >> 5; u.pm = TP / BM + (uu >> 3); u.pn = uu & 7;
            const int base = nblk / 8, rem = nblk % 8; u.kb0 = u.slice * base + (u.slice < rem ? u.slice : rem); u.nkt = 2 * (base + (u.slice < rem ? 1 : 0)); return true; }
        int wgid = (int)L; { const int q = nwg / NXCD, r = nwg % NXCD, xcd = wgid % NXCD, off = wgid / NXCD; wgid = (xcd < r ? xcd * (q + 1) : r * (q + 1) + (xcd - r) * q) + off; }
        const int nig = WGM * nN, gid = wgid / nig, fm = gid * WGM, gsz = (nM - fm) < WGM ? (nM - fm) : WGM;
        u.pm = fm + ((wgid % nig) % gsz); u.pn = (wgid % nig) / gsz; return true;
    }
};

struct Epi {
    int mode;
    int ldo;
    bf16* ob;
    float* of; const float* resP; const float* resS;
    const float* lb; float* logf; unsigned char* wsb;
    float* part;
    const float* cw; const float* cbias; bf16* act; float* edge;
    DI bool perm() const { return mode != 2; }
    DI void operator()(const f32x4 (&acc)[2][2][4][2], const Unit& u, int wr, int wc, int fr, int fq) const {
        const int row0 = u.pm * BM + wr * 64 + fr;
        if (mode == 2 && u.slice >= 0) {
            const int col0 = u.pn * BM + wc * 32 + 4 * fq;
#pragma unroll
            for (int ai = 0; ai < 2; ++ai)
#pragma unroll
                for (int m = 0; m < 4; ++m) {
                    float* op = part + ((size_t)u.slice * TS + (row0 + ai * HALF + m * 16 - TP)) * D + col0;
#pragma unroll
                    for (int bj = 0; bj < 2; ++bj)
#pragma unroll
                        for (int n = 0; n < 2; ++n) *(f32x4*)(op + bj * HALF + n * 16) = acc[ai][bj][m][n];
                }
        } else if (mode == 2) {
            const int col0 = u.pn * BM + wc * 32 + 4 * fq;
#pragma unroll
            for (int ai = 0; ai < 2; ++ai) {
                f32x4 rr[4][2][2];
#pragma unroll
                for (int m = 0; m < 4; ++m) {
                    const int row = row0 + ai * HALF + m * 16;
                    const float* rp = (row < TP ? resP + (size_t)row * D : resS + (size_t)(row - TP) * D) + col0;
#pragma unroll
                    for (int bj = 0; bj < 2; ++bj)
#pragma unroll
                        for (int n = 0; n < 2; ++n) rr[m][bj][n] = *(const f32x4*)(rp + bj * HALF + n * 16);
                }
#pragma unroll
                for (int m = 0; m < 4; ++m) {
                    float* op = of + (size_t)(row0 + ai * HALF + m * 16) * D + col0;
#pragma unroll
                    for (int bj = 0; bj < 2; ++bj)
#pragma unroll
                        for (int n = 0; n < 2; ++n) *(f32x4*)(op + bj * HALF + n * 16) = rr[m][bj][n] + acc[ai][bj][m][n];
                }
            }
        } else if (mode == 3) {
            const int cc0 = u.pn * HALF + wc * 32 + 8 * fq;
            float w0[8], w1[8], w2[8], cb[8];
            { const f32x4 a0 = *(const f32x4*)(cw + cc0), a1 = *(const f32x4*)(cw + cc0 + 4), b0 = *(const f32x4*)(cw + FF + cc0), b1 = *(const f32x4*)(cw + FF + cc0 + 4);
              const f32x4 c0 = *(const f32x4*)(cw + 2 * FF + cc0), c1 = *(const f32x4*)(cw + 2 * FF + cc0 + 4), d0 = *(const f32x4*)(cbias + cc0), d1 = *(const f32x4*)(cbias + cc0 + 4);
#pragma unroll
              for (int e = 0; e < 4; ++e) { w0[e] = a0[e]; w0[4 + e] = a1[e]; w1[e] = b0[e]; w1[4 + e] = b1[e]; w2[e] = c0[e]; w2[4 + e] = c1[e]; cb[e] = d0[e]; cb[4 + e] = d1[e]; } }
            float* const eu_first = edge; float* const eg_first = edge + (size_t)(T / 32) * 2 * FF; float* const eu_last = edge + (size_t)(T / 32) * 4 * FF;
#pragma unroll
            for (int ai = 0; ai < 2; ++ai)
#pragma unroll
                for (int m = 0; m < 4; ++m) {
                    const int row = row0 + ai * HALF + m * 16, hb = row >> 5;
                    float a[8];
#pragma unroll
                    for (int n = 0; n < 2; ++n)
#pragma unroll
                        for (int e = 0; e < 4; ++e) {
                            const float cur = acc[ai][0][m][n][e];
                            const float prv = (m & 1) ? acc[ai][0][m - 1][n][e] : 0.f;
                            const int ci = __float_as_int(cur), pi = __float_as_int(prv);
                            const int r1 = __builtin_amdgcn_update_dpp(0, pi, 0x121, 0xf, 0xf, false), r2 = __builtin_amdgcn_update_dpp(0, pi, 0x122, 0xf, 0xf, false);
                            const float p1 = __int_as_float(__builtin_amdgcn_update_dpp(r1, ci, 0x111, 0xf, 0xf, false));
                            const float p2 = __int_as_float(__builtin_amdgcn_update_dpp(r2, ci, 0x112, 0xf, 0xf, false));
                            const int k = 4 * n + e;
                            a[k] = fsilu(cb[k] + p2 * w0[k] + p1 * w1[k] + cur * w2[k]) * acc[ai][1][m][n][e];
                        }
                    const bool first2 = ((m & 1) == 0) && (fr < 2), last2 = ((m & 1) == 1) && (fr >= 14);
                    if (!first2) { u32x4 o; o.x = pk2(a[0], a[1]); o.y = pk2(a[2], a[3]); o.z = pk2(a[4], a[5]); o.w = pk2(a[6], a[7]); *(u32x4*)(act + (size_t)row * FF + cc0) = o; }
                    else { float* du = eu_first + ((size_t)hb * 2 + fr) * FF + cc0; float* dg = eg_first + ((size_t)hb * 2 + fr) * FF + cc0;
                        *(f32x4*)du = acc[ai][0][m][0]; *(f32x4*)(du + 4) = acc[ai][0][m][1]; *(f32x4*)dg = acc[ai][1][m][0]; *(f32x4*)(dg + 4) = acc[ai][1][m][1]; }
                    if (last2) { float* du = eu_last + ((size_t)hb * 2 + (fr - 14)) * FF + cc0; *(f32x4*)du = acc[ai][0][m][0]; *(f32x4*)(du + 4) = acc[ai][0][m][1]; }
                }
        } else if (mode == 1) {
            const int col0 = u.pn * BM + wc * 32 + 8 * fq;
#pragma unroll
            for (int ai = 0; ai < 2; ++ai)
#pragma unroll
                for (int m = 0; m < 4; ++m) {
                    bf16* op = ob + (size_t)(row0 + ai * HALF + m * 16) * ldo + col0;
#pragma unroll
                    for (int bj = 0; bj < 2; ++bj) { const f32x4 v0 = acc[ai][bj][m][0], v1 = acc[ai][bj][m][1];
                        u32x4 o; o.x = pk2(v0.x, v0.y); o.y = pk2(v0.z, v0.w); o.z = pk2(v1.x, v1.y); o.w = pk2(v1.z, v1.w);
                        *(u32x4*)(op + bj * HALF) = o; }
                }
        } else {
            const int type = u.pn >> 3, col0 = (u.pn & 7) * BM + wc * 32 + 8 * fq;
#pragma unroll
            for (int bj = 0; bj < 2; ++bj) {
                const int col = col0 + bj * HALF;
                f32x4 l0 = {0.f, 0.f, 0.f, 0.f}, l1 = l0;
                if (type == 1) { l0 = *(const f32x4*)(lb + col); l1 = *(const f32x4*)(lb + col + 4); }
#pragma unroll
                for (int ai = 0; ai < 2; ++ai)
#pragma unroll
                    for (int m = 0; m < 4; ++m) {
                        const size_t off = (size_t)(row0 + ai * HALF + m * 16) * D + col;
                        f32x4 v0 = acc[ai][bj][m][0], v1 = acc[ai][bj][m][1];
                        if (type == 1) {
#pragma unroll
                            for (int e = 0; e < 4; ++e) { v0[e] = __logf(l0[e] + (1.f - l0[e]) * fsigmoid(v0[e])); v1[e] = __logf(l1[e] + (1.f - l1[e]) * fsigmoid(v1[e])); }
                            *(f32x4*)(logf + off) = v0; *(f32x4*)(logf + off + 4) = v1;
                        } else {
                            if (type == 3) {
#pragma unroll
                                for (int e = 0; e < 4; ++e) { v0[e] = fsilu(v0[e]); v1[e] = fsilu(v1[e]); }
                            }
                            u32x4 o; o.x = pk2(v0.x, v0.y); o.y = pk2(v0.z, v0.w); o.z = pk2(v1.x, v1.y); o.w = pk2(v1.z, v1.w);
                            bf16* dst = (bf16*)(wsb + (type == 0 ? WS_QB : (type == 2 ? WS_VB : WS_SG)));
                            *(u32x4*)(dst + off) = o;
                        }
                    }
            }
        }
    }
};

DI void gemm_phase(LAS unsigned char* lds, const Gemm g, const StaticOrder& S, const Epi& E, const int tid) {
    const int wid = __builtin_amdgcn_readfirstlane(tid >> 6), lane = tid & 63, wr = wid >> 2, wc = wid & 3, fr = lane & 15, fq = lane >> 4;
    const int K = g.K;
    const bool PERM = E.perm();
    unsigned voffA[2], voffB[2];
#pragma unroll
    for (int i = 0; i < 2; ++i) { int R, C; stage_rc(tid * 16 + i * 8192, R, C); const int Rb = PERM ? ((R & ~31) + perm32(R & 31)) : R;
        voffA[i] = (unsigned)(R * K + C) * 2u; voffB[i] = (unsigned)(Rb * K + C) * 2u; }
    const size_t kstep = (size_t)(BK * 2);
    const size_t hstep = (size_t)HALF * K * 2;
    const size_t tstep = 2 * hstep;
    const unsigned ldsw = (unsigned)wid * 1024u;
    const int aoff = lds_byte(wr * 64 + fr, fq * 8), boff = lds_byte(wc * 32 + fr, fq * 8);
#define PG8_SA(b, h) (((b) * 2 + (h)) * HTB)
#define PG8_SB(b, h) ((4 + (b) * 2 + (h)) * HTB)
#define PG8_STAGE(bufoff, gbase, voff) do { _Pragma("unroll") for (int _i = 0; _i < 2; ++_i) \
        __builtin_amdgcn_global_load_lds((const unsigned*)((const char*)(gbase) + (voff)[_i]), (LAS unsigned*)(lds + (bufoff) + ldsw + _i * 8192), 16, 0, 0); } while (0)
#define PG8_LDA(dst, b, h) do { _Pragma("unroll") for (int m = 0; m < 4; ++m) _Pragma("unroll") for (int k = 0; k < 2; ++k) dst[m][k] = *(const LAS bf16x8*)(lds + PG8_SA(b, h) + aoff + m * 2048 + k * 1024); } while (0)
#define PG8_LDB(dst, b, h) do { _Pragma("unroll") for (int n = 0; n < 2; ++n) _Pragma("unroll") for (int k = 0; k < 2; ++k) dst[n][k] = *(const LAS bf16x8*)(lds + PG8_SB(b, h) + boff + n * 2048 + k * 1024); } while (0)
#define PG8_MMA(ai, bj, At, Bt) do { __builtin_amdgcn_s_setprio(1); _Pragma("unroll") for (int m = 0; m < 4; ++m) _Pragma("unroll") for (int n = 0; n < 2; ++n) _Pragma("unroll") for (int k = 0; k < 2; ++k) \
        acc[ai][bj][m][n] = __builtin_amdgcn_mfma_f32_16x16x32_bf16(Bt[n][k], At[m][k], acc[ai][bj][m][n], 0, 0, 0); __builtin_amdgcn_s_setprio(0); } while (0)
#define PG8_WAIT_V(n) asm volatile("s_waitcnt vmcnt(" #n ")" ::: "memory")
#define PG8_WAIT_L(n) asm volatile("s_waitcnt lgkmcnt(" #n ")" ::: "memory")
#define PG8_BAR __builtin_amdgcn_s_barrier()
#define PG8_SCHED __builtin_amdgcn_sched_barrier(0)
    Unit cur, nxt; int ui = 0;
    if (!S.next(0, cur)) return;
    f32x4 acc[2][2][4][2];
#pragma unroll
    for (int a = 0; a < 2; ++a)
#pragma unroll
        for (int b = 0; b < 2; ++b)
#pragma unroll
            for (int m = 0; m < 4; ++m)
#pragma unroll
                for (int n = 0; n < 2; ++n) acc[a][b][m][n] = (f32x4){0.f, 0.f, 0.f, 0.f};
    bf16x8 At[4][2], B0[2][2], B1[2][2];
    const char* cA = (const char*)g.A + (size_t)cur.pm * tstep + (size_t)cur.kb0 * 256; const char* cB = (const char*)g.Bt + (size_t)cur.pn * tstep + (size_t)cur.kb0 * 256;
    PG8_STAGE(PG8_SB(0, 0), cB, voffB); PG8_STAGE(PG8_SA(0, 0), cA, voffA); PG8_STAGE(PG8_SB(0, 1), cB + hstep, voffB); PG8_STAGE(PG8_SA(0, 1), cA + hstep, voffA);
    if (wr == 1) PG8_BAR;
    PG8_WAIT_V(4); PG8_BAR;
    PG8_STAGE(PG8_SB(1, 0), cB + kstep, voffB); PG8_STAGE(PG8_SA(1, 0), cA + kstep, voffA); PG8_STAGE(PG8_SB(1, 1), cB + hstep + kstep, voffB);
    PG8_WAIT_V(6); PG8_BAR;
    for (;;) {
        const bool has_next = S.next(ui + 1, nxt);
        const char* nA = has_next ? (const char*)g.A + (size_t)nxt.pm * tstep + (size_t)nxt.kb0 * 256 : cA; const char* nB = has_next ? (const char*)g.Bt + (size_t)nxt.pn * tstep + (size_t)nxt.kb0 * 256 : cB;
        const int nt = cur.nkt;
        for (int t = 0; t < nt; t += 2) {
            const bool last = (t == nt - 2);
            const char* a1 = cA + (size_t)(t + 1) * kstep;
            const char* a2 = last ? nA : cA + (size_t)(t + 2) * kstep; const char* b2 = last ? nB : cB + (size_t)(t + 2) * kstep;
            const char* a3 = a2 + kstep; const char* b3 = b2 + kstep;
            PG8_LDB(B0, 0, 0); PG8_SCHED; PG8_LDA(At, 0, 0); PG8_STAGE(PG8_SA(1, 1), a1 + hstep, voffA);
            PG8_WAIT_L(8); PG8_BAR; PG8_WAIT_L(0); PG8_MMA(0, 0, At, B0); PG8_BAR; PG8_SCHED;
            PG8_LDB(B1, 0, 1); PG8_STAGE(PG8_SB(0, 0), b2, voffB);
            PG8_BAR; PG8_WAIT_L(0); PG8_MMA(0, 1, At, B1); PG8_BAR;
            PG8_LDA(At, 0, 1); PG8_STAGE(PG8_SA(0, 0), a2, voffA);
            PG8_BAR; PG8_WAIT_L(0); PG8_MMA(1, 0, At, B0); PG8_BAR; PG8_SCHED;
            PG8_STAGE(PG8_SB(0, 1), b2 + hstep, voffB);
            PG8_WAIT_V(6); PG8_BAR; PG8_MMA(1, 1, At, B1); PG8_BAR;
            PG8_LDB(B0, 1, 0); PG8_SCHED; PG8_LDA(At, 1, 0); PG8_STAGE(PG8_SA(0, 1), a2 + hstep, voffA);
            PG8_WAIT_L(8); PG8_BAR; PG8_WAIT_L(0); PG8_MMA(0, 0, At, B0); PG8_BAR; PG8_SCHED;
            PG8_LDB(B1, 1, 1); PG8_STAGE(PG8_SB(1, 0), b3, voffB);
            PG8_BAR; PG8_WAIT_L(0); PG8_MMA(0, 1, At, B1); PG8_BAR;
            PG8_LDA(At, 1, 1); PG8_STAGE(PG8_SA(1, 0), a3, voffA);
            PG8_BAR; PG8_WAIT_L(0); PG8_MMA(1, 0, At, B0); PG8_BAR; PG8_SCHED;
            PG8_STAGE(PG8_SB(1, 1), b3 + hstep, voffB);
            PG8_WAIT_V(6); PG8_BAR; PG8_MMA(1, 1, At, B1); PG8_BAR;
        }
        E(acc, cur, wr, wc, fr, fq);
        if (!has_next) break;
#pragma unroll
        for (int a = 0; a < 2; ++a)
#pragma unroll
            for (int b = 0; b < 2; ++b)
#pragma unroll
                for (int m = 0; m < 4; ++m)
#pragma unroll
                    for (int n = 0; n < 2; ++n) acc[a][b][m][n] = (f32x4){0.f, 0.f, 0.f, 0.f};
        cur = nxt; cA = nA; cB = nB; ++ui;
    }
    PG8_WAIT_V(0);
    if (wr == 0) PG8_BAR;
    PG8_BAR;
#undef PG8_SA
#undef PG8_SB
#undef PG8_STAGE
#undef PG8_LDA
#undef PG8_LDB
#undef PG8_MMA
#undef PG8_WAIT_V
#undef PG8_WAIT_L
#undef PG8_BAR
#undef PG8_SCHED
}
}

struct Frame {
    Params p; LAS unsigned char* lds; int tid, lane, wave, G, bid;
    bf16 *WinA, *WoA, *Wqkv, *WoB, *Fin0, *Fin1, *Fdn0, *Fdn1;
    float* LB; bf16 *HB, *QB;
    float* LOGF; bf16 *VB, *SG; float *OI, *LOCAL, *DEC;
    bf16 *QKV, *KN, *KS, *VT, *VTS, *UP, *ACT;
};

DI void transpose_item(const float* __restrict__ W, int K, int N, bf16* __restrict__ WT, LAS float* scr, int item, int lane, const bool ilv = false) {
    const int nblk = N / 64, kb = item / nblk, nb = item % nblk, k0 = 64 * kb, n0 = 64 * nb;
    const int lr = lane >> 4, lc = (lane & 15) * 4;
    f32x4 v[16];
    const float* src = W + (size_t)(k0 + lr) * N + n0 + lc;
#pragma unroll
    for (int i = 0; i < 16; ++i) v[i] = *(const f32x4*)(src + (size_t)(4 * i) * N);
#pragma unroll
    for (int i = 0; i < 16; ++i) { LAS float* d = scr + (4 * i + lr) * 65 + lc; d[0] = v[i].x; d[1] = v[i].y; d[2] = v[i].z; d[3] = v[i].w; }
    asm volatile("s_waitcnt lgkmcnt(0)" ::: "memory");
    const int c = lane & 7;
#pragma unroll
    for (int j = 0; j < 8; ++j) { const int n = (lane >> 3) + 8 * j; const LAS float* s = scr + (8 * c) * 65 + n;
        u32x4 o; o.x = pk2(s[0 * 65], s[1 * 65]); o.y = pk2(s[2 * 65], s[3 * 65]); o.z = pk2(s[4 * 65], s[5 * 65]); o.w = pk2(s[6 * 65], s[7 * 65]);
        int nd = n0 + n; if (ilv) nd = (nd < FF) ? (((nd >> 7) << 8) + (nd & 127)) : ((((nd - FF) >> 7) << 8) + 128 + ((nd - FF) & 127));
        *(u32x4*)(WT + (size_t)nd * K + k0 + 8 * c) = o; }
    asm volatile("s_waitcnt lgkmcnt(0)" ::: "memory");
}
DI void rms_row(const float* __restrict__ xrow, const float* __restrict__ g, bf16* __restrict__ orow, int lane, const float* __restrict__ part, float* __restrict__ xdst) {
    const f32x4* xr = (const f32x4*)xrow + lane; const f32x4* gr = (const f32x4*)g + lane;
    f32x4 v[8]; float s = 0.f;
#pragma unroll
    for (int j = 0; j < 8; ++j) v[j] = xr[64 * j];
    if (part) {
#pragma unroll
        for (int sl = 0; sl < 8; ++sl) { const f32x4* pr = (const f32x4*)(part + (size_t)sl * TS * D) + lane;
#pragma unroll
            for (int j = 0; j < 8; ++j) v[j] += pr[64 * j]; }
#pragma unroll
        for (int j = 0; j < 8; ++j) ((f32x4*)xdst + lane)[64 * j] = v[j];
    }
#pragma unroll
    for (int j = 0; j < 8; ++j) s += (v[j].x * v[j].x + v[j].y * v[j].y) + (v[j].z * v[j].z + v[j].w * v[j].w);
    const float rstd = rsqrtf(wave_sum(s) * (1.f / D) + EPS);
    u32x2* o8 = (u32x2*)orow + lane;
#pragma unroll
    for (int j = 0; j < 8; ++j) { const f32x4 gg = gr[64 * j]; u32x2 o; o.x = pk2(v[j].x * rstd * gg.x, v[j].y * rstd * gg.y); o.y = pk2(v[j].z * rstd * gg.z, v[j].w * rstd * gg.w); o8[64 * j] = o; }
}
DI void rms_phase(Frame& F, const float* srcP, const float* srcS, const float* g, const float* part, float* xs) {
    const int gw = F.bid * NWAVES + F.wave, NGW = F.G * NWAVES;
    for (int m = gw; m < T; m += NGW) {
        if (m < TP) rms_row(srcP + (size_t)m * D, g, F.HB + (size_t)m * D, F.lane, nullptr, nullptr);
        else rms_row(srcS + (size_t)(m - TP) * D, g, F.HB + (size_t)m * D, F.lane, part ? part + (size_t)(m - TP) * D : nullptr, xs + (size_t)(m - TP) * D);
    }
}
DI void fin_phase(Frame& F, float* xs, const float* part) {
    const int gt = F.bid * NTHR + F.tid, NGT = F.G * NTHR;
    for (int it = gt; it < TS * D / 4; it += NGT) {
        f32x4 v = ((const f32x4*)xs)[it];
#pragma unroll
        for (int sl = 0; sl < 8; ++sl) v += ((const f32x4*)(part + (size_t)sl * TS * D))[it];
        ((f32x4*)xs)[it] = v;
    }
}
DI void p0_phase(Frame& F) {
    const Params& p = F.p;
    LAS float* scr = (LAS float*)(F.lds + F.wave * 16640);
    const int gw = F.bid * NWAVES + F.wave, NGW = F.G * NWAVES;
    constexpr int I_WINA = (D / 64) * (NWIN / 64), I_WO = (D / 64) * (D / 64), I_QKV = (D / 64) * (NQKV / 64), I_FIN = (D / 64) * (NUP / 64), I_FDN = (FF / 64) * (D / 64);
    constexpr int NITEMS = I_WINA + 2 * I_WO + I_QKV + 2 * I_FIN + 2 * I_FDN;
    for (int it = gw; it < NITEMS; it += NGW) {
        int r = it;
        if (r < I_WINA) { transpose_item(p.a_w_in, D, NWIN, F.WinA, scr, r, F.lane); continue; } r -= I_WINA;
        if (r < I_WO) { transpose_item(p.a_w_o, D, D, F.WoA, scr, r, F.lane); continue; } r -= I_WO;
        if (r < I_QKV) { transpose_item(p.b_w_qkv, D, NQKV, F.Wqkv, scr, r, F.lane); continue; } r -= I_QKV;
        if (r < I_WO) { transpose_item(p.b_w_o, D, D, F.WoB, scr, r, F.lane); continue; } r -= I_WO;
        if (r < I_FIN) { transpose_item(p.f_w_in, D, NUP, F.Fin0, scr, r, F.lane, true); continue; } r -= I_FIN;
        if (r < I_FIN) { transpose_item(p.f_w_in + (size_t)D * NUP, D, NUP, F.Fin1, scr, r, F.lane, true); continue; } r -= I_FIN;
        if (r < I_FDN) { transpose_item(p.f_w_down, FF, D, F.Fdn0, scr, r, F.lane); continue; } r -= I_FDN;
        transpose_item(p.f_w_down + (size_t)FF * D, FF, D, F.Fdn1, scr, r, F.lane);
    }
    for (int c = F.bid * NTHR + F.tid; c < D; c += F.G * NTHR) {
        const float g0 = p.a_gamma[c], g1 = p.a_gamma[D + c], g2 = p.a_gamma[2 * D + c];
        const float mx = fmaxf(g0, fmaxf(g1, g2));
        const float e0 = __expf(g0 - mx), e1 = __expf(g1 - mx), e2 = __expf(g2 - mx);
        F.LB[c] = e0 / (e0 + e1 + e2);
    }
    rms_phase(F, p.x_prompt, p.x_sample, p.norm_mix, nullptr, nullptr);
}

constexpr int GLA_UNITS = 2048 + 512;
constexpr int QT_STRIDE = 136, TT_STRIDE = 72;
constexpr int L_BCUM = 0, L_QT = 32768, L_KT = L_QT + 64 * QT_STRIDE * 2, L_KHT = L_KT + 64 * QT_STRIDE * 2, L_VT = L_KHT + 128 * TT_STRIDE * 2, L_PM = L_VT + 128 * TT_STRIDE * 2, L_GLA_END = L_PM + 64 * TT_STRIDE * 2;
static_assert(L_GLA_END <= LDS_BYTES, "gla lds");

DI f32x16 mma_lds(const LAS bf16* A, int astride, int arow0, const LAS bf16* B, int bstride, int brow0, int nks, int lane) {
    f32x16 acc; for (int i = 0; i < 16; ++i) acc[i] = 0.f;
    const int r = lane & 31, hf = lane >> 5;
    const LAS bf16* ap = A + (arow0 + r) * astride + 8 * hf; const LAS bf16* bp = B + (brow0 + r) * bstride + 8 * hf;
    for (int ks = 0; ks < nks; ++ks) { const bf16x8 a = *(const LAS bf16x8*)(ap + 16 * ks), b = *(const LAS bf16x8*)(bp + 16 * ks); acc = MFMA32(a, b, acc); }
    return acc;
}

template <int BLK>
DI void gla_a_unit(Frame& F, int u, int row0, int h) {
    LAS float* bcum = (LAS float*)(F.lds + L_BCUM);
    LAS bf16* qt = (LAS bf16*)(F.lds + L_QT); LAS bf16* kt = (LAS bf16*)(F.lds + L_KT); LAS bf16* khT = (LAS bf16*)(F.lds + L_KHT);
    LAS bf16* vT = (LAS bf16*)(F.lds + L_VT); LAS bf16* Pm = (LAS bf16*)(F.lds + L_PM);
    const int tid = F.tid, lane = F.lane, w = F.wave;
    const size_t hoff = (size_t)h * HD;
    constexpr int SEG = BLK / 4;
    { const int seg = tid >> 7, kc = tid & 127; float a = 0.f;
      const float* lp = F.LOGF + (size_t)(row0 + seg * SEG) * D + hoff + kc;
#pragma unroll
      for (int t = 0; t < SEG; ++t) { a += lp[(size_t)t * D]; bcum[(seg * SEG + t) * 128 + kc] = a; }
      __syncthreads();
      float off = 0.f;
      for (int s = 0; s < seg; ++s) off += bcum[(s * SEG + SEG - 1) * 128 + kc];
      __syncthreads();
      if (seg > 0) {
#pragma unroll
          for (int t = 0; t < SEG; ++t) bcum[(seg * SEG + t) * 128 + kc] += off;
      }
      __syncthreads(); }
    for (int i = tid; i < BLK * 16; i += NTHR) {
        const int t = i >> 4, c0 = (i & 15) * 8;
        const size_t goff = (size_t)(row0 + t) * D + hoff + c0;
        const u32x4 qv = *(const u32x4*)(F.QB + goff);
        const u32x4 vv = *(const u32x4*)(F.VB + goff);
        const f32x4 lf0 = *(const f32x4*)(F.LOGF + goff), lf1 = *(const f32x4*)(F.LOGF + goff + 4);
        float q[8] = {bflo(qv.x), bfhi(qv.x), bflo(qv.y), bfhi(qv.y), bflo(qv.z), bfhi(qv.z), bflo(qv.w), bfhi(qv.w)};
        float lf[8] = {lf0.x, lf0.y, lf0.z, lf0.w, lf1.x, lf1.y, lf1.z, lf1.w};
        float qtv[8], ktv[8], qhv[8], khv[8];
#pragma unroll
        for (int e = 0; e < 8; ++e) {
            const float b = bcum[t * 128 + c0 + e], bmid = bcum[(BLK / 2 - 1) * 128 + c0 + e], bend = bcum[(BLK - 1) * 128 + c0 + e];
            const float kk = 1.f - __expf(lf[e]);
            qtv[e] = q[e] * __expf(b - bmid); ktv[e] = kk * __expf(bmid - b); qhv[e] = q[e] * __expf(b); khv[e] = kk * __expf(bend - b);
            if (t == BLK - 1) F.DEC[(size_t)u * 128 + c0 + e] = __expf(bend);
        }
        u32x4 o; o.x = pk2(qtv[0], qtv[1]); o.y = pk2(qtv[2], qtv[3]); o.z = pk2(qtv[4], qtv[5]); o.w = pk2(qtv[6], qtv[7]);
        *(LAS u32x4*)(qt + t * QT_STRIDE + c0) = o;
        o.x = pk2(ktv[0], ktv[1]); o.y = pk2(ktv[2], ktv[3]); o.z = pk2(ktv[4], ktv[5]); o.w = pk2(ktv[6], ktv[7]);
        *(LAS u32x4*)(kt + t * QT_STRIDE + c0) = o;
        o.x = pk2(qhv[0], qhv[1]); o.y = pk2(qhv[2], qhv[3]); o.z = pk2(qhv[4], qhv[5]); o.w = pk2(qhv[6], qhv[7]);
        *(u32x4*)(F.QB + goff) = o;
        const unsigned vw[4] = {vv.x, vv.y, vv.z, vv.w};
#pragma unroll
        for (int e = 0; e < 8; ++e) {
            khT[(c0 + e) * TT_STRIDE + t] = f2bf(khv[e]);
            vT[(c0 + e) * TT_STRIDE + t] = (bf16)((e & 1) ? (vw[e >> 1] >> 16) : (vw[e >> 1] & 0xffffu));
        }
    }
    __syncthreads();
    const int r = lane & 31, hf = lane >> 5;
#pragma unroll
    for (int q2 = 0; q2 < 2; ++q2) {
        const int tl = w * 2 + q2, mt = tl >> 2, nt = tl & 3;
        const f32x16 acc = mma_lds(khT, TT_STRIDE, 32 * mt, vT, TT_STRIDE, 32 * nt, BLK / 16, lane);
        float* lp = F.LOCAL + (size_t)u * 16384 + 32 * nt + r;
#pragma unroll
        for (int i = 0; i < 16; ++i) lp[(size_t)(32 * mt + crow(i, hf)) * 128] = acc[i];
    }
    constexpr int NT2 = BLK / 32;
    if (w < NT2 * NT2) {
        const int mt = w / NT2, nt = w % NT2;
        if (nt > mt) {
#pragma unroll
            for (int i = 0; i < 16; ++i) Pm[(32 * mt + crow(i, hf)) * TT_STRIDE + 32 * nt + r] = 0;
        } else {
            const f32x16 acc = mma_lds(qt, QT_STRIDE, 32 * mt, kt, QT_STRIDE, 32 * nt, 8, lane);
#pragma unroll
            for (int i = 0; i < 16; ++i) { const int t = 32 * mt + crow(i, hf), s = 32 * nt + r; Pm[t * TT_STRIDE + s] = (s <= t) ? f2bf(acc[i]) : (bf16)0; }
        }
    }
    __syncthreads();
    if (w < NT2 * 4) {
        const int mt = w >> 2, nt = w & 3;
        const f32x16 acc = mma_lds(Pm, TT_STRIDE, 32 * mt, vT, TT_STRIDE, 32 * nt, BLK / 16, lane);
        float* op = F.OI + (size_t)(row0 + 32 * mt) * D + hoff + 32 * nt + r;
#pragma unroll
        for (int i = 0; i < 16; ++i) op[(size_t)crow(i, hf) * D] = acc[i];
    }
    __syncthreads();
}
DI void gla_a_phase(Frame& F) {
    for (int u = F.bid; u < GLA_UNITS; u += F.G) {
        if (u < 2048) { const int b = u >> 10, h = (u >> 6) & 15, c = u & 63; gla_a_unit<64>(F, u, b * SEQ + c * 64, h); }
        else { const int su = u - 2048, b = su >> 4, h = su & 15; gla_a_unit<32>(F, u, TP + b * 32, h); }
    }
}
DI void scan_phase(Frame& F) {
    const int gt = F.bid * NTHR + F.tid, NGT = F.G * NTHR;
    for (int it = gt; it < 32 * 4096; it += NGT) {
        const int bh = it >> 12, e = (it & 4095) * 4, kc = e >> 7;
        f32x4 S = {0.f, 0.f, 0.f, 0.f};
        float* __restrict__ lp = F.LOCAL + (size_t)(bh * 64) * 16384 + e; const float* __restrict__ dp = F.DEC + (size_t)(bh * 64) * 128 + kc;
        for (int c0 = 0; c0 < 64; c0 += 8) {
            f32x4 loc[8]; float d[8];
#pragma unroll
            for (int j = 0; j < 8; ++j) { loc[j] = *(const f32x4*)(lp + (size_t)(c0 + j) * 16384); d[j] = dp[(c0 + j) * 128]; }
#pragma unroll
            for (int j = 0; j < 8; ++j) { *(f32x4*)(lp + (size_t)(c0 + j) * 16384) = S; S = S * d[j] + loc[j]; }
        }
        *(f32x4*)(F.p.out + O_SP + (size_t)bh * 16384 + e) = S;
    }
    for (int it0 = gt; it0 < 512 * 4096; it0 += 4 * NGT) {
        f32x4 S0[4], loc[4]; float d[4];
#pragma unroll
        for (int j = 0; j < 4; ++j) { const int it = it0 + j * NGT; if (it < 512 * 4096) { const int bh = it >> 12, e = (it & 4095) * 4, kc = e >> 7;
            S0[j] = *(const f32x4*)(F.p.state_a_S + (size_t)bh * 16384 + e); loc[j] = *(const f32x4*)(F.LOCAL + (size_t)(2048 + bh) * 16384 + e); d[j] = F.DEC[(size_t)(2048 + bh) * 128 + kc]; } }
#pragma unroll
        for (int j = 0; j < 4; ++j) { const int it = it0 + j * NGT; if (it < 512 * 4096) { const int bh = it >> 12, e = (it & 4095) * 4;
            *(f32x4*)(F.p.out + O_SS + (size_t)bh * 16384 + e) = S0[j] * d[j] + loc[j]; } }
    }
}
constexpr int OB_STRIDE = 132;
template <int BLK>
DI void gla_c_unit(Frame& F, const float* __restrict__ S, int row0, int h) {
    LAS float* ob = (LAS float*)F.lds;
    const int tid = F.tid, lane = F.lane, w = F.wave, r = lane & 31, hf = lane >> 5;
    const size_t hoff = (size_t)h * HD;
    if (w < (BLK / 32) * 4) {
        const int mt = w >> 2, nt = w & 3;
        f32x16 acc; for (int i = 0; i < 16; ++i) acc[i] = 0.f;
        const bf16* ap = F.QB + (size_t)(row0 + 32 * mt + r) * D + hoff + 8 * hf;
        const float* sp = S + (size_t)(8 * hf) * 128 + 32 * nt + r;
#pragma unroll
        for (int ks = 0; ks < 8; ++ks) {
            const bf16x8 a = *(const bf16x8*)(ap + 16 * ks);
            float sv[8];
#pragma unroll
            for (int e = 0; e < 8; ++e) sv[e] = sp[(size_t)(16 * ks + e) * 128];
            u32x4 bb; bb.x = pk2(sv[0], sv[1]); bb.y = pk2(sv[2], sv[3]); bb.z = pk2(sv[4], sv[5]); bb.w = pk2(sv[6], sv[7]);
            acc = MFMA32(a, __builtin_bit_cast(bf16x8, bb), acc);
        }
        const float* oi = F.OI + (size_t)(row0 + 32 * mt) * D + hoff + 32 * nt + r;
#pragma unroll
        for (int i = 0; i < 16; ++i) { const int t = crow(i, hf); ob[(32 * mt + t) * OB_STRIDE + 32 * nt + r] = acc[i] + oi[(size_t)t * D]; }
    }
    __syncthreads();
    {
        constexpr int TPR = NTHR / BLK;
        constexpr int CPT = 128 / TPR;
        const int t = tid / TPR, j = tid % TPR, c0 = j * CPT;
        float v[CPT]; float ss = 0.f;
#pragma unroll
        for (int e = 0; e < CPT; ++e) { v[e] = ob[t * OB_STRIDE + c0 + e]; ss += v[e] * v[e]; }
#pragma unroll
        for (int o = 1; o < TPR; o <<= 1) ss += __shfl_xor(ss, o);
        const float rstd = rsqrtf(ss * (1.f / HD) + EPS);
        const size_t goff = (size_t)(row0 + t) * D + hoff + c0;
#pragma unroll
        for (int e8 = 0; e8 < CPT / 8; ++e8) {
            const u32x4 sg = *(const u32x4*)(F.SG + goff + 8 * e8);
            const f32x4 n0 = *(const f32x4*)(F.p.a_norm_o + c0 + 8 * e8), n1 = *(const f32x4*)(F.p.a_norm_o + c0 + 8 * e8 + 4);
            const float* vv = v + 8 * e8;
            u32x4 o;
            o.x = pk2(vv[0] * rstd * n0.x * bflo(sg.x), vv[1] * rstd * n0.y * bfhi(sg.x));
            o.y = pk2(vv[2] * rstd * n0.z * bflo(sg.y), vv[3] * rstd * n0.w * bfhi(sg.y));
            o.z = pk2(vv[4] * rstd * n1.x * bflo(sg.z), vv[5] * rstd * n1.y * bfhi(sg.z));
            o.w = pk2(vv[6] * rstd * n1.z * bflo(sg.w), vv[7] * rstd * n1.w * bfhi(sg.w));
            *(u32x4*)(F.HB + goff + 8 * e8) = o;
        }
    }
    __syncthreads();
}
DI void gla_c_phase(Frame& F) {
    for (int u = F.bid; u < GLA_UNITS; u += F.G) {
        if (u < 2048) { const int b = u >> 10, h = (u >> 6) & 15, c = u & 63; gla_c_unit<64>(F, F.LOCAL + (size_t)u * 16384, b * SEQ + c * 64, h); }
        else { const int su = u - 2048, b = su >> 4, h = su & 15; gla_c_unit<32>(F, F.p.state_a_S + (size_t)su * 16384, TP + b * 32, h); }
    }
}
DI void convfix_phase(Frame& F, int layer, const float* edge) {
    const Params& p = F.p;
    const int gt = F.bid * NTHR + F.tid, NGT = F.G * NTHR;
    constexpr int NCG = FF / 8, NHB = T / 32;
    const float* cw = p.f_conv_w + (size_t)layer * 3 * FF; const float* cbp = p.f_conv_b + (size_t)layer * FF;
    const float* eu_first = edge; const float* eg_first = edge + (size_t)NHB * 2 * FF; const float* eu_last = edge + (size_t)NHB * 4 * FF;
    for (int it = gt; it < NHB * NCG; it += NGT) {
        const int hb = it / NCG, c0 = (it % NCG) * 8;
        const bool smp = hb >= 256; const bool first = smp || ((hb & 127) == 0), lastb = smp || ((hb & 127) == 127);
        float um2[8], um1[8], u0[8], u1[8], g0[8], g1[8], w0[8], w1[8], w2[8], bb[8];
#pragma unroll
        for (int e = 0; e < 8; ++e) { w0[e] = cw[c0 + e]; w1[e] = cw[FF + c0 + e]; w2[e] = cw[2 * FF + c0 + e]; bb[e] = cbp[c0 + e]; um2[e] = 0.f; um1[e] = 0.f;
            u0[e] = eu_first[((size_t)hb * 2) * FF + c0 + e]; u1[e] = eu_first[((size_t)hb * 2 + 1) * FF + c0 + e];
            g0[e] = eg_first[((size_t)hb * 2) * FF + c0 + e]; g1[e] = eg_first[((size_t)hb * 2 + 1) * FF + c0 + e]; }
        if (first) {
            if (smp) { const float* st = p.conv_state + ((size_t)(layer * 32 + (hb - 256)) * 2) * FF + c0;
#pragma unroll
                for (int e = 0; e < 8; ++e) { um2[e] = st[e]; um1[e] = st[FF + e]; } }
        } else {
#pragma unroll
            for (int e = 0; e < 8; ++e) { um2[e] = eu_last[((size_t)(hb - 1) * 2) * FF + c0 + e]; um1[e] = eu_last[((size_t)(hb - 1) * 2 + 1) * FF + c0 + e]; }
        }
        float a0[8], a1[8];
#pragma unroll
        for (int e = 0; e < 8; ++e) { a0[e] = fsilu(bb[e] + um2[e] * w0[e] + um1[e] * w1[e] + u0[e] * w2[e]) * g0[e]; a1[e] = fsilu(bb[e] + um1[e] * w0[e] + u0[e] * w1[e] + u1[e] * w2[e]) * g1[e]; }
        u32x4 o; o.x = pk2(a0[0], a0[1]); o.y = pk2(a0[2], a0[3]); o.z = pk2(a0[4], a0[5]); o.w = pk2(a0[6], a0[7]);
        *(u32x4*)(F.ACT + (size_t)(hb * 32) * FF + c0) = o;
        o.x = pk2(a1[0], a1[1]); o.y = pk2(a1[2], a1[3]); o.z = pk2(a1[4], a1[5]); o.w = pk2(a1[6], a1[7]);
        *(u32x4*)(F.ACT + (size_t)(hb * 32 + 1) * FF + c0) = o;
        if (lastb) {
            float* dst = smp ? p.out + O_CS + ((size_t)(layer * 32 + (hb - 256)) * 2) * FF + c0 : p.out + O_CP + ((size_t)(layer * 2 + (hb >> 7)) * 2) * FF + c0;
#pragma unroll
            for (int e = 0; e < 8; ++e) { dst[e] = eu_last[((size_t)hb * 2) * FF + c0 + e]; dst[FF + e] = eu_last[((size_t)hb * 2 + 1) * FF + c0 + e]; }
        }
    }
}
DI void prep_phase(Frame& F) {
    const Params& p = F.p;
    const int gw = F.bid * NWAVES + F.wave, NGW = F.G * NWAVES, lane = F.lane;
    const float qscale = 0.08838834764831845f * 1.4426950408889634f;
    for (int m = gw; m < T; m += NGW) {
        const bf16* src = F.QKV + (size_t)m * NQKV + lane * 8;
        const bool smp = m >= TP; const int b = smp ? (m - TP) >> 5 : m >> 12, t = smp ? (m - TP) & 31 : m & 4095;
        const int hc = (lane & 15) * 8;
        u32x4 xq[4], xk[4], xv[4];
#pragma unroll
        for (int j = 0; j < 4; ++j) { xq[j] = *(const u32x4*)(src + j * 512); xk[j] = *(const u32x4*)(src + D + j * 512); xv[j] = *(const u32x4*)(src + 2 * D + j * 512); }
        float* ko = nullptr; float* vo = nullptr;
        if (smp) { ko = p.out + O_KSM + (size_t)(m - TP) * D + lane * 8; vo = p.out + O_VSM + (size_t)(m - TP) * D + lane * 8; }
        else if (t >= SEQ - 512) { ko = p.out + O_KP + ((size_t)b * 512 + (t - (SEQ - 512))) * D + lane * 8; vo = p.out + O_VP + ((size_t)b * 512 + (t - (SEQ - 512))) * D + lane * 8; }
        const f32x4 gq0 = *(const f32x4*)(p.b_q_norm + hc), gq1 = *(const f32x4*)(p.b_q_norm + hc + 4);
        const f32x4 gk0 = *(const f32x4*)(p.b_k_norm + hc), gk1 = *(const f32x4*)(p.b_k_norm + hc + 4);
        bf16* qdst = F.QB + (size_t)m * D + lane * 8;
        bf16* kdst = smp ? F.KS + ((size_t)b * SROWS + 512 + t) * D + lane * 8 : F.KN + (size_t)m * D + lane * 8;
#pragma unroll
        for (int j = 0; j < 4; ++j) {
            { const u32x4 x = xq[j]; const float v[8] = {bflo(x.x), bfhi(x.x), bflo(x.y), bfhi(x.y), bflo(x.z), bfhi(x.z), bflo(x.w), bfhi(x.w)};
              float ss = 0.f;
#pragma unroll
              for (int e = 0; e < 8; ++e) ss += v[e] * v[e];
              ss += __shfl_xor(ss, 1); ss += __shfl_xor(ss, 2); ss += __shfl_xor(ss, 4); ss += __shfl_xor(ss, 8);
              const float rstd = rsqrtf(ss * (1.f / HD) + EPS) * qscale;
              u32x4 o; o.x = pk2(v[0] * rstd * gq0.x, v[1] * rstd * gq0.y); o.y = pk2(v[2] * rstd * gq0.z, v[3] * rstd * gq0.w);
              o.z = pk2(v[4] * rstd * gq1.x, v[5] * rstd * gq1.y); o.w = pk2(v[6] * rstd * gq1.z, v[7] * rstd * gq1.w);
              *(u32x4*)(qdst + j * 512) = o; }
            { const u32x4 x = xk[j]; const float v[8] = {bflo(x.x), bfhi(x.x), bflo(x.y), bfhi(x.y), bflo(x.z), bfhi(x.z), bflo(x.w), bfhi(x.w)};
              float ss = 0.f;
#pragma unroll
              for (int e = 0; e < 8; ++e) ss += v[e] * v[e];
              ss += __shfl_xor(ss, 1); ss += __shfl_xor(ss, 2); ss += __shfl_xor(ss, 4); ss += __shfl_xor(ss, 8);
              const float rstd = rsqrtf(ss * (1.f / HD) + EPS);
              const f32x4 a = {v[0] * rstd * gk0.x, v[1] * rstd * gk0.y, v[2] * rstd * gk0.z, v[3] * rstd * gk0.w};
              const f32x4 c = {v[4] * rstd * gk1.x, v[5] * rstd * gk1.y, v[6] * rstd * gk1.z, v[7] * rstd * gk1.w};
              u32x4 o; o.x = pk2(a.x, a.y); o.y = pk2(a.z, a.w); o.z = pk2(c.x, c.y); o.w = pk2(c.z, c.w);
              *(u32x4*)(kdst + j * 512) = o;
              if (ko) { *(f32x4*)(ko + j * 512) = a; *(f32x4*)(ko + j * 512 + 4) = c; } }
            if (vo) { const u32x4 x = xv[j];
              const f32x4 a = {bflo(x.x), bfhi(x.x), bflo(x.y), bfhi(x.y)}, c = {bflo(x.z), bfhi(x.z), bflo(x.w), bfhi(x.w)};
              *(f32x4*)(vo + j * 512) = a; *(f32x4*)(vo + j * 512 + 4) = c; }
        }
    }
    { const int gt = F.bid * NTHR + F.tid, NGT = F.G * NTHR;
      for (int it0 = gt; it0 < 32 * 512 * (D / 8); it0 += 4 * NGT) {
          f32x4 a[4], c[4];
#pragma unroll
          for (int j = 0; j < 4; ++j) { const int it = it0 + j * NGT; if (it < 32 * 512 * (D / 8)) { const int row = it >> 8, cc = (it & 255) * 8;
              a[j] = *(const f32x4*)(p.cache_k + (size_t)row * D + cc); c[j] = *(const f32x4*)(p.cache_k + (size_t)row * D + cc + 4); } }
#pragma unroll
          for (int j = 0; j < 4; ++j) { const int it = it0 + j * NGT; if (it < 32 * 512 * (D / 8)) { const int row = it >> 8, cc = (it & 255) * 8, b = row >> 9, jj = row & 511;
              u32x4 o; o.x = pk2(a[j].x, a[j].y); o.y = pk2(a[j].z, a[j].w); o.z = pk2(c[j].x, c[j].y); o.w = pk2(c[j].z, c[j].w);
              *(u32x4*)(F.KS + ((size_t)b * SROWS + jj) * D + cc) = o; } }
      } }
    { LAS bf16* tile = (LAS bf16*)(F.lds + F.wave * 16640);
      constexpr int NP = 2 * 64 * 16, NS = 32 * 16 * 9;
      for (int it = gw; it < NP + NS; it += NGW) {
          int nrows = 64; bf16* dst; int dstride;
          if (it < NP) {
              const int h = it & 15, tb = (it >> 4) & 63, b = it >> 10;
              const bf16* src = F.QKV + (size_t)(b * SEQ + tb * 64) * NQKV + 2 * D + h * HD + 2 * lane;
              unsigned u[64];
#pragma unroll
              for (int i = 0; i < 64; ++i) u[i] = *(const unsigned*)(src + (size_t)i * NQKV);
#pragma unroll
              for (int i = 0; i < 64; ++i) *(LAS unsigned*)(tile + i * 130 + 2 * lane) = u[i];
              dst = F.VT + ((size_t)(b * 16 + h) * HD) * SEQ + tb * 64; dstride = SEQ;
          } else {
              const int r = it - NP, h = r & 15, jb = (r >> 4) % 9, b = r / 144;
              if (jb < 8) {
                  const float* src = p.cache_v + ((size_t)(b * 512 + jb * 64) * NH + h) * HD + 2 * lane;
#pragma unroll
                  for (int hh = 0; hh < 2; ++hh) {
                      f32x2 x[32];
#pragma unroll
                      for (int i = 0; i < 32; ++i) x[i] = *(const f32x2*)(src + (size_t)(32 * hh + i) * D);
#pragma unroll
                      for (int i = 0; i < 32; ++i) *(LAS unsigned*)(tile + (32 * hh + i) * 130 + 2 * lane) = pk2(x[i].x, x[i].y);
                  }
              } else {
                  nrows = 32;
                  const bf16* src = F.QKV + (size_t)(TP + b * 32) * NQKV + 2 * D + h * HD + 2 * lane;
                  unsigned u[32];
#pragma unroll
                  for (int i = 0; i < 32; ++i) u[i] = *(const unsigned*)(src + (size_t)i * NQKV);
#pragma unroll
                  for (int i = 0; i < 32; ++i) *(LAS unsigned*)(tile + i * 130 + 2 * lane) = u[i];
              }
              dst = F.VTS + ((size_t)(b * 16 + h) * HD) * SROWS + jb * 64; dstride = SROWS;
          }
          asm volatile("s_waitcnt lgkmcnt(0)" ::: "memory");
          const int tp = lane & 31, dh = lane >> 5;
          if (2 * tp < nrows) {
#pragma unroll 8
              for (int pp = 0; pp < 64; ++pp) { const int dv = 2 * pp + dh;
                  const unsigned lo = tile[(2 * tp) * 130 + dv], hi = tile[(2 * tp + 1) * 130 + dv];
                  *(unsigned*)(dst + (size_t)dv * dstride + 2 * tp) = lo | (hi << 16); }
          }
          asm volatile("s_waitcnt lgkmcnt(0)" ::: "memory");
      } }
}
DI void attn_step(f32x16 (&oacc)[4], float& mrun, float& lsum, const bf16x8 (&qf)[8], const bf16x8 (&kf)[8], const bf16x8 (&vf)[2][4], int relb, const float* __restrict__ bias, float bias0, int hf) {
    constexpr float L2E = 1.4426950408889634f;
    f32x16 s; for (int i = 0; i < 16; ++i) s[i] = 0.f;
#pragma unroll
    for (int kk = 0; kk < 8; ++kk) s = MFMA32(kf[kk], qf[kk], s);
    if (relb + 31 <= -128) {
#pragma unroll
        for (int i = 0; i < 16; ++i) s[i] += bias0;
    } else {
#pragma unroll
        for (int i = 0; i < 16; ++i) { int rel = relb + crow(i, hf); rel = rel < -128 ? -128 : (rel > 63 ? 63 : rel); s[i] += bias[(rel + 128) * NH] * L2E; }
    }
    float mt = s[0];
#pragma unroll
    for (int i = 1; i < 16; ++i) mt = fmaxf(mt, s[i]);
    mt = fmaxf(mt, __shfl_xor(mt, 32));
    const float mnew = fmaxf(mrun, mt), alpha = exp2f(mrun - mnew);
    mrun = mnew;
    float ps = 0.f; float pv[16];
#pragma unroll
    for (int i = 0; i < 16; ++i) { pv[i] = exp2f(s[i] - mnew); ps += pv[i]; }
    lsum = lsum * alpha + ps;
#pragma unroll
    for (int bl = 0; bl < 4; ++bl)
#pragma unroll
        for (int i = 0; i < 16; ++i) oacc[bl][i] *= alpha;
#pragma unroll
    for (int kb = 0; kb < 2; ++kb) {
        u32x4 pb; pb.x = pk2(pv[8 * kb], pv[8 * kb + 1]); pb.y = pk2(pv[8 * kb + 2], pv[8 * kb + 3]); pb.z = pk2(pv[8 * kb + 4], pv[8 * kb + 5]); pb.w = pk2(pv[8 * kb + 6], pv[8 * kb + 7]);
        const bf16x8 pfr = __builtin_bit_cast(bf16x8, pb);
#pragma unroll
        for (int bl = 0; bl < 4; ++bl) oacc[bl] = MFMA32(vf[kb][bl], pfr, oacc[bl]);
    }
}
constexpr int AK_STRIDE = 136, AV_STRIDE = 72, A_KBYTES = 64 * AK_STRIDE * 2, A_VBYTES = 128 * AV_STRIDE * 2, A_BUF = A_KBYTES + A_VBYTES;
static_assert(2 * A_BUF <= LDS_BYTES - 16 && 8 * 16384 + 8 * 256 <= LDS_BYTES - 16, "attention lds");

DI void attn_phase(Frame& F) {
    const Params& p = F.p;
    const int lane = F.lane, w = F.wave, tid = F.tid, r = lane & 31, hf = lane >> 5;
    constexpr float L2E = 1.4426950408889634f;
    for (int su = F.bid; su < 512; su += F.G) {
        const int h = su & 15, b = su >> 4, qrow0 = TP + b * 32;
        const bf16* kbase = F.KS + (size_t)(b * SROWS) * D + h * HD; const bf16* vbase = F.VTS + ((size_t)(b * 16 + h) * HD) * SROWS;
        const float* bias = p.b_rel_bias + h; const float bias0 = bias[0] * L2E;
        bf16x8 qf[8];
        { const bf16* qp = F.QB + (size_t)(qrow0 + r) * D + h * HD + 8 * hf;
#pragma unroll
          for (int kk = 0; kk < 8; ++kk) qf[kk] = *(const bf16x8*)(qp + 16 * kk); }
        f32x16 oacc[4];
#pragma unroll
        for (int bl = 0; bl < 4; ++bl) for (int i = 0; i < 16; ++i) oacc[bl][i] = 0.f;
        float mrun = -1e30f, lsum = 0.f;
        for (int kt = w; kt < 17; kt += 8) {
            bf16x8 kf[8], vf[2][4];
            { const bf16* kp = kbase + (size_t)(32 * kt + r) * D + 8 * hf;
#pragma unroll
              for (int kk = 0; kk < 8; ++kk) kf[kk] = *(const bf16x8*)(kp + 16 * kk); }
#pragma unroll
            for (int kb = 0; kb < 2; ++kb)
#pragma unroll
                for (int bl = 0; bl < 4; ++bl) { const bf16* vp = vbase + (size_t)(32 * bl + r) * SROWS + 32 * kt + 16 * kb + 4 * hf;
                    const u32x2 v0 = *(const u32x2*)vp, v1 = *(const u32x2*)(vp + 8); u32x4 vv; vv.x = v0.x; vv.y = v0.y; vv.z = v1.x; vv.w = v1.y; vf[kb][bl] = __builtin_bit_cast(bf16x8, vv); }
            attn_step(oacc, mrun, lsum, qf, kf, vf, -512 + 32 * kt - r, bias, bias0, hf);
        }
        lsum += __shfl_xor(lsum, 32);
        LAS float* op = (LAS float*)(F.lds + w * 16384); LAS float* ml = (LAS float*)(F.lds + 8 * 16384 + w * 256);
#pragma unroll
        for (int bl = 0; bl < 4; ++bl)
#pragma unroll
            for (int i = 0; i < 16; ++i) op[(32 * bl + crow(i, hf)) * 32 + r] = oacc[bl][i];
        if (hf == 0) { ml[2 * r] = mrun; ml[2 * r + 1] = lsum; }
        __syncthreads();
        { const int q = tid & 31, dv0 = (tid >> 5) * 8;
          float mw[8], M = -1e30f;
#pragma unroll
          for (int ww = 0; ww < 8; ++ww) { mw[ww] = ((LAS float*)(F.lds + 8 * 16384 + ww * 256))[2 * q]; M = fmaxf(M, mw[ww]); }
          float o[8] = {0.f, 0.f, 0.f, 0.f, 0.f, 0.f, 0.f, 0.f}, L = 0.f;
#pragma unroll
          for (int ww = 0; ww < 8; ++ww) { const float sc = exp2f(mw[ww] - M); L += sc * ((LAS float*)(F.lds + 8 * 16384 + ww * 256))[2 * q + 1];
              const LAS float* pp = (LAS float*)(F.lds + ww * 16384) + dv0 * 32 + q;
#pragma unroll
              for (int e = 0; e < 8; ++e) o[e] += sc * pp[e * 32]; }
          const float inv = 1.f / L;
          u32x4 ov; ov.x = pk2(o[0] * inv, o[1] * inv); ov.y = pk2(o[2] * inv, o[3] * inv); ov.z = pk2(o[4] * inv, o[5] * inv); ov.w = pk2(o[6] * inv, o[7] * inv);
          *(u32x4*)(F.HB + (size_t)(qrow0 + q) * D + h * HD + dv0) = ov; }
        __syncthreads();
    }
    for (int unit = F.bid; unit < 512; unit += F.G) {
        const int cq = unit & 15, h = (unit >> 4) & 15, b = unit >> 8;
        const int cw = 4 * cq + (w >> 1), qrow0 = b * SEQ + cw * 64 + (w & 1) * 32;
        const int kc_lo = (4 * cq - 8) > 0 ? 4 * cq - 8 : 0, kc_hi = 4 * cq + 3;
        const float* bias = p.b_rel_bias + h; const float bias0 = bias[0] * L2E;
        const bf16* kg = F.KN + (size_t)(b * SEQ) * D + h * HD;
        const bf16* vg = F.VT + ((size_t)(b * 16 + h) * HD) * SEQ;
        const int kr0 = tid >> 4, ks0 = tid & 15, vr0 = tid >> 3, vs0 = tid & 7;
        u32x4 st[4];
#define A_GLOAD(kc) do { st[0] = *(const u32x4*)(kg + (size_t)((kc) * 64 + kr0) * D + ks0 * 8); st[1] = *(const u32x4*)(kg + (size_t)((kc) * 64 + kr0 + 32) * D + ks0 * 8); \
                         st[2] = *(const u32x4*)(vg + (size_t)vr0 * SEQ + (kc) * 64 + vs0 * 8); st[3] = *(const u32x4*)(vg + (size_t)(vr0 + 64) * SEQ + (kc) * 64 + vs0 * 8); } while (0)
#define A_LWRITE(buf) do { LAS bf16* kb_ = (LAS bf16*)(F.lds + (buf) * A_BUF); LAS bf16* vb_ = (LAS bf16*)(F.lds + (buf) * A_BUF + A_KBYTES); \
                         *(LAS u32x4*)(kb_ + kr0 * AK_STRIDE + ks0 * 8) = st[0]; *(LAS u32x4*)(kb_ + (kr0 + 32) * AK_STRIDE + ks0 * 8) = st[1]; \
                         *(LAS u32x4*)(vb_ + vr0 * AV_STRIDE + vs0 * 8) = st[2]; *(LAS u32x4*)(vb_ + (vr0 + 64) * AV_STRIDE + vs0 * 8) = st[3]; } while (0)
        A_GLOAD(kc_lo);
        bf16x8 qf[8];
        { const bf16* qp = F.QB + (size_t)(qrow0 + r) * D + h * HD + 8 * hf;
#pragma unroll
          for (int kk = 0; kk < 8; ++kk) qf[kk] = *(const bf16x8*)(qp + 16 * kk); }
        f32x16 oacc[4];
#pragma unroll
        for (int bl = 0; bl < 4; ++bl) for (int i = 0; i < 16; ++i) oacc[bl][i] = 0.f;
        float mrun = -1e30f, lsum = 0.f;
        A_LWRITE(0);
        __syncthreads();
        for (int kc = kc_lo; kc <= kc_hi; ++kc) {
            const int cur = (kc - kc_lo) & 1;
            if (kc < kc_hi) A_GLOAD(kc + 1);
            if (kc >= cw - 8 && kc <= cw) {
                const LAS bf16* Kb = (const LAS bf16*)(F.lds + cur * A_BUF); const LAS bf16* Vb = (const LAS bf16*)(F.lds + cur * A_BUF + A_KBYTES);
#pragma unroll 1
                for (int t = 0; t < 2; ++t) {
                    bf16x8 kf[8], vf[2][4];
#pragma unroll
                    for (int kk = 0; kk < 8; ++kk) kf[kk] = *(const LAS bf16x8*)(Kb + (32 * t + r) * AK_STRIDE + 16 * kk + 8 * hf);
#pragma unroll
                    for (int kb = 0; kb < 2; ++kb)
#pragma unroll
                        for (int bl = 0; bl < 4; ++bl) { const LAS bf16* vp = Vb + (32 * bl + r) * AV_STRIDE + 32 * t + 16 * kb + 4 * hf;
                            const u32x2 v0 = *(const LAS u32x2*)vp, v1 = *(const LAS u32x2*)(vp + 8); u32x4 vv; vv.x = v0.x; vv.y = v0.y; vv.z = v1.x; vv.w = v1.y; vf[kb][bl] = __builtin_bit_cast(bf16x8, vv); }
                    attn_step(oacc, mrun, lsum, qf, kf, vf, (kc * 64 + 32 * t) - (cw * 64 + (w & 1) * 32) - r, bias, bias0, hf);
                }
            }
            if (kc < kc_hi) A_LWRITE(cur ^ 1);
            __syncthreads();
        }
#undef A_GLOAD
#undef A_LWRITE
        lsum += __shfl_xor(lsum, 32);
        const float inv = 1.f / lsum;
        bf16* op = F.HB + (size_t)(qrow0 + r) * D + h * HD;
#pragma unroll
        for (int bl = 0; bl < 4; ++bl)
#pragma unroll
            for (int g4 = 0; g4 < 4; ++g4) {
                u32x2 o; o.x = pk2(oacc[bl][4 * g4] * inv, oacc[bl][4 * g4 + 1] * inv); o.y = pk2(oacc[bl][4 * g4 + 2] * inv, oacc[bl][4 * g4 + 3] * inv);
                *(u32x2*)(op + 32 * bl + 8 * g4 + 4 * hf) = o;
            }
    }
}

#define XB_TMO      128
#define XB_XCNT(j)  (256  + 64 * (j))
#define XB_XSUB(j)  (1280 + 64 * (j))
#define XB_XGEN(j)  (2304 + 64 * (j))
#define XB_TOP      3328
#define XB_TOPGEN   3392
#define XCD_BAR_WORDS 3456
#define XB_SPIN_CAP (1u << 18)
DI unsigned xb_ld(unsigned* p)              { return __hip_atomic_load(p, __ATOMIC_RELAXED, __HIP_MEMORY_SCOPE_AGENT); }
DI unsigned xb_add(unsigned* p, unsigned v) { return __hip_atomic_fetch_add(p, v, __ATOMIC_RELAXED, __HIP_MEMORY_SCOPE_AGENT); }
DI unsigned xb_xcc_id() { return (unsigned)__builtin_amdgcn_s_getreg((3 << 11) | 20) & 0xFu; }
#define XB_SPIN(cond, bar) do { unsigned _sp = 0; while (cond) { __builtin_amdgcn_s_sleep(1); \
    if ((++_sp & 255u) == 0u) { if (xb_ld(&(bar)[XB_TMO])) break; if (_sp > XB_SPIN_CAP) { atomicAdd(&(bar)[XB_TMO], 1u); break; } } } } while (0)
struct XcdBarrier { unsigned* bar; unsigned x; volatile LAS unsigned* st; };
DI XcdBarrier xcd_barrier_post(unsigned* bar, volatile LAS unsigned* st) {
    XcdBarrier b; b.bar = bar; b.x = xb_xcc_id(); b.st = st;
    if (threadIdx.x == 0) (void)xb_add(&bar[XB_XCNT(b.x)], 1u);
    return b;
}
DI void xcd_barrier_complete(unsigned* bar, unsigned x, unsigned& nloc, unsigned& nx) {
    const unsigned G = gridDim.x * gridDim.y * gridDim.z;
    unsigned sum, cnt, mine, sp = 0u;
    for (;;) {
        sum = 0u; cnt = 0u; mine = 0u;
#pragma unroll
        for (unsigned j = 0; j < 16; ++j) { const unsigned c = xb_ld(&bar[XB_XCNT(j)]); sum += c; cnt += (c > 0u) ? 1u : 0u; mine = (j == x) ? c : mine; }
        if (sum == G) break;
        __builtin_amdgcn_s_sleep(1);
        if ((++sp & 255u) == 0u) { if (xb_ld(&bar[XB_TMO])) break; if (sp > XB_SPIN_CAP) { atomicAdd(&bar[XB_TMO], 1u); break; } }
    }
    nloc = mine > 0u ? mine : 1u; nx = cnt > 0u ? cnt : 1u;
}
DI void xcd_barrier(const XcdBarrier& b) {
    asm volatile("s_waitcnt vmcnt(0)" ::: "memory");
    __syncthreads();
    if (threadIdx.x == 0) {
        unsigned* bar = b.bar;
        __builtin_amdgcn_s_waitcnt(0);
        unsigned nloc = b.st[0], nx = b.st[1];
        if (nloc == 0u) { xcd_barrier_complete(bar, b.x, nloc, nx); b.st[0] = nloc; b.st[1] = nx; }
        const unsigned old = xb_add(&bar[XB_XSUB(b.x)], 1u);
        const unsigned gen = old / nloc;
        if (old + 1u == (gen + 1u) * nloc) {
            __builtin_amdgcn_fence(__ATOMIC_RELEASE, "agent");
            asm volatile("s_waitcnt vmcnt(0)" ::: "memory");
            const unsigned og = xb_add(&bar[XB_TOP], 1u);
            const unsigned tg = og / nx;
            if (og + 1u == (tg + 1u) * nx) xb_add(&bar[XB_TOPGEN], 1u);
            else XB_SPIN(xb_ld(&bar[XB_TOPGEN]) == tg, bar);
            __builtin_amdgcn_fence(__ATOMIC_ACQUIRE, "agent");
            xb_add(&bar[XB_XGEN(b.x)], 1u);
            asm volatile("s_waitcnt vmcnt(0)" ::: "memory");
        } else {
            XB_SPIN(xb_ld(&bar[XB_XGEN(b.x)]) == gen, bar);
            __builtin_amdgcn_fence(__ATOMIC_ACQUIRE, "agent");
            asm volatile("s_waitcnt vmcnt(0)" ::: "memory");
        }
    }
    __syncthreads();
}

enum { PH_P0, PH_G1, PH_GLA_A, PH_SCAN, PH_GLA_C, PH_G2, PH_RMS_F0, PH_G3_0, PH_CONV0, PH_G4_0, PH_RMS_M1, PH_G5, PH_PREP, PH_ATTN, PH_G6, PH_RMS_F1, PH_G3_1, PH_CONV1, PH_G4_1, PH_FIN, NPH };

__global__ void __launch_bounds__(NTHR, 2) fwd_megakernel(Params prm) {
    extern __shared__ __attribute__((aligned(16))) unsigned char lds_raw[];
    cg::grid_group grid = cg::this_grid();
    float* const X0 = prm.out;
    volatile LAS unsigned* bst = (volatile LAS unsigned*)((LAS unsigned char*)lds_raw + (LDS_BYTES - 16));
    if (threadIdx.x < 4) bst[threadIdx.x] = 0u;
    __syncthreads();
    XcdBarrier xbar = xcd_barrier_post((unsigned*)(prm.ws + WS_BAR), bst);
    for (int ph = prm.ph_lo; ph < prm.ph_hi; ++ph) {
      for (int rep = 0, nrep = 1 + ((REP_MASK >> ph) & 1); rep < nrep; ++rep) {
        int tid_ = threadIdx.x; asm volatile("" : "+v"(tid_));
        size_t zoff = 0; asm volatile("" : "+s"(zoff));
        unsigned char* ws = prm.ws + zoff;
        float* X = X0 + zoff;
        Frame F;
        F.p = prm; F.lds = (LAS unsigned char*)lds_raw;
        F.tid = tid_; F.lane = F.tid & 63; F.wave = __builtin_amdgcn_readfirstlane(F.tid >> 6); F.G = gridDim.x; F.bid = blockIdx.x;
        F.WinA = (bf16*)(ws + WS_WINA); F.WoA = (bf16*)(ws + WS_WOA); F.Wqkv = (bf16*)(ws + WS_WQKV); F.WoB = (bf16*)(ws + WS_WOB);
        F.Fin0 = (bf16*)(ws + WS_FIN0); F.Fin1 = (bf16*)(ws + WS_FIN1); F.Fdn0 = (bf16*)(ws + WS_FDN0); F.Fdn1 = (bf16*)(ws + WS_FDN1);
        F.LB = (float*)(ws + WS_LB); F.HB = (bf16*)(ws + WS_HB); F.QB = (bf16*)(ws + WS_QB);
        F.LOGF = (float*)(ws + WS_LOGF); F.VB = (bf16*)(ws + WS_VB); F.SG = (bf16*)(ws + WS_SG); F.OI = (float*)(ws + WS_OI); F.LOCAL = (float*)(ws + WS_LOCAL); F.DEC = (float*)(ws + WS_DEC);
        F.QKV = (bf16*)(ws + WS_QKV); F.KN = (bf16*)(ws + WS_KN); F.KS = (bf16*)(ws + WS_KS); F.VT = (bf16*)(ws + WS_VT); F.VTS = (bf16*)(ws + WS_VTS);
        F.UP = (bf16*)(ws + WS_UP); F.ACT = (bf16*)(ws + WS_ACT);
        switch (ph) {
        case PH_P0: if (EN_MASK & 1) p0_phase(F); break;
        case PH_GLA_A: if (EN_MASK & 2) gla_a_phase(F); break;
        case PH_SCAN: if (EN_MASK & 4) scan_phase(F); break;
        case PH_GLA_C: if (EN_MASK & 8) gla_c_phase(F); break;
        case PH_RMS_F0: if (EN_MASK & 16) rms_phase(F, X, prm.x_sample, prm.norm_ffn, (const float*)(ws + WS_PART), X + (size_t)TP * D); break;
        case PH_RMS_M1: if (EN_MASK & 16) rms_phase(F, X, X + (size_t)TP * D, prm.norm_mix + D, (const float*)(ws + WS_PART), X + (size_t)TP * D); break;
        case PH_RMS_F1: if (EN_MASK & 16) rms_phase(F, X, X + (size_t)TP * D, prm.norm_ffn + D, (const float*)(ws + WS_PART), X + (size_t)TP * D); break;
        case PH_FIN: fin_phase(F, X + (size_t)TP * D, (const float*)(ws + WS_PART)); break;
        case PH_CONV0: if (EN_MASK & 32) convfix_phase(F, 0, (const float*)(ws + WS_PART)); break;
        case PH_CONV1: if (EN_MASK & 32) convfix_phase(F, 1, (const float*)(ws + WS_PART)); break;
        case PH_PREP: if (EN_MASK & 64) prep_phase(F); break;
        case PH_ATTN: if (EN_MASK & 128) attn_phase(F); break;
        default: if (EN_MASK & 256) {
            pg8::Gemm g; pg8::Epi E; E.mode = 2; E.cw = nullptr; E.cbias = nullptr; E.ldo = D; E.ob = nullptr; E.of = X; E.resP = X; E.resS = X + (size_t)TP * D;
            E.lb = F.LB; E.logf = F.LOGF; E.wsb = ws;
            g.A = F.HB; g.M = T; g.K = D; g.N = D; g.Bt = F.WoA;
            if (ph == PH_G1) { g.Bt = F.WinA; g.N = NWIN; E.mode = 0; }
            else if (ph == PH_G2) { g.Bt = F.WoA; E.resP = prm.x_prompt; E.resS = prm.x_sample; }
            else if (ph == PH_G3_0 || ph == PH_G3_1) { const int l = (ph == PH_G3_1); g.Bt = l ? F.Fin1 : F.Fin0; g.N = NUP; E.mode = 3; E.cw = prm.f_conv_w + (size_t)l * 3 * FF; E.cbias = prm.f_conv_b + (size_t)l * FF; }
            else if (ph == PH_G4_0 || ph == PH_G4_1) { g.A = F.ACT; g.Bt = (ph == PH_G4_1) ? F.Fdn1 : F.Fdn0; g.K = FF; }
            else if (ph == PH_G5) { g.Bt = F.Wqkv; g.N = NQKV; E.mode = 1; E.ob = F.QKV; E.ldo = NQKV; }
            else { g.Bt = F.WoB; }
            E.part = (float*)(ws + WS_PART); E.act = F.ACT; E.edge = (float*)(ws + WS_PART);
            pg8::StaticOrder S; S.init(g.M, g.N, g.K, F.G, F.bid, E.mode == 2);
            pg8::gemm_phase(F.lds, g, S, E, F.tid);
        } break;
        }
      }
        if (prm.ph_hi > 1000) grid.sync();
        if (ph + 1 < prm.ph_hi) xcd_barrier(xbar);
    }
}

extern "C" void kernel_launch(void* const* d_in, const int* in_sizes, int n_in, void* d_out, int out_size, void* d_ws, size_t ws_size, hipStream_t stream) {
    static int grid_blocks = 0;
    if (!grid_blocks) {
        int dev = 0, cus = 0, per_cu = 0;
        hipGetDevice(&dev);
        hipDeviceGetAttribute(&cus, hipDeviceAttributeMultiprocessorCount, dev);
        if (hipFuncSetAttribute((const void*)fwd_megakernel, hipFuncAttributeMaxDynamicSharedMemorySize, LDS_BYTES) != hipSuccess) fprintf(stderr, "kernel_launch: hipFuncSetAttribute failed\n");
        hipOccupancyMaxActiveBlocksPerMultiprocessor(&per_cu, (const void*)fwd_megakernel, NTHR, LDS_BYTES);
        if (per_cu < 1) per_cu = 1;
        if (per_cu > 1) per_cu = 1;
        grid_blocks = cus * per_cu;
        if (n_in != 21 || (size_t)out_size != O_END || ws_size < WS_END) fprintf(stderr, "kernel_launch: unexpected sizes n_in %d out %d ws %zu (need %zu)\n", n_in, out_size, ws_size, (size_t)WS_END);
    }
    Params p{};
    p.x_prompt = (const float*)d_in[0]; p.x_sample = (const float*)d_in[1]; p.state_a_S = (const float*)d_in[2]; p.cache_k = (const float*)d_in[3]; p.cache_v = (const float*)d_in[4];
    p.conv_state = (const float*)d_in[5]; p.norm_mix = (const float*)d_in[6]; p.norm_ffn = (const float*)d_in[7]; p.a_w_in = (const float*)d_in[8]; p.a_gamma = (const float*)d_in[9];
    p.a_norm_o = (const float*)d_in[10]; p.a_w_o = (const float*)d_in[11]; p.b_w_qkv = (const float*)d_in[12]; p.b_q_norm = (const float*)d_in[13]; p.b_k_norm = (const float*)d_in[14];
    p.b_rel_bias = (const float*)d_in[15]; p.b_w_o = (const float*)d_in[16]; p.f_w_in = (const float*)d_in[17]; p.f_conv_w = (const float*)d_in[18]; p.f_conv_b = (const float*)d_in[19];
    p.f_w_down = (const float*)d_in[20];
    p.out = (float*)d_out; p.ws = (unsigned char*)d_ws;
#if MK_N_LAUNCHES == 1
    p.ph_lo = 0; p.ph_hi = NPH;
    if (hipMemsetAsync((char*)d_ws + WS_BAR, 0, 16384, stream) != hipSuccess) fprintf(stderr, "kernel_launch: memset of barrier words failed\n");
    void* args[] = {&p};
    hipError_t e = hipLaunchCooperativeKernel((const void*)fwd_megakernel, dim3(grid_blocks), dim3(NTHR), args, LDS_BYTES, stream);
    if (e != hipSuccess) fprintf(stderr, "cooperative launch failed: %s (grid %d)\n", hipGetErrorString(e), grid_blocks);
#else
    for (int ph = 0; ph < NPH; ++ph) {
        p.ph_lo = ph; p.ph_hi = ph + 1;
        hipLaunchKernelGGL(fwd_megakernel, dim3(grid_blocks), dim3(NTHR), LDS_BYTES, stream, p);
    }
#endif
}
```

```cpp
#include <hip/hip_runtime.h>
#include <hip/hip_cooperative_groups.h>
#include <cstdio>
#include <cstdint>
namespace cg = cooperative_groups;

#define DI __device__ __forceinline__
#define LAS __attribute__((address_space(3)))
#define GAS __attribute__((address_space(1)))
typedef unsigned short bf16;
typedef short bf16x8 __attribute__((ext_vector_type(8)));
typedef float f32x2 __attribute__((ext_vector_type(2)));
typedef float f32x4 __attribute__((ext_vector_type(4)));
typedef float f32x16 __attribute__((ext_vector_type(16)));
typedef unsigned u32x2 __attribute__((ext_vector_type(2)));
typedef unsigned u32x4 __attribute__((ext_vector_type(4)));
typedef __bf16 bf16x2_t __attribute__((ext_vector_type(2)));

#ifndef EN_MASK
#define EN_MASK 0xffffu
#endif
#ifndef REP_MASK
#define REP_MASK 0
#endif
#ifndef MK_N_LAUNCHES
#define MK_N_LAUNCHES 1
#endif

constexpr int D = 2048, TP = 8192, TS = 1024, T = TP + TS, SEQ = 4096, NH = 16, HD = 128, FF = 5632;
constexpr int NQKV = 3 * D, NWIN = 4 * D, NUP = 2 * FF;
constexpr int SROWS = 544;
constexpr float EPS = 1e-6f;
constexpr int NWAVES = 8, NTHR = 512;
constexpr int LDS_BYTES = 147456;

constexpr size_t MiB = 1u << 20;
constexpr size_t WS_WINA = 0, WS_WOA = 32 * MiB, WS_WQKV = 40 * MiB, WS_WOB = 64 * MiB, WS_FIN0 = 72 * MiB, WS_FIN1 = 116 * MiB, WS_FDN0 = 160 * MiB, WS_FDN1 = 182 * MiB;
constexpr size_t WS_LB = 204 * MiB, WS_HB = 205 * MiB, WS_QB = 241 * MiB, WS_MIX = 277 * MiB;
constexpr size_t WS_LOGF = WS_MIX, WS_VB = WS_MIX + 72 * MiB, WS_SG = WS_MIX + 108 * MiB, WS_OI = WS_MIX + 144 * MiB, WS_LOCAL = WS_MIX + 216 * MiB, WS_DEC = WS_MIX + 376 * MiB;
constexpr size_t WS_QKV = WS_MIX, WS_KN = WS_MIX + 108 * MiB, WS_KS = WS_MIX + 140 * MiB, WS_VT = WS_MIX + 208 * MiB, WS_VTS = WS_MIX + 240 * MiB;
constexpr size_t WS_UP = WS_MIX, WS_ACT = WS_MIX + 198 * MiB;
constexpr size_t WS_PART = WS_MIX + 300 * MiB;
constexpr size_t WS_BAR = WS_LB + 64 * 1024;
constexpr size_t WS_END = WS_MIX + 378 * MiB;

constexpr size_t O_YP = 0, O_YS = O_YP + (size_t)TP * D, O_SP = O_YS + (size_t)TS * D, O_SS = O_SP + 2 * 16 * 128 * 128, O_KP = O_SS + 32 * 16 * 128 * 128,
                 O_VP = O_KP + 2 * 512 * 2048, O_KSM = O_VP + 2 * 512 * 2048, O_VSM = O_KSM + 32 * 32 * 2048, O_CP = O_VSM + 32 * 32 * 2048, O_CS = O_CP + 2 * 2 * 2 * FF,
                 O_END = O_CS + 2 * 32 * 2 * FF;

struct Params {
    const float* x_prompt; const float* x_sample; const float* state_a_S; const float* cache_k; const float* cache_v; const float* conv_state;
    const float* norm_mix; const float* norm_ffn; const float* a_w_in; const float* a_gamma; const float* a_norm_o; const float* a_w_o;
    const float* b_w_qkv; const float* b_q_norm; const float* b_k_norm; const float* b_rel_bias; const float* b_w_o;
    const float* f_w_in; const float* f_conv_w; const float* f_conv_b; const float* f_w_down;
    float* out; unsigned char* ws; int ph_lo, ph_hi;
};

DI unsigned pk2(float lo, float hi) { f32x2 v = {lo, hi}; return __builtin_bit_cast(unsigned, __builtin_convertvector(v, bf16x2_t)); }
DI bf16 f2bf(float f) { return (bf16)(pk2(f, 0.f) & 0xffffu); }
DI float bflo(unsigned p) { return __uint_as_float(p << 16); }
DI float bfhi(unsigned p) { return __uint_as_float(p & 0xffff0000u); }
DI float wave_sum(float v) {
#pragma unroll
    for (int o = 1; o < 64; o <<= 1) v += __shfl_xor(v, o);
    return v;
}
DI float fexp(float x) { return __builtin_amdgcn_exp2f(x * 1.4426950408889634f); }
DI float fsigmoid(float z) { return __builtin_amdgcn_rcpf(1.f + fexp(-z)); }
DI float fsilu(float z) { return z * __builtin_amdgcn_rcpf(1.f + fexp(-z)); }
DI float flog(float x) { return __builtin_amdgcn_logf(x) * 0.6931471805599453f; }
DI int crow(int reg, int h) { return (reg & 3) + 8 * (reg >> 2) + 4 * h; }
#define MFMA32(a, b, c) __builtin_amdgcn_mfma_f32_32x32x16_bf16((a), (b), (c), 0, 0, 0)

namespace pg8 {
constexpr int BM = 256, BK = 64, HALF = 128, HTB = HALF * BK * 2, STAGE_BYTES = 8 * HTB, NXCD = 8, WGM = 8;
DI int lds_byte(int r, int c) { const int st = (r >> 4) * 2 + (c >> 5), rr = r & 15, cc = c & 31, ob = rr * 64 + cc * 2; return st * 1024 + (ob ^ (((ob >> 9) & 1) << 5)); }
DI void stage_rc(int b, int& R, int& C) { const int st = b / 1024, sb = b % 1024, swz = sb ^ (((sb >> 9) & 1) << 5); R = (st >> 1) * 16 + swz / 64; C = (st & 1) * 32 + (swz % 64) / 2; }
DI int perm32(int rho) { const int n = rho >> 4, i = rho & 15; return 8 * (i >> 2) + 4 * n + (i & 3); }
struct Unit { int pm, pn, kb0, nkt, slice; };
struct Gemm { const bf16* A; const bf16* Bt; int M, N, K; };
struct StaticOrder {
    int nM, nN, nwg, G, c, tail, nblk, nitems;
    DI void init(int M, int N, int K, int G_, int c_, int tail_) { tail = tail_; nM = tail ? TP / BM : M / BM; nN = N / BM; nwg = nM * nN; G = G_; c = c_; nblk = K / 128; nitems = nwg + (tail ? 256 : 0); }
    DI bool next(int i, Unit& u) const {
        const long L = (long)i * G + c; if (L >= nitems) return false;
        u.slice = -1; u.kb0 = 0; u.nkt = nblk * 2;
        if (L >= nwg) { const int j = (int)L - nwg, uu = j & 31; u.slice = j >> 5; u.pm = TP / BM + (uu >> 3); u.pn = uu & 7;
            const int base = nblk / 8, rem = nblk % 8; u.kb0 = u.slice * base + (u.slice < rem ? u.slice : rem); u.nkt = 2 * (base + (u.slice < rem ? 1 : 0)); return true; }
        int wgid = (int)L; { const int q = nwg / NXCD, r = nwg % NXCD, xcd = wgid % NXCD, off = wgid / NXCD; wgid = (xcd < r ? xcd * (q + 1) : r * (q + 1) + (xcd - r) * q) + off; }
        const int nig = WGM * nN, gid = wgid / nig, fm = gid * WGM, gsz = (nM - fm) < WGM ? (nM - fm) : WGM;
        u.pm = fm + ((wgid % nig) % gsz); u.pn = (wgid % nig) / gsz; return true;
    }
};

struct Epi {
    int mode;
    int ldo;
    bf16* ob;
    float* of; const float* resP; const float* resS;
    const float* lb; float* logf; unsigned char* wsb;
    float* part;
    const float* cw; const float* cbias; bf16* act; float* edge;
    DI bool perm() const { return mode != 2; }
    DI void operator()(const f32x4 (&acc)[2][2][4][2], const Unit& u, int wr, int wc, int fr, int fq) const {
        const int row0 = u.pm * BM + wr * 64 + fr;
        if (mode == 2 && u.slice >= 0) {
            const int col0 = u.pn * BM + wc * 32 + 4 * fq;
#pragma unroll
            for (int ai = 0; ai < 2; ++ai)
#pragma unroll
                for (int m = 0; m < 4; ++m) {
                    float* op = part + ((size_t)u.slice * TS + (row0 + ai * HALF + m * 16 - TP)) * D + col0;
#pragma unroll
                    for (int bj = 0; bj < 2; ++bj)
#pragma unroll
                        for (int n = 0; n < 2; ++n) *(f32x4*)(op + bj * HALF + n * 16) = acc[ai][bj][m][n];
                }
        } else if (mode == 2) {
            const int col0 = u.pn * BM + wc * 32 + 4 * fq;
#pragma unroll
            for (int ai = 0; ai < 2; ++ai) {
                f32x4 rr[4][2][2];
#pragma unroll
                for (int m = 0; m < 4; ++m) {
                    const int row = row0 + ai * HALF + m * 16;
                    const float* rp = (row < TP ? resP + (size_t)row * D : resS + (size_t)(row - TP) * D) + col0;
#pragma unroll
                    for (int bj = 0; bj < 2; ++bj)
#pragma unroll
                        for (int n = 0; n < 2; ++n) rr[m][bj][n] = *(const f32x4*)(rp + bj * HALF + n * 16);
                }
#pragma unroll
                for (int m = 0; m < 4; ++m) {
                    float* op = of + (size_t)(row0 + ai * HALF + m * 16) * D + col0;
#pragma unroll
                    for (int bj = 0; bj < 2; ++bj)
#pragma unroll
                        for (int n = 0; n < 2; ++n) *(f32x4*)(op + bj * HALF + n * 16) = rr[m][bj][n] + acc[ai][bj][m][n];
                }
            }
        } else if (mode == 3) {
            const int cc0 = u.pn * HALF + wc * 32 + 8 * fq;
            float w0[8], w1[8], w2[8], cb[8];
            { const f32x4 a0 = *(const f32x4*)(cw + cc0), a1 = *(const f32x4*)(cw + cc0 + 4), b0 = *(const f32x4*)(cw + FF + cc0), b1 = *(const f32x4*)(cw + FF + cc0 + 4);
              const f32x4 c0 = *(const f32x4*)(cw + 2 * FF + cc0), c1 = *(const f32x4*)(cw + 2 * FF + cc0 + 4), d0 = *(const f32x4*)(cbias + cc0), d1 = *(const f32x4*)(cbias + cc0 + 4);
#pragma unroll
              for (int e = 0; e < 4; ++e) { w0[e] = a0[e]; w0[4 + e] = a1[e]; w1[e] = b0[e]; w1[4 + e] = b1[e]; w2[e] = c0[e]; w2[4 + e] = c1[e]; cb[e] = d0[e]; cb[4 + e] = d1[e]; } }
            float* const eu_first = edge; float* const eg_first = edge + (size_t)(T / 32) * 2 * FF; float* const eu_last = edge + (size_t)(T / 32) * 4 * FF;
#pragma unroll
            for (int ai = 0; ai < 2; ++ai)
#pragma unroll
                for (int m = 0; m < 4; ++m) {
                    const int row = row0 + ai * HALF + m * 16, hb = row >> 5;
                    float a[8];
#pragma unroll
                    for (int n = 0; n < 2; ++n)
#pragma unroll
                        for (int e = 0; e < 4; ++e) {
                            const float cur = acc[ai][0][m][n][e];
                            const float prv = (m & 1) ? acc[ai][0][m - 1][n][e] : 0.f;
                            const int ci = __float_as_int(cur), pi = __float_as_int(prv);
                            const int r1 = __builtin_amdgcn_update_dpp(0, pi, 0x121, 0xf, 0xf, false), r2 = __builtin_amdgcn_update_dpp(0, pi, 0x122, 0xf, 0xf, false);
                            const float p1 = __int_as_float(__builtin_amdgcn_update_dpp(r1, ci, 0x111, 0xf, 0xf, false));
                            const float p2 = __int_as_float(__builtin_amdgcn_update_dpp(r2, ci, 0x112, 0xf, 0xf, false));
                            const int k = 4 * n + e;
                            a[k] = fsilu(cb[k] + p2 * w0[k] + p1 * w1[k] + cur * w2[k]) * acc[ai][1][m][n][e];
                        }
                    const bool first2 = ((m & 1) == 0) && (fr < 2), last2 = ((m & 1) == 1) && (fr >= 14);
                    if (!first2) { u32x4 o; o.x = pk2(a[0], a[1]); o.y = pk2(a[2], a[3]); o.z = pk2(a[4], a[5]); o.w = pk2(a[6], a[7]); *(u32x4*)(act + (size_t)row * FF + cc0) = o; }
                    else { float* du = eu_first + ((size_t)hb * 2 + fr) * FF + cc0; float* dg = eg_first + ((size_t)hb * 2 + fr) * FF + cc0;
                        *(f32x4*)du = acc[ai][0][m][0]; *(f32x4*)(du + 4) = acc[ai][0][m][1]; *(f32x4*)dg = acc[ai][1][m][0]; *(f32x4*)(dg + 4) = acc[ai][1][m][1]; }
                    if (last2) { float* du = eu_last + ((size_t)hb * 2 + (fr - 14)) * FF + cc0; *(f32x4*)du = acc[ai][0][m][0]; *(f32x4*)(du + 4) = acc[ai][0][m][1]; }
                }
        } else if (mode == 1) {
            const int col0 = u.pn * BM + wc * 32 + 8 * fq;
#pragma unroll
            for (int ai = 0; ai < 2; ++ai)
#pragma unroll
                for (int m = 0; m < 4; ++m) {
                    bf16* op = ob + (size_t)(row0 + ai * HALF + m * 16) * ldo + col0;
#pragma unroll
                    for (int bj = 0; bj < 2; ++bj) { const f32x4 v0 = acc[ai][bj][m][0], v1 = acc[ai][bj][m][1];
                        u32x4 o; o.x = pk2(v0.x, v0.y); o.y = pk2(v0.z, v0.w); o.z = pk2(v1.x, v1.y); o.w = pk2(v1.z, v1.w);
                        *(u32x4*)(op + bj * HALF) = o; }
                }
        } else {
            const int type = u.pn >> 3, col0 = (u.pn & 7) * BM + wc * 32 + 8 * fq;
#pragma unroll
            for (int bj = 0; bj < 2; ++bj) {
                const int col = col0 + bj * HALF;
                f32x4 l0 = {0.f, 0.f, 0.f, 0.f}, l1 = l0;
                if (type == 1) { l0 = *(const f32x4*)(lb + col); l1 = *(const f32x4*)(lb + col + 4); }
#pragma unroll
                for (int ai = 0; ai < 2; ++ai)
#pragma unroll
                    for (int m = 0; m < 4; ++m) {
                        const size_t off = (size_t)(row0 + ai * HALF + m * 16) * D + col;
                        f32x4 v0 = acc[ai][bj][m][0], v1 = acc[ai][bj][m][1];
                        if (type == 1) {
#pragma unroll
                            for (int e = 0; e < 4; ++e) { v0[e] = flog(l0[e] + (1.f - l0[e]) * fsigmoid(v0[e])); v1[e] = flog(l1[e] + (1.f - l1[e]) * fsigmoid(v1[e])); }
                            *(f32x4*)(logf + off) = v0; *(f32x4*)(logf + off + 4) = v1;
                        } else {
                            if (type == 3) {
#pragma unroll
                                for (int e = 0; e < 4; ++e) { v0[e] = fsilu(v0[e]); v1[e] = fsilu(v1[e]); }
                            }
                            u32x4 o; o.x = pk2(v0.x, v0.y); o.y = pk2(v0.z, v0.w); o.z = pk2(v1.x, v1.y); o.w = pk2(v1.z, v1.w);
                            bf16* dst = (bf16*)(wsb + (type == 0 ? WS_QB : (type == 2 ? WS_VB : WS_SG)));
                            *(u32x4*)(dst + off) = o;
                        }
                    }
            }
        }
    }
};

DI void gemm_phase(LAS unsigned char* lds, const Gemm g, const StaticOrder& S, const Epi& E, const int tid) {
    const int wid = __builtin_amdgcn_readfirstlane(tid >> 6), lane = tid & 63, wr = wid >> 2, wc = wid & 3, fr = lane & 15, fq = lane >> 4;
    const int K = g.K;
    const bool PERM = E.perm();
    unsigned voffA[2], voffB[2];
#pragma unroll
    for (int i = 0; i < 2; ++i) { int R, C; stage_rc(tid * 16 + i * 8192, R, C); const int Rb = PERM ? ((R & ~31) + perm32(R & 31)) : R;
        voffA[i] = (unsigned)(R * K + C) * 2u; voffB[i] = (unsigned)(Rb * K + C) * 2u; }
    const size_t kstep = (size_t)(BK * 2);
    const size_t hstep = (size_t)HALF * K * 2;
    const size_t tstep = 2 * hstep;
    const unsigned ldsw = (unsigned)wid * 1024u;
    const int aoff = lds_byte(wr * 64 + fr, fq * 8), boff = lds_byte(wc * 32 + fr, fq * 8);
#define PG8_SA(b, h) (((b) * 2 + (h)) * HTB)
#define PG8_SB(b, h) ((4 + (b) * 2 + (h)) * HTB)
#define PG8_STAGE(bufoff, gbase, voff) do { _Pragma("unroll") for (int _i = 0; _i < 2; ++_i) \
        __builtin_amdgcn_global_load_lds((const unsigned*)((const char*)(gbase) + (voff)[_i]), (LAS unsigned*)(lds + (bufoff) + ldsw + _i * 8192), 16, 0, 0); } while (0)
#define PG8_LDA(dst, b, h) do { _Pragma("unroll") for (int m = 0; m < 4; ++m) _Pragma("unroll") for (int k = 0; k < 2; ++k) dst[m][k] = *(const LAS bf16x8*)(lds + PG8_SA(b, h) + aoff + m * 2048 + k * 1024); } while (0)
#define PG8_LDB(dst, b, h) do { _Pragma("unroll") for (int n = 0; n < 2; ++n) _Pragma("unroll") for (int k = 0; k < 2; ++k) dst[n][k] = *(const LAS bf16x8*)(lds + PG8_SB(b, h) + boff + n * 2048 + k * 1024); } while (0)
#define PG8_MMA(ai, bj, At, Bt) do { __builtin_amdgcn_s_setprio(1); _Pragma("unroll") for (int m = 0; m < 4; ++m) _Pragma("unroll") for (int n = 0; n < 2; ++n) _Pragma("unroll") for (int k = 0; k < 2; ++k) \
        acc[ai][bj][m][n] = __builtin_amdgcn_mfma_f32_16x16x32_bf16(Bt[n][k], At[m][k], acc[ai][bj][m][n], 0, 0, 0); __builtin_amdgcn_s_setprio(0); } while (0)
#define PG8_WAIT_V(n) asm volatile("s_waitcnt vmcnt(" #n ")" ::: "memory")
#define PG8_WAIT_L(n) asm volatile("s_waitcnt lgkmcnt(" #n ")" ::: "memory")
#define PG8_BAR __builtin_amdgcn_s_barrier()
#define PG8_SCHED __builtin_amdgcn_sched_barrier(0)
    Unit cur, nxt; int ui = 0;
    if (!S.next(0, cur)) return;
    f32x4 acc[2][2][4][2];
#pragma unroll
    for (int a = 0; a < 2; ++a)
#pragma unroll
        for (int b = 0; b < 2; ++b)
#pragma unroll
            for (int m = 0; m < 4; ++m)
#pragma unroll
                for (int n = 0; n < 2; ++n) acc[a][b][m][n] = (f32x4){0.f, 0.f, 0.f, 0.f};
    bf16x8 At[4][2], B0[2][2], B1[2][2];
    const char* cA = (const char*)g.A + (size_t)cur.pm * tstep + (size_t)cur.kb0 * 256; const char* cB = (const char*)g.Bt + (size_t)cur.pn * tstep + (size_t)cur.kb0 * 256;
    PG8_STAGE(PG8_SB(0, 0), cB, voffB); PG8_STAGE(PG8_SA(0, 0), cA, voffA); PG8_STAGE(PG8_SB(0, 1), cB + hstep, voffB); PG8_STAGE(PG8_SA(0, 1), cA + hstep, voffA);
    if (wr == 1) PG8_BAR;
    PG8_WAIT_V(4); PG8_BAR;
    PG8_STAGE(PG8_SB(1, 0), cB + kstep, voffB); PG8_STAGE(PG8_SA(1, 0), cA + kstep, voffA); PG8_STAGE(PG8_SB(1, 1), cB + hstep + kstep, voffB);
    PG8_WAIT_V(6); PG8_BAR;
    for (;;) {
        const bool has_next = S.next(ui + 1, nxt);
        const char* nA = has_next ? (const char*)g.A + (size_t)nxt.pm * tstep + (size_t)nxt.kb0 * 256 : cA; const char* nB = has_next ? (const char*)g.Bt + (size_t)nxt.pn * tstep + (size_t)nxt.kb0 * 256 : cB;
        const int nt = cur.nkt;
        for (int t = 0; t < nt; t += 2) {
            const bool last = (t == nt - 2);
            const char* a1 = cA + (size_t)(t + 1) * kstep;
            const char* a2 = last ? nA : cA + (size_t)(t + 2) * kstep; const char* b2 = last ? nB : cB + (size_t)(t + 2) * kstep;
            const char* a3 = a2 + kstep; const char* b3 = b2 + kstep;
            PG8_LDB(B0, 0, 0); PG8_SCHED; PG8_LDA(At, 0, 0); PG8_STAGE(PG8_SA(1, 1), a1 + hstep, voffA);
            PG8_WAIT_L(8); PG8_BAR; PG8_WAIT_L(0); PG8_MMA(0, 0, At, B0); PG8_BAR; PG8_SCHED;
            PG8_LDB(B1, 0, 1); PG8_STAGE(PG8_SB(0, 0), b2, voffB);
            PG8_BAR; PG8_WAIT_L(0); PG8_MMA(0, 1, At, B1); PG8_BAR;
            PG8_LDA(At, 0, 1); PG8_STAGE(PG8_SA(0, 0), a2, voffA);
            PG8_BAR; PG8_WAIT_L(0); PG8_MMA(1, 0, At, B0); PG8_BAR; PG8_SCHED;
            PG8_STAGE(PG8_SB(0, 1), b2 + hstep, voffB);
            PG8_WAIT_V(6); PG8_BAR; PG8_MMA(1, 1, At, B1); PG8_BAR;
            PG8_LDB(B0, 1, 0); PG8_SCHED; PG8_LDA(At, 1, 0); PG8_STAGE(PG8_SA(0, 1), a2 + hstep, voffA);
            PG8_WAIT_L(8); PG8_BAR; PG8_WAIT_L(0); PG8_MMA(0, 0, At, B0); PG8_BAR; PG8_SCHED;
            PG8_LDB(B1, 1, 1); PG8_STAGE(PG8_SB(1, 0), b3, voffB);
            PG8_BAR; PG8_WAIT_L(0); PG8_MMA(0, 1, At, B1); PG8_BAR;
            PG8_LDA(At, 1, 1); PG8_STAGE(PG8_SA(1, 0), a3, voffA);
            PG8_BAR; PG8_WAIT_L(0); PG8_MMA(1, 0, At, B0); PG8_BAR; PG8_SCHED;
            PG8_STAGE(PG8_SB(1, 1), b3 + hstep, voffB);
            PG8_WAIT_V(6); PG8_BAR; PG8_MMA(1, 1, At, B1); PG8_BAR;
        }
        E(acc, cur, wr, wc, fr, fq);
        if (!has_next) break;
#pragma unroll
        for (int a = 0; a < 2; ++a)
#pragma unroll
            for (int b = 0; b < 2; ++b)
#pragma unroll
                for (int m = 0; m < 4; ++m)
#pragma unroll
                    for (int n = 0; n < 2; ++n) acc[a][b][m][n] = (f32x4){0.f, 0.f, 0.f, 0.f};
        cur = nxt; cA = nA; cB = nB; ++ui;
    }
    PG8_WAIT_V(0);
    if (wr == 0) PG8_BAR;
    PG8_BAR;
#undef PG8_SA
#undef PG8_SB
#undef PG8_STAGE
#undef PG8_LDA
#undef PG8_LDB
#undef PG8_MMA
#undef PG8_WAIT_V
#undef PG8_WAIT_L
#undef PG8_BAR
#undef PG8_SCHED
}
}

struct Frame {
    Params p; LAS unsigned char* lds; int tid, lane, wave, G, bid;
    bf16 *WinA, *WoA, *Wqkv, *WoB, *Fin0, *Fin1, *Fdn0, *Fdn1;
    float* LB; bf16 *HB, *QB;
    float* LOGF; bf16 *VB, *SG; float *OI, *LOCAL, *DEC;
    bf16 *QKV, *KN, *KS, *VT, *VTS, *UP, *ACT;
};

DI void transpose_item(const float* __restrict__ W, int K, int N, bf16* __restrict__ WT, LAS float* scr, int item, int lane, const bool ilv = false) {
    const int nblk = N / 64, kb = item / nblk, nb = item % nblk, k0 = 64 * kb, n0 = 64 * nb;
    const int lr = lane >> 4, lc = (lane & 15) * 4;
    f32x4 v[16];
    const float* src = W + (size_t)(k0 + lr) * N + n0 + lc;
#pragma unroll
    for (int i = 0; i < 16; ++i) v[i] = *(const f32x4*)(src + (size_t)(4 * i) * N);
#pragma unroll
    for (int i = 0; i < 16; ++i) { LAS float* d = scr + (4 * i + lr) * 65 + lc; d[0] = v[i].x; d[1] = v[i].y; d[2] = v[i].z; d[3] = v[i].w; }
    asm volatile("s_waitcnt lgkmcnt(0)" ::: "memory");
    const int c = lane & 7;
#pragma unroll
    for (int j = 0; j < 8; ++j) { const int n = (lane >> 3) + 8 * j; const LAS float* s = scr + (8 * c) * 65 + n;
        u32x4 o; o.x = pk2(s[0 * 65], s[1 * 65]); o.y = pk2(s[2 * 65], s[3 * 65]); o.z = pk2(s[4 * 65], s[5 * 65]); o.w = pk2(s[6 * 65], s[7 * 65]);
        int nd = n0 + n; if (ilv) nd = (nd < FF) ? (((nd >> 7) << 8) + (nd & 127)) : ((((nd - FF) >> 7) << 8) + 128 + ((nd - FF) & 127));
        *(u32x4*)(WT + (size_t)nd * K + k0 + 8 * c) = o; }
    asm volatile("s_waitcnt lgkmcnt(0)" ::: "memory");
}
DI void rms_row(const float* __restrict__ xrow, const float* __restrict__ g, bf16* __restrict__ orow, int lane, const float* __restrict__ part, float* __restrict__ xdst) {
    const f32x4* xr = (const f32x4*)xrow + lane; const f32x4* gr = (const f32x4*)g + lane;
    f32x4 v[8]; float s = 0.f;
#pragma unroll
    for (int j = 0; j < 8; ++j) v[j] = xr[64 * j];
    if (part) {
#pragma unroll
        for (int sl = 0; sl < 8; ++sl) { const f32x4* pr = (const f32x4*)(part + (size_t)sl * TS * D) + lane;
#pragma unroll
            for (int j = 0; j < 8; ++j) v[j] += pr[64 * j]; }
#pragma unroll
        for (int j = 0; j < 8; ++j) ((f32x4*)xdst + lane)[64 * j] = v[j];
    }
#pragma unroll
    for (int j = 0; j < 8; ++j) s += (v[j].x * v[j].x + v[j].y * v[j].y) + (v[j].z * v[j].z + v[j].w * v[j].w);
    const float rstd = rsqrtf(wave_sum(s) * (1.f / D) + EPS);
    u32x2* o8 = (u32x2*)orow + lane;
#pragma unroll
    for (int j = 0; j < 8; ++j) { const f32x4 gg = gr[64 * j]; u32x2 o; o.x = pk2(v[j].x * rstd * gg.x, v[j].y * rstd * gg.y); o.y = pk2(v[j].z * rstd * gg.z, v[j].w * rstd * gg.w); o8[64 * j] = o; }
}
DI void rms_phase(Frame& F, const float* srcP, const float* srcS, const float* g, const float* part, float* xs) {
    const int gw = F.bid * NWAVES + F.wave, NGW = F.G * NWAVES;
    for (int m = gw; m < T; m += NGW) {
        if (m < TP) rms_row(srcP + (size_t)m * D, g, F.HB + (size_t)m * D, F.lane, nullptr, nullptr);
        else rms_row(srcS + (size_t)(m - TP) * D, g, F.HB + (size_t)m * D, F.lane, part ? part + (size_t)(m - TP) * D : nullptr, xs + (size_t)(m - TP) * D);
    }
}
DI void fin_phase(Frame& F, float* xs, const float* part) {
    const int gt = F.bid * NTHR + F.tid, NGT = F.G * NTHR;
    for (int it = gt; it < TS * D / 4; it += NGT) {
        f32x4 v = ((const f32x4*)xs)[it];
#pragma unroll
        for (int sl = 0; sl < 8; ++sl) v += ((const f32x4*)(part + (size_t)sl * TS * D))[it];
        ((f32x4*)xs)[it] = v;
    }
}
DI void p0_phase(Frame& F) {
    const Params& p = F.p;
    LAS float* scr = (LAS float*)(F.lds + F.wave * 16640);
    const int gw = F.bid * NWAVES + F.wave, NGW = F.G * NWAVES;
    constexpr int I_WINA = (D / 64) * (NWIN / 64), I_WO = (D / 64) * (D / 64), I_QKV = (D / 64) * (NQKV / 64), I_FIN = (D / 64) * (NUP / 64), I_FDN = (FF / 64) * (D / 64);
    constexpr int NITEMS = I_WINA + 2 * I_WO + I_QKV + 2 * I_FIN + 2 * I_FDN;
    for (int it = gw; it < NITEMS; it += NGW) {
        int r = it;
        if (r < I_WINA) { transpose_item(p.a_w_in, D, NWIN, F.WinA, scr, r, F.lane); continue; } r -= I_WINA;
        if (r < I_WO) { transpose_item(p.a_w_o, D, D, F.WoA, scr, r, F.lane); continue; } r -= I_WO;
        if (r < I_QKV) { transpose_item(p.b_w_qkv, D, NQKV, F.Wqkv, scr, r, F.lane); continue; } r -= I_QKV;
        if (r < I_WO) { transpose_item(p.b_w_o, D, D, F.WoB, scr, r, F.lane); continue; } r -= I_WO;
        if (r < I_FIN) { transpose_item(p.f_w_in, D, NUP, F.Fin0, scr, r, F.lane, true); continue; } r -= I_FIN;
        if (r < I_FIN) { transpose_item(p.f_w_in + (size_t)D * NUP, D, NUP, F.Fin1, scr, r, F.lane, true); continue; } r -= I_FIN;
        if (r < I_FDN) { transpose_item(p.f_w_down, FF, D, F.Fdn0, scr, r, F.lane); continue; } r -= I_FDN;
        transpose_item(p.f_w_down + (size_t)FF * D, FF, D, F.Fdn1, scr, r, F.lane);
    }
    for (int c = F.bid * NTHR + F.tid; c < D; c += F.G * NTHR) {
        const float g0 = p.a_gamma[c], g1 = p.a_gamma[D + c], g2 = p.a_gamma[2 * D + c];
        const float mx = fmaxf(g0, fmaxf(g1, g2));
        const float e0 = __expf(g0 - mx), e1 = __expf(g1 - mx), e2 = __expf(g2 - mx);
        F.LB[c] = e0 / (e0 + e1 + e2);
    }
    rms_phase(F, p.x_prompt, p.x_sample, p.norm_mix, nullptr, nullptr);
}

constexpr int GLA_UNITS = 2048 + 512;
constexpr int QT_STRIDE = 136, TT_STRIDE = 72;
constexpr int L_BCUM = 0, L_QT = 32768, L_KT = L_QT + 64 * QT_STRIDE * 2, L_KHT = L_KT + 64 * QT_STRIDE * 2, L_VT = L_KHT + 128 * TT_STRIDE * 2, L_PM = L_VT + 128 * TT_STRIDE * 2, L_GLA_END = L_PM + 64 * TT_STRIDE * 2;
static_assert(L_GLA_END <= LDS_BYTES, "gla lds");

DI f32x16 mma_lds(const LAS bf16* A, int astride, int arow0, const LAS bf16* B, int bstride, int brow0, int nks, int lane) {
    f32x16 acc; for (int i = 0; i < 16; ++i) acc[i] = 0.f;
    const int r = lane & 31, hf = lane >> 5;
    const LAS bf16* ap = A + (arow0 + r) * astride + 8 * hf; const LAS bf16* bp = B + (brow0 + r) * bstride + 8 * hf;
    for (int ks = 0; ks < nks; ++ks) { const bf16x8 a = *(const LAS bf16x8*)(ap + 16 * ks), b = *(const LAS bf16x8*)(bp + 16 * ks); acc = MFMA32(a, b, acc); }
    return acc;
}

template <int BLK>
DI void gla_a_unit(Frame& F, int u, int row0, int h) {
    LAS float* bcum = (LAS float*)(F.lds + L_BCUM);
    LAS bf16* qt = (LAS bf16*)(F.lds + L_QT); LAS bf16* kt = (LAS bf16*)(F.lds + L_KT); LAS bf16* khT = (LAS bf16*)(F.lds + L_KHT);
    LAS bf16* vT = (LAS bf16*)(F.lds + L_VT); LAS bf16* Pm = (LAS bf16*)(F.lds + L_PM);
    const int tid = F.tid, lane = F.lane, w = F.wave;
    const size_t hoff = (size_t)h * HD;
    constexpr int SEG = BLK / 4;
    { const int seg = tid >> 7, kc = tid & 127; float a = 0.f;
      const float* lp = F.LOGF + (size_t)(row0 + seg * SEG) * D + hoff + kc;
#pragma unroll
      for (int t = 0; t < SEG; ++t) { a += lp[(size_t)t * D]; bcum[(seg * SEG + t) * 128 + kc] = a; }
      __syncthreads();
      float off = 0.f;
      for (int s = 0; s < seg; ++s) off += bcum[(s * SEG + SEG - 1) * 128 + kc];
      __syncthreads();
      if (seg > 0) {
#pragma unroll
          for (int t = 0; t < SEG; ++t) bcum[(seg * SEG + t) * 128 + kc] += off;
      }
      __syncthreads(); }
    for (int i = tid; i < BLK * 16; i += NTHR) {
        const int t = i >> 4, c0 = (i & 15) * 8;
        const size_t goff = (size_t)(row0 + t) * D + hoff + c0;
        const u32x4 qv = *(const u32x4*)(F.QB + goff);
        const u32x4 vv = *(const u32x4*)(F.VB + goff);
        const f32x4 lf0 = *(const f32x4*)(F.LOGF + goff), lf1 = *(const f32x4*)(F.LOGF + goff + 4);
        float q[8] = {bflo(qv.x), bfhi(qv.x), bflo(qv.y), bfhi(qv.y), bflo(qv.z), bfhi(qv.z), bflo(qv.w), bfhi(qv.w)};
        float lf[8] = {lf0.x, lf0.y, lf0.z, lf0.w, lf1.x, lf1.y, lf1.z, lf1.w};
        float qtv[8], ktv[8], qhv[8], khv[8];
#pragma unroll
        for (int e = 0; e < 8; ++e) {
            const float b = bcum[t * 128 + c0 + e], bmid = bcum[(BLK / 2 - 1) * 128 + c0 + e], bend = bcum[(BLK - 1) * 128 + c0 + e];
            const float kk = 1.f - __expf(lf[e]);
            qtv[e] = q[e] * __expf(b - bmid); ktv[e] = kk * __expf(bmid - b); qhv[e] = q[e] * __expf(b); khv[e] = kk * __expf(bend - b);
            if (t == BLK - 1) F.DEC[(size_t)u * 128 + c0 + e] = __expf(bend);
        }
        u32x4 o; o.x = pk2(qtv[0], qtv[1]); o.y = pk2(qtv[2], qtv[3]); o.z = pk2(qtv[4], qtv[5]); o.w = pk2(qtv[6], qtv[7]);
        *(LAS u32x4*)(qt + t * QT_STRIDE + c0) = o;
        o.x = pk2(ktv[0], ktv[1]); o.y = pk2(ktv[2], ktv[3]); o.z = pk2(ktv[4], ktv[5]); o.w = pk2(ktv[6], ktv[7]);
        *(LAS u32x4*)(kt + t * QT_STRIDE + c0) = o;
        o.x = pk2(qhv[0], qhv[1]); o.y = pk2(qhv[2], qhv[3]); o.z = pk2(qhv[4], qhv[5]); o.w = pk2(qhv[6], qhv[7]);
        *(u32x4*)(F.QB + goff) = o;
        const unsigned vw[4] = {vv.x, vv.y, vv.z, vv.w};
#pragma unroll
        for (int e = 0; e < 8; ++e) {
            khT[(c0 + e) * TT_STRIDE + t] = f2bf(khv[e]);
            vT[(c0 + e) * TT_STRIDE + t] = (bf16)((e & 1) ? (vw[e >> 1] >> 16) : (vw[e >> 1] & 0xffffu));
        }
    }
    __syncthreads();
    const int r = lane & 31, hf = lane >> 5;
#pragma unroll
    for (int q2 = 0; q2 < 2; ++q2) {
        const int tl = w * 2 + q2, mt = tl >> 2, nt = tl & 3;
        const f32x16 acc = mma_lds(khT, TT_STRIDE, 32 * mt, vT, TT_STRIDE, 32 * nt, BLK / 16, lane);
        float* lp = F.LOCAL + (size_t)u * 16384 + 32 * nt + r;
#pragma unroll
        for (int i = 0; i < 16; ++i) lp[(size_t)(32 * mt + crow(i, hf)) * 128] = acc[i];
    }
    constexpr int NT2 = BLK / 32;
    if (w < NT2 * NT2) {
        const int mt = w / NT2, nt = w % NT2;
        if (nt > mt) {
#pragma unroll
            for (int i = 0; i < 16; ++i) Pm[(32 * mt + crow(i, hf)) * TT_STRIDE + 32 * nt + r] = 0;
        } else {
            const f32x16 acc = mma_lds(qt, QT_STRIDE, 32 * mt, kt, QT_STRIDE, 32 * nt, 8, lane);
#pragma unroll
            for (int i = 0; i < 16; ++i) { const int t = 32 * mt + crow(i, hf), s = 32 * nt + r; Pm[t * TT_STRIDE + s] = (s <= t) ? f2bf(acc[i]) : (bf16)0; }
        }
    }
    __syncthreads();
    if (w < NT2 * 4) {
        const int mt = w >> 2, nt = w & 3;
        const f32x16 acc = mma_lds(Pm, TT_STRIDE, 32 * mt, vT, TT_STRIDE, 32 * nt, BLK / 16, lane);
        float* op = F.OI + (size_t)(row0 + 32 * mt) * D + hoff + 32 * nt + r;
#pragma unroll
        for (int i = 0; i < 16; ++i) op[(size_t)crow(i, hf) * D] = acc[i];
    }
    __syncthreads();
}
DI void gla_a_phase(Frame& F) {
    for (int u = F.bid; u < GLA_UNITS; u += F.G) {
        if (u < 2048) { const int b = u >> 10, h = (u >> 6) & 15, c = u & 63; gla_a_unit<64>(F, u, b * SEQ + c * 64, h); }
        else { const int su = u - 2048, b = su >> 4, h = su & 15; gla_a_unit<32>(F, u, TP + b * 32, h); }
    }
}
DI void scan_phase(Frame& F) {
    const int gt = F.bid * NTHR + F.tid, NGT = F.G * NTHR;
    for (int it = gt; it < 32 * 4096; it += NGT) {
        const int bh = it >> 12, e = (it & 4095) * 4, kc = e >> 7;
        f32x4 S = {0.f, 0.f, 0.f, 0.f};
        float* __restrict__ lp = F.LOCAL + (size_t)(bh * 64) * 16384 + e; const float* __restrict__ dp = F.DEC + (size_t)(bh * 64) * 128 + kc;
        for (int c0 = 0; c0 < 64; c0 += 8) {
            f32x4 loc[8]; float d[8];
#pragma unroll
            for (int j = 0; j < 8; ++j) { loc[j] = *(const f32x4*)(lp + (size_t)(c0 + j) * 16384); d[j] = dp[(c0 + j) * 128]; }
#pragma unroll
            for (int j = 0; j < 8; ++j) { *(f32x4*)(lp + (size_t)(c0 + j) * 16384) = S; S = S * d[j] + loc[j]; }
        }
        *(f32x4*)(F.p.out + O_SP + (size_t)bh * 16384 + e) = S;
    }
    for (int it0 = gt; it0 < 512 * 4096; it0 += 4 * NGT) {
        f32x4 S0[4], loc[4]; float d[4];
#pragma unroll
        for (int j = 0; j < 4; ++j) { const int it = it0 + j * NGT; if (it < 512 * 4096) { const int bh = it >> 12, e = (it & 4095) * 4, kc = e >> 7;
            S0[j] = *(const f32x4*)(F.p.state_a_S + (size_t)bh * 16384 + e); loc[j] = *(const f32x4*)(F.LOCAL + (size_t)(2048 + bh) * 16384 + e); d[j] = F.DEC[(size_t)(2048 + bh) * 128 + kc]; } }
#pragma unroll
        for (int j = 0; j < 4; ++j) { const int it = it0 + j * NGT; if (it < 512 * 4096) { const int bh = it >> 12, e = (it & 4095) * 4;
            *(f32x4*)(F.p.out + O_SS + (size_t)bh * 16384 + e) = S0[j] * d[j] + loc[j]; } }
    }
}
constexpr int OB_STRIDE = 132;
template <int BLK>
DI void gla_c_unit(Frame& F, const float* __restrict__ S, int row0, int h) {
    LAS float* ob = (LAS float*)F.lds;
    const int tid = F.tid, lane = F.lane, w = F.wave, r = lane & 31, hf = lane >> 5;
    const size_t hoff = (size_t)h * HD;
    constexpr int TPR_ = NTHR / BLK, CPT_ = 128 / TPR_;
    u32x4 sgv[CPT_ / 8];
    { const int t = tid / TPR_, c0 = (tid % TPR_) * CPT_;
#pragma unroll
      for (int e8 = 0; e8 < CPT_ / 8; ++e8) sgv[e8] = *(const u32x4*)(F.SG + (size_t)(row0 + t) * D + hoff + c0 + 8 * e8); }
    if (w < (BLK / 32) * 4) {
        const int mt = w >> 2, nt = w & 3;
        f32x16 acc; for (int i = 0; i < 16; ++i) acc[i] = 0.f;
        float oiv[16];
        { const float* oi = F.OI + (size_t)(row0 + 32 * mt) * D + hoff + 32 * nt + r;
#pragma unroll
          for (int i = 0; i < 16; ++i) oiv[i] = oi[(size_t)crow(i, hf) * D]; }
        const bf16* ap = F.QB + (size_t)(row0 + 32 * mt + r) * D + hoff + 8 * hf;
        const float* sp = S + (size_t)(8 * hf) * 128 + 32 * nt + r;
#pragma unroll
        for (int ks = 0; ks < 8; ++ks) {
            const bf16x8 a = *(const bf16x8*)(ap + 16 * ks);
            float sv[8];
#pragma unroll
            for (int e = 0; e < 8; ++e) sv[e] = sp[(size_t)(16 * ks + e) * 128];
            u32x4 bb; bb.x = pk2(sv[0], sv[1]); bb.y = pk2(sv[2], sv[3]); bb.z = pk2(sv[4], sv[5]); bb.w = pk2(sv[6], sv[7]);
            acc = MFMA32(a, __builtin_bit_cast(bf16x8, bb), acc);
        }
#pragma unroll
        for (int i = 0; i < 16; ++i) { const int t = crow(i, hf); ob[(32 * mt + t) * OB_STRIDE + 32 * nt + r] = acc[i] + oiv[i]; }
    }
    __syncthreads();
    {
        constexpr int TPR = NTHR / BLK;
        constexpr int CPT = 128 / TPR;
        const int t = tid / TPR, j = tid % TPR, c0 = j * CPT;
        float v[CPT]; float ss = 0.f;
#pragma unroll
        for (int e = 0; e < CPT; ++e) { v[e] = ob[t * OB_STRIDE + c0 + e]; ss += v[e] * v[e]; }
#pragma unroll
        for (int o = 1; o < TPR; o <<= 1) ss += __shfl_xor(ss, o);
        const float rstd = rsqrtf(ss * (1.f / HD) + EPS);
        const size_t goff = (size_t)(row0 + t) * D + hoff + c0;
#pragma unroll
        for (int e8 = 0; e8 < CPT / 8; ++e8) {
            const u32x4 sg = sgv[e8];
            const f32x4 n0 = *(const f32x4*)(F.p.a_norm_o + c0 + 8 * e8), n1 = *(const f32x4*)(F.p.a_norm_o + c0 + 8 * e8 + 4);
            const float* vv = v + 8 * e8;
            u32x4 o;
            o.x = pk2(vv[0] * rstd * n0.x * bflo(sg.x), vv[1] * rstd * n0.y * bfhi(sg.x));
            o.y = pk2(vv[2] * rstd * n0.z * bflo(sg.y), vv[3] * rstd * n0.w * bfhi(sg.y));
            o.z = pk2(vv[4] * rstd * n1.x * bflo(sg.z), vv[5] * rstd * n1.y * bfhi(sg.z));
            o.w = pk2(vv[6] * rstd * n1.z * bflo(sg.w), vv[7] * rstd * n1.w * bfhi(sg.w));
            *(u32x4*)(F.HB + goff + 8 * e8) = o;
        }
    }
    __syncthreads();
}
DI void gla_c_phase(Frame& F) {
    for (int u = F.bid; u < GLA_UNITS; u += F.G) {
        if (u < 2048) { const int b = u >> 10, h = (u >> 6) & 15, c = u & 63; gla_c_unit<64>(F, F.LOCAL + (size_t)u * 16384, b * SEQ + c * 64, h); }
        else { const int su = u - 2048, b = su >> 4, h = su & 15; gla_c_unit<32>(F, F.p.state_a_S + (size_t)su * 16384, TP + b * 32, h); }
    }
}
DI void convfix_phase(Frame& F, int layer, const float* edge) {
    const Params& p = F.p;
    const int gt = F.bid * NTHR + F.tid, NGT = F.G * NTHR;
    constexpr int NCG = FF / 8, NHB = T / 32;
    const float* cw = p.f_conv_w + (size_t)layer * 3 * FF; const float* cbp = p.f_conv_b + (size_t)layer * FF;
    const float* eu_first = edge; const float* eg_first = edge + (size_t)NHB * 2 * FF; const float* eu_last = edge + (size_t)NHB * 4 * FF;
    for (int it = gt; it < NHB * NCG; it += NGT) {
        const int hb = it / NCG, c0 = (it % NCG) * 8;
        const bool smp = hb >= 256; const bool first = smp || ((hb & 127) == 0), lastb = smp || ((hb & 127) == 127);
        float um2[8], um1[8], u0[8], u1[8], g0[8], g1[8], w0[8], w1[8], w2[8], bb[8];
#pragma unroll
        for (int e = 0; e < 8; ++e) { w0[e] = cw[c0 + e]; w1[e] = cw[FF + c0 + e]; w2[e] = cw[2 * FF + c0 + e]; bb[e] = cbp[c0 + e]; um2[e] = 0.f; um1[e] = 0.f;
            u0[e] = eu_first[((size_t)hb * 2) * FF + c0 + e]; u1[e] = eu_first[((size_t)hb * 2 + 1) * FF + c0 + e];
            g0[e] = eg_first[((size_t)hb * 2) * FF + c0 + e]; g1[e] = eg_first[((size_t)hb * 2 + 1) * FF + c0 + e]; }
        if (first) {
            if (smp) { const float* st = p.conv_state + ((size_t)(layer * 32 + (hb - 256)) * 2) * FF + c0;
#pragma unroll
                for (int e = 0; e < 8; ++e) { um2[e] = st[e]; um1[e] = st[FF + e]; } }
        } else {
#pragma unroll
            for (int e = 0; e < 8; ++e) { um2[e] = eu_last[((size_t)(hb - 1) * 2) * FF + c0 + e]; um1[e] = eu_last[((size_t)(hb - 1) * 2 + 1) * FF + c0 + e]; }
        }
        float a0[8], a1[8];
#pragma unroll
        for (int e = 0; e < 8; ++e) { a0[e] = fsilu(bb[e] + um2[e] * w0[e] + um1[e] * w1[e] + u0[e] * w2[e]) * g0[e]; a1[e] = fsilu(bb[e] + um1[e] * w0[e] + u0[e] * w1[e] + u1[e] * w2[e]) * g1[e]; }
        u32x4 o; o.x = pk2(a0[0], a0[1]); o.y = pk2(a0[2], a0[3]); o.z = pk2(a0[4], a0[5]); o.w = pk2(a0[6], a0[7]);
        *(u32x4*)(F.ACT + (size_t)(hb * 32) * FF + c0) = o;
        o.x = pk2(a1[0], a1[1]); o.y = pk2(a1[2], a1[3]); o.z = pk2(a1[4], a1[5]); o.w = pk2(a1[6], a1[7]);
        *(u32x4*)(F.ACT + (size_t)(hb * 32 + 1) * FF + c0) = o;
        if (lastb) {
            float* dst = smp ? p.out + O_CS + ((size_t)(layer * 32 + (hb - 256)) * 2) * FF + c0 : p.out + O_CP + ((size_t)(layer * 2 + (hb >> 7)) * 2) * FF + c0;
#pragma unroll
            for (int e = 0; e < 8; ++e) { dst[e] = eu_last[((size_t)hb * 2) * FF + c0 + e]; dst[FF + e] = eu_last[((size_t)hb * 2 + 1) * FF + c0 + e]; }
        }
    }
}
DI void prep_phase(Frame& F) {
    const Params& p = F.p;
    const int gw = F.bid * NWAVES + F.wave, NGW = F.G * NWAVES, lane = F.lane;
    const float qscale = 0.08838834764831845f * 1.4426950408889634f;
    for (int m = gw; m < T; m += NGW) {
        const bf16* src = F.QKV + (size_t)m * NQKV + lane * 8;
        const bool smp = m >= TP; const int b = smp ? (m - TP) >> 5 : m >> 12, t = smp ? (m - TP) & 31 : m & 4095;
        const int hc = (lane & 15) * 8;
        u32x4 xq[4], xk[4], xv[4];
#pragma unroll
        for (int j = 0; j < 4; ++j) { xq[j] = *(const u32x4*)(src + j * 512); xk[j] = *(const u32x4*)(src + D + j * 512); xv[j] = *(const u32x4*)(src + 2 * D + j * 512); }
        float* ko = nullptr; float* vo = nullptr;
        if (smp) { ko = p.out + O_KSM + (size_t)(m - TP) * D + lane * 8; vo = p.out + O_VSM + (size_t)(m - TP) * D + lane * 8; }
        else if (t >= SEQ - 512) { ko = p.out + O_KP + ((size_t)b * 512 + (t - (SEQ - 512))) * D + lane * 8; vo = p.out + O_VP + ((size_t)b * 512 + (t - (SEQ - 512))) * D + lane * 8; }
        const f32x4 gq0 = *(const f32x4*)(p.b_q_norm + hc), gq1 = *(const f32x4*)(p.b_q_norm + hc + 4);
        const f32x4 gk0 = *(const f32x4*)(p.b_k_norm + hc), gk1 = *(const f32x4*)(p.b_k_norm + hc + 4);
        bf16* qdst = F.QB + (size_t)m * D + lane * 8;
        bf16* kdst = smp ? F.KS + ((size_t)b * SROWS + 512 + t) * D + lane * 8 : F.KN + (size_t)m * D + lane * 8;
#pragma unroll
        for (int j = 0; j < 4; ++j) {
            { const u32x4 x = xq[j]; const float v[8] = {bflo(x.x), bfhi(x.x), bflo(x.y), bfhi(x.y), bflo(x.z), bfhi(x.z), bflo(x.w), bfhi(x.w)};
              float ss = 0.f;
#pragma unroll
              for (int e = 0; e < 8; ++e) ss += v[e] * v[e];
              ss += __shfl_xor(ss, 1); ss += __shfl_xor(ss, 2); ss += __shfl_xor(ss, 4); ss += __shfl_xor(ss, 8);
              const float rstd = rsqrtf(ss * (1.f / HD) + EPS) * qscale;
              u32x4 o; o.x = pk2(v[0] * rstd * gq0.x, v[1] * rstd * gq0.y); o.y = pk2(v[2] * rstd * gq0.z, v[3] * rstd * gq0.w);
              o.z = pk2(v[4] * rstd * gq1.x, v[5] * rstd * gq1.y); o.w = pk2(v[6] * rstd * gq1.z, v[7] * rstd * gq1.w);
              *(u32x4*)(qdst + j * 512) = o; }
            { const u32x4 x = xk[j]; const float v[8] = {bflo(x.x), bfhi(x.x), bflo(x.y), bfhi(x.y), bflo(x.z), bfhi(x.z), bflo(x.w), bfhi(x.w)};
              float ss = 0.f;
#pragma unroll
              for (int e = 0; e < 8; ++e) ss += v[e] * v[e];
              ss += __shfl_xor(ss, 1); ss += __shfl_xor(ss, 2); ss += __shfl_xor(ss, 4); ss += __shfl_xor(ss, 8);
              const float rstd = rsqrtf(ss * (1.f / HD) + EPS);
              const f32x4 a = {v[0] * rstd * gk0.x, v[1] * rstd * gk0.y, v[2] * rstd * gk0.z, v[3] * rstd * gk0.w};
              const f32x4 c = {v[4] * rstd * gk1.x, v[5] * rstd * gk1.y, v[6] * rstd * gk1.z, v[7] * rstd * gk1.w};
              u32x4 o; o.x = pk2(a.x, a.y); o.y = pk2(a.z, a.w); o.z = pk2(c.x, c.y); o.w = pk2(c.z, c.w);
              *(u32x4*)(kdst + j * 512) = o;
              if (ko) { *(f32x4*)(ko + j * 512) = a; *(f32x4*)(ko + j * 512 + 4) = c; } }
            if (vo) { const u32x4 x = xv[j];
              const f32x4 a = {bflo(x.x), bfhi(x.x), bflo(x.y), bfhi(x.y)}, c = {bflo(x.z), bfhi(x.z), bflo(x.w), bfhi(x.w)};
              *(f32x4*)(vo + j * 512) = a; *(f32x4*)(vo + j * 512 + 4) = c; }
        }
    }
    { const int gt = F.bid * NTHR + F.tid, NGT = F.G * NTHR;
      for (int it0 = gt; it0 < 32 * 512 * (D / 8); it0 += 4 * NGT) {
          f32x4 a[4], c[4];
#pragma unroll
          for (int j = 0; j < 4; ++j) { const int it = it0 + j * NGT; if (it < 32 * 512 * (D / 8)) { const int row = it >> 8, cc = (it & 255) * 8;
              a[j] = *(const f32x4*)(p.cache_k + (size_t)row * D + cc); c[j] = *(const f32x4*)(p.cache_k + (size_t)row * D + cc + 4); } }
#pragma unroll
          for (int j = 0; j < 4; ++j) { const int it = it0 + j * NGT; if (it < 32 * 512 * (D / 8)) { const int row = it >> 8, cc = (it & 255) * 8, b = row >> 9, jj = row & 511;
              u32x4 o; o.x = pk2(a[j].x, a[j].y); o.y = pk2(a[j].z, a[j].w); o.z = pk2(c[j].x, c[j].y); o.w = pk2(c[j].z, c[j].w);
              *(u32x4*)(F.KS + ((size_t)b * SROWS + jj) * D + cc) = o; } }
      } }
    { LAS bf16* tile = (LAS bf16*)(F.lds + F.wave * 16640);
      constexpr int NP = 2 * 64 * 16, NS = 32 * 16 * 9;
      for (int it = gw; it < NP + NS; it += NGW) {
          int nrows = 64; bf16* dst; int dstride;
          if (it < NP) {
              const int h = it & 15, tb = (it >> 4) & 63, b = it >> 10;
              const bf16* src = F.QKV + (size_t)(b * SEQ + tb * 64) * NQKV + 2 * D + h * HD + 2 * lane;
              unsigned u[64];
#pragma unroll
              for (int i = 0; i < 64; ++i) u[i] = *(const unsigned*)(src + (size_t)i * NQKV);
#pragma unroll
              for (int i = 0; i < 64; ++i) *(LAS unsigned*)(tile + i * 130 + 2 * lane) = u[i];
              dst = F.VT + ((size_t)(b * 16 + h) * HD) * SEQ + tb * 64; dstride = SEQ;
          } else {
              const int r = it - NP, h = r & 15, jb = (r >> 4) % 9, b = r / 144;
              if (jb < 8) {
                  const float* src = p.cache_v + ((size_t)(b * 512 + jb * 64) * NH + h) * HD + 2 * lane;
#pragma unroll
                  for (int hh = 0; hh < 2; ++hh) {
                      f32x2 x[32];
#pragma unroll
                      for (int i = 0; i < 32; ++i) x[i] = *(const f32x2*)(src + (size_t)(32 * hh + i) * D);
#pragma unroll
                      for (int i = 0; i < 32; ++i) *(LAS unsigned*)(tile + (32 * hh + i) * 130 + 2 * lane) = pk2(x[i].x, x[i].y);
                  }
              } else {
                  nrows = 32;
                  const bf16* src = F.QKV + (size_t)(TP + b * 32) * NQKV + 2 * D + h * HD + 2 * lane;
                  unsigned u[32];
#pragma unroll
                  for (int i = 0; i < 32; ++i) u[i] = *(const unsigned*)(src + (size_t)i * NQKV);
#pragma unroll
                  for (int i = 0; i < 32; ++i) *(LAS unsigned*)(tile + i * 130 + 2 * lane) = u[i];
              }
              dst = F.VTS + ((size_t)(b * 16 + h) * HD) * SROWS + jb * 64; dstride = SROWS;
          }
          asm volatile("s_waitcnt lgkmcnt(0)" ::: "memory");
          const int tp = lane & 31, dh = lane >> 5;
          if (2 * tp < nrows) {
#pragma unroll 8
              for (int pp = 0; pp < 64; ++pp) { const int dv = 2 * pp + dh;
                  const unsigned lo = tile[(2 * tp) * 130 + dv], hi = tile[(2 * tp + 1) * 130 + dv];
                  *(unsigned*)(dst + (size_t)dv * dstride + 2 * tp) = lo | (hi << 16); }
          }
          asm volatile("s_waitcnt lgkmcnt(0)" ::: "memory");
      } }
}
DI void attn_step(f32x16 (&oacc)[4], float& mrun, float& lsum, const bf16x8 (&qf)[8], const bf16x8 (&kf)[8], const bf16x8 (&vf)[2][4], int relb, const LAS float* bias, float bias0, int hf) {
    f32x16 s; for (int i = 0; i < 16; ++i) s[i] = 0.f;
#pragma unroll
    for (int kk = 0; kk < 8; ++kk) s = MFMA32(kf[kk], qf[kk], s);
    if (relb + 31 <= -128) {
#pragma unroll
        for (int i = 0; i < 16; ++i) s[i] += bias0;
    } else {
#pragma unroll
        for (int i = 0; i < 16; ++i) { int rel = relb + crow(i, hf); rel = rel < -128 ? -128 : (rel > 63 ? 63 : rel); s[i] += bias[rel + 128]; }
    }
    float mt = s[0];
#pragma unroll
    for (int i = 1; i < 16; ++i) mt = fmaxf(mt, s[i]);
    mt = fmaxf(mt, __shfl_xor(mt, 32));
    const float mnew = fmaxf(mrun, mt), alpha = __builtin_amdgcn_exp2f(mrun - mnew);
    mrun = mnew;
    float ps = 0.f; float pv[16];
#pragma unroll
    for (int i = 0; i < 16; ++i) { pv[i] = __builtin_amdgcn_exp2f(s[i] - mnew); ps += pv[i]; }
    lsum = lsum * alpha + ps;
#pragma unroll
    for (int bl = 0; bl < 4; ++bl)
#pragma unroll
        for (int i = 0; i < 16; ++i) oacc[bl][i] *= alpha;
#pragma unroll
    for (int kb = 0; kb < 2; ++kb) {
        u32x4 pb; pb.x = pk2(pv[8 * kb], pv[8 * kb + 1]); pb.y = pk2(pv[8 * kb + 2], pv[8 * kb + 3]); pb.z = pk2(pv[8 * kb + 4], pv[8 * kb + 5]); pb.w = pk2(pv[8 * kb + 6], pv[8 * kb + 7]);
        const bf16x8 pfr = __builtin_bit_cast(bf16x8, pb);
#pragma unroll
        for (int bl = 0; bl < 4; ++bl) oacc[bl] = MFMA32(vf[kb][bl], pfr, oacc[bl]);
    }
}
constexpr int AK_STRIDE = 136, AV_STRIDE = 72, A_KBYTES = 64 * AK_STRIDE * 2, A_VBYTES = 128 * AV_STRIDE * 2, A_BUF = A_KBYTES + A_VBYTES;
constexpr int A_BIAS_OFF = 135168;
static_assert(2 * A_BUF <= A_BIAS_OFF && 8 * 16384 + 8 * 256 <= A_BIAS_OFF && A_BIAS_OFF + 768 <= LDS_BYTES - 16, "attention lds");

DI void attn_phase(Frame& F) {
    const Params& p = F.p;
    const int lane = F.lane, w = F.wave, tid = F.tid, r = lane & 31, hf = lane >> 5;
    constexpr float L2E = 1.4426950408889634f;
    for (int su = F.bid; su < 512; su += F.G) {
        const int h = su & 15, b = su >> 4, qrow0 = TP + b * 32;
        const bf16* kbase = F.KS + (size_t)(b * SROWS) * D + h * HD; const bf16* vbase = F.VTS + ((size_t)(b * 16 + h) * HD) * SROWS;
        LAS float* bias = (LAS float*)(F.lds + A_BIAS_OFF);
        if (tid < 192) bias[tid] = p.b_rel_bias[tid * NH + h] * L2E;
        bf16x8 qf[8];
        { const bf16* qp = F.QB + (size_t)(qrow0 + r) * D + h * HD + 8 * hf;
#pragma unroll
          for (int kk = 0; kk < 8; ++kk) qf[kk] = *(const bf16x8*)(qp + 16 * kk); }
        f32x16 oacc[4];
#pragma unroll
        for (int bl = 0; bl < 4; ++bl) for (int i = 0; i < 16; ++i) oacc[bl][i] = 0.f;
        float mrun = -1e30f, lsum = 0.f;
        __syncthreads();
        const float bias0 = bias[0];
        for (int kt = w; kt < 17; kt += 8) {
            bf16x8 kf[8], vf[2][4];
            { const bf16* kp = kbase + (size_t)(32 * kt + r) * D + 8 * hf;
#pragma unroll
              for (int kk = 0; kk < 8; ++kk) kf[kk] = *(const bf16x8*)(kp + 16 * kk); }
#pragma unroll
            for (int kb = 0; kb < 2; ++kb)
#pragma unroll
                for (int bl = 0; bl < 4; ++bl) { const bf16* vp = vbase + (size_t)(32 * bl + r) * SROWS + 32 * kt + 16 * kb + 4 * hf;
                    const u32x2 v0 = *(const u32x2*)vp, v1 = *(const u32x2*)(vp + 8); u32x4 vv; vv.x = v0.x; vv.y = v0.y; vv.z = v1.x; vv.w = v1.y; vf[kb][bl] = __builtin_bit_cast(bf16x8, vv); }
            attn_step(oacc, mrun, lsum, qf, kf, vf, -512 + 32 * kt - r, bias, bias0, hf);
        }
        lsum += __shfl_xor(lsum, 32);
        LAS float* op = (LAS float*)(F.lds + w * 16384); LAS float* ml = (LAS float*)(F.lds + 8 * 16384 + w * 256);
#pragma unroll
        for (int bl = 0; bl < 4; ++bl)
#pragma unroll
            for (int i = 0; i < 16; ++i) op[(32 * bl + crow(i, hf)) * 32 + r] = oacc[bl][i];
        if (hf == 0) { ml[2 * r] = mrun; ml[2 * r + 1] = lsum; }
        __syncthreads();
        { const int q = tid & 31, dv0 = (tid >> 5) * 8;
          float mw[8], M = -1e30f;
#pragma unroll
          for (int ww = 0; ww < 8; ++ww) { mw[ww] = ((LAS float*)(F.lds + 8 * 16384 + ww * 256))[2 * q]; M = fmaxf(M, mw[ww]); }
          float o[8] = {0.f, 0.f, 0.f, 0.f, 0.f, 0.f, 0.f, 0.f}, L = 0.f;
#pragma unroll
          for (int ww = 0; ww < 8; ++ww) { const float sc = __builtin_amdgcn_exp2f(mw[ww] - M); L += sc * ((LAS float*)(F.lds + 8 * 16384 + ww * 256))[2 * q + 1];
              const LAS float* pp = (LAS float*)(F.lds + ww * 16384) + dv0 * 32 + q;
#pragma unroll
              for (int e = 0; e < 8; ++e) o[e] += sc * pp[e * 32]; }
          const float inv = 1.f / L;
          u32x4 ov; ov.x = pk2(o[0] * inv, o[1] * inv); ov.y = pk2(o[2] * inv, o[3] * inv); ov.z = pk2(o[4] * inv, o[5] * inv); ov.w = pk2(o[6] * inv, o[7] * inv);
          *(u32x4*)(F.HB + (size_t)(qrow0 + q) * D + h * HD + dv0) = ov; }
        __syncthreads();
    }
    for (int unit = F.bid; unit < 512; unit += F.G) {
        const int cq = unit & 15, h = (unit >> 4) & 15, b = unit >> 8;
        const int cw = 4 * cq + (w >> 1), qrow0 = b * SEQ + cw * 64 + (w & 1) * 32;
        const int kc_lo = (4 * cq - 8) > 0 ? 4 * cq - 8 : 0, kc_hi = 4 * cq + 3;
        LAS float* bias = (LAS float*)(F.lds + A_BIAS_OFF);
        if (tid < 192) bias[tid] = p.b_rel_bias[tid * NH + h] * L2E;
        const bf16* kg = F.KN + (size_t)(b * SEQ) * D + h * HD;
        const bf16* vg = F.VT + ((size_t)(b * 16 + h) * HD) * SEQ;
        const int kr0 = tid >> 4, ks0 = tid & 15, vr0 = tid >> 3, vs0 = tid & 7;
        u32x4 st[4];
#define A_GLOAD(kc) do { st[0] = *(const u32x4*)(kg + (size_t)((kc) * 64 + kr0) * D + ks0 * 8); st[1] = *(const u32x4*)(kg + (size_t)((kc) * 64 + kr0 + 32) * D + ks0 * 8); \
                         st[2] = *(const u32x4*)(vg + (size_t)vr0 * SEQ + (kc) * 64 + vs0 * 8); st[3] = *(const u32x4*)(vg + (size_t)(vr0 + 64) * SEQ + (kc) * 64 + vs0 * 8); } while (0)
#define A_LWRITE(buf) do { LAS bf16* kb_ = (LAS bf16*)(F.lds + (buf) * A_BUF); LAS bf16* vb_ = (LAS bf16*)(F.lds + (buf) * A_BUF + A_KBYTES); \
                         *(LAS u32x4*)(kb_ + kr0 * AK_STRIDE + ks0 * 8) = st[0]; *(LAS u32x4*)(kb_ + (kr0 + 32) * AK_STRIDE + ks0 * 8) = st[1]; \
                         *(LAS u32x4*)(vb_ + vr0 * AV_STRIDE + vs0 * 8) = st[2]; *(LAS u32x4*)(vb_ + (vr0 + 64) * AV_STRIDE + vs0 * 8) = st[3]; } while (0)
        A_GLOAD(kc_lo);
        bf16x8 qf[8];
        { const bf16* qp = F.QB + (size_t)(qrow0 + r) * D + h * HD + 8 * hf;
#pragma unroll
          for (int kk = 0; kk < 8; ++kk) qf[kk] = *(const bf16x8*)(qp + 16 * kk); }
        f32x16 oacc[4];
#pragma unroll
        for (int bl = 0; bl < 4; ++bl) for (int i = 0; i < 16; ++i) oacc[bl][i] = 0.f;
        float mrun = -1e30f, lsum = 0.f;
        A_LWRITE(0);
        __syncthreads();
        const float bias0 = bias[0];
        for (int kc = kc_lo; kc <= kc_hi; ++kc) {
            const int cur = (kc - kc_lo) & 1;
            if (kc < kc_hi) A_GLOAD(kc + 1);
            if (kc >= cw - 8 && kc <= cw) {
                const LAS bf16* Kb = (const LAS bf16*)(F.lds + cur * A_BUF); const LAS bf16* Vb = (const LAS bf16*)(F.lds + cur * A_BUF + A_KBYTES);
#pragma unroll 1
                for (int t = 0; t < 2; ++t) {
                    bf16x8 kf[8], vf[2][4];
#pragma unroll
                    for (int kk = 0; kk < 8; ++kk) kf[kk] = *(const LAS bf16x8*)(Kb + (32 * t + r) * AK_STRIDE + 16 * kk + 8 * hf);
#pragma unroll
                    for (int kb = 0; kb < 2; ++kb)
#pragma unroll
                        for (int bl = 0; bl < 4; ++bl) { const LAS bf16* vp = Vb + (32 * bl + r) * AV_STRIDE + 32 * t + 16 * kb + 4 * hf;
                            const u32x2 v0 = *(const LAS u32x2*)vp, v1 = *(const LAS u32x2*)(vp + 8); u32x4 vv; vv.x = v0.x; vv.y = v0.y; vv.z = v1.x; vv.w = v1.y; vf[kb][bl] = __builtin_bit_cast(bf16x8, vv); }
                    attn_step(oacc, mrun, lsum, qf, kf, vf, (kc * 64 + 32 * t) - (cw * 64 + (w & 1) * 32) - r, bias, bias0, hf);
                }
            }
            if (kc < kc_hi) A_LWRITE(cur ^ 1);
            __syncthreads();
        }
#undef A_GLOAD
#undef A_LWRITE
        lsum += __shfl_xor(lsum, 32);
        const float inv = 1.f / lsum;
        bf16* op = F.HB + (size_t)(qrow0 + r) * D + h * HD;
#pragma unroll
        for (int bl = 0; bl < 4; ++bl)
#pragma unroll
            for (int g4 = 0; g4 < 4; ++g4) {
                u32x2 o; o.x = pk2(oacc[bl][4 * g4] * inv, oacc[bl][4 * g4 + 1] * inv); o.y = pk2(oacc[bl][4 * g4 + 2] * inv, oacc[bl][4 * g4 + 3] * inv);
                *(u32x2*)(op + 32 * bl + 8 * g4 + 4 * hf) = o;
            }
    }
}

#define XB_TMO      128
#define XB_XCNT(j)  (256  + 64 * (j))
#define XB_XSUB(j)  (1280 + 64 * (j))
#define XB_XGEN(j)  (2304 + 64 * (j))
#define XB_TOP      3328
#define XB_TOPGEN   3392
#define XCD_BAR_WORDS 3456
#define XB_SPIN_CAP (1u << 18)
DI unsigned xb_ld(unsigned* p)              { return __hip_atomic_load(p, __ATOMIC_RELAXED, __HIP_MEMORY_SCOPE_AGENT); }
DI unsigned xb_add(unsigned* p, unsigned v) { return __hip_atomic_fetch_add(p, v, __ATOMIC_RELAXED, __HIP_MEMORY_SCOPE_AGENT); }
DI unsigned xb_xcc_id() { return (unsigned)__builtin_amdgcn_s_getreg((3 << 11) | 20) & 0xFu; }
#define XB_SPIN(cond, bar) do { unsigned _sp = 0; while (cond) { __builtin_amdgcn_s_sleep(1); \
    if ((++_sp & 255u) == 0u) { if (xb_ld(&(bar)[XB_TMO])) break; if (_sp > XB_SPIN_CAP) { atomicAdd(&(bar)[XB_TMO], 1u); break; } } } } while (0)
struct XcdBarrier { unsigned* bar; unsigned x; volatile LAS unsigned* st; };
DI XcdBarrier xcd_barrier_post(unsigned* bar, volatile LAS unsigned* st) {
    XcdBarrier b; b.bar = bar; b.x = xb_xcc_id(); b.st = st;
    if (threadIdx.x == 0) (void)xb_add(&bar[XB_XCNT(b.x)], 1u);
    return b;
}
DI void xcd_barrier_complete(unsigned* bar, unsigned x, unsigned& nloc, unsigned& nx) {
    const unsigned G = gridDim.x * gridDim.y * gridDim.z;
    unsigned sum, cnt, mine, sp = 0u;
    for (;;) {
        sum = 0u; cnt = 0u; mine = 0u;
#pragma unroll
        for (unsigned j = 0; j < 16; ++j) { const unsigned c = xb_ld(&bar[XB_XCNT(j)]); sum += c; cnt += (c > 0u) ? 1u : 0u; mine = (j == x) ? c : mine; }
        if (sum == G) break;
        __builtin_amdgcn_s_sleep(1);
        if ((++sp & 255u) == 0u) { if (xb_ld(&bar[XB_TMO])) break; if (sp > XB_SPIN_CAP) { atomicAdd(&bar[XB_TMO], 1u); break; } }
    }
    nloc = mine > 0u ? mine : 1u; nx = cnt > 0u ? cnt : 1u;
}
DI void xcd_barrier(const XcdBarrier& b) {
    asm volatile("s_waitcnt vmcnt(0)" ::: "memory");
    __syncthreads();
    if (threadIdx.x == 0) {
        unsigned* bar = b.bar;
        __builtin_amdgcn_s_waitcnt(0);
        unsigned nloc = b.st[0], nx = b.st[1];
        if (nloc == 0u) { xcd_barrier_complete(bar, b.x, nloc, nx); b.st[0] = nloc; b.st[1] = nx; }
        const unsigned old = xb_add(&bar[XB_XSUB(b.x)], 1u);
        const unsigned gen = old / nloc;
        if (old + 1u == (gen + 1u) * nloc) {
            __builtin_amdgcn_fence(__ATOMIC_RELEASE, "agent");
            asm volatile("s_waitcnt vmcnt(0)" ::: "memory");
            const unsigned og = xb_add(&bar[XB_TOP], 1u);
            const unsigned tg = og / nx;
            if (og + 1u == (tg + 1u) * nx) xb_add(&bar[XB_TOPGEN], 1u);
            else XB_SPIN(xb_ld(&bar[XB_TOPGEN]) == tg, bar);
            __builtin_amdgcn_fence(__ATOMIC_ACQUIRE, "agent");
            xb_add(&bar[XB_XGEN(b.x)], 1u);
            asm volatile("s_waitcnt vmcnt(0)" ::: "memory");
        } else {
            XB_SPIN(xb_ld(&bar[XB_XGEN(b.x)]) == gen, bar);
            __builtin_amdgcn_fence(__ATOMIC_ACQUIRE, "agent");
            asm volatile("s_waitcnt vmcnt(0)" ::: "memory");
        }
    }
    __syncthreads();
}

enum { PH_P0, PH_G1, PH_GLA_A, PH_SCAN, PH_GLA_C, PH_G2, PH_RMS_F0, PH_G3_0, PH_CONV0, PH_G4_0, PH_RMS_M1, PH_G5, PH_PREP, PH_ATTN, PH_G6, PH_RMS_F1, PH_G3_1, PH_CONV1, PH_G4_1, PH_FIN, NPH };

__global__ void __launch_bounds__(NTHR, 2) fwd_megakernel(Params prm) {
    extern __shared__ __attribute__((aligned(16))) unsigned char lds_raw[];
    cg::grid_group grid = cg::this_grid();
    float* const X0 = prm.out;
    volatile LAS unsigned* bst = (volatile LAS unsigned*)((LAS unsigned char*)lds_raw + (LDS_BYTES - 16));
    if (threadIdx.x < 4) bst[threadIdx.x] = 0u;
    __syncthreads();
    XcdBarrier xbar = xcd_barrier_post((unsigned*)(prm.ws + WS_BAR), bst);
    for (int ph = prm.ph_lo; ph < prm.ph_hi; ++ph) {
      for (int rep = 0, nrep = 1 + ((REP_MASK >> ph) & 1); rep < nrep; ++rep) {
        int tid_ = threadIdx.x; asm volatile("" : "+v"(tid_));
        size_t zoff = 0; asm volatile("" : "+s"(zoff));
        unsigned char* ws = prm.ws + zoff;
        float* X = X0 + zoff;
        Frame F;
        F.p = prm; F.lds = (LAS unsigned char*)lds_raw;
        F.tid = tid_; F.lane = F.tid & 63; F.wave = __builtin_amdgcn_readfirstlane(F.tid >> 6); F.G = gridDim.x; F.bid = blockIdx.x;
        F.WinA = (bf16*)(ws + WS_WINA); F.WoA = (bf16*)(ws + WS_WOA); F.Wqkv = (bf16*)(ws + WS_WQKV); F.WoB = (bf16*)(ws + WS_WOB);
        F.Fin0 = (bf16*)(ws + WS_FIN0); F.Fin1 = (bf16*)(ws + WS_FIN1); F.Fdn0 = (bf16*)(ws + WS_FDN0); F.Fdn1 = (bf16*)(ws + WS_FDN1);
        F.LB = (float*)(ws + WS_LB); F.HB = (bf16*)(ws + WS_HB); F.QB = (bf16*)(ws + WS_QB);
        F.LOGF = (float*)(ws + WS_LOGF); F.VB = (bf16*)(ws + WS_VB); F.SG = (bf16*)(ws + WS_SG); F.OI = (float*)(ws + WS_OI); F.LOCAL = (float*)(ws + WS_LOCAL); F.DEC = (float*)(ws + WS_DEC);
        F.QKV = (bf16*)(ws + WS_QKV); F.KN = (bf16*)(ws + WS_KN); F.KS = (bf16*)(ws + WS_KS); F.VT = (bf16*)(ws + WS_VT); F.VTS = (bf16*)(ws + WS_VTS);
        F.UP = (bf16*)(ws + WS_UP); F.ACT = (bf16*)(ws + WS_ACT);
        switch (ph) {
        case PH_P0: if (EN_MASK & 1) p0_phase(F); break;
        case PH_GLA_A: if (EN_MASK & 2) gla_a_phase(F); break;
        case PH_SCAN: if (EN_MASK & 4) scan_phase(F); break;
        case PH_GLA_C: if (EN_MASK & 8) gla_c_phase(F); break;
        case PH_RMS_F0: if (EN_MASK & 16) rms_phase(F, X, prm.x_sample, prm.norm_ffn, (const float*)(ws + WS_PART), X + (size_t)TP * D); break;
        case PH_RMS_M1: if (EN_MASK & 16) rms_phase(F, X, X + (size_t)TP * D, prm.norm_mix + D, (const float*)(ws + WS_PART), X + (size_t)TP * D); break;
        case PH_RMS_F1: if (EN_MASK & 16) rms_phase(F, X, X + (size_t)TP * D, prm.norm_ffn + D, (const float*)(ws + WS_PART), X + (size_t)TP * D); break;
        case PH_FIN: fin_phase(F, X + (size_t)TP * D, (const float*)(ws + WS_PART)); break;
        case PH_CONV0: if (EN_MASK & 32) convfix_phase(F, 0, (const float*)(ws + WS_PART)); break;
        case PH_CONV1: if (EN_MASK & 32) convfix_phase(F, 1, (const float*)(ws + WS_PART)); break;
        case PH_PREP: if (EN_MASK & 64) prep_phase(F); break;
        case PH_ATTN: if (EN_MASK & 128) attn_phase(F); break;
        default: if (EN_MASK & 256) {
            pg8::Gemm g; pg8::Epi E; E.mode = 2; E.cw = nullptr; E.cbias = nullptr; E.ldo = D; E.ob = nullptr; E.of = X; E.resP = X; E.resS = X + (size_t)TP * D;
            E.lb = F.LB; E.logf = F.LOGF; E.wsb = ws;
            g.A = F.HB; g.M = T; g.K = D; g.N = D; g.Bt = F.WoA;
            if (ph == PH_G1) { g.Bt = F.WinA; g.N = NWIN; E.mode = 0; }
            else if (ph == PH_G2) { g.Bt = F.WoA; E.resP = prm.x_prompt; E.resS = prm.x_sample; }
            else if (ph == PH_G3_0 || ph == PH_G3_1) { const int l = (ph == PH_G3_1); g.Bt = l ? F.Fin1 : F.Fin0; g.N = NUP; E.mode = 3; E.cw = prm.f_conv_w + (size_t)l * 3 * FF; E.cbias = prm.f_conv_b + (size_t)l * FF; }
            else if (ph == PH_G4_0 || ph == PH_G4_1) { g.A = F.ACT; g.Bt = (ph == PH_G4_1) ? F.Fdn1 : F.Fdn0; g.K = FF; }
            else if (ph == PH_G5) { g.Bt = F.Wqkv; g.N = NQKV; E.mode = 1; E.ob = F.QKV; E.ldo = NQKV; }
            else { g.Bt = F.WoB; }
            E.part = (float*)(ws + WS_PART); E.act = F.ACT; E.edge = (float*)(ws + WS_PART);
            pg8::StaticOrder S; S.init(g.M, g.N, g.K, F.G, F.bid, E.mode == 2);
            pg8::gemm_phase(F.lds, g, S, E, F.tid);
        } break;
        }
      }
        if (prm.ph_hi > 1000) grid.sync();
        if (ph + 1 < prm.ph_hi) xcd_barrier(xbar);
    }
}

extern "C" void kernel_launch(void* const* d_in, const int* in_sizes, int n_in, void* d_out, int out_size, void* d_ws, size_t ws_size, hipStream_t stream) {
    static int grid_blocks = 0;
    if (!grid_blocks) {
        int dev = 0, cus = 0, per_cu = 0;
        hipGetDevice(&dev);
        hipDeviceGetAttribute(&cus, hipDeviceAttributeMultiprocessorCount, dev);
        if (hipFuncSetAttribute((const void*)fwd_megakernel, hipFuncAttributeMaxDynamicSharedMemorySize, LDS_BYTES) != hipSuccess) fprintf(stderr, "kernel_launch: hipFuncSetAttribute failed\n");
        hipOccupancyMaxActiveBlocksPerMultiprocessor(&per_cu, (const void*)fwd_megakernel, NTHR, LDS_BYTES);
        if (per_cu < 1) per_cu = 1;
        if (per_cu > 1) per_cu = 1;
        grid_blocks = cus * per_cu;
        if (n_in != 21 || (size_t)out_size != O_END || ws_size < WS_END) fprintf(stderr, "kernel_launch: unexpected sizes n_in %d out %d ws %zu (need %zu)\n", n_in, out_size, ws_size, (size_t)WS_END);
    }
    Params p{};
    p.x_prompt = (const float*)d_in[0]; p.x_sample = (const float*)d_in[1]; p.state_a_S = (const float*)d_in[2]; p.cache_k = (const float*)d_in[3]; p.cache_v = (const float*)d_in[4];
    p.conv_state = (const float*)d_in[5]; p.norm_mix = (const float*)d_in[6]; p.norm_ffn = (const float*)d_in[7]; p.a_w_in = (const float*)d_in[8]; p.a_gamma = (const float*)d_in[9];
    p.a_norm_o = (const float*)d_in[10]; p.a_w_o = (const float*)d_in[11]; p.b_w_qkv = (const float*)d_in[12]; p.b_q_norm = (const float*)d_in[13]; p.b_k_norm = (const float*)d_in[14];
    p.b_rel_bias = (const float*)d_in[15]; p.b_w_o = (const float*)d_in[16]; p.f_w_in = (const float*)d_in[17]; p.f_conv_w = (const float*)d_in[18]; p.f_conv_b = (const float*)d_in[19];
    p.f_w_down = (const float*)d_in[20];
    p.out = (float*)d_out; p.ws = (unsigned char*)d_ws;
#if MK_N_LAUNCHES == 1
    p.ph_lo = 0; p.ph_hi = NPH;
    if (hipMemsetAsync((char*)d_ws + WS_BAR, 0, 16384, stream) != hipSuccess) fprintf(stderr, "kernel_launch: memset of barrier words failed\n");
    void* args[] = {&p};
    hipError_t e = hipLaunchCooperativeKernel((const void*)fwd_megakernel, dim3(grid_blocks), dim3(NTHR), args, LDS_BYTES, stream);
    if (e != hipSuccess) fprintf(stderr, "cooperative launch failed: %s (grid %d)\n", hipGetErrorString(e), grid_blocks);
#else
    for (int ph = 0; ph < NPH; ++ph) {
        p.ph_lo = ph; p.ph_hi = ph + 1;
        hipLaunchKernelGGL(fwd_megakernel, dim3(grid_blocks), dim3(NTHR), LDS_BYTES, stream, p);
    }
#endif
}
```

```cpp
#include <hip/hip_runtime.h>
#include <hip/hip_cooperative_groups.h>
#include <cstdio>
#include <cstdint>
namespace cg = cooperative_groups;

#define DI __device__ __forceinline__
#define LAS __attribute__((address_space(3)))
#define GAS __attribute__((address_space(1)))
typedef unsigned short bf16;
typedef short bf16x8 __attribute__((ext_vector_type(8)));
typedef float f32x2 __attribute__((ext_vector_type(2)));
typedef float f32x4 __attribute__((ext_vector_type(4)));
typedef float f32x16 __attribute__((ext_vector_type(16)));
typedef unsigned u32x2 __attribute__((ext_vector_type(2)));
typedef unsigned u32x4 __attribute__((ext_vector_type(4)));
typedef __bf16 bf16x2_t __attribute__((ext_vector_type(2)));

#ifndef EN_MASK
#define EN_MASK 0xffffu
#endif
#ifndef REP_MASK
#define REP_MASK 0
#endif
#ifndef MK_N_LAUNCHES
#define MK_N_LAUNCHES 1
#endif

constexpr int D = 2048, TP = 8192, TS = 1024, T = TP + TS, SEQ = 4096, NH = 16, HD = 128, FF = 5632;
constexpr int NQKV = 3 * D, NWIN = 4 * D, NUP = 2 * FF;
constexpr int SROWS = 544;
constexpr float EPS = 1e-6f;
constexpr int NWAVES = 8, NTHR = 512;
constexpr int LDS_BYTES = 147456;

constexpr size_t MiB = 1u << 20;
constexpr size_t WS_WINA = 0, WS_WOA = 32 * MiB, WS_WQKV = 40 * MiB, WS_WOB = 64 * MiB, WS_FIN0 = 72 * MiB, WS_FIN1 = 116 * MiB, WS_FDN0 = 160 * MiB, WS_FDN1 = 182 * MiB;
constexpr size_t WS_LB = 204 * MiB, WS_HB = 205 * MiB, WS_QB = 241 * MiB, WS_MIX = 277 * MiB;
constexpr size_t WS_LOGF = WS_MIX, WS_VB = WS_MIX + 72 * MiB, WS_SG = WS_MIX + 108 * MiB, WS_OI = WS_MIX + 144 * MiB, WS_LOCAL = WS_MIX + 216 * MiB, WS_DEC = WS_MIX + 376 * MiB;
constexpr size_t WS_KS = WS_MIX, WS_VTS = WS_MIX + 68 * MiB, WS_QKV = WS_MIX + 136 * MiB, WS_KN = WS_MIX + 244 * MiB, WS_VT = WS_MIX + 276 * MiB;
constexpr size_t WS_UP = WS_MIX + 136 * MiB, WS_ACT = WS_MIX + 136 * MiB;
constexpr size_t WS_PART = WS_MIX + 236 * MiB;
constexpr size_t WS_BAR = WS_LB + 64 * 1024;
constexpr size_t WS_END = WS_MIX + 378 * MiB;

constexpr size_t O_YP = 0, O_YS = O_YP + (size_t)TP * D, O_SP = O_YS + (size_t)TS * D, O_SS = O_SP + 2 * 16 * 128 * 128, O_KP = O_SS + 32 * 16 * 128 * 128,
                 O_VP = O_KP + 2 * 512 * 2048, O_KSM = O_VP + 2 * 512 * 2048, O_VSM = O_KSM + 32 * 32 * 2048, O_CP = O_VSM + 32 * 32 * 2048, O_CS = O_CP + 2 * 2 * 2 * FF,
                 O_END = O_CS + 2 * 32 * 2 * FF;

struct Params {
    const float* x_prompt; const float* x_sample; const float* state_a_S; const float* cache_k; const float* cache_v; const float* conv_state;
    const float* norm_mix; const float* norm_ffn; const float* a_w_in; const float* a_gamma; const float* a_norm_o; const float* a_w_o;
    const float* b_w_qkv; const float* b_q_norm; const float* b_k_norm; const float* b_rel_bias; const float* b_w_o;
    const float* f_w_in; const float* f_conv_w; const float* f_conv_b; const float* f_w_down;
    float* out; unsigned char* ws; int ph_lo, ph_hi;
};

DI unsigned pk2(float lo, float hi) { f32x2 v = {lo, hi}; return __builtin_bit_cast(unsigned, __builtin_convertvector(v, bf16x2_t)); }
DI bf16 f2bf(float f) { return (bf16)(pk2(f, 0.f) & 0xffffu); }
DI float bflo(unsigned p) { return __uint_as_float(p << 16); }
DI float bfhi(unsigned p) { return __uint_as_float(p & 0xffff0000u); }
DI float wave_sum(float v) {
#pragma unroll
    for (int o = 1; o < 64; o <<= 1) v += __shfl_xor(v, o);
    return v;
}
DI float fexp(float x) { return __builtin_amdgcn_exp2f(x * 1.4426950408889634f); }
DI float fsigmoid(float z) { return __builtin_amdgcn_rcpf(1.f + fexp(-z)); }
DI float fsilu(float z) { return z * __builtin_amdgcn_rcpf(1.f + fexp(-z)); }
DI float flog(float x) { return __builtin_amdgcn_logf(x) * 0.6931471805599453f; }
DI int crow(int reg, int h) { return (reg & 3) + 8 * (reg >> 2) + 4 * h; }
#define MFMA32(a, b, c) __builtin_amdgcn_mfma_f32_32x32x16_bf16((a), (b), (c), 0, 0, 0)

namespace pg8 {
constexpr int BM = 256, BK = 64, HALF = 128, HTB = HALF * BK * 2, STAGE_BYTES = 8 * HTB, NXCD = 8, WGM = 8;
DI int lds_byte(int r, int c) { const int st = (r >> 4) * 2 + (c >> 5), rr = r & 15, cc = c & 31, ob = rr * 64 + cc * 2; return st * 1024 + (ob ^ (((ob >> 9) & 1) << 5)); }
DI void stage_rc(int b, int& R, int& C) { const int st = b / 1024, sb = b % 1024, swz = sb ^ (((sb >> 9) & 1) << 5); R = (st >> 1) * 16 + swz / 64; C = (st & 1) * 32 + (swz % 64) / 2; }
DI int perm32(int rho) { const int n = rho >> 4, i = rho & 15; return 8 * (i >> 2) + 4 * n + (i & 3); }
struct Unit { int pm, pn, kb0, nkt, slice; };
struct Gemm { const bf16* A; const bf16* Bt; int M, N, K; };
struct StaticOrder {
    int nM, nN, nwg, G, c, tail, nblk, nitems;
    DI void init(int M, int N, int K, int G_, int c_, int tail_) { tail = tail_; nM = tail ? TP / BM : M / BM; nN = N / BM; nwg = nM * nN; G = G_; c = c_; nblk = K / 128; nitems = nwg + (tail ? 256 : 0); }
    DI bool next(int i, Unit& u) const {
        const long L = (long)i * G + c; if (L >= nitems) return false;
        u.slice = -1; u.kb0 = 0; u.nkt = nblk * 2;
        if (L >= nwg) { const int j = (int)L - nwg, uu = j & 31; u.slice = j >> 5; u.pm = TP / BM + (uu >> 3); u.pn = uu & 7;
            const int base = nblk / 8, rem = nblk % 8; u.kb0 = u.slice * base + (u.slice < rem ? u.slice : rem); u.nkt = 2 * (base + (u.slice < rem ? 1 : 0)); return true; }
        int wgid = (int)L; { const int q = nwg / NXCD, r = nwg % NXCD, xcd = wgid % NXCD, off = wgid / NXCD; wgid = (xcd < r ? xcd * (q + 1) : r * (q + 1) + (xcd - r) * q) + off; }
        const int nig = WGM * nN, gid = wgid / nig, fm = gid * WGM, gsz = (nM - fm) < WGM ? (nM - fm) : WGM;
        u.pm = fm + ((wgid % nig) % gsz); u.pn = (wgid % nig) / gsz; return true;
    }
};

struct Epi {
    int mode;
    int ldo;
    bf16* ob;
    float* of; const float* resP; const float* resS;
    const float* lb; float* logf; unsigned char* wsb;
    float* part;
    const float* cw; const float* cbias; bf16* act; float* edge;
    DI bool perm() const { return mode != 2; }
    DI void operator()(const f32x4 (&acc)[2][2][4][2], const Unit& u, int wr, int wc, int fr, int fq) const {
        const int row0 = u.pm * BM + wr * 64 + fr;
        if (mode == 2 && u.slice >= 0) {
            const int col0 = u.pn * BM + wc * 32 + 4 * fq;
#pragma unroll
            for (int ai = 0; ai < 2; ++ai)
#pragma unroll
                for (int m = 0; m < 4; ++m) {
                    float* op = part + ((size_t)u.slice * TS + (row0 + ai * HALF + m * 16 - TP)) * D + col0;
#pragma unroll
                    for (int bj = 0; bj < 2; ++bj)
#pragma unroll
                        for (int n = 0; n < 2; ++n) *(f32x4*)(op + bj * HALF + n * 16) = acc[ai][bj][m][n];
                }
        } else if (mode == 2) {
            const int col0 = u.pn * BM + wc * 32 + 4 * fq;
#pragma unroll
            for (int ai = 0; ai < 2; ++ai) {
                f32x4 rr[4][2][2];
#pragma unroll
                for (int m = 0; m < 4; ++m) {
                    const int row = row0 + ai * HALF + m * 16;
                    const float* rp = (row < TP ? resP + (size_t)row * D : resS + (size_t)(row - TP) * D) + col0;
#pragma unroll
                    for (int bj = 0; bj < 2; ++bj)
#pragma unroll
                        for (int n = 0; n < 2; ++n) rr[m][bj][n] = *(const f32x4*)(rp + bj * HALF + n * 16);
                }
#pragma unroll
                for (int m = 0; m < 4; ++m) {
                    float* op = of + (size_t)(row0 + ai * HALF + m * 16) * D + col0;
#pragma unroll
                    for (int bj = 0; bj < 2; ++bj)
#pragma unroll
                        for (int n = 0; n < 2; ++n) *(f32x4*)(op + bj * HALF + n * 16) = rr[m][bj][n] + acc[ai][bj][m][n];
                }
            }
        } else if (mode == 3) {
            const int cc0 = u.pn * HALF + wc * 32 + 8 * fq;
            float w0[8], w1[8], w2[8], cb[8];
            { const f32x4 a0 = *(const f32x4*)(cw + cc0), a1 = *(const f32x4*)(cw + cc0 + 4), b0 = *(const f32x4*)(cw + FF + cc0), b1 = *(const f32x4*)(cw + FF + cc0 + 4);
              const f32x4 c0 = *(const f32x4*)(cw + 2 * FF + cc0), c1 = *(const f32x4*)(cw + 2 * FF + cc0 + 4), d0 = *(const f32x4*)(cbias + cc0), d1 = *(const f32x4*)(cbias + cc0 + 4);
#pragma unroll
              for (int e = 0; e < 4; ++e) { w0[e] = a0[e]; w0[4 + e] = a1[e]; w1[e] = b0[e]; w1[4 + e] = b1[e]; w2[e] = c0[e]; w2[4 + e] = c1[e]; cb[e] = d0[e]; cb[4 + e] = d1[e]; } }
            float* const eu_first = edge; float* const eg_first = edge + (size_t)(T / 32) * 2 * FF; float* const eu_last = edge + (size_t)(T / 32) * 4 * FF;
#pragma unroll
            for (int ai = 0; ai < 2; ++ai)
#pragma unroll
                for (int m = 0; m < 4; ++m) {
                    const int row = row0 + ai * HALF + m * 16, hb = row >> 5;
                    float a[8];
#pragma unroll
                    for (int n = 0; n < 2; ++n)
#pragma unroll
                        for (int e = 0; e < 4; ++e) {
                            const float cur = acc[ai][0][m][n][e];
                            const float prv = (m & 1) ? acc[ai][0][m - 1][n][e] : 0.f;
                            const int ci = __float_as_int(cur), pi = __float_as_int(prv);
                            const int r1 = __builtin_amdgcn_update_dpp(0, pi, 0x121, 0xf, 0xf, false), r2 = __builtin_amdgcn_update_dpp(0, pi, 0x122, 0xf, 0xf, false);
                            const float p1 = __int_as_float(__builtin_amdgcn_update_dpp(r1, ci, 0x111, 0xf, 0xf, false));
                            const float p2 = __int_as_float(__builtin_amdgcn_update_dpp(r2, ci, 0x112, 0xf, 0xf, false));
                            const int k = 4 * n + e;
                            a[k] = fsilu(cb[k] + p2 * w0[k] + p1 * w1[k] + cur * w2[k]) * acc[ai][1][m][n][e];
                        }
                    const bool first2 = ((m & 1) == 0) && (fr < 2), last2 = ((m & 1) == 1) && (fr >= 14);
                    if (!first2) { u32x4 o; o.x = pk2(a[0], a[1]); o.y = pk2(a[2], a[3]); o.z = pk2(a[4], a[5]); o.w = pk2(a[6], a[7]); *(u32x4*)(act + (size_t)row * FF + cc0) = o; }
                    else { float* du = eu_first + ((size_t)hb * 2 + fr) * FF + cc0; float* dg = eg_first + ((size_t)hb * 2 + fr) * FF + cc0;
                        *(f32x4*)du = acc[ai][0][m][0]; *(f32x4*)(du + 4) = acc[ai][0][m][1]; *(f32x4*)dg = acc[ai][1][m][0]; *(f32x4*)(dg + 4) = acc[ai][1][m][1]; }
                    if (last2) { float* du = eu_last + ((size_t)hb * 2 + (fr - 14)) * FF + cc0; *(f32x4*)du = acc[ai][0][m][0]; *(f32x4*)(du + 4) = acc[ai][0][m][1]; }
                }
        } else if (mode == 1) {
            const int col0 = u.pn * BM + wc * 32 + 8 * fq;
#pragma unroll
            for (int ai = 0; ai < 2; ++ai)
#pragma unroll
                for (int m = 0; m < 4; ++m) {
                    bf16* op = ob + (size_t)(row0 + ai * HALF + m * 16) * ldo + col0;
#pragma unroll
                    for (int bj = 0; bj < 2; ++bj) { const f32x4 v0 = acc[ai][bj][m][0], v1 = acc[ai][bj][m][1];
                        u32x4 o; o.x = pk2(v0.x, v0.y); o.y = pk2(v0.z, v0.w); o.z = pk2(v1.x, v1.y); o.w = pk2(v1.z, v1.w);
                        *(u32x4*)(op + bj * HALF) = o; }
                }
        } else {
            const int type = u.pn >> 3, col0 = (u.pn & 7) * BM + wc * 32 + 8 * fq;
#pragma unroll
            for (int bj = 0; bj < 2; ++bj) {
                const int col = col0 + bj * HALF;
                f32x4 l0 = {0.f, 0.f, 0.f, 0.f}, l1 = l0;
                if (type == 1) { l0 = *(const f32x4*)(lb + col); l1 = *(const f32x4*)(lb + col + 4); }
#pragma unroll
                for (int ai = 0; ai < 2; ++ai)
#pragma unroll
                    for (int m = 0; m < 4; ++m) {
                        const size_t off = (size_t)(row0 + ai * HALF + m * 16) * D + col;
                        f32x4 v0 = acc[ai][bj][m][0], v1 = acc[ai][bj][m][1];
                        if (type == 1) {
#pragma unroll
                            for (int e = 0; e < 4; ++e) { v0[e] = flog(l0[e] + (1.f - l0[e]) * fsigmoid(v0[e])); v1[e] = flog(l1[e] + (1.f - l1[e]) * fsigmoid(v1[e])); }
                            *(f32x4*)(logf + off) = v0; *(f32x4*)(logf + off + 4) = v1;
                        } else {
                            if (type == 3) {
#pragma unroll
                                for (int e = 0; e < 4; ++e) { v0[e] = fsilu(v0[e]); v1[e] = fsilu(v1[e]); }
                            }
                            u32x4 o; o.x = pk2(v0.x, v0.y); o.y = pk2(v0.z, v0.w); o.z = pk2(v1.x, v1.y); o.w = pk2(v1.z, v1.w);
                            bf16* dst = (bf16*)(wsb + (type == 0 ? WS_QB : (type == 2 ? WS_VB : WS_SG)));
                            *(u32x4*)(dst + off) = o;
                        }
                    }
            }
        }
    }
};

DI void gemm_phase(LAS unsigned char* lds, const Gemm g, const StaticOrder& S, const Epi& E, const int tid) {
    const int wid = __builtin_amdgcn_readfirstlane(tid >> 6), lane = tid & 63, wr = wid >> 2, wc = wid & 3, fr = lane & 15, fq = lane >> 4;
    const int K = g.K;
    const bool PERM = E.perm();
    unsigned voffA[2], voffB[2];
#pragma unroll
    for (int i = 0; i < 2; ++i) { int R, C; stage_rc(tid * 16 + i * 8192, R, C); const int Rb = PERM ? ((R & ~31) + perm32(R & 31)) : R;
        voffA[i] = (unsigned)(R * K + C) * 2u; voffB[i] = (unsigned)(Rb * K + C) * 2u; }
    const size_t kstep = (size_t)(BK * 2);
    const size_t hstep = (size_t)HALF * K * 2;
    const size_t tstep = 2 * hstep;
    const unsigned ldsw = (unsigned)wid * 1024u;
    const int aoff = lds_byte(wr * 64 + fr, fq * 8), boff = lds_byte(wc * 32 + fr, fq * 8);
#define PG8_SA(b, h) (((b) * 2 + (h)) * HTB)
#define PG8_SB(b, h) ((4 + (b) * 2 + (h)) * HTB)
#define PG8_STAGE(bufoff, gbase, voff) do { _Pragma("unroll") for (int _i = 0; _i < 2; ++_i) \
        __builtin_amdgcn_global_load_lds((const unsigned*)((const char*)(gbase) + (voff)[_i]), (LAS unsigned*)(lds + (bufoff) + ldsw + _i * 8192), 16, 0, 0); } while (0)
#define PG8_LDA(dst, b, h) do { _Pragma("unroll") for (int m = 0; m < 4; ++m) _Pragma("unroll") for (int k = 0; k < 2; ++k) dst[m][k] = *(const LAS bf16x8*)(lds + PG8_SA(b, h) + aoff + m * 2048 + k * 1024); } while (0)
#define PG8_LDB(dst, b, h) do { _Pragma("unroll") for (int n = 0; n < 2; ++n) _Pragma("unroll") for (int k = 0; k < 2; ++k) dst[n][k] = *(const LAS bf16x8*)(lds + PG8_SB(b, h) + boff + n * 2048 + k * 1024); } while (0)
#define PG8_MMA(ai, bj, At, Bt) do { __builtin_amdgcn_s_setprio(1); _Pragma("unroll") for (int m = 0; m < 4; ++m) _Pragma("unroll") for (int n = 0; n < 2; ++n) _Pragma("unroll") for (int k = 0; k < 2; ++k) \
        acc[ai][bj][m][n] = __builtin_amdgcn_mfma_f32_16x16x32_bf16(Bt[n][k], At[m][k], acc[ai][bj][m][n], 0, 0, 0); __builtin_amdgcn_s_setprio(0); } while (0)
#define PG8_WAIT_V(n) asm volatile("s_waitcnt vmcnt(" #n ")" ::: "memory")
#define PG8_WAIT_L(n) asm volatile("s_waitcnt lgkmcnt(" #n ")" ::: "memory")
#define PG8_BAR __builtin_amdgcn_s_barrier()
#define PG8_SCHED __builtin_amdgcn_sched_barrier(0)
    Unit cur, nxt; int ui = 0;
    if (!S.next(0, cur)) return;
    f32x4 acc[2][2][4][2];
#pragma unroll
    for (int a = 0; a < 2; ++a)
#pragma unroll
        for (int b = 0; b < 2; ++b)
#pragma unroll
            for (int m = 0; m < 4; ++m)
#pragma unroll
                for (int n = 0; n < 2; ++n) acc[a][b][m][n] = (f32x4){0.f, 0.f, 0.f, 0.f};
    bf16x8 At[4][2], B0[2][2], B1[2][2];
    const char* cA = (const char*)g.A + (size_t)cur.pm * tstep + (size_t)cur.kb0 * 256; const char* cB = (const char*)g.Bt + (size_t)cur.pn * tstep + (size_t)cur.kb0 * 256;
    PG8_STAGE(PG8_SB(0, 0), cB, voffB); PG8_STAGE(PG8_SA(0, 0), cA, voffA); PG8_STAGE(PG8_SB(0, 1), cB + hstep, voffB); PG8_STAGE(PG8_SA(0, 1), cA + hstep, voffA);
    if (wr == 1) PG8_BAR;
    PG8_WAIT_V(4); PG8_BAR;
    PG8_STAGE(PG8_SB(1, 0), cB + kstep, voffB); PG8_STAGE(PG8_SA(1, 0), cA + kstep, voffA); PG8_STAGE(PG8_SB(1, 1), cB + hstep + kstep, voffB);
    PG8_WAIT_V(6); PG8_BAR;
    for (;;) {
        const bool has_next = S.next(ui + 1, nxt);
        const char* nA = has_next ? (const char*)g.A + (size_t)nxt.pm * tstep + (size_t)nxt.kb0 * 256 : cA; const char* nB = has_next ? (const char*)g.Bt + (size_t)nxt.pn * tstep + (size_t)nxt.kb0 * 256 : cB;
        const int nt = cur.nkt;
        for (int t = 0; t < nt; t += 2) {
            const bool last = (t == nt - 2);
            const char* a1 = cA + (size_t)(t + 1) * kstep;
            const char* a2 = last ? nA : cA + (size_t)(t + 2) * kstep; const char* b2 = last ? nB : cB + (size_t)(t + 2) * kstep;
            const char* a3 = a2 + kstep; const char* b3 = b2 + kstep;
            PG8_LDB(B0, 0, 0); PG8_SCHED; PG8_LDA(At, 0, 0); PG8_STAGE(PG8_SA(1, 1), a1 + hstep, voffA);
            PG8_WAIT_L(8); PG8_BAR; PG8_WAIT_L(0); PG8_MMA(0, 0, At, B0); PG8_BAR; PG8_SCHED;
            PG8_LDB(B1, 0, 1); PG8_STAGE(PG8_SB(0, 0), b2, voffB);
            PG8_BAR; PG8_WAIT_L(0); PG8_MMA(0, 1, At, B1); PG8_BAR;
            PG8_LDA(At, 0, 1); PG8_STAGE(PG8_SA(0, 0), a2, voffA);
            PG8_BAR; PG8_WAIT_L(0); PG8_MMA(1, 0, At, B0); PG8_BAR; PG8_SCHED;
            PG8_STAGE(PG8_SB(0, 1), b2 + hstep, voffB);
            PG8_WAIT_V(6); PG8_BAR; PG8_MMA(1, 1, At, B1); PG8_BAR;
            PG8_LDB(B0, 1, 0); PG8_SCHED; PG8_LDA(At, 1, 0); PG8_STAGE(PG8_SA(0, 1), a2 + hstep, voffA);
            PG8_WAIT_L(8); PG8_BAR; PG8_WAIT_L(0); PG8_MMA(0, 0, At, B0); PG8_BAR; PG8_SCHED;
            PG8_LDB(B1, 1, 1); PG8_STAGE(PG8_SB(1, 0), b3, voffB);
            PG8_BAR; PG8_WAIT_L(0); PG8_MMA(0, 1, At, B1); PG8_BAR;
            PG8_LDA(At, 1, 1); PG8_STAGE(PG8_SA(1, 0), a3, voffA);
            PG8_BAR; PG8_WAIT_L(0); PG8_MMA(1, 0, At, B0); PG8_BAR; PG8_SCHED;
            PG8_STAGE(PG8_SB(1, 1), b3 + hstep, voffB);
            PG8_WAIT_V(6); PG8_BAR; PG8_MMA(1, 1, At, B1); PG8_BAR;
        }
        E(acc, cur, wr, wc, fr, fq);
        if (!has_next) break;
#pragma unroll
        for (int a = 0; a < 2; ++a)
#pragma unroll
            for (int b = 0; b < 2; ++b)
#pragma unroll
                for (int m = 0; m < 4; ++m)
#pragma unroll
                    for (int n = 0; n < 2; ++n) acc[a][b][m][n] = (f32x4){0.f, 0.f, 0.f, 0.f};
        cur = nxt; cA = nA; cB = nB; ++ui;
    }
    PG8_WAIT_V(0);
    if (wr == 0) PG8_BAR;
    PG8_BAR;
#undef PG8_SA
#undef PG8_SB
#undef PG8_STAGE
#undef PG8_LDA
#undef PG8_LDB
#undef PG8_MMA
#undef PG8_WAIT_V
#undef PG8_WAIT_L
#undef PG8_BAR
#undef PG8_SCHED
}
}

struct Frame {
    Params p; LAS unsigned char* lds; int tid, lane, wave, G, bid;
    bf16 *WinA, *WoA, *Wqkv, *WoB, *Fin0, *Fin1, *Fdn0, *Fdn1;
    float* LB; bf16 *HB, *QB;
    float* LOGF; bf16 *VB, *SG; float *OI, *LOCAL, *DEC;
    bf16 *QKV, *KN, *KS, *VT, *VTS, *UP, *ACT;
};

DI void transpose_item(const float* __restrict__ W, int K, int N, bf16* __restrict__ WT, LAS float* scr, int item, int lane, const bool ilv = false) {
    const int nblk = N / 64, kb = item / nblk, nb = item % nblk, k0 = 64 * kb, n0 = 64 * nb;
    const int lr = lane >> 4, lc = (lane & 15) * 4;
    f32x4 v[16];
    const float* src = W + (size_t)(k0 + lr) * N + n0 + lc;
#pragma unroll
    for (int i = 0; i < 16; ++i) v[i] = __builtin_nontemporal_load((const f32x4*)(src + (size_t)(4 * i) * N));
#pragma unroll
    for (int i = 0; i < 16; ++i) { LAS float* d = scr + (4 * i + lr) * 65 + lc; d[0] = v[i].x; d[1] = v[i].y; d[2] = v[i].z; d[3] = v[i].w; }
    asm volatile("s_waitcnt lgkmcnt(0)" ::: "memory");
    const int c = lane & 7;
#pragma unroll
    for (int j = 0; j < 8; ++j) { const int n = (lane >> 3) + 8 * j; const LAS float* s = scr + (8 * c) * 65 + n;
        u32x4 o; o.x = pk2(s[0 * 65], s[1 * 65]); o.y = pk2(s[2 * 65], s[3 * 65]); o.z = pk2(s[4 * 65], s[5 * 65]); o.w = pk2(s[6 * 65], s[7 * 65]);
        int nd = n0 + n; if (ilv) nd = (nd < FF) ? (((nd >> 7) << 8) + (nd & 127)) : ((((nd - FF) >> 7) << 8) + 128 + ((nd - FF) & 127));
        __builtin_nontemporal_store(o, (u32x4*)(WT + (size_t)nd * K + k0 + 8 * c)); }
    asm volatile("s_waitcnt lgkmcnt(0)" ::: "memory");
}
DI void rms_row(const float* __restrict__ xrow, const float* __restrict__ g, bf16* __restrict__ orow, int lane, const float* __restrict__ part, float* __restrict__ xdst) {
    const f32x4* xr = (const f32x4*)xrow + lane; const f32x4* gr = (const f32x4*)g + lane;
    f32x4 v[8]; float s = 0.f;
#pragma unroll
    for (int j = 0; j < 8; ++j) v[j] = xr[64 * j];
    if (part) {
#pragma unroll
        for (int sl = 0; sl < 8; ++sl) { const f32x4* pr = (const f32x4*)(part + (size_t)sl * TS * D) + lane;
#pragma unroll
            for (int j = 0; j < 8; ++j) v[j] += pr[64 * j]; }
#pragma unroll
        for (int j = 0; j < 8; ++j) ((f32x4*)xdst + lane)[64 * j] = v[j];
    }
#pragma unroll
    for (int j = 0; j < 8; ++j) s += (v[j].x * v[j].x + v[j].y * v[j].y) + (v[j].z * v[j].z + v[j].w * v[j].w);
    const float rstd = rsqrtf(wave_sum(s) * (1.f / D) + EPS);
    u32x2* o8 = (u32x2*)orow + lane;
#pragma unroll
    for (int j = 0; j < 8; ++j) { const f32x4 gg = gr[64 * j]; u32x2 o; o.x = pk2(v[j].x * rstd * gg.x, v[j].y * rstd * gg.y); o.y = pk2(v[j].z * rstd * gg.z, v[j].w * rstd * gg.w); o8[64 * j] = o; }
}
DI void rms_phase(Frame& F, const float* srcP, const float* srcS, const float* g, const float* part, float* xs) {
    const int gw = F.bid * NWAVES + F.wave, NGW = F.G * NWAVES;
    for (int m = gw; m < T; m += NGW) {
        if (m < TP) rms_row(srcP + (size_t)m * D, g, F.HB + (size_t)m * D, F.lane, nullptr, nullptr);
        else rms_row(srcS + (size_t)(m - TP) * D, g, F.HB + (size_t)m * D, F.lane, part ? part + (size_t)(m - TP) * D : nullptr, xs + (size_t)(m - TP) * D);
    }
}
DI void fin_phase(Frame& F, float* xs, const float* part) {
    const int gt = F.bid * NTHR + F.tid, NGT = F.G * NTHR;
    for (int it = gt; it < TS * D / 4; it += NGT) {
        f32x4 v = ((const f32x4*)xs)[it];
#pragma unroll
        for (int sl = 0; sl < 8; ++sl) v += ((const f32x4*)(part + (size_t)sl * TS * D))[it];
        ((f32x4*)xs)[it] = v;
    }
}
constexpr int I_WINA = (D / 64) * (NWIN / 64), I_WO = (D / 64) * (D / 64), I_QKV = (D / 64) * (NQKV / 64), I_FIN = (D / 64) * (NUP / 64), I_FDN = (FF / 64) * (D / 64);
constexpr int WC_EARLY = I_WINA + 2 * I_WO + I_QKV + I_FIN + I_FDN, WC_ALL = WC_EARLY + I_FIN + I_FDN;
DI void wconv_items(Frame& F, int it_lo, int it_hi, int widx, int nw) {
    const Params& p = F.p;
    LAS float* scr = (LAS float*)(F.lds + F.wave * 16640);
    for (int it = it_lo + widx * NWAVES + F.wave; it < it_hi; it += nw * NWAVES) {
        int r = it;
        if (r < I_WINA) { transpose_item(p.a_w_in, D, NWIN, F.WinA, scr, r, F.lane); continue; } r -= I_WINA;
        if (r < I_WO) { transpose_item(p.a_w_o, D, D, F.WoA, scr, r, F.lane); continue; } r -= I_WO;
        if (r < I_QKV) { transpose_item(p.b_w_qkv, D, NQKV, F.Wqkv, scr, r, F.lane); continue; } r -= I_QKV;
        if (r < I_WO) { transpose_item(p.b_w_o, D, D, F.WoB, scr, r, F.lane); continue; } r -= I_WO;
        if (r < I_FIN) { transpose_item(p.f_w_in, D, NUP, F.Fin0, scr, r, F.lane, true); continue; } r -= I_FIN;
        if (r < I_FDN) { transpose_item(p.f_w_down, FF, D, F.Fdn0, scr, r, F.lane); continue; } r -= I_FDN;
        if (r < I_FIN) { transpose_item(p.f_w_in + (size_t)D * NUP, D, NUP, F.Fin1, scr, r, F.lane, true); continue; } r -= I_FIN;
        transpose_item(p.f_w_down + (size_t)FF * D, FF, D, F.Fdn1, scr, r, F.lane);
    }
}
DI void p0_phase(Frame& F) {
    const Params& p = F.p;
    wconv_items(F, 0, WC_EARLY, F.bid, F.G);
    for (int c = F.bid * NTHR + F.tid; c < D; c += F.G * NTHR) {
        const float g0 = p.a_gamma[c], g1 = p.a_gamma[D + c], g2 = p.a_gamma[2 * D + c];
        const float mx = fmaxf(g0, fmaxf(g1, g2));
        const float e0 = __expf(g0 - mx), e1 = __expf(g1 - mx), e2 = __expf(g2 - mx);
        F.LB[c] = e0 / (e0 + e1 + e2);
    }
    rms_phase(F, p.x_prompt, p.x_sample, p.norm_mix, nullptr, nullptr);
}

constexpr int GLA_UNITS = 2048 + 512;
constexpr int QT_STRIDE = 136, TT_STRIDE = 72;
constexpr int L_BCUM = 0, L_QT = 32768, L_KT = L_QT + 64 * QT_STRIDE * 2, L_KHT = L_KT + 64 * QT_STRIDE * 2, L_VT = L_KHT + 128 * TT_STRIDE * 2, L_PM = L_VT + 128 * TT_STRIDE * 2, L_GLA_END = L_PM + 64 * TT_STRIDE * 2;
static_assert(L_GLA_END <= LDS_BYTES, "gla lds");

DI f32x16 mma_lds(const LAS bf16* A, int astride, int arow0, const LAS bf16* B, int bstride, int brow0, int nks, int lane) {
    f32x16 acc; for (int i = 0; i < 16; ++i) acc[i] = 0.f;
    const int r = lane & 31, hf = lane >> 5;
    const LAS bf16* ap = A + (arow0 + r) * astride + 8 * hf; const LAS bf16* bp = B + (brow0 + r) * bstride + 8 * hf;
    for (int ks = 0; ks < nks; ++ks) { const bf16x8 a = *(const LAS bf16x8*)(ap + 16 * ks), b = *(const LAS bf16x8*)(bp + 16 * ks); acc = MFMA32(a, b, acc); }
    return acc;
}

template <int BLK>
DI void gla_a_unit(Frame& F, int u, int row0, int h) {
    LAS float* bcum = (LAS float*)(F.lds + L_BCUM);
    LAS bf16* qt = (LAS bf16*)(F.lds + L_QT); LAS bf16* kt = (LAS bf16*)(F.lds + L_KT); LAS bf16* khT = (LAS bf16*)(F.lds + L_KHT);
    LAS bf16* vT = (LAS bf16*)(F.lds + L_VT); LAS bf16* Pm = (LAS bf16*)(F.lds + L_PM);
    const int tid = F.tid, lane = F.lane, w = F.wave;
    const size_t hoff = (size_t)h * HD;
    constexpr int SEG = BLK / 4;
    { const int seg = tid >> 7, kc = tid & 127; float a = 0.f;
      const float* lp = F.LOGF + (size_t)(row0 + seg * SEG) * D + hoff + kc;
#pragma unroll
      for (int t = 0; t < SEG; ++t) { a += lp[(size_t)t * D]; bcum[(seg * SEG + t) * 128 + kc] = a; }
      __syncthreads();
      float off = 0.f;
      for (int s = 0; s < seg; ++s) off += bcum[(s * SEG + SEG - 1) * 128 + kc];
      __syncthreads();
      if (seg > 0) {
#pragma unroll
          for (int t = 0; t < SEG; ++t) bcum[(seg * SEG + t) * 128 + kc] += off;
      }
      __syncthreads(); }
    for (int i = tid; i < BLK * 16; i += NTHR) {
        const int t = i >> 4, c0 = (i & 15) * 8;
        const size_t goff = (size_t)(row0 + t) * D + hoff + c0;
        const u32x4 qv = *(const u32x4*)(F.QB + goff);
        const u32x4 vv = *(const u32x4*)(F.VB + goff);
        const f32x4 lf0 = *(const f32x4*)(F.LOGF + goff), lf1 = *(const f32x4*)(F.LOGF + goff + 4);
        float q[8] = {bflo(qv.x), bfhi(qv.x), bflo(qv.y), bfhi(qv.y), bflo(qv.z), bfhi(qv.z), bflo(qv.w), bfhi(qv.w)};
        float lf[8] = {lf0.x, lf0.y, lf0.z, lf0.w, lf1.x, lf1.y, lf1.z, lf1.w};
        float qtv[8], ktv[8], qhv[8], khv[8];
#pragma unroll
        for (int e = 0; e < 8; ++e) {
            const float b = bcum[t * 128 + c0 + e], bmid = bcum[(BLK / 2 - 1) * 128 + c0 + e], bend = bcum[(BLK - 1) * 128 + c0 + e];
            const float kk = 1.f - __expf(lf[e]);
            qtv[e] = q[e] * __expf(b - bmid); ktv[e] = kk * __expf(bmid - b); qhv[e] = q[e] * __expf(b); khv[e] = kk * __expf(bend - b);
            if (t == BLK - 1) F.DEC[(size_t)u * 128 + c0 + e] = __expf(bend);
        }
        u32x4 o; o.x = pk2(qtv[0], qtv[1]); o.y = pk2(qtv[2], qtv[3]); o.z = pk2(qtv[4], qtv[5]); o.w = pk2(qtv[6], qtv[7]);
        *(LAS u32x4*)(qt + t * QT_STRIDE + c0) = o;
        o.x = pk2(ktv[0], ktv[1]); o.y = pk2(ktv[2], ktv[3]); o.z = pk2(ktv[4], ktv[5]); o.w = pk2(ktv[6], ktv[7]);
        *(LAS u32x4*)(kt + t * QT_STRIDE + c0) = o;
        o.x = pk2(qhv[0], qhv[1]); o.y = pk2(qhv[2], qhv[3]); o.z = pk2(qhv[4], qhv[5]); o.w = pk2(qhv[6], qhv[7]);
        *(u32x4*)(F.QB + goff) = o;
        const unsigned vw[4] = {vv.x, vv.y, vv.z, vv.w};
#pragma unroll
        for (int e = 0; e < 8; ++e) {
            khT[(c0 + e) * TT_STRIDE + t] = f2bf(khv[e]);
            vT[(c0 + e) * TT_STRIDE + t] = (bf16)((e & 1) ? (vw[e >> 1] >> 16) : (vw[e >> 1] & 0xffffu));
        }
    }
    __syncthreads();
    const int r = lane & 31, hf = lane >> 5;
#pragma unroll
    for (int q2 = 0; q2 < 2; ++q2) {
        const int tl = w * 2 + q2, mt = tl >> 2, nt = tl & 3;
        const f32x16 acc = mma_lds(khT, TT_STRIDE, 32 * mt, vT, TT_STRIDE, 32 * nt, BLK / 16, lane);
        float* lp = F.LOCAL + (size_t)u * 16384 + 32 * nt + r;
#pragma unroll
        for (int i = 0; i < 16; ++i) lp[(size_t)(32 * mt + crow(i, hf)) * 128] = acc[i];
    }
    constexpr int NT2 = BLK / 32;
    if (w < NT2 * NT2) {
        const int mt = w / NT2, nt = w % NT2;
        if (nt > mt) {
#pragma unroll
            for (int i = 0; i < 16; ++i) Pm[(32 * mt + crow(i, hf)) * TT_STRIDE + 32 * nt + r] = 0;
        } else {
            const f32x16 acc = mma_lds(qt, QT_STRIDE, 32 * mt, kt, QT_STRIDE, 32 * nt, 8, lane);
#pragma unroll
            for (int i = 0; i < 16; ++i) { const int t = 32 * mt + crow(i, hf), s = 32 * nt + r; Pm[t * TT_STRIDE + s] = (s <= t) ? f2bf(acc[i]) : (bf16)0; }
        }
    }
    __syncthreads();
    if (w < NT2 * 4) {
        const int mt = w >> 2, nt = w & 3;
        const f32x16 acc = mma_lds(Pm, TT_STRIDE, 32 * mt, vT, TT_STRIDE, 32 * nt, BLK / 16, lane);
        float* op = F.OI + (size_t)(row0 + 32 * mt) * D + hoff + 32 * nt + r;
#pragma unroll
        for (int i = 0; i < 16; ++i) op[(size_t)crow(i, hf) * D] = acc[i];
    }
    __syncthreads();
}
DI void gla_a_phase(Frame& F) {
    for (int u = F.bid; u < GLA_UNITS; u += F.G) {
        if (u < 2048) { const int b = u >> 10, h = (u >> 6) & 15, c = u & 63; gla_a_unit<64>(F, u, b * SEQ + c * 64, h); }
        else { const int su = u - 2048, b = su >> 4, h = su & 15; gla_a_unit<32>(F, u, TP + b * 32, h); }
    }
}
DI void scan_phase(Frame& F) {
    const int gt = F.bid * NTHR + F.tid, NGT = F.G * NTHR;
    for (int it = gt; it < 32 * 4096; it += NGT) {
        const int bh = it >> 12, e = (it & 4095) * 4, kc = e >> 7;
        f32x4 S = {0.f, 0.f, 0.f, 0.f};
        float* __restrict__ lp = F.LOCAL + (size_t)(bh * 64) * 16384 + e; const float* __restrict__ dp = F.DEC + (size_t)(bh * 64) * 128 + kc;
        for (int c0 = 0; c0 < 64; c0 += 8) {
            f32x4 loc[8]; float d[8];
#pragma unroll
            for (int j = 0; j < 8; ++j) { loc[j] = *(const f32x4*)(lp + (size_t)(c0 + j) * 16384); d[j] = dp[(c0 + j) * 128]; }
#pragma unroll
            for (int j = 0; j < 8; ++j) { *(f32x4*)(lp + (size_t)(c0 + j) * 16384) = S; S = S * d[j] + loc[j]; }
        }
        *(f32x4*)(F.p.out + O_SP + (size_t)bh * 16384 + e) = S;
    }
    for (int it0 = gt; it0 < 512 * 4096; it0 += 4 * NGT) {
        f32x4 S0[4], loc[4]; float d[4];
#pragma unroll
        for (int j = 0; j < 4; ++j) { const int it = it0 + j * NGT; if (it < 512 * 4096) { const int bh = it >> 12, e = (it & 4095) * 4, kc = e >> 7;
            S0[j] = *(const f32x4*)(F.p.state_a_S + (size_t)bh * 16384 + e); loc[j] = *(const f32x4*)(F.LOCAL + (size_t)(2048 + bh) * 16384 + e); d[j] = F.DEC[(size_t)(2048 + bh) * 128 + kc]; } }
#pragma unroll
        for (int j = 0; j < 4; ++j) { const int it = it0 + j * NGT; if (it < 512 * 4096) { const int bh = it >> 12, e = (it & 4095) * 4;
            *(f32x4*)(F.p.out + O_SS + (size_t)bh * 16384 + e) = S0[j] * d[j] + loc[j]; } }
    }
}
constexpr int OB_STRIDE = 132;
template <int BLK>
DI void gla_c_unit(Frame& F, const float* __restrict__ S, int row0, int h) {
    LAS float* ob = (LAS float*)F.lds;
    const int tid = F.tid, lane = F.lane, w = F.wave, r = lane & 31, hf = lane >> 5;
    const size_t hoff = (size_t)h * HD;
    constexpr int TPR_ = NTHR / BLK, CPT_ = 128 / TPR_;
    u32x4 sgv[CPT_ / 8];
    { const int t = tid / TPR_, c0 = (tid % TPR_) * CPT_;
#pragma unroll
      for (int e8 = 0; e8 < CPT_ / 8; ++e8) sgv[e8] = *(const u32x4*)(F.SG + (size_t)(row0 + t) * D + hoff + c0 + 8 * e8); }
    if (w < (BLK / 32) * 4) {
        const int mt = w >> 2, nt = w & 3;
        f32x16 acc; for (int i = 0; i < 16; ++i) acc[i] = 0.f;
        float oiv[16];
        { const float* oi = F.OI + (size_t)(row0 + 32 * mt) * D + hoff + 32 * nt + r;
#pragma unroll
          for (int i = 0; i < 16; ++i) oiv[i] = oi[(size_t)crow(i, hf) * D]; }
        const bf16* ap = F.QB + (size_t)(row0 + 32 * mt + r) * D + hoff + 8 * hf;
        const float* sp = S + (size_t)(8 * hf) * 128 + 32 * nt + r;
#pragma unroll
        for (int ks = 0; ks < 8; ++ks) {
            const bf16x8 a = *(const bf16x8*)(ap + 16 * ks);
            float sv[8];
#pragma unroll
            for (int e = 0; e < 8; ++e) sv[e] = sp[(size_t)(16 * ks + e) * 128];
            u32x4 bb; bb.x = pk2(sv[0], sv[1]); bb.y = pk2(sv[2], sv[3]); bb.z = pk2(sv[4], sv[5]); bb.w = pk2(sv[6], sv[7]);
            acc = MFMA32(a, __builtin_bit_cast(bf16x8, bb), acc);
        }
#pragma unroll
        for (int i = 0; i < 16; ++i) { const int t = crow(i, hf); ob[(32 * mt + t) * OB_STRIDE + 32 * nt + r] = acc[i] + oiv[i]; }
    }
    __syncthreads();
    {
        constexpr int TPR = NTHR / BLK;
        constexpr int CPT = 128 / TPR;
        const int t = tid / TPR, j = tid % TPR, c0 = j * CPT;
        float v[CPT]; float ss = 0.f;
#pragma unroll
        for (int e = 0; e < CPT; ++e) { v[e] = ob[t * OB_STRIDE + c0 + e]; ss += v[e] * v[e]; }
#pragma unroll
        for (int o = 1; o < TPR; o <<= 1) ss += __shfl_xor(ss, o);
        const float rstd = rsqrtf(ss * (1.f / HD) + EPS);
        const size_t goff = (size_t)(row0 + t) * D + hoff + c0;
#pragma unroll
        for (int e8 = 0; e8 < CPT / 8; ++e8) {
            const u32x4 sg = sgv[e8];
            const f32x4 n0 = *(const f32x4*)(F.p.a_norm_o + c0 + 8 * e8), n1 = *(const f32x4*)(F.p.a_norm_o + c0 + 8 * e8 + 4);
            const float* vv = v + 8 * e8;
            u32x4 o;
            o.x = pk2(vv[0] * rstd * n0.x * bflo(sg.x), vv[1] * rstd * n0.y * bfhi(sg.x));
            o.y = pk2(vv[2] * rstd * n0.z * bflo(sg.y), vv[3] * rstd * n0.w * bfhi(sg.y));
            o.z = pk2(vv[4] * rstd * n1.x * bflo(sg.z), vv[5] * rstd * n1.y * bfhi(sg.z));
            o.w = pk2(vv[6] * rstd * n1.z * bflo(sg.w), vv[7] * rstd * n1.w * bfhi(sg.w));
            *(u32x4*)(F.HB + goff + 8 * e8) = o;
        }
    }
    __syncthreads();
}
DI void gla_c_phase(Frame& F) {
    for (int u = F.bid; u < GLA_UNITS; u += F.G) {
        if (u < 2048) { const int b = u >> 10, h = (u >> 6) & 15, c = u & 63; gla_c_unit<64>(F, F.LOCAL + (size_t)u * 16384, b * SEQ + c * 64, h); }
        else { const int su = u - 2048, b = su >> 4, h = su & 15; gla_c_unit<32>(F, F.p.state_a_S + (size_t)su * 16384, TP + b * 32, h); }
    }
}
DI void convfix_phase(Frame& F, int layer, const float* edge) {
    const Params& p = F.p;
    const int gt = F.bid * NTHR + F.tid, NGT = F.G * NTHR;
    constexpr int NCG = FF / 8, NHB = T / 32;
    const float* cw = p.f_conv_w + (size_t)layer * 3 * FF; const float* cbp = p.f_conv_b + (size_t)layer * FF;
    const float* eu_first = edge; const float* eg_first = edge + (size_t)NHB * 2 * FF; const float* eu_last = edge + (size_t)NHB * 4 * FF;
    for (int it = gt; it < NHB * NCG; it += NGT) {
        const int hb = it / NCG, c0 = (it % NCG) * 8;
        const bool smp = hb >= 256; const bool first = smp || ((hb & 127) == 0), lastb = smp || ((hb & 127) == 127);
        float um2[8], um1[8], u0[8], u1[8], g0[8], g1[8], w0[8], w1[8], w2[8], bb[8];
#pragma unroll
        for (int e = 0; e < 8; ++e) { w0[e] = cw[c0 + e]; w1[e] = cw[FF + c0 + e]; w2[e] = cw[2 * FF + c0 + e]; bb[e] = cbp[c0 + e]; um2[e] = 0.f; um1[e] = 0.f;
            u0[e] = eu_first[((size_t)hb * 2) * FF + c0 + e]; u1[e] = eu_first[((size_t)hb * 2 + 1) * FF + c0 + e];
            g0[e] = eg_first[((size_t)hb * 2) * FF + c0 + e]; g1[e] = eg_first[((size_t)hb * 2 + 1) * FF + c0 + e]; }
        if (first) {
            if (smp) { const float* st = p.conv_state + ((size_t)(layer * 32 + (hb - 256)) * 2) * FF + c0;
#pragma unroll
                for (int e = 0; e < 8; ++e) { um2[e] = st[e]; um1[e] = st[FF + e]; } }
        } else {
#pragma unroll
            for (int e = 0; e < 8; ++e) { um2[e] = eu_last[((size_t)(hb - 1) * 2) * FF + c0 + e]; um1[e] = eu_last[((size_t)(hb - 1) * 2 + 1) * FF + c0 + e]; }
        }
        float a0[8], a1[8];
#pragma unroll
        for (int e = 0; e < 8; ++e) { a0[e] = fsilu(bb[e] + um2[e] * w0[e] + um1[e] * w1[e] + u0[e] * w2[e]) * g0[e]; a1[e] = fsilu(bb[e] + um1[e] * w0[e] + u0[e] * w1[e] + u1[e] * w2[e]) * g1[e]; }
        u32x4 o; o.x = pk2(a0[0], a0[1]); o.y = pk2(a0[2], a0[3]); o.z = pk2(a0[4], a0[5]); o.w = pk2(a0[6], a0[7]);
        *(u32x4*)(F.ACT + (size_t)(hb * 32) * FF + c0) = o;
        o.x = pk2(a1[0], a1[1]); o.y = pk2(a1[2], a1[3]); o.z = pk2(a1[4], a1[5]); o.w = pk2(a1[6], a1[7]);
        *(u32x4*)(F.ACT + (size_t)(hb * 32 + 1) * FF + c0) = o;
        if (lastb) {
            float* dst = smp ? p.out + O_CS + ((size_t)(layer * 32 + (hb - 256)) * 2) * FF + c0 : p.out + O_CP + ((size_t)(layer * 2 + (hb >> 7)) * 2) * FF + c0;
#pragma unroll
            for (int e = 0; e < 8; ++e) { dst[e] = eu_last[((size_t)hb * 2) * FF + c0 + e]; dst[FF + e] = eu_last[((size_t)hb * 2 + 1) * FF + c0 + e]; }
        }
    }
}
DI void cacheK_fill(Frame& F, int widx, int nw) {
    const Params& p = F.p;
    const int gt = widx * NTHR + F.tid, NGT = nw * NTHR;
    for (int it0 = gt; it0 < 32 * 512 * (D / 8); it0 += 4 * NGT) {
        f32x4 a[4], c[4];
#pragma unroll
        for (int j = 0; j < 4; ++j) { const int it = it0 + j * NGT; if (it < 32 * 512 * (D / 8)) { const int row = it >> 8, cc = (it & 255) * 8;
            a[j] = __builtin_nontemporal_load((const f32x4*)(p.cache_k + (size_t)row * D + cc)); c[j] = __builtin_nontemporal_load((const f32x4*)(p.cache_k + (size_t)row * D + cc + 4)); } }
#pragma unroll
        for (int j = 0; j < 4; ++j) { const int it = it0 + j * NGT; if (it < 32 * 512 * (D / 8)) { const int row = it >> 8, cc = (it & 255) * 8, b = row >> 9, jj = row & 511;
            u32x4 o; o.x = pk2(a[j].x, a[j].y); o.y = pk2(a[j].z, a[j].w); o.z = pk2(c[j].x, c[j].y); o.w = pk2(c[j].z, c[j].w);
            __builtin_nontemporal_store(o, (u32x4*)(F.KS + ((size_t)b * SROWS + jj) * D + cc)); } }
    }
}
constexpr int VT_NP = 2 * 64 * 16, VT_NN = 32 * 16, VT_NC = 32 * 16 * 8;
DI void vtrans_items(Frame& F, int it_lo, int it_hi, int widx, int nw) {
    const Params& p = F.p; const int lane = F.lane;
    LAS bf16* tile = (LAS bf16*)(F.lds + F.wave * 16640);
    for (int it = it_lo + widx * NWAVES + F.wave; it < it_hi; it += nw * NWAVES) {
        int nrows = 64; bf16* dst; int dstride;
        if (it < VT_NP) {
            const int h = it & 15, tb = (it >> 4) & 63, b = it >> 10;
            const bf16* src = F.QKV + (size_t)(b * SEQ + tb * 64) * NQKV + 2 * D + h * HD + 2 * lane;
            unsigned u[64];
#pragma unroll
            for (int i = 0; i < 64; ++i) u[i] = *(const unsigned*)(src + (size_t)i * NQKV);
#pragma unroll
            for (int i = 0; i < 64; ++i) *(LAS unsigned*)(tile + i * 130 + 2 * lane) = u[i];
            dst = F.VT + ((size_t)(b * 16 + h) * HD) * SEQ + tb * 64; dstride = SEQ;
        } else if (it < VT_NP + VT_NN) {
            const int r = it - VT_NP, h = r & 15, b = r >> 4;
            nrows = 32;
            const bf16* src = F.QKV + (size_t)(TP + b * 32) * NQKV + 2 * D + h * HD + 2 * lane;
            unsigned u[32];
#pragma unroll
            for (int i = 0; i < 32; ++i) u[i] = *(const unsigned*)(src + (size_t)i * NQKV);
#pragma unroll
            for (int i = 0; i < 32; ++i) *(LAS unsigned*)(tile + i * 130 + 2 * lane) = u[i];
            dst = F.VTS + ((size_t)(b * 16 + h) * HD) * SROWS + 512; dstride = SROWS;
        } else {
            const int r = it - VT_NP - VT_NN, h = r & 15, jb = (r >> 4) & 7, b = r >> 7;
            const float* src = p.cache_v + ((size_t)(b * 512 + jb * 64) * NH + h) * HD + 2 * lane;
#pragma unroll
            for (int hh = 0; hh < 2; ++hh) {
                f32x2 x[32];
#pragma unroll
                for (int i = 0; i < 32; ++i) x[i] = __builtin_nontemporal_load((const f32x2*)(src + (size_t)(32 * hh + i) * D));
#pragma unroll
                for (int i = 0; i < 32; ++i) *(LAS unsigned*)(tile + (32 * hh + i) * 130 + 2 * lane) = pk2(x[i].x, x[i].y);
            }
            dst = F.VTS + ((size_t)(b * 16 + h) * HD) * SROWS + jb * 64; dstride = SROWS;
        }
        asm volatile("s_waitcnt lgkmcnt(0)" ::: "memory");
        const int tp = lane & 31, dh = lane >> 5;
        if (2 * tp < nrows) {
#pragma unroll 8
            for (int pp = 0; pp < 64; ++pp) { const int dv = 2 * pp + dh;
                const unsigned lo = tile[(2 * tp) * 130 + dv], hi = tile[(2 * tp + 1) * 130 + dv];
                *(unsigned*)(dst + (size_t)dv * dstride + 2 * tp) = lo | (hi << 16); }
        }
        asm volatile("s_waitcnt lgkmcnt(0)" ::: "memory");
    }
}
DI void prep_phase(Frame& F) {
    const Params& p = F.p;
    const int gw = F.bid * NWAVES + F.wave, NGW = F.G * NWAVES, lane = F.lane;
    const float qscale = 0.08838834764831845f * 1.4426950408889634f;
    for (int m = gw; m < T; m += NGW) {
        const bf16* src = F.QKV + (size_t)m * NQKV + lane * 8;
        const bool smp = m >= TP; const int b = smp ? (m - TP) >> 5 : m >> 12, t = smp ? (m - TP) & 31 : m & 4095;
        const int hc = (lane & 15) * 8;
        u32x4 xq[4], xk[4], xv[4];
#pragma unroll
        for (int j = 0; j < 4; ++j) { xq[j] = *(const u32x4*)(src + j * 512); xk[j] = *(const u32x4*)(src + D + j * 512); xv[j] = *(const u32x4*)(src + 2 * D + j * 512); }
        float* ko = nullptr; float* vo = nullptr;
        if (smp) { ko = p.out + O_KSM + (size_t)(m - TP) * D + lane * 8; vo = p.out + O_VSM + (size_t)(m - TP) * D + lane * 8; }
        else if (t >= SEQ - 512) { ko = p.out + O_KP + ((size_t)b * 512 + (t - (SEQ - 512))) * D + lane * 8; vo = p.out + O_VP + ((size_t)b * 512 + (t - (SEQ - 512))) * D + lane * 8; }
        const f32x4 gq0 = *(const f32x4*)(p.b_q_norm + hc), gq1 = *(const f32x4*)(p.b_q_norm + hc + 4);
        const f32x4 gk0 = *(const f32x4*)(p.b_k_norm + hc), gk1 = *(const f32x4*)(p.b_k_norm + hc + 4);
        bf16* qdst = F.QB + (size_t)m * D + lane * 8;
        bf16* kdst = smp ? F.KS + ((size_t)b * SROWS + 512 + t) * D + lane * 8 : F.KN + (size_t)m * D + lane * 8;
#pragma unroll
        for (int j = 0; j < 4; ++j) {
            { const u32x4 x = xq[j]; const float v[8] = {bflo(x.x), bfhi(x.x), bflo(x.y), bfhi(x.y), bflo(x.z), bfhi(x.z), bflo(x.w), bfhi(x.w)};
              float ss = 0.f;
#pragma unroll
              for (int e = 0; e < 8; ++e) ss += v[e] * v[e];
              ss += __shfl_xor(ss, 1); ss += __shfl_xor(ss, 2); ss += __shfl_xor(ss, 4); ss += __shfl_xor(ss, 8);
              const float rstd = rsqrtf(ss * (1.f / HD) + EPS) * qscale;
              u32x4 o; o.x = pk2(v[0] * rstd * gq0.x, v[1] * rstd * gq0.y); o.y = pk2(v[2] * rstd * gq0.z, v[3] * rstd * gq0.w);
              o.z = pk2(v[4] * rstd * gq1.x, v[5] * rstd * gq1.y); o.w = pk2(v[6] * rstd * gq1.z, v[7] * rstd * gq1.w);
              *(u32x4*)(qdst + j * 512) = o; }
            { const u32x4 x = xk[j]; const float v[8] = {bflo(x.x), bfhi(x.x), bflo(x.y), bfhi(x.y), bflo(x.z), bfhi(x.z), bflo(x.w), bfhi(x.w)};
              float ss = 0.f;
#pragma unroll
              for (int e = 0; e < 8; ++e) ss += v[e] * v[e];
              ss += __shfl_xor(ss, 1); ss += __shfl_xor(ss, 2); ss += __shfl_xor(ss, 4); ss += __shfl_xor(ss, 8);
              const float rstd = rsqrtf(ss * (1.f / HD) + EPS);
              const f32x4 a = {v[0] * rstd * gk0.x, v[1] * rstd * gk0.y, v[2] * rstd * gk0.z, v[3] * rstd * gk0.w};
              const f32x4 c = {v[4] * rstd * gk1.x, v[5] * rstd * gk1.y, v[6] * rstd * gk1.z, v[7] * rstd * gk1.w};
              u32x4 o; o.x = pk2(a.x, a.y); o.y = pk2(a.z, a.w); o.z = pk2(c.x, c.y); o.w = pk2(c.z, c.w);
              *(u32x4*)(kdst + j * 512) = o;
              if (ko) { *(f32x4*)(ko + j * 512) = a; *(f32x4*)(ko + j * 512 + 4) = c; } }
            if (vo) { const u32x4 x = xv[j];
              const f32x4 a = {bflo(x.x), bfhi(x.x), bflo(x.y), bfhi(x.y)}, c = {bflo(x.z), bfhi(x.z), bflo(x.w), bfhi(x.w)};
              *(f32x4*)(vo + j * 512) = a; *(f32x4*)(vo + j * 512 + 4) = c; }
        }
    }
    vtrans_items(F, 0, VT_NP + VT_NN, F.bid, F.G);
}
DI void attn_step(f32x16 (&oacc)[4], float& mrun, float& lsum, const bf16x8 (&qf)[8], const bf16x8 (&kf)[8], const bf16x8 (&vf)[2][4], int relb, const LAS float* bias, float bias0, int hf) {
    f32x16 s; for (int i = 0; i < 16; ++i) s[i] = 0.f;
#pragma unroll
    for (int kk = 0; kk < 8; ++kk) s = MFMA32(kf[kk], qf[kk], s);
    if (relb + 31 <= -128) {
#pragma unroll
        for (int i = 0; i < 16; ++i) s[i] += bias0;
    } else {
#pragma unroll
        for (int i = 0; i < 16; ++i) { int rel = relb + crow(i, hf); rel = rel < -128 ? -128 : (rel > 63 ? 63 : rel); s[i] += bias[rel + 128]; }
    }
    float mt = s[0];
#pragma unroll
    for (int i = 1; i < 16; ++i) mt = fmaxf(mt, s[i]);
    mt = fmaxf(mt, __shfl_xor(mt, 32));
    const float mnew = fmaxf(mrun, mt), alpha = __builtin_amdgcn_exp2f(mrun - mnew);
    mrun = mnew;
    float ps = 0.f; float pv[16];
#pragma unroll
    for (int i = 0; i < 16; ++i) { pv[i] = __builtin_amdgcn_exp2f(s[i] - mnew); ps += pv[i]; }
    lsum = lsum * alpha + ps;
#pragma unroll
    for (int bl = 0; bl < 4; ++bl)
#pragma unroll
        for (int i = 0; i < 16; ++i) oacc[bl][i] *= alpha;
#pragma unroll
    for (int kb = 0; kb < 2; ++kb) {
        u32x4 pb; pb.x = pk2(pv[8 * kb], pv[8 * kb + 1]); pb.y = pk2(pv[8 * kb + 2], pv[8 * kb + 3]); pb.z = pk2(pv[8 * kb + 4], pv[8 * kb + 5]); pb.w = pk2(pv[8 * kb + 6], pv[8 * kb + 7]);
        const bf16x8 pfr = __builtin_bit_cast(bf16x8, pb);
#pragma unroll
        for (int bl = 0; bl < 4; ++bl) oacc[bl] = MFMA32(vf[kb][bl], pfr, oacc[bl]);
    }
}
constexpr int AK_STRIDE = 136, AV_STRIDE = 72, A_KBYTES = 64 * AK_STRIDE * 2, A_VBYTES = 128 * AV_STRIDE * 2, A_BUF = A_KBYTES + A_VBYTES;
constexpr int A_BIAS_OFF = 135168;
static_assert(2 * A_BUF <= A_BIAS_OFF && 8 * 16384 + 8 * 256 <= A_BIAS_OFF && A_BIAS_OFF + 768 <= LDS_BYTES - 16, "attention lds");

DI void attn_phase(Frame& F) {
    const Params& p = F.p;
    const int lane = F.lane, w = F.wave, tid = F.tid, r = lane & 31, hf = lane >> 5;
    constexpr float L2E = 1.4426950408889634f;
    for (int su = F.bid; su < 512; su += F.G) {
        const int h = su & 15, b = su >> 4, qrow0 = TP + b * 32;
        const bf16* kbase = F.KS + (size_t)(b * SROWS) * D + h * HD; const bf16* vbase = F.VTS + ((size_t)(b * 16 + h) * HD) * SROWS;
        LAS float* bias = (LAS float*)(F.lds + A_BIAS_OFF);
        if (tid < 192) bias[tid] = p.b_rel_bias[tid * NH + h] * L2E;
        bf16x8 qf[8];
        { const bf16* qp = F.QB + (size_t)(qrow0 + r) * D + h * HD + 8 * hf;
#pragma unroll
          for (int kk = 0; kk < 8; ++kk) qf[kk] = *(const bf16x8*)(qp + 16 * kk); }
        f32x16 oacc[4];
#pragma unroll
        for (int bl = 0; bl < 4; ++bl) for (int i = 0; i < 16; ++i) oacc[bl][i] = 0.f;
        float mrun = -1e30f, lsum = 0.f;
        __syncthreads();
        const float bias0 = bias[0];
        for (int kt = w; kt < 17; kt += 8) {
            bf16x8 kf[8], vf[2][4];
            { const bf16* kp = kbase + (size_t)(32 * kt + r) * D + 8 * hf;
#pragma unroll
              for (int kk = 0; kk < 8; ++kk) kf[kk] = *(const bf16x8*)(kp + 16 * kk); }
#pragma unroll
            for (int kb = 0; kb < 2; ++kb)
#pragma unroll
                for (int bl = 0; bl < 4; ++bl) { const bf16* vp = vbase + (size_t)(32 * bl + r) * SROWS + 32 * kt + 16 * kb + 4 * hf;
                    const u32x2 v0 = *(const u32x2*)vp, v1 = *(const u32x2*)(vp + 8); u32x4 vv; vv.x = v0.x; vv.y = v0.y; vv.z = v1.x; vv.w = v1.y; vf[kb][bl] = __builtin_bit_cast(bf16x8, vv); }
            attn_step(oacc, mrun, lsum, qf, kf, vf, -512 + 32 * kt - r, bias, bias0, hf);
        }
        lsum += __shfl_xor(lsum, 32);
        LAS float* op = (LAS float*)(F.lds + w * 16384); LAS float* ml = (LAS float*)(F.lds + 8 * 16384 + w * 256);
#pragma unroll
        for (int bl = 0; bl < 4; ++bl)
#pragma unroll
            for (int i = 0; i < 16; ++i) op[(32 * bl + crow(i, hf)) * 32 + r] = oacc[bl][i];
        if (hf == 0) { ml[2 * r] = mrun; ml[2 * r + 1] = lsum; }
        __syncthreads();
        { const int q = tid & 31, dv0 = (tid >> 5) * 8;
          float mw[8], M = -1e30f;
#pragma unroll
          for (int ww = 0; ww < 8; ++ww) { mw[ww] = ((LAS float*)(F.lds + 8 * 16384 + ww * 256))[2 * q]; M = fmaxf(M, mw[ww]); }
          float o[8] = {0.f, 0.f, 0.f, 0.f, 0.f, 0.f, 0.f, 0.f}, L = 0.f;
#pragma unroll
          for (int ww = 0; ww < 8; ++ww) { const float sc = __builtin_amdgcn_exp2f(mw[ww] - M); L += sc * ((LAS float*)(F.lds + 8 * 16384 + ww * 256))[2 * q + 1];
              const LAS float* pp = (LAS float*)(F.lds + ww * 16384) + dv0 * 32 + q;
#pragma unroll
              for (int e = 0; e < 8; ++e) o[e] += sc * pp[e * 32]; }
          const float inv = 1.f / L;
          u32x4 ov; ov.x = pk2(o[0] * inv, o[1] * inv); ov.y = pk2(o[2] * inv, o[3] * inv); ov.z = pk2(o[4] * inv, o[5] * inv); ov.w = pk2(o[6] * inv, o[7] * inv);
          *(u32x4*)(F.HB + (size_t)(qrow0 + q) * D + h * HD + dv0) = ov; }
        __syncthreads();
    }
    for (int unit = F.bid; unit < 512; unit += F.G) {
        const int cq = unit & 15, h = (unit >> 4) & 15, b = unit >> 8;
        const int cw = 4 * cq + (w >> 1), qrow0 = b * SEQ + cw * 64 + (w & 1) * 32;
        const int kc_lo = (4 * cq - 8) > 0 ? 4 * cq - 8 : 0, kc_hi = 4 * cq + 3;
        LAS float* bias = (LAS float*)(F.lds + A_BIAS_OFF);
        if (tid < 192) bias[tid] = p.b_rel_bias[tid * NH + h] * L2E;
        const bf16* kg = F.KN + (size_t)(b * SEQ) * D + h * HD;
        const bf16* vg = F.VT + ((size_t)(b * 16 + h) * HD) * SEQ;
        const int kr0 = tid >> 4, ks0 = tid & 15, vr0 = tid >> 3, vs0 = tid & 7;
        u32x4 st[4];
#define A_GLOAD(kc) do { st[0] = *(const u32x4*)(kg + (size_t)((kc) * 64 + kr0) * D + ks0 * 8); st[1] = *(const u32x4*)(kg + (size_t)((kc) * 64 + kr0 + 32) * D + ks0 * 8); \
                         st[2] = *(const u32x4*)(vg + (size_t)vr0 * SEQ + (kc) * 64 + vs0 * 8); st[3] = *(const u32x4*)(vg + (size_t)(vr0 + 64) * SEQ + (kc) * 64 + vs0 * 8); } while (0)
#define A_LWRITE(buf) do { LAS bf16* kb_ = (LAS bf16*)(F.lds + (buf) * A_BUF); LAS bf16* vb_ = (LAS bf16*)(F.lds + (buf) * A_BUF + A_KBYTES); \
                         *(LAS u32x4*)(kb_ + kr0 * AK_STRIDE + ks0 * 8) = st[0]; *(LAS u32x4*)(kb_ + (kr0 + 32) * AK_STRIDE + ks0 * 8) = st[1]; \
                         *(LAS u32x4*)(vb_ + vr0 * AV_STRIDE + vs0 * 8) = st[2]; *(LAS u32x4*)(vb_ + (vr0 + 64) * AV_STRIDE + vs0 * 8) = st[3]; } while (0)
        A_GLOAD(kc_lo);
        bf16x8 qf[8];
        { const bf16* qp = F.QB + (size_t)(qrow0 + r) * D + h * HD + 8 * hf;
#pragma unroll
          for (int kk = 0; kk < 8; ++kk) qf[kk] = *(const bf16x8*)(qp + 16 * kk); }
        f32x16 oacc[4];
#pragma unroll
        for (int bl = 0; bl < 4; ++bl) for (int i = 0; i < 16; ++i) oacc[bl][i] = 0.f;
        float mrun = -1e30f, lsum = 0.f;
        A_LWRITE(0);
        __syncthreads();
        const float bias0 = bias[0];
        for (int kc = kc_lo; kc <= kc_hi; ++kc) {
            const int cur = (kc - kc_lo) & 1;
            if (kc < kc_hi) A_GLOAD(kc + 1);
            if (kc >= cw - 8 && kc <= cw) {
                const LAS bf16* Kb = (const LAS bf16*)(F.lds + cur * A_BUF); const LAS bf16* Vb = (const LAS bf16*)(F.lds + cur * A_BUF + A_KBYTES);
#pragma unroll 1
                for (int t = 0; t < 2; ++t) {
                    bf16x8 kf[8], vf[2][4];
#pragma unroll
                    for (int kk = 0; kk < 8; ++kk) kf[kk] = *(const LAS bf16x8*)(Kb + (32 * t + r) * AK_STRIDE + 16 * kk + 8 * hf);
#pragma unroll
                    for (int kb = 0; kb < 2; ++kb)
#pragma unroll
                        for (int bl = 0; bl < 4; ++bl) { const LAS bf16* vp = Vb + (32 * bl + r) * AV_STRIDE + 32 * t + 16 * kb + 4 * hf;
                            const u32x2 v0 = *(const LAS u32x2*)vp, v1 = *(const LAS u32x2*)(vp + 8); u32x4 vv; vv.x = v0.x; vv.y = v0.y; vv.z = v1.x; vv.w = v1.y; vf[kb][bl] = __builtin_bit_cast(bf16x8, vv); }
                    attn_step(oacc, mrun, lsum, qf, kf, vf, (kc * 64 + 32 * t) - (cw * 64 + (w & 1) * 32) - r, bias, bias0, hf);
                }
            }
            if (kc < kc_hi) A_LWRITE(cur ^ 1);
            __syncthreads();
        }
#undef A_GLOAD
#undef A_LWRITE
        lsum += __shfl_xor(lsum, 32);
        const float inv = 1.f / lsum;
        bf16* op = F.HB + (size_t)(qrow0 + r) * D + h * HD;
#pragma unroll
        for (int bl = 0; bl < 4; ++bl)
#pragma unroll
            for (int g4 = 0; g4 < 4; ++g4) {
                u32x2 o; o.x = pk2(oacc[bl][4 * g4] * inv, oacc[bl][4 * g4 + 1] * inv); o.y = pk2(oacc[bl][4 * g4 + 2] * inv, oacc[bl][4 * g4 + 3] * inv);
                *(u32x2*)(op + 32 * bl + 8 * g4 + 4 * hf) = o;
            }
    }
}

#define XB_TMO      128
#define XB_XCNT(j)  (256  + 64 * (j))
#define XB_XSUB(j)  (1280 + 64 * (j))
#define XB_XGEN(j)  (2304 + 64 * (j))
#define XB_TOP      3328
#define XB_TOPGEN   3392
#define XCD_BAR_WORDS 3456
#define XB_SPIN_CAP (1u << 18)
DI unsigned xb_ld(unsigned* p)              { return __hip_atomic_load(p, __ATOMIC_RELAXED, __HIP_MEMORY_SCOPE_AGENT); }
DI unsigned xb_add(unsigned* p, unsigned v) { return __hip_atomic_fetch_add(p, v, __ATOMIC_RELAXED, __HIP_MEMORY_SCOPE_AGENT); }
DI unsigned xb_xcc_id() { return (unsigned)__builtin_amdgcn_s_getreg((3 << 11) | 20) & 0xFu; }
#define XB_SPIN(cond, bar) do { unsigned _sp = 0; while (cond) { __builtin_amdgcn_s_sleep(1); \
    if ((++_sp & 255u) == 0u) { if (xb_ld(&(bar)[XB_TMO])) break; if (_sp > XB_SPIN_CAP) { atomicAdd(&(bar)[XB_TMO], 1u); break; } } } } while (0)
struct XcdBarrier { unsigned* bar; unsigned x; volatile LAS unsigned* st; };
DI XcdBarrier xcd_barrier_post(unsigned* bar, volatile LAS unsigned* st) {
    XcdBarrier b; b.bar = bar; b.x = xb_xcc_id(); b.st = st;
    if (threadIdx.x == 0) (void)xb_add(&bar[XB_XCNT(b.x)], 1u);
    return b;
}
DI void xcd_barrier_complete(unsigned* bar, unsigned x, unsigned& nloc, unsigned& nx) {
    const unsigned G = gridDim.x * gridDim.y * gridDim.z;
    unsigned sum, cnt, mine, sp = 0u;
    for (;;) {
        sum = 0u; cnt = 0u; mine = 0u;
#pragma unroll
        for (unsigned j = 0; j < 16; ++j) { const unsigned c = xb_ld(&bar[XB_XCNT(j)]); sum += c; cnt += (c > 0u) ? 1u : 0u; mine = (j == x) ? c : mine; }
        if (sum == G) break;
        __builtin_amdgcn_s_sleep(1);
        if ((++sp & 255u) == 0u) { if (xb_ld(&bar[XB_TMO])) break; if (sp > XB_SPIN_CAP) { atomicAdd(&bar[XB_TMO], 1u); break; } }
    }
    nloc = mine > 0u ? mine : 1u; nx = cnt > 0u ? cnt : 1u;
}
DI void xcd_barrier(const XcdBarrier& b) {
    asm volatile("s_waitcnt vmcnt(0)" ::: "memory");
    __syncthreads();
    if (threadIdx.x == 0) {
        unsigned* bar = b.bar;
        __builtin_amdgcn_s_waitcnt(0);
        unsigned nloc = b.st[0], nx = b.st[1];
        if (nloc == 0u) { xcd_barrier_complete(bar, b.x, nloc, nx); b.st[0] = nloc; b.st[1] = nx; }
        const unsigned old = xb_add(&bar[XB_XSUB(b.x)], 1u);
        const unsigned gen = old / nloc;
        if (old + 1u == (gen + 1u) * nloc) {
            __builtin_amdgcn_fence(__ATOMIC_RELEASE, "agent");
            asm volatile("s_waitcnt vmcnt(0)" ::: "memory");
            const unsigned og = xb_add(&bar[XB_TOP], 1u);
            const unsigned tg = og / nx;
            if (og + 1u == (tg + 1u) * nx) xb_add(&bar[XB_TOPGEN], 1u);
            else XB_SPIN(xb_ld(&bar[XB_TOPGEN]) == tg, bar);
            __builtin_amdgcn_fence(__ATOMIC_ACQUIRE, "agent");
            xb_add(&bar[XB_XGEN(b.x)], 1u);
            asm volatile("s_waitcnt vmcnt(0)" ::: "memory");
        } else {
            XB_SPIN(xb_ld(&bar[XB_XGEN(b.x)]) == gen, bar);
            __builtin_amdgcn_fence(__ATOMIC_ACQUIRE, "agent");
            asm volatile("s_waitcnt vmcnt(0)" ::: "memory");
        }
    }
    __syncthreads();
}

enum { PH_P0, PH_G1, PH_GLA_A, PH_SCAN, PH_GLA_C, PH_G2, PH_RMS_F0, PH_G3_0, PH_CONV0, PH_G4_0, PH_RMS_M1, PH_G5, PH_PREP, PH_ATTN, PH_G6, PH_RMS_F1, PH_G3_1, PH_CONV1, PH_G4_1, PH_FIN, NPH };

__global__ void __launch_bounds__(NTHR, 2) fwd_megakernel(Params prm) {
    extern __shared__ __attribute__((aligned(16))) unsigned char lds_raw[];
    cg::grid_group grid = cg::this_grid();
    float* const X0 = prm.out;
    volatile LAS unsigned* bst = (volatile LAS unsigned*)((LAS unsigned char*)lds_raw + (LDS_BYTES - 16));
    if (threadIdx.x < 4) bst[threadIdx.x] = 0u;
    __syncthreads();
    XcdBarrier xbar = xcd_barrier_post((unsigned*)(prm.ws + WS_BAR), bst);
    for (int ph = prm.ph_lo; ph < prm.ph_hi; ++ph) {
      for (int rep = 0, nrep = 1 + ((REP_MASK >> ph) & 1); rep < nrep; ++rep) {
        int tid_ = threadIdx.x; asm volatile("" : "+v"(tid_));
        size_t zoff = 0; asm volatile("" : "+s"(zoff));
        unsigned char* ws = prm.ws + zoff;
        float* X = X0 + zoff;
        Frame F;
        F.p = prm; F.lds = (LAS unsigned char*)lds_raw;
        F.tid = tid_; F.lane = F.tid & 63; F.wave = __builtin_amdgcn_readfirstlane(F.tid >> 6); F.G = gridDim.x; F.bid = blockIdx.x;
        F.WinA = (bf16*)(ws + WS_WINA); F.WoA = (bf16*)(ws + WS_WOA); F.Wqkv = (bf16*)(ws + WS_WQKV); F.WoB = (bf16*)(ws + WS_WOB);
        F.Fin0 = (bf16*)(ws + WS_FIN0); F.Fin1 = (bf16*)(ws + WS_FIN1); F.Fdn0 = (bf16*)(ws + WS_FDN0); F.Fdn1 = (bf16*)(ws + WS_FDN1);
        F.LB = (float*)(ws + WS_LB); F.HB = (bf16*)(ws + WS_HB); F.QB = (bf16*)(ws + WS_QB);
        F.LOGF = (float*)(ws + WS_LOGF); F.VB = (bf16*)(ws + WS_VB); F.SG = (bf16*)(ws + WS_SG); F.OI = (float*)(ws + WS_OI); F.LOCAL = (float*)(ws + WS_LOCAL); F.DEC = (float*)(ws + WS_DEC);
        F.QKV = (bf16*)(ws + WS_QKV); F.KN = (bf16*)(ws + WS_KN); F.KS = (bf16*)(ws + WS_KS); F.VT = (bf16*)(ws + WS_VT); F.VTS = (bf16*)(ws + WS_VTS);
        F.UP = (bf16*)(ws + WS_UP); F.ACT = (bf16*)(ws + WS_ACT);
        switch (ph) {
        case PH_P0: if (EN_MASK & 1) p0_phase(F); break;
        case PH_GLA_A: if (EN_MASK & 2) gla_a_phase(F); break;
        case PH_SCAN: if (EN_MASK & 4) scan_phase(F); break;
        case PH_GLA_C: if (EN_MASK & 8) gla_c_phase(F); break;
        case PH_RMS_F0: if (EN_MASK & 16) rms_phase(F, X, prm.x_sample, prm.norm_ffn, (const float*)(ws + WS_PART), X + (size_t)TP * D); break;
        case PH_RMS_M1: if (EN_MASK & 16) rms_phase(F, X, X + (size_t)TP * D, prm.norm_mix + D, (const float*)(ws + WS_PART), X + (size_t)TP * D); break;
        case PH_RMS_F1: if (EN_MASK & 16) rms_phase(F, X, X + (size_t)TP * D, prm.norm_ffn + D, (const float*)(ws + WS_PART), X + (size_t)TP * D); break;
        case PH_FIN: fin_phase(F, X + (size_t)TP * D, (const float*)(ws + WS_PART)); break;
        case PH_CONV0: if (EN_MASK & 32) convfix_phase(F, 0, (const float*)(ws + WS_PART)); break;
        case PH_CONV1: if (EN_MASK & 32) convfix_phase(F, 1, (const float*)(ws + WS_PART)); break;
        case PH_PREP: if (EN_MASK & 64) prep_phase(F); break;
        case PH_ATTN: if (EN_MASK & 128) attn_phase(F); break;
        default: if (EN_MASK & 256) {
            pg8::Gemm g; pg8::Epi E; E.mode = 2; E.cw = nullptr; E.cbias = nullptr; E.ldo = D; E.ob = nullptr; E.of = X; E.resP = X; E.resS = X + (size_t)TP * D;
            E.lb = F.LB; E.logf = F.LOGF; E.wsb = ws;
            g.A = F.HB; g.M = T; g.K = D; g.N = D; g.Bt = F.WoA;
            if (ph == PH_G1) { g.Bt = F.WinA; g.N = NWIN; E.mode = 0; }
            else if (ph == PH_G2) { g.Bt = F.WoA; E.resP = prm.x_prompt; E.resS = prm.x_sample; }
            else if (ph == PH_G3_0 || ph == PH_G3_1) { const int l = (ph == PH_G3_1); g.Bt = l ? F.Fin1 : F.Fin0; g.N = NUP; E.mode = 3; E.cw = prm.f_conv_w + (size_t)l * 3 * FF; E.cbias = prm.f_conv_b + (size_t)l * FF; }
            else if (ph == PH_G4_0 || ph == PH_G4_1) { g.A = F.ACT; g.Bt = (ph == PH_G4_1) ? F.Fdn1 : F.Fdn0; g.K = FF; }
            else if (ph == PH_G5) { g.Bt = F.Wqkv; g.N = NQKV; E.mode = 1; E.ob = F.QKV; E.ldo = NQKV; }
            else { g.Bt = F.WoB; }
            E.part = (float*)(ws + WS_PART); E.act = F.ACT; E.edge = (float*)(ws + WS_PART);
            pg8::StaticOrder S; S.init(g.M, g.N, g.K, F.G, F.bid, E.mode == 2);
            pg8::gemm_phase(F.lds, g, S, E, F.tid);
            if (ph == PH_G1 || ph == PH_G3_0 || ph == PH_G5) {
                const int rem = S.nitems % F.G;
                if (rem == 0 || F.bid >= rem) {
                    const int widx = rem ? F.bid - rem : F.bid, nw = rem ? F.G - rem : F.G;
                    if (ph == PH_G1) wconv_items(F, WC_EARLY, WC_ALL, widx, nw);
                    else if (ph == PH_G3_0) cacheK_fill(F, widx, nw);
                    else vtrans_items(F, VT_NP + VT_NN, VT_NP + VT_NN + VT_NC, widx, nw);
                }
            }
        } break;
        }
      }
        if (prm.ph_hi > 1000) grid.sync();
        if (ph + 1 < prm.ph_hi) xcd_barrier(xbar);
    }
}

extern "C" void kernel_launch(void* const* d_in, const int* in_sizes, int n_in, void* d_out, int out_size, void* d_ws, size_t ws_size, hipStream_t stream) {
    static int grid_blocks = 0;
    if (!grid_blocks) {
        int dev = 0, cus = 0, per_cu = 0;
        hipGetDevice(&dev);
        hipDeviceGetAttribute(&cus, hipDeviceAttributeMultiprocessorCount, dev);
        if (hipFuncSetAttribute((const void*)fwd_megakernel, hipFuncAttributeMaxDynamicSharedMemorySize, LDS_BYTES) != hipSuccess) fprintf(stderr, "kernel_launch: hipFuncSetAttribute failed\n");
        hipOccupancyMaxActiveBlocksPerMultiprocessor(&per_cu, (const void*)fwd_megakernel, NTHR, LDS_BYTES);
        if (per_cu < 1) per_cu = 1;
        if (per_cu > 1) per_cu = 1;
        grid_blocks = cus * per_cu;
        if (n_in != 21 || (size_t)out_size != O_END || ws_size < WS_END) fprintf(stderr, "kernel_launch: unexpected sizes n_in %d out %d ws %zu (need %zu)\n", n_in, out_size, ws_size, (size_t)WS_END);
    }
    Params p{};
    p.x_prompt = (const float*)d_in[0]; p.x_sample = (const float*)d_in[1]; p.state_a_S = (const float*)d_in[2]; p.cache_k = (const float*)d_in[3]; p.cache_v = (const float*)d_in[4];
    p.conv_state = (const float*)d_in[5]; p.norm_mix = (const float*)d_in[6]; p.norm_ffn = (const float*)d_in[7]; p.a_w_in = (const float*)d_in[8]; p.a_gamma = (const float*)d_in[9];
    p.a_norm_o = (const float*)d_in[10]; p.a_w_o = (const float*)d_in[11]; p.b_w_qkv = (const float*)d_in[12]; p.b_q_norm = (const float*)d_in[13]; p.b_k_norm = (const float*)d_in[14];
    p.b_rel_bias = (const float*)d_in[15]; p.b_w_o = (const float*)d_in[16]; p.f_w_in = (const float*)d_in[17]; p.f_conv_w = (const float*)d_in[18]; p.f_conv_b = (const float*)d_in[19];
    p.f_w_down = (const float*)d_in[20];
    p.out = (float*)d_out; p.ws = (unsigned char*)d_ws;
#if MK_N_LAUNCHES == 1
    p.ph_lo = 0; p.ph_hi = NPH;
    if (hipMemsetAsync((char*)d_ws + WS_BAR, 0, 16384, stream) != hipSuccess) fprintf(stderr, "kernel_launch: memset of barrier words failed\n");
    void* args[] = {&p};
    hipError_t e = hipLaunchCooperativeKernel((const void*)fwd_megakernel, dim3(grid_blocks), dim3(NTHR), args, LDS_BYTES, stream);
    if (e != hipSuccess) fprintf(stderr, "cooperative launch failed: %s (grid %d)\n", hipGetErrorString(e), grid_blocks);
#else
    for (int ph = 0; ph < NPH; ++ph) {
        p.ph_lo = ph; p.ph_hi = ph + 1;
        hipLaunchKernelGGL(fwd_megakernel, dim3(grid_blocks), dim3(NTHR), LDS_BYTES, stream, p);
    }
#endif
}
```

```cpp
#include <hip/hip_runtime.h>
#include <hip/hip_cooperative_groups.h>
#include <cstdio>
#include <cstdint>
namespace cg = cooperative_groups;

#define DI __device__ __forceinline__
#define LAS __attribute__((address_space(3)))
#define GAS __attribute__((address_space(1)))
typedef unsigned short bf16;
typedef short bf16x8 __attribute__((ext_vector_type(8)));
typedef float f32x2 __attribute__((ext_vector_type(2)));
typedef float f32x4 __attribute__((ext_vector_type(4)));
typedef float f32x16 __attribute__((ext_vector_type(16)));
typedef unsigned u32x2 __attribute__((ext_vector_type(2)));
typedef unsigned u32x4 __attribute__((ext_vector_type(4)));
typedef __bf16 bf16x2_t __attribute__((ext_vector_type(2)));

#ifndef EN_MASK
#define EN_MASK 0xffffu
#endif
#ifndef REP_MASK
#define REP_MASK 0
#endif
#ifndef MK_N_LAUNCHES
#define MK_N_LAUNCHES 1
#endif

constexpr int D = 2048, TP = 8192, TS = 1024, T = TP + TS, SEQ = 4096, NH = 16, HD = 128, FF = 5632;
constexpr int NQKV = 3 * D, NWIN = 4 * D, NUP = 2 * FF;
constexpr int SROWS = 544;
constexpr float EPS = 1e-6f;
constexpr int NWAVES = 8, NTHR = 512;
constexpr int LDS_BYTES = 147456;

constexpr size_t MiB = 1u << 20;
constexpr size_t WS_WINA = 0, WS_WOA = 32 * MiB, WS_WQKV = 40 * MiB, WS_WOB = 64 * MiB, WS_FIN0 = 72 * MiB, WS_FIN1 = 116 * MiB, WS_FDN0 = 160 * MiB, WS_FDN1 = 182 * MiB;
constexpr size_t WS_LB = 204 * MiB, WS_HB = 205 * MiB, WS_QB = 241 * MiB, WS_MIX = 277 * MiB;
constexpr size_t WS_LOGF = WS_MIX, WS_VB = WS_MIX + 72 * MiB, WS_SG = WS_MIX + 108 * MiB, WS_OI = WS_MIX + 144 * MiB, WS_LOCAL = WS_MIX + 216 * MiB, WS_DEC = WS_MIX + 376 * MiB;
constexpr size_t WS_KS = WS_MIX, WS_VTS = WS_MIX + 68 * MiB, WS_QKV = WS_MIX + 136 * MiB, WS_KN = WS_MIX + 244 * MiB, WS_VT = WS_MIX + 276 * MiB;
constexpr size_t WS_UP = WS_MIX + 136 * MiB, WS_ACT = WS_MIX + 136 * MiB;
constexpr size_t WS_PART = WS_MIX + 236 * MiB;
constexpr size_t WS_BAR = WS_LB + 64 * 1024;
constexpr size_t WS_END = WS_MIX + 378 * MiB;

constexpr size_t O_YP = 0, O_YS = O_YP + (size_t)TP * D, O_SP = O_YS + (size_t)TS * D, O_SS = O_SP + 2 * 16 * 128 * 128, O_KP = O_SS + 32 * 16 * 128 * 128,
                 O_VP = O_KP + 2 * 512 * 2048, O_KSM = O_VP + 2 * 512 * 2048, O_VSM = O_KSM + 32 * 32 * 2048, O_CP = O_VSM + 32 * 32 * 2048, O_CS = O_CP + 2 * 2 * 2 * FF,
                 O_END = O_CS + 2 * 32 * 2 * FF;

struct Params {
    const float* x_prompt; const float* x_sample; const float* state_a_S; const float* cache_k; const float* cache_v; const float* conv_state;
    const float* norm_mix; const float* norm_ffn; const float* a_w_in; const float* a_gamma; const float* a_norm_o; const float* a_w_o;
    const float* b_w_qkv; const float* b_q_norm; const float* b_k_norm; const float* b_rel_bias; const float* b_w_o;
    const float* f_w_in; const float* f_conv_w; const float* f_conv_b; const float* f_w_down;
    float* out; unsigned char* ws; int ph_lo, ph_hi;
};

DI unsigned pk2(float lo, float hi) { f32x2 v = {lo, hi}; return __builtin_bit_cast(unsigned, __builtin_convertvector(v, bf16x2_t)); }
DI bf16 f2bf(float f) { return (bf16)(pk2(f, 0.f) & 0xffffu); }
DI float bflo(unsigned p) { return __uint_as_float(p << 16); }
DI float bfhi(unsigned p) { return __uint_as_float(p & 0xffff0000u); }
DI float wave_sum(float v) {
#pragma unroll
    for (int o = 1; o < 64; o <<= 1) v += __shfl_xor(v, o);
    return v;
}
DI float fexp(float x) { return __builtin_amdgcn_exp2f(x * 1.4426950408889634f); }
DI float fsigmoid(float z) { return __builtin_amdgcn_rcpf(1.f + fexp(-z)); }
DI float fsilu(float z) { return z * __builtin_amdgcn_rcpf(1.f + fexp(-z)); }
DI float flog(float x) { return __builtin_amdgcn_logf(x) * 0.6931471805599453f; }
DI int crow(int reg, int h) { return (reg & 3) + 8 * (reg >> 2) + 4 * h; }
#define MFMA32(a, b, c) __builtin_amdgcn_mfma_f32_32x32x16_bf16((a), (b), (c), 0, 0, 0)

namespace pg8 {
constexpr int BM = 256, BK = 64, HALF = 128, HTB = HALF * BK * 2, STAGE_BYTES = 8 * HTB, NXCD = 8, WGM = 8;
DI int lds_byte(int r, int c) { const int st = (r >> 4) * 2 + (c >> 5), rr = r & 15, cc = c & 31, ob = rr * 64 + cc * 2; return st * 1024 + (ob ^ (((ob >> 9) & 1) << 5)); }
DI void stage_rc(int b, int& R, int& C) { const int st = b / 1024, sb = b % 1024, swz = sb ^ (((sb >> 9) & 1) << 5); R = (st >> 1) * 16 + swz / 64; C = (st & 1) * 32 + (swz % 64) / 2; }
DI int perm32(int rho) { const int n = rho >> 4, i = rho & 15; return 8 * (i >> 2) + 4 * n + (i & 3); }
struct Unit { int pm, pn, kb0, nkt, slice; };
struct Gemm { const bf16* A; const bf16* Bt; int M, N, K; };
struct StaticOrder {
    int nM, nN, nwg, G, c, tail, nblk, nitems;
    DI void init(int M, int N, int K, int G_, int c_, int tail_) { tail = tail_; nM = tail ? TP / BM : M / BM; nN = N / BM; nwg = nM * nN; G = G_; c = c_; nblk = K / 128; nitems = nwg + (tail ? 256 : 0); }
    DI bool next(int i, Unit& u) const {
        const long L = (long)i * G + c; if (L >= nitems) return false;
        u.slice = -1; u.kb0 = 0; u.nkt = nblk * 2;
        if (L >= nwg) { const int j = (int)L - nwg, uu = j & 31; u.slice = j >> 5; u.pm = TP / BM + (uu >> 3); u.pn = uu & 7;
            const int base = nblk / 8, rem = nblk % 8; u.kb0 = u.slice * base + (u.slice < rem ? u.slice : rem); u.nkt = 2 * (base + (u.slice < rem ? 1 : 0)); return true; }
        int wgid = (int)L; { const int q = nwg / NXCD, r = nwg % NXCD, xcd = wgid % NXCD, off = wgid / NXCD; wgid = (xcd < r ? xcd * (q + 1) : r * (q + 1) + (xcd - r) * q) + off; }
        const int nig = WGM * nN, gid = wgid / nig, fm = gid * WGM, gsz = (nM - fm) < WGM ? (nM - fm) : WGM;
        u.pm = fm + ((wgid % nig) % gsz); u.pn = (wgid % nig) / gsz; return true;
    }
};

struct Epi {
    int mode;
    int ldo;
    bf16* ob;
    float* of; const float* resP; const float* resS;
    const float* lb; float* logf; unsigned char* wsb;
    float* part;
    const float* cw; const float* cbias; bf16* act; float* edge;
    DI bool perm() const { return mode != 2; }
    DI void operator()(const f32x4 (&acc)[2][2][4][2], const Unit& u, int wr, int wc, int fr, int fq) const {
        const int row0 = u.pm * BM + wr * 64 + fr;
        if (mode == 2 && u.slice >= 0) {
            const int col0 = u.pn * BM + wc * 32 + 4 * fq;
#pragma unroll
            for (int ai = 0; ai < 2; ++ai)
#pragma unroll
                for (int m = 0; m < 4; ++m) {
                    float* op = part + ((size_t)u.slice * TS + (row0 + ai * HALF + m * 16 - TP)) * D + col0;
#pragma unroll
                    for (int bj = 0; bj < 2; ++bj)
#pragma unroll
                        for (int n = 0; n < 2; ++n) *(f32x4*)(op + bj * HALF + n * 16) = acc[ai][bj][m][n];
                }
        } else if (mode == 2) {
            const int col0 = u.pn * BM + wc * 32 + 4 * fq;
#pragma unroll
            for (int ai = 0; ai < 2; ++ai) {
                f32x4 rr[4][2][2];
#pragma unroll
                for (int m = 0; m < 4; ++m) {
                    const int row = row0 + ai * HALF + m * 16;
                    const float* rp = (row < TP ? resP + (size_t)row * D : resS + (size_t)(row - TP) * D) + col0;
#pragma unroll
                    for (int bj = 0; bj < 2; ++bj)
#pragma unroll
                        for (int n = 0; n < 2; ++n) rr[m][bj][n] = *(const f32x4*)(rp + bj * HALF + n * 16);
                }
#pragma unroll
                for (int m = 0; m < 4; ++m) {
                    float* op = of + (size_t)(row0 + ai * HALF + m * 16) * D + col0;
#pragma unroll
                    for (int bj = 0; bj < 2; ++bj)
#pragma unroll
                        for (int n = 0; n < 2; ++n) *(f32x4*)(op + bj * HALF + n * 16) = rr[m][bj][n] + acc[ai][bj][m][n];
                }
            }
        } else if (mode == 3) {
            const int cc0 = u.pn * HALF + wc * 32 + 8 * fq;
            float w0[8], w1[8], w2[8], cb[8];
            { const f32x4 a0 = *(const f32x4*)(cw + cc0), a1 = *(const f32x4*)(cw + cc0 + 4), b0 = *(const f32x4*)(cw + FF + cc0), b1 = *(const f32x4*)(cw + FF + cc0 + 4);
              const f32x4 c0 = *(const f32x4*)(cw + 2 * FF + cc0), c1 = *(const f32x4*)(cw + 2 * FF + cc0 + 4), d0 = *(const f32x4*)(cbias + cc0), d1 = *(const f32x4*)(cbias + cc0 + 4);
#pragma unroll
              for (int e = 0; e < 4; ++e) { w0[e] = a0[e]; w0[4 + e] = a1[e]; w1[e] = b0[e]; w1[4 + e] = b1[e]; w2[e] = c0[e]; w2[4 + e] = c1[e]; cb[e] = d0[e]; cb[4 + e] = d1[e]; } }
            float* const eu_first = edge; float* const eg_first = edge + (size_t)(T / 32) * 2 * FF; float* const eu_last = edge + (size_t)(T / 32) * 4 * FF;
#pragma unroll
            for (int ai = 0; ai < 2; ++ai)
#pragma unroll
                for (int m = 0; m < 4; ++m) {
                    const int row = row0 + ai * HALF + m * 16, hb = row >> 5;
                    float a[8];
#pragma unroll
                    for (int n = 0; n < 2; ++n)
#pragma unroll
                        for (int e = 0; e < 4; ++e) {
                            const float cur = acc[ai][0][m][n][e];
                            const float prv = (m & 1) ? acc[ai][0][m - 1][n][e] : 0.f;
                            const int ci = __float_as_int(cur), pi = __float_as_int(prv);
                            const int r1 = __builtin_amdgcn_update_dpp(0, pi, 0x121, 0xf, 0xf, false), r2 = __builtin_amdgcn_update_dpp(0, pi, 0x122, 0xf, 0xf, false);
                            const float p1 = __int_as_float(__builtin_amdgcn_update_dpp(r1, ci, 0x111, 0xf, 0xf, false));
                            const float p2 = __int_as_float(__builtin_amdgcn_update_dpp(r2, ci, 0x112, 0xf, 0xf, false));
                            const int k = 4 * n + e;
                            a[k] = fsilu(cb[k] + p2 * w0[k] + p1 * w1[k] + cur * w2[k]) * acc[ai][1][m][n][e];
                        }
                    const bool first2 = ((m & 1) == 0) && (fr < 2), last2 = ((m & 1) == 1) && (fr >= 14);
                    if (!first2) { u32x4 o; o.x = pk2(a[0], a[1]); o.y = pk2(a[2], a[3]); o.z = pk2(a[4], a[5]); o.w = pk2(a[6], a[7]); *(u32x4*)(act + (size_t)row * FF + cc0) = o; }
                    else { float* du = eu_first + ((size_t)hb * 2 + fr) * FF + cc0; float* dg = eg_first + ((size_t)hb * 2 + fr) * FF + cc0;
                        *(f32x4*)du = acc[ai][0][m][0]; *(f32x4*)(du + 4) = acc[ai][0][m][1]; *(f32x4*)dg = acc[ai][1][m][0]; *(f32x4*)(dg + 4) = acc[ai][1][m][1]; }
                    if (last2) { float* du = eu_last + ((size_t)hb * 2 + (fr - 14)) * FF + cc0; *(f32x4*)du = acc[ai][0][m][0]; *(f32x4*)(du + 4) = acc[ai][0][m][1]; }
                }
        } else if (mode == 1) {
            const int col0 = u.pn * BM + wc * 32 + 8 * fq;
#pragma unroll
            for (int ai = 0; ai < 2; ++ai)
#pragma unroll
                for (int m = 0; m < 4; ++m) {
                    bf16* op = ob + (size_t)(row0 + ai * HALF + m * 16) * ldo + col0;
#pragma unroll
                    for (int bj = 0; bj < 2; ++bj) { const f32x4 v0 = acc[ai][bj][m][0], v1 = acc[ai][bj][m][1];
                        u32x4 o; o.x = pk2(v0.x, v0.y); o.y = pk2(v0.z, v0.w); o.z = pk2(v1.x, v1.y); o.w = pk2(v1.z, v1.w);
                        *(u32x4*)(op + bj * HALF) = o; }
                }
        } else {
            const int type = u.pn >> 3, col0 = (u.pn & 7) * BM + wc * 32 + 8 * fq;
#pragma unroll
            for (int bj = 0; bj < 2; ++bj) {
                const int col = col0 + bj * HALF;
                f32x4 l0 = {0.f, 0.f, 0.f, 0.f}, l1 = l0;
                if (type == 1) { l0 = *(const f32x4*)(lb + col); l1 = *(const f32x4*)(lb + col + 4); }
#pragma unroll
                for (int ai = 0; ai < 2; ++ai)
#pragma unroll
                    for (int m = 0; m < 4; ++m) {
                        const size_t off = (size_t)(row0 + ai * HALF + m * 16) * D + col;
                        f32x4 v0 = acc[ai][bj][m][0], v1 = acc[ai][bj][m][1];
                        if (type == 1) {
#pragma unroll
                            for (int e = 0; e < 4; ++e) { v0[e] = flog(l0[e] + (1.f - l0[e]) * fsigmoid(v0[e])); v1[e] = flog(l1[e] + (1.f - l1[e]) * fsigmoid(v1[e])); }
                            *(f32x4*)(logf + off) = v0; *(f32x4*)(logf + off + 4) = v1;
                        } else {
                            if (type == 3) {
#pragma unroll
                                for (int e = 0; e < 4; ++e) { v0[e] = fsilu(v0[e]); v1[e] = fsilu(v1[e]); }
                            }
                            u32x4 o; o.x = pk2(v0.x, v0.y); o.y = pk2(v0.z, v0.w); o.z = pk2(v1.x, v1.y); o.w = pk2(v1.z, v1.w);
                            bf16* dst = (bf16*)(wsb + (type == 0 ? WS_QB : (type == 2 ? WS_VB : WS_SG)));
                            *(u32x4*)(dst + off) = o;
                        }
                    }
            }
        }
    }
};

DI void gemm_phase(LAS unsigned char* lds, const Gemm g, const StaticOrder& S, const Epi& E, const int tid) {
    const int wid = __builtin_amdgcn_readfirstlane(tid >> 6), lane = tid & 63, wr = wid >> 2, wc = wid & 3, fr = lane & 15, fq = lane >> 4;
    const int K = g.K;
    const bool PERM = E.perm();
    unsigned voffA[2], voffB[2];
#pragma unroll
    for (int i = 0; i < 2; ++i) { int R, C; stage_rc(tid * 16 + i * 8192, R, C); const int Rb = PERM ? ((R & ~31) + perm32(R & 31)) : R;
        voffA[i] = (unsigned)(R * K + C) * 2u; voffB[i] = (unsigned)(Rb * K + C) * 2u; }
    const size_t kstep = (size_t)(BK * 2);
    const size_t hstep = (size_t)HALF * K * 2;
    const size_t tstep = 2 * hstep;
    const unsigned ldsw = (unsigned)wid * 1024u;
    const int aoff = lds_byte(wr * 64 + fr, fq * 8), boff = lds_byte(wc * 32 + fr, fq * 8);
#define PG8_SA(b, h) (((b) * 2 + (h)) * HTB)
#define PG8_SB(b, h) ((4 + (b) * 2 + (h)) * HTB)
#define PG8_STAGE(bufoff, gbase, voff) do { _Pragma("unroll") for (int _i = 0; _i < 2; ++_i) \
        __builtin_amdgcn_global_load_lds((const unsigned*)((const char*)(gbase) + (voff)[_i]), (LAS unsigned*)(lds + (bufoff) + ldsw + _i * 8192), 16, 0, 0); } while (0)
#define PG8_LDA(dst, b, h) do { _Pragma("unroll") for (int m = 0; m < 4; ++m) _Pragma("unroll") for (int k = 0; k < 2; ++k) dst[m][k] = *(const LAS bf16x8*)(lds + PG8_SA(b, h) + aoff + m * 2048 + k * 1024); } while (0)
#define PG8_LDB(dst, b, h) do { _Pragma("unroll") for (int n = 0; n < 2; ++n) _Pragma("unroll") for (int k = 0; k < 2; ++k) dst[n][k] = *(const LAS bf16x8*)(lds + PG8_SB(b, h) + boff + n * 2048 + k * 1024); } while (0)
#define PG8_MMA(ai, bj, At, Bt) do { __builtin_amdgcn_s_setprio(1); _Pragma("unroll") for (int m = 0; m < 4; ++m) _Pragma("unroll") for (int n = 0; n < 2; ++n) _Pragma("unroll") for (int k = 0; k < 2; ++k) \
        acc[ai][bj][m][n] = __builtin_amdgcn_mfma_f32_16x16x32_bf16(Bt[n][k], At[m][k], acc[ai][bj][m][n], 0, 0, 0); __builtin_amdgcn_s_setprio(0); } while (0)
#define PG8_WAIT_V(n) asm volatile("s_waitcnt vmcnt(" #n ")" ::: "memory")
#define PG8_WAIT_L(n) asm volatile("s_waitcnt lgkmcnt(" #n ")" ::: "memory")
#define PG8_BAR __builtin_amdgcn_s_barrier()
#define PG8_SCHED __builtin_amdgcn_sched_barrier(0)
    Unit cur, nxt; int ui = 0;
    if (!S.next(0, cur)) return;
    f32x4 acc[2][2][4][2];
#pragma unroll
    for (int a = 0; a < 2; ++a)
#pragma unroll
        for (int b = 0; b < 2; ++b)
#pragma unroll
            for (int m = 0; m < 4; ++m)
#pragma unroll
                for (int n = 0; n < 2; ++n) acc[a][b][m][n] = (f32x4){0.f, 0.f, 0.f, 0.f};
    bf16x8 At[4][2], B0[2][2], B1[2][2];
    const char* cA = (const char*)g.A + (size_t)cur.pm * tstep + (size_t)cur.kb0 * 256; const char* cB = (const char*)g.Bt + (size_t)cur.pn * tstep + (size_t)cur.kb0 * 256;
    PG8_STAGE(PG8_SB(0, 0), cB, voffB); PG8_STAGE(PG8_SA(0, 0), cA, voffA); PG8_STAGE(PG8_SB(0, 1), cB + hstep, voffB); PG8_STAGE(PG8_SA(0, 1), cA + hstep, voffA);
    if (wr == 1) PG8_BAR;
    PG8_WAIT_V(4); PG8_BAR;
    PG8_STAGE(PG8_SB(1, 0), cB + kstep, voffB); PG8_STAGE(PG8_SA(1, 0), cA + kstep, voffA); PG8_STAGE(PG8_SB(1, 1), cB + hstep + kstep, voffB);
    PG8_WAIT_V(6); PG8_BAR;
    for (;;) {
        const bool has_next = S.next(ui + 1, nxt);
        const char* nA = has_next ? (const char*)g.A + (size_t)nxt.pm * tstep + (size_t)nxt.kb0 * 256 : cA; const char* nB = has_next ? (const char*)g.Bt + (size_t)nxt.pn * tstep + (size_t)nxt.kb0 * 256 : cB;
        const int nt = cur.nkt;
        for (int t = 0; t < nt; t += 2) {
            const bool last = (t == nt - 2);
            const char* a1 = cA + (size_t)(t + 1) * kstep;
            const char* a2 = last ? nA : cA + (size_t)(t + 2) * kstep; const char* b2 = last ? nB : cB + (size_t)(t + 2) * kstep;
            const char* a3 = a2 + kstep; const char* b3 = b2 + kstep;
            PG8_LDB(B0, 0, 0); PG8_SCHED; PG8_LDA(At, 0, 0); PG8_STAGE(PG8_SA(1, 1), a1 + hstep, voffA);
            PG8_WAIT_L(8); PG8_BAR; PG8_WAIT_L(0); PG8_MMA(0, 0, At, B0); PG8_BAR; PG8_SCHED;
            PG8_LDB(B1, 0, 1); PG8_STAGE(PG8_SB(0, 0), b2, voffB);
            PG8_BAR; PG8_WAIT_L(0); PG8_MMA(0, 1, At, B1); PG8_BAR;
            PG8_LDA(At, 0, 1); PG8_STAGE(PG8_SA(0, 0), a2, voffA);
            PG8_BAR; PG8_WAIT_L(0); PG8_MMA(1, 0, At, B0); PG8_BAR; PG8_SCHED;
            PG8_STAGE(PG8_SB(0, 1), b2 + hstep, voffB);
            PG8_WAIT_V(6); PG8_BAR; PG8_MMA(1, 1, At, B1); PG8_BAR;
            PG8_LDB(B0, 1, 0); PG8_SCHED; PG8_LDA(At, 1, 0); PG8_STAGE(PG8_SA(0, 1), a2 + hstep, voffA);
            PG8_WAIT_L(8); PG8_BAR; PG8_WAIT_L(0); PG8_MMA(0, 0, At, B0); PG8_BAR; PG8_SCHED;
            PG8_LDB(B1, 1, 1); PG8_STAGE(PG8_SB(1, 0), b3, voffB);
            PG8_BAR; PG8_WAIT_L(0); PG8_MMA(0, 1, At, B1); PG8_BAR;
            PG8_LDA(At, 1, 1); PG8_STAGE(PG8_SA(1, 0), a3, voffA);
            PG8_BAR; PG8_WAIT_L(0); PG8_MMA(1, 0, At, B0); PG8_BAR; PG8_SCHED;
            PG8_STAGE(PG8_SB(1, 1), b3 + hstep, voffB);
            PG8_WAIT_V(6); PG8_BAR; PG8_MMA(1, 1, At, B1); PG8_BAR;
        }
        E(acc, cur, wr, wc, fr, fq);
        if (!has_next) break;
#pragma unroll
        for (int a = 0; a < 2; ++a)
#pragma unroll
            for (int b = 0; b < 2; ++b)
#pragma unroll
                for (int m = 0; m < 4; ++m)
#pragma unroll
                    for (int n = 0; n < 2; ++n) acc[a][b][m][n] = (f32x4){0.f, 0.f, 0.f, 0.f};
        cur = nxt; cA = nA; cB = nB; ++ui;
    }
    PG8_WAIT_V(0);
    if (wr == 0) PG8_BAR;
    PG8_BAR;
#undef PG8_SA
#undef PG8_SB
#undef PG8_STAGE
#undef PG8_LDA
#undef PG8_LDB
#undef PG8_MMA
#undef PG8_WAIT_V
#undef PG8_WAIT_L
#undef PG8_BAR
#undef PG8_SCHED
}
}

struct Frame {
    Params p; LAS unsigned char* lds; int tid, lane, wave, G, bid;
    bf16 *WinA, *WoA, *Wqkv, *WoB, *Fin0, *Fin1, *Fdn0, *Fdn1;
    float* LB; bf16 *HB, *QB;
    float* LOGF; bf16 *VB, *SG; float *OI, *LOCAL, *DEC;
    bf16 *QKV, *KN, *KS, *VT, *VTS, *UP, *ACT;
};

DI void transpose_item(const float* __restrict__ W, int K, int N, bf16* __restrict__ WT, LAS float* scr, int item, int lane, const bool ilv = false) {
    const int nblk = N / 64, kb = item / nblk, nb = item % nblk, k0 = 64 * kb, n0 = 64 * nb;
    const int lr = lane >> 4, lc = (lane & 15) * 4;
    f32x4 v[16];
    const float* src = W + (size_t)(k0 + lr) * N + n0 + lc;
#pragma unroll
    for (int i = 0; i < 16; ++i) v[i] = __builtin_nontemporal_load((const f32x4*)(src + (size_t)(4 * i) * N));
#pragma unroll
    for (int i = 0; i < 16; ++i) { LAS float* d = scr + (4 * i + lr) * 65 + lc; d[0] = v[i].x; d[1] = v[i].y; d[2] = v[i].z; d[3] = v[i].w; }
    asm volatile("s_waitcnt lgkmcnt(0)" ::: "memory");
    const int c = lane & 7;
#pragma unroll
    for (int j = 0; j < 8; ++j) { const int n = (lane >> 3) + 8 * j; const LAS float* s = scr + (8 * c) * 65 + n;
        u32x4 o; o.x = pk2(s[0 * 65], s[1 * 65]); o.y = pk2(s[2 * 65], s[3 * 65]); o.z = pk2(s[4 * 65], s[5 * 65]); o.w = pk2(s[6 * 65], s[7 * 65]);
        int nd = n0 + n; if (ilv) nd = (nd < FF) ? (((nd >> 7) << 8) + (nd & 127)) : ((((nd - FF) >> 7) << 8) + 128 + ((nd - FF) & 127));
        __builtin_nontemporal_store(o, (u32x4*)(WT + (size_t)nd * K + k0 + 8 * c)); }
    asm volatile("s_waitcnt lgkmcnt(0)" ::: "memory");
}
DI void rms_row(const float* __restrict__ xrow, const float* __restrict__ g, bf16* __restrict__ orow, int lane, const float* __restrict__ part, float* __restrict__ xdst) {
    const f32x4* xr = (const f32x4*)xrow + lane; const f32x4* gr = (const f32x4*)g + lane;
    f32x4 v[8]; float s = 0.f;
#pragma unroll
    for (int j = 0; j < 8; ++j) v[j] = xr[64 * j];
    if (part) {
#pragma unroll
        for (int sl = 0; sl < 8; ++sl) { const f32x4* pr = (const f32x4*)(part + (size_t)sl * TS * D) + lane;
#pragma unroll
            for (int j = 0; j < 8; ++j) v[j] += pr[64 * j]; }
#pragma unroll
        for (int j = 0; j < 8; ++j) ((f32x4*)xdst + lane)[64 * j] = v[j];
    }
#pragma unroll
    for (int j = 0; j < 8; ++j) s += (v[j].x * v[j].x + v[j].y * v[j].y) + (v[j].z * v[j].z + v[j].w * v[j].w);
    const float rstd = rsqrtf(wave_sum(s) * (1.f / D) + EPS);
    u32x2* o8 = (u32x2*)orow + lane;
#pragma unroll
    for (int j = 0; j < 8; ++j) { const f32x4 gg = gr[64 * j]; u32x2 o; o.x = pk2(v[j].x * rstd * gg.x, v[j].y * rstd * gg.y); o.y = pk2(v[j].z * rstd * gg.z, v[j].w * rstd * gg.w); o8[64 * j] = o; }
}
DI void rms_phase(Frame& F, const float* srcP, const float* srcS, const float* g, const float* part, float* xs) {
    const int gw = F.bid * NWAVES + F.wave, NGW = F.G * NWAVES;
    for (int m = gw; m < T; m += NGW) {
        if (m < TP) rms_row(srcP + (size_t)m * D, g, F.HB + (size_t)m * D, F.lane, nullptr, nullptr);
        else rms_row(srcS + (size_t)(m - TP) * D, g, F.HB + (size_t)m * D, F.lane, part ? part + (size_t)(m - TP) * D : nullptr, xs + (size_t)(m - TP) * D);
    }
}
DI void fin_phase(Frame& F, float* xs, const float* part) {
    const int gt = F.bid * NTHR + F.tid, NGT = F.G * NTHR;
    for (int it = gt; it < TS * D / 4; it += NGT) {
        f32x4 v = ((const f32x4*)xs)[it];
#pragma unroll
        for (int sl = 0; sl < 8; ++sl) v += ((const f32x4*)(part + (size_t)sl * TS * D))[it];
        ((f32x4*)xs)[it] = v;
    }
}
constexpr int I_WINA = (D / 64) * (NWIN / 64), I_WO = (D / 64) * (D / 64), I_QKV = (D / 64) * (NQKV / 64), I_FIN = (D / 64) * (NUP / 64), I_FDN = (FF / 64) * (D / 64);
constexpr int WC_EARLY = I_WINA + 2 * I_WO + I_QKV + I_FIN + I_FDN, WC_ALL = WC_EARLY + I_FIN + I_FDN;
DI void wconv_items(Frame& F, int it_lo, int it_hi, int widx, int nw) {
    const Params& p = F.p;
    LAS float* scr = (LAS float*)(F.lds + F.wave * 16640);
    for (int it = it_lo + widx * NWAVES + F.wave; it < it_hi; it += nw * NWAVES) {
        int r = it;
        if (r < I_WINA) { transpose_item(p.a_w_in, D, NWIN, F.WinA, scr, r, F.lane); continue; } r -= I_WINA;
        if (r < I_WO) { transpose_item(p.a_w_o, D, D, F.WoA, scr, r, F.lane); continue; } r -= I_WO;
        if (r < I_QKV) { transpose_item(p.b_w_qkv, D, NQKV, F.Wqkv, scr, r, F.lane); continue; } r -= I_QKV;
        if (r < I_WO) { transpose_item(p.b_w_o, D, D, F.WoB, scr, r, F.lane); continue; } r -= I_WO;
        if (r < I_FIN) { transpose_item(p.f_w_in, D, NUP, F.Fin0, scr, r, F.lane, true); continue; } r -= I_FIN;
        if (r < I_FDN) { transpose_item(p.f_w_down, FF, D, F.Fdn0, scr, r, F.lane); continue; } r -= I_FDN;
        if (r < I_FIN) { transpose_item(p.f_w_in + (size_t)D * NUP, D, NUP, F.Fin1, scr, r, F.lane, true); continue; } r -= I_FIN;
        transpose_item(p.f_w_down + (size_t)FF * D, FF, D, F.Fdn1, scr, r, F.lane);
    }
}
DI void p0_phase(Frame& F) {
    const Params& p = F.p;
    wconv_items(F, 0, WC_EARLY, F.bid, F.G);
    for (int c = F.bid * NTHR + F.tid; c < D; c += F.G * NTHR) {
        const float g0 = p.a_gamma[c], g1 = p.a_gamma[D + c], g2 = p.a_gamma[2 * D + c];
        const float mx = fmaxf(g0, fmaxf(g1, g2));
        const float e0 = __expf(g0 - mx), e1 = __expf(g1 - mx), e2 = __expf(g2 - mx);
        F.LB[c] = e0 / (e0 + e1 + e2);
    }
    rms_phase(F, p.x_prompt, p.x_sample, p.norm_mix, nullptr, nullptr);
}

constexpr int GLA_UNITS = 2048 + 512;
constexpr int QT_STRIDE = 136, TT_STRIDE = 72;
constexpr int L_BCUM = 0, L_QT = 32768, L_KT = L_QT + 64 * QT_STRIDE * 2, L_KHT = L_KT + 64 * QT_STRIDE * 2, L_VT = L_KHT + 128 * TT_STRIDE * 2, L_PM = L_VT + 128 * TT_STRIDE * 2, L_GLA_END = L_PM + 64 * TT_STRIDE * 2;
static_assert(L_GLA_END <= LDS_BYTES, "gla lds");

DI f32x16 mma_lds(const LAS bf16* A, int astride, int arow0, const LAS bf16* B, int bstride, int brow0, int nks, int lane) {
    f32x16 acc; for (int i = 0; i < 16; ++i) acc[i] = 0.f;
    const int r = lane & 31, hf = lane >> 5;
    const LAS bf16* ap = A + (arow0 + r) * astride + 8 * hf; const LAS bf16* bp = B + (brow0 + r) * bstride + 8 * hf;
    for (int ks = 0; ks < nks; ++ks) { const bf16x8 a = *(const LAS bf16x8*)(ap + 16 * ks), b = *(const LAS bf16x8*)(bp + 16 * ks); acc = MFMA32(a, b, acc); }
    return acc;
}

template <int BLK>
DI void gla_a_unit(Frame& F, int u, int row0, int h) {
    LAS float* bcum = (LAS float*)(F.lds + L_BCUM);
    LAS bf16* qt = (LAS bf16*)(F.lds + L_QT); LAS bf16* kt = (LAS bf16*)(F.lds + L_KT); LAS bf16* khT = (LAS bf16*)(F.lds + L_KHT);
    LAS bf16* vT = (LAS bf16*)(F.lds + L_VT); LAS bf16* Pm = (LAS bf16*)(F.lds + L_PM);
    const int tid = F.tid, lane = F.lane, w = F.wave;
    const size_t hoff = (size_t)h * HD;
    constexpr int SEG = BLK / 4;
    { const int seg = tid >> 7, kc = tid & 127; float a = 0.f;
      const float* lp = F.LOGF + (size_t)(row0 + seg * SEG) * D + hoff + kc;
#pragma unroll
      for (int t = 0; t < SEG; ++t) { a += lp[(size_t)t * D]; bcum[(seg * SEG + t) * 128 + kc] = a; }
      __syncthreads();
      float off = 0.f;
      for (int s = 0; s < seg; ++s) off += bcum[(s * SEG + SEG - 1) * 128 + kc];
      __syncthreads();
      if (seg > 0) {
#pragma unroll
          for (int t = 0; t < SEG; ++t) bcum[(seg * SEG + t) * 128 + kc] += off;
      }
      __syncthreads(); }
    for (int i = tid; i < BLK * 16; i += NTHR) {
        const int t = i >> 4, c0 = (i & 15) * 8;
        const size_t goff = (size_t)(row0 + t) * D + hoff + c0;
        const u32x4 qv = *(const u32x4*)(F.QB + goff);
        const u32x4 vv = *(const u32x4*)(F.VB + goff);
        const f32x4 lf0 = *(const f32x4*)(F.LOGF + goff), lf1 = *(const f32x4*)(F.LOGF + goff + 4);
        float q[8] = {bflo(qv.x), bfhi(qv.x), bflo(qv.y), bfhi(qv.y), bflo(qv.z), bfhi(qv.z), bflo(qv.w), bfhi(qv.w)};
        float lf[8] = {lf0.x, lf0.y, lf0.z, lf0.w, lf1.x, lf1.y, lf1.z, lf1.w};
        float qtv[8], ktv[8], qhv[8], khv[8];
#pragma unroll
        for (int e = 0; e < 8; ++e) {
            const float b = bcum[t * 128 + c0 + e], bmid = bcum[(BLK / 2 - 1) * 128 + c0 + e], bend = bcum[(BLK - 1) * 128 + c0 + e];
            const float kk = 1.f - __expf(lf[e]);
            qtv[e] = q[e] * __expf(b - bmid); ktv[e] = kk * __expf(bmid - b); qhv[e] = q[e] * __expf(b); khv[e] = kk * __expf(bend - b);
            if (t == BLK - 1) F.DEC[(size_t)u * 128 + c0 + e] = __expf(bend);
        }
        u32x4 o; o.x = pk2(qtv[0], qtv[1]); o.y = pk2(qtv[2], qtv[3]); o.z = pk2(qtv[4], qtv[5]); o.w = pk2(qtv[6], qtv[7]);
        *(LAS u32x4*)(qt + t * QT_STRIDE + c0) = o;
        o.x = pk2(ktv[0], ktv[1]); o.y = pk2(ktv[2], ktv[3]); o.z = pk2(ktv[4], ktv[5]); o.w = pk2(ktv[6], ktv[7]);
        *(LAS u32x4*)(kt + t * QT_STRIDE + c0) = o;
        o.x = pk2(qhv[0], qhv[1]); o.y = pk2(qhv[2], qhv[3]); o.z = pk2(qhv[4], qhv[5]); o.w = pk2(qhv[6], qhv[7]);
        *(u32x4*)(F.QB + goff) = o;
        const unsigned vw[4] = {vv.x, vv.y, vv.z, vv.w};
#pragma unroll
        for (int e = 0; e < 8; ++e) {
            khT[(c0 + e) * TT_STRIDE + t] = f2bf(khv[e]);
            vT[(c0 + e) * TT_STRIDE + t] = (bf16)((e & 1) ? (vw[e >> 1] >> 16) : (vw[e >> 1] & 0xffffu));
        }
    }
    __syncthreads();
    const int r = lane & 31, hf = lane >> 5;
#pragma unroll
    for (int q2 = 0; q2 < 2; ++q2) {
        const int tl = w * 2 + q2, mt = tl >> 2, nt = tl & 3;
        const f32x16 acc = mma_lds(khT, TT_STRIDE, 32 * mt, vT, TT_STRIDE, 32 * nt, BLK / 16, lane);
        float* lp = F.LOCAL + (size_t)u * 16384 + 32 * nt + r;
#pragma unroll
        for (int i = 0; i < 16; ++i) lp[(size_t)(32 * mt + crow(i, hf)) * 128] = acc[i];
    }
    constexpr int NT2 = BLK / 32;
    if (w < NT2 * NT2) {
        const int mt = w / NT2, nt = w % NT2;
        if (nt > mt) {
#pragma unroll
            for (int i = 0; i < 16; ++i) Pm[(32 * mt + crow(i, hf)) * TT_STRIDE + 32 * nt + r] = 0;
        } else {
            const f32x16 acc = mma_lds(qt, QT_STRIDE, 32 * mt, kt, QT_STRIDE, 32 * nt, 8, lane);
#pragma unroll
            for (int i = 0; i < 16; ++i) { const int t = 32 * mt + crow(i, hf), s = 32 * nt + r; Pm[t * TT_STRIDE + s] = (s <= t) ? f2bf(acc[i]) : (bf16)0; }
        }
    }
    __syncthreads();
    if (w < NT2 * 4) {
        const int mt = w >> 2, nt = w & 3;
        const f32x16 acc = mma_lds(Pm, TT_STRIDE, 32 * mt, vT, TT_STRIDE, 32 * nt, BLK / 16, lane);
        float* op = F.OI + (size_t)(row0 + 32 * mt) * D + hoff + 32 * nt + r;
#pragma unroll
        for (int i = 0; i < 16; ++i) op[(size_t)crow(i, hf) * D] = acc[i];
    }
    __syncthreads();
}
DI void gla_a_phase(Frame& F) {
    for (int u = F.bid; u < GLA_UNITS; u += F.G) {
        if (u < 2048) { const int b = u >> 10, h = (u >> 6) & 15, c = u & 63; gla_a_unit<64>(F, u, b * SEQ + c * 64, h); }
        else { const int su = u - 2048, b = su >> 4, h = su & 15; gla_a_unit<32>(F, u, TP + b * 32, h); }
    }
}
DI void scan_phase(Frame& F) {
    const int gt = F.bid * NTHR + F.tid, NGT = F.G * NTHR;
    for (int it = gt; it < 32 * 4096; it += NGT) {
        const int bh = it >> 12, e = (it & 4095) * 4, kc = e >> 7;
        f32x4 S = {0.f, 0.f, 0.f, 0.f};
        float* __restrict__ lp = F.LOCAL + (size_t)(bh * 64) * 16384 + e; const float* __restrict__ dp = F.DEC + (size_t)(bh * 64) * 128 + kc;
        for (int c0 = 0; c0 < 64; c0 += 8) {
            f32x4 loc[8]; float d[8];
#pragma unroll
            for (int j = 0; j < 8; ++j) { loc[j] = *(const f32x4*)(lp + (size_t)(c0 + j) * 16384); d[j] = dp[(c0 + j) * 128]; }
#pragma unroll
            for (int j = 0; j < 8; ++j) { *(f32x4*)(lp + (size_t)(c0 + j) * 16384) = S; S = S * d[j] + loc[j]; }
        }
        *(f32x4*)(F.p.out + O_SP + (size_t)bh * 16384 + e) = S;
    }
    for (int it0 = gt; it0 < 512 * 4096; it0 += 4 * NGT) {
        f32x4 S0[4], loc[4]; float d[4];
#pragma unroll
        for (int j = 0; j < 4; ++j) { const int it = it0 + j * NGT; if (it < 512 * 4096) { const int bh = it >> 12, e = (it & 4095) * 4, kc = e >> 7;
            S0[j] = *(const f32x4*)(F.p.state_a_S + (size_t)bh * 16384 + e); loc[j] = *(const f32x4*)(F.LOCAL + (size_t)(2048 + bh) * 16384 + e); d[j] = F.DEC[(size_t)(2048 + bh) * 128 + kc]; } }
#pragma unroll
        for (int j = 0; j < 4; ++j) { const int it = it0 + j * NGT; if (it < 512 * 4096) { const int bh = it >> 12, e = (it & 4095) * 4;
            *(f32x4*)(F.p.out + O_SS + (size_t)bh * 16384 + e) = S0[j] * d[j] + loc[j]; } }
    }
}
constexpr int OB_STRIDE = 132;
template <int BLK>
DI void gla_c_unit(Frame& F, const float* __restrict__ S, int row0, int h) {
    LAS float* ob = (LAS float*)F.lds;
    const int tid = F.tid, lane = F.lane, w = F.wave, r = lane & 31, hf = lane >> 5;
    const size_t hoff = (size_t)h * HD;
    constexpr int TPR_ = NTHR / BLK, CPT_ = 128 / TPR_;
    u32x4 sgv[CPT_ / 8];
    { const int t = tid / TPR_, c0 = (tid % TPR_) * CPT_;
#pragma unroll
      for (int e8 = 0; e8 < CPT_ / 8; ++e8) sgv[e8] = *(const u32x4*)(F.SG + (size_t)(row0 + t) * D + hoff + c0 + 8 * e8); }
    if (w < (BLK / 32) * 4) {
        const int mt = w >> 2, nt = w & 3;
        f32x16 acc; for (int i = 0; i < 16; ++i) acc[i] = 0.f;
        float oiv[16];
        { const float* oi = F.OI + (size_t)(row0 + 32 * mt) * D + hoff + 32 * nt + r;
#pragma unroll
          for (int i = 0; i < 16; ++i) oiv[i] = oi[(size_t)crow(i, hf) * D]; }
        const bf16* ap = F.QB + (size_t)(row0 + 32 * mt + r) * D + hoff + 8 * hf;
        const float* sp = S + (size_t)(8 * hf) * 128 + 32 * nt + r;
#pragma unroll
        for (int ks = 0; ks < 8; ++ks) {
            const bf16x8 a = *(const bf16x8*)(ap + 16 * ks);
            float sv[8];
#pragma unroll
            for (int e = 0; e < 8; ++e) sv[e] = sp[(size_t)(16 * ks + e) * 128];
            u32x4 bb; bb.x = pk2(sv[0], sv[1]); bb.y = pk2(sv[2], sv[3]); bb.z = pk2(sv[4], sv[5]); bb.w = pk2(sv[6], sv[7]);
            acc = MFMA32(a, __builtin_bit_cast(bf16x8, bb), acc);
        }
#pragma unroll
        for (int i = 0; i < 16; ++i) { const int t = crow(i, hf); ob[(32 * mt + t) * OB_STRIDE + 32 * nt + r] = acc[i] + oiv[i]; }
    }
    __syncthreads();
    {
        constexpr int TPR = NTHR / BLK;
        constexpr int CPT = 128 / TPR;
        const int t = tid / TPR, j = tid % TPR, c0 = j * CPT;
        float v[CPT]; float ss = 0.f;
#pragma unroll
        for (int e = 0; e < CPT; ++e) { v[e] = ob[t * OB_STRIDE + c0 + e]; ss += v[e] * v[e]; }
#pragma unroll
        for (int o = 1; o < TPR; o <<= 1) ss += __shfl_xor(ss, o);
        const float rstd = rsqrtf(ss * (1.f / HD) + EPS);
        const size_t goff = (size_t)(row0 + t) * D + hoff + c0;
#pragma unroll
        for (int e8 = 0; e8 < CPT / 8; ++e8) {
            const u32x4 sg = sgv[e8];
            const f32x4 n0 = *(const f32x4*)(F.p.a_norm_o + c0 + 8 * e8), n1 = *(const f32x4*)(F.p.a_norm_o + c0 + 8 * e8 + 4);
            const float* vv = v + 8 * e8;
            u32x4 o;
            o.x = pk2(vv[0] * rstd * n0.x * bflo(sg.x), vv[1] * rstd * n0.y * bfhi(sg.x));
            o.y = pk2(vv[2] * rstd * n0.z * bflo(sg.y), vv[3] * rstd * n0.w * bfhi(sg.y));
            o.z = pk2(vv[4] * rstd * n1.x * bflo(sg.z), vv[5] * rstd * n1.y * bfhi(sg.z));
            o.w = pk2(vv[6] * rstd * n1.z * bflo(sg.w), vv[7] * rstd * n1.w * bfhi(sg.w));
            *(u32x4*)(F.HB + goff + 8 * e8) = o;
        }
    }
    __syncthreads();
}
DI void gla_c_phase(Frame& F) {
    for (int u = F.bid; u < GLA_UNITS; u += F.G) {
        if (u < 2048) { const int b = u >> 10, h = (u >> 6) & 15, c = u & 63; gla_c_unit<64>(F, F.LOCAL + (size_t)u * 16384, b * SEQ + c * 64, h); }
        else { const int su = u - 2048, b = su >> 4, h = su & 15; gla_c_unit<32>(F, F.p.state_a_S + (size_t)su * 16384, TP + b * 32, h); }
    }
}
DI void convfix_phase(Frame& F, int layer, const float* edge) {
    const Params& p = F.p;
    const int gt = F.bid * NTHR + F.tid, NGT = F.G * NTHR;
    constexpr int NCG = FF / 8, NHB = T / 32;
    const float* cw = p.f_conv_w + (size_t)layer * 3 * FF; const float* cbp = p.f_conv_b + (size_t)layer * FF;
    const float* eu_first = edge; const float* eg_first = edge + (size_t)NHB * 2 * FF; const float* eu_last = edge + (size_t)NHB * 4 * FF;
    for (int it = gt; it < NHB * NCG; it += NGT) {
        const int hb = it / NCG, c0 = (it % NCG) * 8;
        const bool smp = hb >= 256; const bool first = smp || ((hb & 127) == 0), lastb = smp || ((hb & 127) == 127);
        float um2[8], um1[8], u0[8], u1[8], g0[8], g1[8], w0[8], w1[8], w2[8], bb[8];
#pragma unroll
        for (int e = 0; e < 8; ++e) { w0[e] = cw[c0 + e]; w1[e] = cw[FF + c0 + e]; w2[e] = cw[2 * FF + c0 + e]; bb[e] = cbp[c0 + e]; um2[e] = 0.f; um1[e] = 0.f;
            u0[e] = eu_first[((size_t)hb * 2) * FF + c0 + e]; u1[e] = eu_first[((size_t)hb * 2 + 1) * FF + c0 + e];
            g0[e] = eg_first[((size_t)hb * 2) * FF + c0 + e]; g1[e] = eg_first[((size_t)hb * 2 + 1) * FF + c0 + e]; }
        if (first) {
            if (smp) { const float* st = p.conv_state + ((size_t)(layer * 32 + (hb - 256)) * 2) * FF + c0;
#pragma unroll
                for (int e = 0; e < 8; ++e) { um2[e] = st[e]; um1[e] = st[FF + e]; } }
        } else {
#pragma unroll
            for (int e = 0; e < 8; ++e) { um2[e] = eu_last[((size_t)(hb - 1) * 2) * FF + c0 + e]; um1[e] = eu_last[((size_t)(hb - 1) * 2 + 1) * FF + c0 + e]; }
        }
        float a0[8], a1[8];
#pragma unroll
        for (int e = 0; e < 8; ++e) { a0[e] = fsilu(bb[e] + um2[e] * w0[e] + um1[e] * w1[e] + u0[e] * w2[e]) * g0[e]; a1[e] = fsilu(bb[e] + um1[e] * w0[e] + u0[e] * w1[e] + u1[e] * w2[e]) * g1[e]; }
        u32x4 o; o.x = pk2(a0[0], a0[1]); o.y = pk2(a0[2], a0[3]); o.z = pk2(a0[4], a0[5]); o.w = pk2(a0[6], a0[7]);
        *(u32x4*)(F.ACT + (size_t)(hb * 32) * FF + c0) = o;
        o.x = pk2(a1[0], a1[1]); o.y = pk2(a1[2], a1[3]); o.z = pk2(a1[4], a1[5]); o.w = pk2(a1[6], a1[7]);
        *(u32x4*)(F.ACT + (size_t)(hb * 32 + 1) * FF + c0) = o;
        if (lastb) {
            float* dst = smp ? p.out + O_CS + ((size_t)(layer * 32 + (hb - 256)) * 2) * FF + c0 : p.out + O_CP + ((size_t)(layer * 2 + (hb >> 7)) * 2) * FF + c0;
#pragma unroll
            for (int e = 0; e < 8; ++e) { dst[e] = eu_last[((size_t)hb * 2) * FF + c0 + e]; dst[FF + e] = eu_last[((size_t)hb * 2 + 1) * FF + c0 + e]; }
        }
    }
}
DI void cacheK_fill(Frame& F, int widx, int nw) {
    const Params& p = F.p;
    const int gt = widx * NTHR + F.tid, NGT = nw * NTHR;
    for (int it0 = gt; it0 < 32 * 512 * (D / 8); it0 += 4 * NGT) {
        f32x4 a[4], c[4];
#pragma unroll
        for (int j = 0; j < 4; ++j) { const int it = it0 + j * NGT; if (it < 32 * 512 * (D / 8)) { const int row = it >> 8, cc = (it & 255) * 8;
            a[j] = __builtin_nontemporal_load((const f32x4*)(p.cache_k + (size_t)row * D + cc)); c[j] = __builtin_nontemporal_load((const f32x4*)(p.cache_k + (size_t)row * D + cc + 4)); } }
#pragma unroll
        for (int j = 0; j < 4; ++j) { const int it = it0 + j * NGT; if (it < 32 * 512 * (D / 8)) { const int row = it >> 8, cc = (it & 255) * 8, b = row >> 9, jj = row & 511;
            u32x4 o; o.x = pk2(a[j].x, a[j].y); o.y = pk2(a[j].z, a[j].w); o.z = pk2(c[j].x, c[j].y); o.w = pk2(c[j].z, c[j].w);
            __builtin_nontemporal_store(o, (u32x4*)(F.KS + ((size_t)b * SROWS + jj) * D + cc)); } }
    }
}
constexpr int VT_NP = 2 * 64 * 16, VT_NN = 32 * 16, VT_NC = 32 * 16 * 8;
DI void vtrans_items(Frame& F, int it_lo, int it_hi, int widx, int nw) {
    const Params& p = F.p; const int lane = F.lane;
    LAS bf16* tile = (LAS bf16*)(F.lds + F.wave * 16640);
    for (int it = it_lo + widx * NWAVES + F.wave; it < it_hi; it += nw * NWAVES) {
        int nrows = 64; bf16* dst; int dstride;
        if (it < VT_NP) {
            const int h = it & 15, tb = (it >> 4) & 63, b = it >> 10;
            const bf16* src = F.QKV + (size_t)(b * SEQ + tb * 64) * NQKV + 2 * D + h * HD + 2 * lane;
            unsigned u[64];
#pragma unroll
            for (int i = 0; i < 64; ++i) u[i] = *(const unsigned*)(src + (size_t)i * NQKV);
#pragma unroll
            for (int i = 0; i < 64; ++i) *(LAS unsigned*)(tile + i * 130 + 2 * lane) = u[i];
            dst = F.VT + ((size_t)(b * 16 + h) * HD) * SEQ + tb * 64; dstride = SEQ;
        } else if (it < VT_NP + VT_NN) {
            const int r = it - VT_NP, h = r & 15, b = r >> 4;
            nrows = 32;
            const bf16* src = F.QKV + (size_t)(TP + b * 32) * NQKV + 2 * D + h * HD + 2 * lane;
            unsigned u[32];
#pragma unroll
            for (int i = 0; i < 32; ++i) u[i] = *(const unsigned*)(src + (size_t)i * NQKV);
#pragma unroll
            for (int i = 0; i < 32; ++i) *(LAS unsigned*)(tile + i * 130 + 2 * lane) = u[i];
            dst = F.VTS + ((size_t)(b * 16 + h) * HD) * SROWS + 512; dstride = SROWS;
        } else {
            const int r = it - VT_NP - VT_NN, h = r & 15, jb = (r >> 4) & 7, b = r >> 7;
            const float* src = p.cache_v + ((size_t)(b * 512 + jb * 64) * NH + h) * HD + 2 * lane;
#pragma unroll
            for (int hh = 0; hh < 2; ++hh) {
                f32x2 x[32];
#pragma unroll
                for (int i = 0; i < 32; ++i) x[i] = __builtin_nontemporal_load((const f32x2*)(src + (size_t)(32 * hh + i) * D));
#pragma unroll
                for (int i = 0; i < 32; ++i) *(LAS unsigned*)(tile + (32 * hh + i) * 130 + 2 * lane) = pk2(x[i].x, x[i].y);
            }
            dst = F.VTS + ((size_t)(b * 16 + h) * HD) * SROWS + jb * 64; dstride = SROWS;
        }
        asm volatile("s_waitcnt lgkmcnt(0)" ::: "memory");
        const int tp = lane & 31, dh = lane >> 5;
        if (2 * tp < nrows) {
#pragma unroll 8
            for (int pp = 0; pp < 64; ++pp) { const int dv = 2 * pp + dh;
                const unsigned lo = tile[(2 * tp) * 130 + dv], hi = tile[(2 * tp + 1) * 130 + dv];
                *(unsigned*)(dst + (size_t)dv * dstride + 2 * tp) = lo | (hi << 16); }
        }
        asm volatile("s_waitcnt lgkmcnt(0)" ::: "memory");
    }
}
DI void prep_phase(Frame& F) {
    const Params& p = F.p;
    const int gw = F.bid * NWAVES + F.wave, NGW = F.G * NWAVES, lane = F.lane;
    const float qscale = 0.08838834764831845f * 1.4426950408889634f;
    for (int m = gw; m < T; m += NGW) {
        const bf16* src = F.QKV + (size_t)m * NQKV + lane * 8;
        const bool smp = m >= TP; const int b = smp ? (m - TP) >> 5 : m >> 12, t = smp ? (m - TP) & 31 : m & 4095;
        const int hc = (lane & 15) * 8;
        u32x4 xq[4], xk[4], xv[4];
#pragma unroll
        for (int j = 0; j < 4; ++j) { xq[j] = *(const u32x4*)(src + j * 512); xk[j] = *(const u32x4*)(src + D + j * 512); xv[j] = *(const u32x4*)(src + 2 * D + j * 512); }
        float* ko = nullptr; float* vo = nullptr;
        if (smp) { ko = p.out + O_KSM + (size_t)(m - TP) * D + lane * 8; vo = p.out + O_VSM + (size_t)(m - TP) * D + lane * 8; }
        else if (t >= SEQ - 512) { ko = p.out + O_KP + ((size_t)b * 512 + (t - (SEQ - 512))) * D + lane * 8; vo = p.out + O_VP + ((size_t)b * 512 + (t - (SEQ - 512))) * D + lane * 8; }
        const f32x4 gq0 = *(const f32x4*)(p.b_q_norm + hc), gq1 = *(const f32x4*)(p.b_q_norm + hc + 4);
        const f32x4 gk0 = *(const f32x4*)(p.b_k_norm + hc), gk1 = *(const f32x4*)(p.b_k_norm + hc + 4);
        bf16* qdst = F.QB + (size_t)m * D + lane * 8;
        bf16* kdst = smp ? F.KS + ((size_t)b * SROWS + 512 + t) * D + lane * 8 : F.KN + (size_t)m * D + lane * 8;
#pragma unroll
        for (int j = 0; j < 4; ++j) {
            { const u32x4 x = xq[j]; const float v[8] = {bflo(x.x), bfhi(x.x), bflo(x.y), bfhi(x.y), bflo(x.z), bfhi(x.z), bflo(x.w), bfhi(x.w)};
              float ss = 0.f;
#pragma unroll
              for (int e = 0; e < 8; ++e) ss += v[e] * v[e];
              ss += __shfl_xor(ss, 1); ss += __shfl_xor(ss, 2); ss += __shfl_xor(ss, 4); ss += __shfl_xor(ss, 8);
              const float rstd = rsqrtf(ss * (1.f / HD) + EPS) * qscale;
              u32x4 o; o.x = pk2(v[0] * rstd * gq0.x, v[1] * rstd * gq0.y); o.y = pk2(v[2] * rstd * gq0.z, v[3] * rstd * gq0.w);
              o.z = pk2(v[4] * rstd * gq1.x, v[5] * rstd * gq1.y); o.w = pk2(v[6] * rstd * gq1.z, v[7] * rstd * gq1.w);
              *(u32x4*)(qdst + j * 512) = o; }
            { const u32x4 x = xk[j]; const float v[8] = {bflo(x.x), bfhi(x.x), bflo(x.y), bfhi(x.y), bflo(x.z), bfhi(x.z), bflo(x.w), bfhi(x.w)};
              float ss = 0.f;
#pragma unroll
              for (int e = 0; e < 8; ++e) ss += v[e] * v[e];
              ss += __shfl_xor(ss, 1); ss += __shfl_xor(ss, 2); ss += __shfl_xor(ss, 4); ss += __shfl_xor(ss, 8);
              const float rstd = rsqrtf(ss * (1.f / HD) + EPS);
              const f32x4 a = {v[0] * rstd * gk0.x, v[1] * rstd * gk0.y, v[2] * rstd * gk0.z, v[3] * rstd * gk0.w};
              const f32x4 c = {v[4] * rstd * gk1.x, v[5] * rstd * gk1.y, v[6] * rstd * gk1.z, v[7] * rstd * gk1.w};
              u32x4 o; o.x = pk2(a.x, a.y); o.y = pk2(a.z, a.w); o.z = pk2(c.x, c.y); o.w = pk2(c.z, c.w);
              *(u32x4*)(kdst + j * 512) = o;
              if (ko) { *(f32x4*)(ko + j * 512) = a; *(f32x4*)(ko + j * 512 + 4) = c; } }
            if (vo) { const u32x4 x = xv[j];
              const f32x4 a = {bflo(x.x), bfhi(x.x), bflo(x.y), bfhi(x.y)}, c = {bflo(x.z), bfhi(x.z), bflo(x.w), bfhi(x.w)};
              *(f32x4*)(vo + j * 512) = a; *(f32x4*)(vo + j * 512 + 4) = c; }
        }
    }
    vtrans_items(F, 0, VT_NP + VT_NN, F.bid, F.G);
}
DI void attn_scores(f32x16 (&oacc)[4], float& mrun, float& lsum, const bf16x8 (&qf)[8], const bf16x8 (&kf)[8], bf16x8 (&pfr)[2], int relb, const LAS float* bias, float bias0, int hf) {
    f32x16 s; for (int i = 0; i < 16; ++i) s[i] = 0.f;
#pragma unroll
    for (int kk = 0; kk < 8; ++kk) s = MFMA32(kf[kk], qf[kk], s);
    if (relb + 31 <= -128) {
#pragma unroll
        for (int i = 0; i < 16; ++i) s[i] += bias0;
    } else {
#pragma unroll
        for (int i = 0; i < 16; ++i) { int rel = relb + crow(i, hf); rel = rel < -128 ? -128 : (rel > 63 ? 63 : rel); s[i] += bias[rel + 128]; }
    }
    float mt = s[0];
#pragma unroll
    for (int i = 1; i < 16; ++i) mt = fmaxf(mt, s[i]);
    mt = fmaxf(mt, __shfl_xor(mt, 32));
    const float mnew = fmaxf(mrun, mt), alpha = __builtin_amdgcn_exp2f(mrun - mnew);
    mrun = mnew;
    float ps = 0.f; float pv[16];
#pragma unroll
    for (int i = 0; i < 16; ++i) { pv[i] = __builtin_amdgcn_exp2f(s[i] - mnew); ps += pv[i]; }
    lsum = lsum * alpha + ps;
#pragma unroll
    for (int bl = 0; bl < 4; ++bl)
#pragma unroll
        for (int i = 0; i < 16; ++i) oacc[bl][i] *= alpha;
#pragma unroll
    for (int kb = 0; kb < 2; ++kb) {
        u32x4 pb; pb.x = pk2(pv[8 * kb], pv[8 * kb + 1]); pb.y = pk2(pv[8 * kb + 2], pv[8 * kb + 3]); pb.z = pk2(pv[8 * kb + 4], pv[8 * kb + 5]); pb.w = pk2(pv[8 * kb + 6], pv[8 * kb + 7]);
        pfr[kb] = __builtin_bit_cast(bf16x8, pb);
    }
}
DI void attn_pv(f32x16 (&oacc)[4], const bf16x8 (&pfr)[2], const bf16x8 (&vf)[2][4]) {
#pragma unroll
    for (int kb = 0; kb < 2; ++kb)
#pragma unroll
        for (int bl = 0; bl < 4; ++bl) oacc[bl] = MFMA32(vf[kb][bl], pfr[kb], oacc[bl]);
}
DI void attn_step(f32x16 (&oacc)[4], float& mrun, float& lsum, const bf16x8 (&qf)[8], const bf16x8 (&kf)[8], const bf16x8 (&vf)[2][4], int relb, const LAS float* bias, float bias0, int hf) {
    bf16x8 pfr[2];
    attn_scores(oacc, mrun, lsum, qf, kf, pfr, relb, bias, bias0, hf);
    attn_pv(oacc, pfr, vf);
}
constexpr int AK_STRIDE = 136, AV_STRIDE = 72, A_KBYTES = 64 * AK_STRIDE * 2, A_VBYTES = 128 * AV_STRIDE * 2, A_BUF = A_KBYTES + A_VBYTES;
constexpr int A_BIAS_OFF = 135168;
static_assert(2 * A_BUF <= A_BIAS_OFF && 8 * 16384 + 8 * 256 <= A_BIAS_OFF && A_BIAS_OFF + 768 <= LDS_BYTES - 16, "attention lds");

DI void attn_phase(Frame& F) {
    const Params& p = F.p;
    const int lane = F.lane, w = F.wave, tid = F.tid, r = lane & 31, hf = lane >> 5;
    constexpr float L2E = 1.4426950408889634f;
    for (int su = F.bid; su < 512; su += F.G) {
        const int h = su & 15, b = su >> 4, qrow0 = TP + b * 32;
        const bf16* kbase = F.KS + (size_t)(b * SROWS) * D + h * HD; const bf16* vbase = F.VTS + ((size_t)(b * 16 + h) * HD) * SROWS;
        LAS float* bias = (LAS float*)(F.lds + A_BIAS_OFF);
        if (tid < 192) bias[tid] = p.b_rel_bias[tid * NH + h] * L2E;
        bf16x8 qf[8];
        { const bf16* qp = F.QB + (size_t)(qrow0 + r) * D + h * HD + 8 * hf;
#pragma unroll
          for (int kk = 0; kk < 8; ++kk) qf[kk] = *(const bf16x8*)(qp + 16 * kk); }
        f32x16 oacc[4];
#pragma unroll
        for (int bl = 0; bl < 4; ++bl) for (int i = 0; i < 16; ++i) oacc[bl][i] = 0.f;
        float mrun = -1e30f, lsum = 0.f;
        __syncthreads();
        const float bias0 = bias[0];
        for (int kt = w; kt < 17; kt += 8) {
            bf16x8 kf[8], vf[2][4];
            { const bf16* kp = kbase + (size_t)(32 * kt + r) * D + 8 * hf;
#pragma unroll
              for (int kk = 0; kk < 8; ++kk) kf[kk] = *(const bf16x8*)(kp + 16 * kk); }
#pragma unroll
            for (int kb = 0; kb < 2; ++kb)
#pragma unroll
                for (int bl = 0; bl < 4; ++bl) { const bf16* vp = vbase + (size_t)(32 * bl + r) * SROWS + 32 * kt + 16 * kb + 4 * hf;
                    const u32x2 v0 = *(const u32x2*)vp, v1 = *(const u32x2*)(vp + 8); u32x4 vv; vv.x = v0.x; vv.y = v0.y; vv.z = v1.x; vv.w = v1.y; vf[kb][bl] = __builtin_bit_cast(bf16x8, vv); }
            attn_step(oacc, mrun, lsum, qf, kf, vf, -512 + 32 * kt - r, bias, bias0, hf);
        }
        lsum += __shfl_xor(lsum, 32);
        LAS float* op = (LAS float*)(F.lds + w * 16384); LAS float* ml = (LAS float*)(F.lds + 8 * 16384 + w * 256);
#pragma unroll
        for (int bl = 0; bl < 4; ++bl)
#pragma unroll
            for (int i = 0; i < 16; ++i) op[(32 * bl + crow(i, hf)) * 32 + r] = oacc[bl][i];
        if (hf == 0) { ml[2 * r] = mrun; ml[2 * r + 1] = lsum; }
        __syncthreads();
        { const int q = tid & 31, dv0 = (tid >> 5) * 8;
          float mw[8], M = -1e30f;
#pragma unroll
          for (int ww = 0; ww < 8; ++ww) { mw[ww] = ((LAS float*)(F.lds + 8 * 16384 + ww * 256))[2 * q]; M = fmaxf(M, mw[ww]); }
          float o[8] = {0.f, 0.f, 0.f, 0.f, 0.f, 0.f, 0.f, 0.f}, L = 0.f;
#pragma unroll
          for (int ww = 0; ww < 8; ++ww) { const float sc = __builtin_amdgcn_exp2f(mw[ww] - M); L += sc * ((LAS float*)(F.lds + 8 * 16384 + ww * 256))[2 * q + 1];
              const LAS float* pp = (LAS float*)(F.lds + ww * 16384) + dv0 * 32 + q;
#pragma unroll
              for (int e = 0; e < 8; ++e) o[e] += sc * pp[e * 32]; }
          const float inv = 1.f / L;
          u32x4 ov; ov.x = pk2(o[0] * inv, o[1] * inv); ov.y = pk2(o[2] * inv, o[3] * inv); ov.z = pk2(o[4] * inv, o[5] * inv); ov.w = pk2(o[6] * inv, o[7] * inv);
          *(u32x4*)(F.HB + (size_t)(qrow0 + q) * D + h * HD + dv0) = ov; }
        __syncthreads();
    }
    for (int unit = F.bid; unit < 512; unit += F.G) {
        const int cq = unit & 15, h = (unit >> 4) & 15, b = unit >> 8;
        const int cw = 4 * cq + (w >> 1), qrow0 = b * SEQ + cw * 64 + (w & 1) * 32;
        const int kc_lo = (4 * cq - 8) > 0 ? 4 * cq - 8 : 0, kc_hi = 4 * cq + 3;
        LAS float* bias = (LAS float*)(F.lds + A_BIAS_OFF);
        if (tid < 192) bias[tid] = p.b_rel_bias[tid * NH + h] * L2E;
        const bf16* kg = F.KN + (size_t)(b * SEQ) * D + h * HD;
        const bf16* vg = F.VT + ((size_t)(b * 16 + h) * HD) * SEQ;
        const int kr0 = tid >> 4, ks0 = tid & 15, vr0 = tid >> 3, vs0 = tid & 7;
        u32x4 stA[4], stB[4];
#define A_GLOAD(kc, st) do { st[0] = *(const u32x4*)(kg + (size_t)((kc) * 64 + kr0) * D + ks0 * 8); st[1] = *(const u32x4*)(kg + (size_t)((kc) * 64 + kr0 + 32) * D + ks0 * 8); \
                         st[2] = *(const u32x4*)(vg + (size_t)vr0 * SEQ + (kc) * 64 + vs0 * 8); st[3] = *(const u32x4*)(vg + (size_t)(vr0 + 64) * SEQ + (kc) * 64 + vs0 * 8); } while (0)
#define A_LWRITE(buf, st) do { LAS bf16* kb_ = (LAS bf16*)(F.lds + (buf) * A_BUF); LAS bf16* vb_ = (LAS bf16*)(F.lds + (buf) * A_BUF + A_KBYTES); \
                         *(LAS u32x4*)(kb_ + kr0 * AK_STRIDE + ks0 * 8) = st[0]; *(LAS u32x4*)(kb_ + (kr0 + 32) * AK_STRIDE + ks0 * 8) = st[1]; \
                         *(LAS u32x4*)(vb_ + vr0 * AV_STRIDE + vs0 * 8) = st[2]; *(LAS u32x4*)(vb_ + (vr0 + 64) * AV_STRIDE + vs0 * 8) = st[3]; } while (0)
#define A_COMPUTE(kc, cur) do { if ((kc) >= cw - 8 && (kc) <= cw) { \
                const LAS bf16* Kb = (const LAS bf16*)(F.lds + (cur) * A_BUF); const LAS bf16* Vb = (const LAS bf16*)(F.lds + (cur) * A_BUF + A_KBYTES); \
                _Pragma("unroll 1") for (int t = 0; t < 2; ++t) { \
                    bf16x8 pfr[2]; \
                    { bf16x8 kf[8]; \
                      _Pragma("unroll") for (int kk = 0; kk < 8; ++kk) kf[kk] = *(const LAS bf16x8*)(Kb + (32 * t + r) * AK_STRIDE + 16 * kk + 8 * hf); \
                      attn_scores(oacc, mrun, lsum, qf, kf, pfr, ((kc) * 64 + 32 * t) - (cw * 64 + (w & 1) * 32) - r, bias, bias0, hf); } \
                    { bf16x8 vf[2][4]; \
                      _Pragma("unroll") for (int kb = 0; kb < 2; ++kb) _Pragma("unroll") for (int bl = 0; bl < 4; ++bl) { const LAS bf16* vp = Vb + (32 * bl + r) * AV_STRIDE + 32 * t + 16 * kb + 4 * hf; \
                            const u32x2 v0 = *(const LAS u32x2*)vp, v1 = *(const LAS u32x2*)(vp + 8); u32x4 vv; vv.x = v0.x; vv.y = v0.y; vv.z = v1.x; vv.w = v1.y; vf[kb][bl] = __builtin_bit_cast(bf16x8, vv); } \
                      attn_pv(oacc, pfr, vf); } } } } while (0)
        A_GLOAD(kc_lo, stA);
        A_GLOAD(kc_lo + 1, stB);
        bf16x8 qf[8];
        { const bf16* qp = F.QB + (size_t)(qrow0 + r) * D + h * HD + 8 * hf;
#pragma unroll
          for (int kk = 0; kk < 8; ++kk) qf[kk] = *(const bf16x8*)(qp + 16 * kk); }
        f32x16 oacc[4];
#pragma unroll
        for (int bl = 0; bl < 4; ++bl) for (int i = 0; i < 16; ++i) oacc[bl][i] = 0.f;
        float mrun = -1e30f, lsum = 0.f;
        A_LWRITE(0, stA);
        __syncthreads();
        const float bias0 = bias[0];
        for (int kc = kc_lo; kc <= kc_hi; kc += 2) {
            if (kc + 2 <= kc_hi) A_GLOAD(kc + 2, stA);
            A_COMPUTE(kc, 0);
            A_LWRITE(1, stB);
            __syncthreads();
            if (kc + 3 <= kc_hi) A_GLOAD(kc + 3, stB);
            A_COMPUTE(kc + 1, 1);
            if (kc + 2 <= kc_hi) A_LWRITE(0, stA);
            __syncthreads();
        }
#undef A_GLOAD
#undef A_LWRITE
#undef A_COMPUTE
        lsum += __shfl_xor(lsum, 32);
        const float inv = 1.f / lsum;
        bf16* op = F.HB + (size_t)(qrow0 + r) * D + h * HD;
#pragma unroll
        for (int bl = 0; bl < 4; ++bl)
#pragma unroll
            for (int g4 = 0; g4 < 4; ++g4) {
                u32x2 o; o.x = pk2(oacc[bl][4 * g4] * inv, oacc[bl][4 * g4 + 1] * inv); o.y = pk2(oacc[bl][4 * g4 + 2] * inv, oacc[bl][4 * g4 + 3] * inv);
                *(u32x2*)(op + 32 * bl + 8 * g4 + 4 * hf) = o;
            }
    }
}

#define XB_TMO      128
#define XB_XCNT(j)  (256  + 64 * (j))
#define XB_XSUB(j)  (1280 + 64 * (j))
#define XB_XGEN(j)  (2304 + 64 * (j))
#define XB_TOP      3328
#define XB_TOPGEN   3392
#define XCD_BAR_WORDS 3456
#define XB_SPIN_CAP (1u << 18)
DI unsigned xb_ld(unsigned* p)              { return __hip_atomic_load(p, __ATOMIC_RELAXED, __HIP_MEMORY_SCOPE_AGENT); }
DI unsigned xb_add(unsigned* p, unsigned v) { return __hip_atomic_fetch_add(p, v, __ATOMIC_RELAXED, __HIP_MEMORY_SCOPE_AGENT); }
DI unsigned xb_xcc_id() { return (unsigned)__builtin_amdgcn_s_getreg((3 << 11) | 20) & 0xFu; }
#define XB_SPIN(cond, bar) do { unsigned _sp = 0; while (cond) { __builtin_amdgcn_s_sleep(1); \
    if ((++_sp & 255u) == 0u) { if (xb_ld(&(bar)[XB_TMO])) break; if (_sp > XB_SPIN_CAP) { atomicAdd(&(bar)[XB_TMO], 1u); break; } } } } while (0)
struct XcdBarrier { unsigned* bar; unsigned x; volatile LAS unsigned* st; };
DI XcdBarrier xcd_barrier_post(unsigned* bar, volatile LAS unsigned* st) {
    XcdBarrier b; b.bar = bar; b.x = xb_xcc_id(); b.st = st;
    if (threadIdx.x == 0) (void)xb_add(&bar[XB_XCNT(b.x)], 1u);
    return b;
}
DI void xcd_barrier_complete(unsigned* bar, unsigned x, unsigned& nloc, unsigned& nx) {
    const unsigned G = gridDim.x * gridDim.y * gridDim.z;
    unsigned sum, cnt, mine, sp = 0u;
    for (;;) {
        sum = 0u; cnt = 0u; mine = 0u;
#pragma unroll
        for (unsigned j = 0; j < 16; ++j) { const unsigned c = xb_ld(&bar[XB_XCNT(j)]); sum += c; cnt += (c > 0u) ? 1u : 0u; mine = (j == x) ? c : mine; }
        if (sum == G) break;
        __builtin_amdgcn_s_sleep(1);
        if ((++sp & 255u) == 0u) { if (xb_ld(&bar[XB_TMO])) break; if (sp > XB_SPIN_CAP) { atomicAdd(&bar[XB_TMO], 1u); break; } }
    }
    nloc = mine > 0u ? mine : 1u; nx = cnt > 0u ? cnt : 1u;
}
DI void xcd_barrier(const XcdBarrier& b) {
    asm volatile("s_waitcnt vmcnt(0)" ::: "memory");
    __syncthreads();
    if (threadIdx.x == 0) {
        unsigned* bar = b.bar;
        __builtin_amdgcn_s_waitcnt(0);
        unsigned nloc = b.st[0], nx = b.st[1];
        if (nloc == 0u) { xcd_barrier_complete(bar, b.x, nloc, nx); b.st[0] = nloc; b.st[1] = nx; }
        const unsigned old = xb_add(&bar[XB_XSUB(b.x)], 1u);
        const unsigned gen = old / nloc;
        if (old + 1u == (gen + 1u) * nloc) {
            __builtin_amdgcn_fence(__ATOMIC_RELEASE, "agent");
            asm volatile("s_waitcnt vmcnt(0)" ::: "memory");
            const unsigned og = xb_add(&bar[XB_TOP], 1u);
            const unsigned tg = og / nx;
            if (og + 1u == (tg + 1u) * nx) xb_add(&bar[XB_TOPGEN], 1u);
            else XB_SPIN(xb_ld(&bar[XB_TOPGEN]) == tg, bar);
            __builtin_amdgcn_fence(__ATOMIC_ACQUIRE, "agent");
            xb_add(&bar[XB_XGEN(b.x)], 1u);
            asm volatile("s_waitcnt vmcnt(0)" ::: "memory");
        } else {
            XB_SPIN(xb_ld(&bar[XB_XGEN(b.x)]) == gen, bar);
            __builtin_amdgcn_fence(__ATOMIC_ACQUIRE, "agent");
            asm volatile("s_waitcnt vmcnt(0)" ::: "memory");
        }
    }
    __syncthreads();
}

enum { PH_P0, PH_G1, PH_GLA_A, PH_SCAN, PH_GLA_C, PH_G2, PH_RMS_F0, PH_G3_0, PH_CONV0, PH_G4_0, PH_RMS_M1, PH_G5, PH_PREP, PH_ATTN, PH_G6, PH_RMS_F1, PH_G3_1, PH_CONV1, PH_G4_1, PH_FIN, NPH };

__global__ void __launch_bounds__(NTHR, 2) fwd_megakernel(Params prm) {
    extern __shared__ __attribute__((aligned(16))) unsigned char lds_raw[];
    cg::grid_group grid = cg::this_grid();
    float* const X0 = prm.out;
    volatile LAS unsigned* bst = (volatile LAS unsigned*)((LAS unsigned char*)lds_raw + (LDS_BYTES - 16));
    if (threadIdx.x < 4) bst[threadIdx.x] = 0u;
    __syncthreads();
    XcdBarrier xbar = xcd_barrier_post((unsigned*)(prm.ws + WS_BAR), bst);
    for (int ph = prm.ph_lo; ph < prm.ph_hi; ++ph) {
      for (int rep = 0, nrep = 1 + ((REP_MASK >> ph) & 1); rep < nrep; ++rep) {
        int tid_ = threadIdx.x; asm volatile("" : "+v"(tid_));
        size_t zoff = 0; asm volatile("" : "+s"(zoff));
        unsigned char* ws = prm.ws + zoff;
        float* X = X0 + zoff;
        Frame F;
        F.p = prm; F.lds = (LAS unsigned char*)lds_raw;
        F.tid = tid_; F.lane = F.tid & 63; F.wave = __builtin_amdgcn_readfirstlane(F.tid >> 6); F.G = gridDim.x; F.bid = blockIdx.x;
        F.WinA = (bf16*)(ws + WS_WINA); F.WoA = (bf16*)(ws + WS_WOA); F.Wqkv = (bf16*)(ws + WS_WQKV); F.WoB = (bf16*)(ws + WS_WOB);
        F.Fin0 = (bf16*)(ws + WS_FIN0); F.Fin1 = (bf16*)(ws + WS_FIN1); F.Fdn0 = (bf16*)(ws + WS_FDN0); F.Fdn1 = (bf16*)(ws + WS_FDN1);
        F.LB = (float*)(ws + WS_LB); F.HB = (bf16*)(ws + WS_HB); F.QB = (bf16*)(ws + WS_QB);
        F.LOGF = (float*)(ws + WS_LOGF); F.VB = (bf16*)(ws + WS_VB); F.SG = (bf16*)(ws + WS_SG); F.OI = (float*)(ws + WS_OI); F.LOCAL = (float*)(ws + WS_LOCAL); F.DEC = (float*)(ws + WS_DEC);
        F.QKV = (bf16*)(ws + WS_QKV); F.KN = (bf16*)(ws + WS_KN); F.KS = (bf16*)(ws + WS_KS); F.VT = (bf16*)(ws + WS_VT); F.VTS = (bf16*)(ws + WS_VTS);
        F.UP = (bf16*)(ws + WS_UP); F.ACT = (bf16*)(ws + WS_ACT);
        switch (ph) {
        case PH_P0: if (EN_MASK & 1) p0_phase(F); break;
        case PH_GLA_A: if (EN_MASK & 2) gla_a_phase(F); break;
        case PH_SCAN: if (EN_MASK & 4) scan_phase(F); break;
        case PH_GLA_C: if (EN_MASK & 8) gla_c_phase(F); break;
        case PH_RMS_F0: if (EN_MASK & 16) rms_phase(F, X, prm.x_sample, prm.norm_ffn, (const float*)(ws + WS_PART), X + (size_t)TP * D); break;
        case PH_RMS_M1: if (EN_MASK & 16) rms_phase(F, X, X + (size_t)TP * D, prm.norm_mix + D, (const float*)(ws + WS_PART), X + (size_t)TP * D); break;
        case PH_RMS_F1: if (EN_MASK & 16) rms_phase(F, X, X + (size_t)TP * D, prm.norm_ffn + D, (const float*)(ws + WS_PART), X + (size_t)TP * D); break;
        case PH_FIN: fin_phase(F, X + (size_t)TP * D, (const float*)(ws + WS_PART)); break;
        case PH_CONV0: if (EN_MASK & 32) convfix_phase(F, 0, (const float*)(ws + WS_PART)); break;
        case PH_CONV1: if (EN_MASK & 32) convfix_phase(F, 1, (const float*)(ws + WS_PART)); break;
        case PH_PREP: if (EN_MASK & 64) prep_phase(F); break;
        case PH_ATTN: if (EN_MASK & 128) attn_phase(F); break;
        default: if (EN_MASK & 256) {
            pg8::Gemm g; pg8::Epi E; E.mode = 2; E.cw = nullptr; E.cbias = nullptr; E.ldo = D; E.ob = nullptr; E.of = X; E.resP = X; E.resS = X + (size_t)TP * D;
            E.lb = F.LB; E.logf = F.LOGF; E.wsb = ws;
            g.A = F.HB; g.M = T; g.K = D; g.N = D; g.Bt = F.WoA;
            if (ph == PH_G1) { g.Bt = F.WinA; g.N = NWIN; E.mode = 0; }
            else if (ph == PH_G2) { g.Bt = F.WoA; E.resP = prm.x_prompt; E.resS = prm.x_sample; }
            else if (ph == PH_G3_0 || ph == PH_G3_1) { const int l = (ph == PH_G3_1); g.Bt = l ? F.Fin1 : F.Fin0; g.N = NUP; E.mode = 3; E.cw = prm.f_conv_w + (size_t)l * 3 * FF; E.cbias = prm.f_conv_b + (size_t)l * FF; }
            else if (ph == PH_G4_0 || ph == PH_G4_1) { g.A = F.ACT; g.Bt = (ph == PH_G4_1) ? F.Fdn1 : F.Fdn0; g.K = FF; }
            else if (ph == PH_G5) { g.Bt = F.Wqkv; g.N = NQKV; E.mode = 1; E.ob = F.QKV; E.ldo = NQKV; }
            else { g.Bt = F.WoB; }
            E.part = (float*)(ws + WS_PART); E.act = F.ACT; E.edge = (float*)(ws + WS_PART);
            pg8::StaticOrder S; S.init(g.M, g.N, g.K, F.G, F.bid, E.mode == 2);
            pg8::gemm_phase(F.lds, g, S, E, F.tid);
            if (ph == PH_G1 || ph == PH_G3_0 || ph == PH_G5) {
                const int rem = S.nitems % F.G;
                if (rem == 0 || F.bid >= rem) {
                    const int widx = rem ? F.bid - rem : F.bid, nw = rem ? F.G - rem : F.G;
                    if (ph == PH_G1) wconv_items(F, WC_EARLY, WC_ALL, widx, nw);
                    else if (ph == PH_G3_0) cacheK_fill(F, widx, nw);
                    else vtrans_items(F, VT_NP + VT_NN, VT_NP + VT_NN + VT_NC, widx, nw);
                }
            }
        } break;
        }
      }
        if (prm.ph_hi > 1000) grid.sync();
        if (ph + 1 < prm.ph_hi) xcd_barrier(xbar);
    }
}

extern "C" void kernel_launch(void* const* d_in, const int* in_sizes, int n_in, void* d_out, int out_size, void* d_ws, size_t ws_size, hipStream_t stream) {
    static int grid_blocks = 0;
    if (!grid_blocks) {
        int dev = 0, cus = 0, per_cu = 0;
        hipGetDevice(&dev);
        hipDeviceGetAttribute(&cus, hipDeviceAttributeMultiprocessorCount, dev);
        if (hipFuncSetAttribute((const void*)fwd_megakernel, hipFuncAttributeMaxDynamicSharedMemorySize, LDS_BYTES) != hipSuccess) fprintf(stderr, "kernel_launch: hipFuncSetAttribute failed\n");
        hipOccupancyMaxActiveBlocksPerMultiprocessor(&per_cu, (const void*)fwd_megakernel, NTHR, LDS_BYTES);
        if (per_cu < 1) per_cu = 1;
        if (per_cu > 1) per_cu = 1;
        grid_blocks = cus * per_cu;
        if (n_in != 21 || (size_t)out_size != O_END || ws_size < WS_END) fprintf(stderr, "kernel_launch: unexpected sizes n_in %d out %d ws %zu (need %zu)\n", n_in, out_size, ws_size, (size_t)WS_END);
    }
    Params p{};
    p.x_prompt = (const float*)d_in[0]; p.x_sample = (const float*)d_in[1]; p.state_a_S = (const float*)d_in[2]; p.cache_k = (const float*)d_in[3]; p.cache_v = (const float*)d_in[4];
    p.conv_state = (const float*)d_in[5]; p.norm_mix = (const float*)d_in[6]; p.norm_ffn = (const float*)d_in[7]; p.a_w_in = (const float*)d_in[8]; p.a_gamma = (const float*)d_in[9];
    p.a_norm_o = (const float*)d_in[10]; p.a_w_o = (const float*)d_in[11]; p.b_w_qkv = (const float*)d_in[12]; p.b_q_norm = (const float*)d_in[13]; p.b_k_norm = (const float*)d_in[14];
    p.b_rel_bias = (const float*)d_in[15]; p.b_w_o = (const float*)d_in[16]; p.f_w_in = (const float*)d_in[17]; p.f_conv_w = (const float*)d_in[18]; p.f_conv_b = (const float*)d_in[19];
    p.f_w_down = (const float*)d_in[20];
    p.out = (float*)d_out; p.ws = (unsigned char*)d_ws;
#if MK_N_LAUNCHES == 1
    p.ph_lo = 0; p.ph_hi = NPH;
    if (hipMemsetAsync((char*)d_ws + WS_BAR, 0, 16384, stream) != hipSuccess) fprintf(stderr, "kernel_launch: memset of barrier words failed\n");
    void* args[] = {&p};
    hipError_t e = hipLaunchCooperativeKernel((const void*)fwd_megakernel, dim3(grid_blocks), dim3(NTHR), args, LDS_BYTES, stream);
    if (e != hipSuccess) fprintf(stderr, "cooperative launch failed: %s (grid %d)\n", hipGetErrorString(e), grid_blocks);
#else
    for (int ph = 0; ph < NPH; ++ph) {
        p.ph_lo = ph; p.ph_hi = ph + 1;
        hipLaunchKernelGGL(fwd_megakernel, dim3(grid_blocks), dim3(NTHR), LDS_BYTES, stream, p);
    }
#endif
}
```

```cpp
#include <hip/hip_runtime.h>
#include <hip/hip_cooperative_groups.h>
#include <cstdio>
#include <cstdint>
namespace cg = cooperative_groups;

#define DI __device__ __forceinline__
#define LAS __attribute__((address_space(3)))
#define GAS __attribute__((address_space(1)))
typedef unsigned short bf16;
typedef short bf16x8 __attribute__((ext_vector_type(8)));
typedef float f32x2 __attribute__((ext_vector_type(2)));
typedef float f32x4 __attribute__((ext_vector_type(4)));
typedef float f32x16 __attribute__((ext_vector_type(16)));
typedef unsigned u32x2 __attribute__((ext_vector_type(2)));
typedef unsigned u32x4 __attribute__((ext_vector_type(4)));
typedef __bf16 bf16x2_t __attribute__((ext_vector_type(2)));

#ifndef EN_MASK
#define EN_MASK 0xffffu
#endif
#ifndef REP_MASK
#define REP_MASK 0
#endif
#ifndef MK_N_LAUNCHES
#define MK_N_LAUNCHES 1
#endif

constexpr int D = 2048, TP = 8192, TS = 1024, T = TP + TS, SEQ = 4096, NH = 16, HD = 128, FF = 5632;
constexpr int NQKV = 3 * D, NWIN = 4 * D, NUP = 2 * FF;
constexpr int SROWS = 544;
constexpr float EPS = 1e-6f;
constexpr int NWAVES = 8, NTHR = 512;
constexpr int LDS_BYTES = 147456;

constexpr size_t MiB = 1u << 20;
constexpr size_t WS_WINA = 0, WS_WOA = 32 * MiB, WS_WQKV = 40 * MiB, WS_WOB = 64 * MiB, WS_FIN0 = 72 * MiB, WS_FIN1 = 116 * MiB, WS_FDN0 = 160 * MiB, WS_FDN1 = 182 * MiB;
constexpr size_t WS_LB = 204 * MiB, WS_HB = 205 * MiB, WS_QB = 241 * MiB, WS_MIX = 277 * MiB;
constexpr size_t WS_LOGF = WS_MIX, WS_VB = WS_MIX + 72 * MiB, WS_SG = WS_MIX + 108 * MiB, WS_OI = WS_MIX + 144 * MiB, WS_LOCAL = WS_MIX + 216 * MiB, WS_DEC = WS_MIX + 376 * MiB;
constexpr size_t WS_KS = WS_MIX, WS_VTS = WS_MIX + 68 * MiB, WS_QKV = WS_MIX + 136 * MiB, WS_KN = WS_MIX + 244 * MiB, WS_VT = WS_MIX + 276 * MiB;
constexpr size_t WS_UP = WS_MIX + 136 * MiB, WS_ACT = WS_MIX + 136 * MiB;
constexpr size_t WS_PART = WS_MIX + 236 * MiB;
constexpr size_t WS_BAR = WS_LB + 64 * 1024;
constexpr size_t WS_END = WS_MIX + 378 * MiB;

constexpr size_t O_YP = 0, O_YS = O_YP + (size_t)TP * D, O_SP = O_YS + (size_t)TS * D, O_SS = O_SP + 2 * 16 * 128 * 128, O_KP = O_SS + 32 * 16 * 128 * 128,
                 O_VP = O_KP + 2 * 512 * 2048, O_KSM = O_VP + 2 * 512 * 2048, O_VSM = O_KSM + 32 * 32 * 2048, O_CP = O_VSM + 32 * 32 * 2048, O_CS = O_CP + 2 * 2 * 2 * FF,
                 O_END = O_CS + 2 * 32 * 2 * FF;

struct Params {
    const float* x_prompt; const float* x_sample; const float* state_a_S; const float* cache_k; const float* cache_v; const float* conv_state;
    const float* norm_mix; const float* norm_ffn; const float* a_w_in; const float* a_gamma; const float* a_norm_o; const float* a_w_o;
    const float* b_w_qkv; const float* b_q_norm; const float* b_k_norm; const float* b_rel_bias; const float* b_w_o;
    const float* f_w_in; const float* f_conv_w; const float* f_conv_b; const float* f_w_down;
    float* out; unsigned char* ws; int ph_lo, ph_hi;
};

DI unsigned pk2(float lo, float hi) { f32x2 v = {lo, hi}; return __builtin_bit_cast(unsigned, __builtin_convertvector(v, bf16x2_t)); }
DI bf16 f2bf(float f) { return (bf16)(pk2(f, 0.f) & 0xffffu); }
DI float bflo(unsigned p) { return __uint_as_float(p << 16); }
DI float bfhi(unsigned p) { return __uint_as_float(p & 0xffff0000u); }
DI float wave_sum(float v) {
#pragma unroll
    for (int o = 1; o < 64; o <<= 1) v += __shfl_xor(v, o);
    return v;
}
DI float fexp(float x) { return __builtin_amdgcn_exp2f(x * 1.4426950408889634f); }
DI float fsigmoid(float z) { return __builtin_amdgcn_rcpf(1.f + fexp(-z)); }
DI float fsilu(float z) { return z * __builtin_amdgcn_rcpf(1.f + fexp(-z)); }
DI float flog(float x) { return __builtin_amdgcn_logf(x) * 0.6931471805599453f; }
DI int crow(int reg, int h) { return (reg & 3) + 8 * (reg >> 2) + 4 * h; }
#define MFMA32(a, b, c) __builtin_amdgcn_mfma_f32_32x32x16_bf16((a), (b), (c), 0, 0, 0)

namespace pg8 {
constexpr int BM = 256, BK = 64, HALF = 128, HTB = HALF * BK * 2, STAGE_BYTES = 8 * HTB, NXCD = 8, WGM = 8;
DI int lds_byte(int r, int c) { const int st = (r >> 4) * 2 + (c >> 5), rr = r & 15, cc = c & 31, ob = rr * 64 + cc * 2; return st * 1024 + (ob ^ (((ob >> 9) & 1) << 5)); }
DI void stage_rc(int b, int& R, int& C) { const int st = b / 1024, sb = b % 1024, swz = sb ^ (((sb >> 9) & 1) << 5); R = (st >> 1) * 16 + swz / 64; C = (st & 1) * 32 + (swz % 64) / 2; }
DI int perm32(int rho) { const int n = rho >> 4, i = rho & 15; return 8 * (i >> 2) + 4 * n + (i & 3); }
struct Unit { int pm, pn, kb0, nkt, slice; };
struct Gemm { const bf16* A; const bf16* Bt; int M, N, K; };
struct StaticOrder {
    int nM, nN, nwg, G, c, tail, nblk, nitems;
    DI void init(int M, int N, int K, int G_, int c_, int tail_) { tail = tail_; nM = tail ? TP / BM : M / BM; nN = N / BM; nwg = nM * nN; G = G_; c = c_; nblk = K / 128; nitems = nwg + (tail ? 256 : 0); }
    DI bool next(int i, Unit& u) const {
        const long L = (long)i * G + c; if (L >= nitems) return false;
        u.slice = -1; u.kb0 = 0; u.nkt = nblk * 2;
        if (L >= nwg) { const int j = (int)L - nwg, uu = j & 31; u.slice = j >> 5; u.pm = TP / BM + (uu >> 3); u.pn = uu & 7;
            const int base = nblk / 8, rem = nblk % 8; u.kb0 = u.slice * base + (u.slice < rem ? u.slice : rem); u.nkt = 2 * (base + (u.slice < rem ? 1 : 0)); return true; }
        int wgid = (int)L; { const int q = nwg / NXCD, r = nwg % NXCD, xcd = wgid % NXCD, off = wgid / NXCD; wgid = (xcd < r ? xcd * (q + 1) : r * (q + 1) + (xcd - r) * q) + off; }
        const int nig = WGM * nN, gid = wgid / nig, fm = gid * WGM, gsz = (nM - fm) < WGM ? (nM - fm) : WGM;
        u.pm = fm + ((wgid % nig) % gsz); u.pn = (wgid % nig) / gsz; return true;
    }
};

struct Epi {
    int mode;
    int ldo;
    bf16* ob;
    float* of; const float* resP; const float* resS;
    const float* lb; float* logf; unsigned char* wsb;
    float* part;
    const float* cw; const float* cbias; bf16* act; float* edge;
    DI bool perm() const { return mode != 2; }
    DI void operator()(const f32x4 (&acc)[2][2][4][2], const Unit& u, int wr, int wc, int fr, int fq) const {
        const int row0 = u.pm * BM + wr * 64 + fr;
        if (mode == 2 && u.slice >= 0) {
            const int col0 = u.pn * BM + wc * 32 + 4 * fq;
#pragma unroll
            for (int ai = 0; ai < 2; ++ai)
#pragma unroll
                for (int m = 0; m < 4; ++m) {
                    float* op = part + ((size_t)u.slice * TS + (row0 + ai * HALF + m * 16 - TP)) * D + col0;
#pragma unroll
                    for (int bj = 0; bj < 2; ++bj)
#pragma unroll
                        for (int n = 0; n < 2; ++n) *(f32x4*)(op + bj * HALF + n * 16) = acc[ai][bj][m][n];
                }
        } else if (mode == 2) {
            const int col0 = u.pn * BM + wc * 32 + 4 * fq;
#pragma unroll
            for (int ai = 0; ai < 2; ++ai) {
                f32x4 rr[4][2][2];
#pragma unroll
                for (int m = 0; m < 4; ++m) {
                    const int row = row0 + ai * HALF + m * 16;
                    const float* rp = (row < TP ? resP + (size_t)row * D : resS + (size_t)(row - TP) * D) + col0;
#pragma unroll
                    for (int bj = 0; bj < 2; ++bj)
#pragma unroll
                        for (int n = 0; n < 2; ++n) rr[m][bj][n] = *(const f32x4*)(rp + bj * HALF + n * 16);
                }
#pragma unroll
                for (int m = 0; m < 4; ++m) {
                    float* op = of + (size_t)(row0 + ai * HALF + m * 16) * D + col0;
#pragma unroll
                    for (int bj = 0; bj < 2; ++bj)
#pragma unroll
                        for (int n = 0; n < 2; ++n) *(f32x4*)(op + bj * HALF + n * 16) = rr[m][bj][n] + acc[ai][bj][m][n];
                }
            }
        } else if (mode == 3) {
            const int cc0 = u.pn * HALF + wc * 32 + 8 * fq;
            float w0[8], w1[8], w2[8], cb[8];
            { const f32x4 a0 = *(const f32x4*)(cw + cc0), a1 = *(const f32x4*)(cw + cc0 + 4), b0 = *(const f32x4*)(cw + FF + cc0), b1 = *(const f32x4*)(cw + FF + cc0 + 4);
              const f32x4 c0 = *(const f32x4*)(cw + 2 * FF + cc0), c1 = *(const f32x4*)(cw + 2 * FF + cc0 + 4), d0 = *(const f32x4*)(cbias + cc0), d1 = *(const f32x4*)(cbias + cc0 + 4);
#pragma unroll
              for (int e = 0; e < 4; ++e) { w0[e] = a0[e]; w0[4 + e] = a1[e]; w1[e] = b0[e]; w1[4 + e] = b1[e]; w2[e] = c0[e]; w2[4 + e] = c1[e]; cb[e] = d0[e]; cb[4 + e] = d1[e]; } }
            float* const eu_first = edge; float* const eg_first = edge + (size_t)(T / 32) * 2 * FF; float* const eu_last = edge + (size_t)(T / 32) * 4 * FF;
#pragma unroll
            for (int ai = 0; ai < 2; ++ai)
#pragma unroll
                for (int m = 0; m < 4; ++m) {
                    const int row = row0 + ai * HALF + m * 16, hb = row >> 5;
                    float a[8];
#pragma unroll
                    for (int n = 0; n < 2; ++n)
#pragma unroll
                        for (int e = 0; e < 4; ++e) {
                            const float cur = acc[ai][0][m][n][e];
                            const float prv = (m & 1) ? acc[ai][0][m - 1][n][e] : 0.f;
                            const int ci = __float_as_int(cur), pi = __float_as_int(prv);
                            const int r1 = __builtin_amdgcn_update_dpp(0, pi, 0x121, 0xf, 0xf, false), r2 = __builtin_amdgcn_update_dpp(0, pi, 0x122, 0xf, 0xf, false);
                            const float p1 = __int_as_float(__builtin_amdgcn_update_dpp(r1, ci, 0x111, 0xf, 0xf, false));
                            const float p2 = __int_as_float(__builtin_amdgcn_update_dpp(r2, ci, 0x112, 0xf, 0xf, false));
                            const int k = 4 * n + e;
                            a[k] = fsilu(cb[k] + p2 * w0[k] + p1 * w1[k] + cur * w2[k]) * acc[ai][1][m][n][e];
                        }
                    const bool first2 = ((m & 1) == 0) && (fr < 2), last2 = ((m & 1) == 1) && (fr >= 14);
                    if (!first2) { u32x4 o; o.x = pk2(a[0], a[1]); o.y = pk2(a[2], a[3]); o.z = pk2(a[4], a[5]); o.w = pk2(a[6], a[7]); *(u32x4*)(act + (size_t)row * FF + cc0) = o; }
                    else { float* du = eu_first + ((size_t)hb * 2 + fr) * FF + cc0; float* dg = eg_first + ((size_t)hb * 2 + fr) * FF + cc0;
                        *(f32x4*)du = acc[ai][0][m][0]; *(f32x4*)(du + 4) = acc[ai][0][m][1]; *(f32x4*)dg = acc[ai][1][m][0]; *(f32x4*)(dg + 4) = acc[ai][1][m][1]; }
                    if (last2) { float* du = eu_last + ((size_t)hb * 2 + (fr - 14)) * FF + cc0; *(f32x4*)du = acc[ai][0][m][0]; *(f32x4*)(du + 4) = acc[ai][0][m][1]; }
                }
        } else if (mode == 1) {
            const int col0 = u.pn * BM + wc * 32 + 8 * fq;
#pragma unroll
            for (int ai = 0; ai < 2; ++ai)
#pragma unroll
                for (int m = 0; m < 4; ++m) {
                    bf16* op = ob + (size_t)(row0 + ai * HALF + m * 16) * ldo + col0;
#pragma unroll
                    for (int bj = 0; bj < 2; ++bj) { const f32x4 v0 = acc[ai][bj][m][0], v1 = acc[ai][bj][m][1];
                        u32x4 o; o.x = pk2(v0.x, v0.y); o.y = pk2(v0.z, v0.w); o.z = pk2(v1.x, v1.y); o.w = pk2(v1.z, v1.w);
                        *(u32x4*)(op + bj * HALF) = o; }
                }
        } else {
            const int type = u.pn >> 3, col0 = (u.pn & 7) * BM + wc * 32 + 8 * fq;
#pragma unroll
            for (int bj = 0; bj < 2; ++bj) {
                const int col = col0 + bj * HALF;
                f32x4 l0 = {0.f, 0.f, 0.f, 0.f}, l1 = l0;
                if (type == 1) { l0 = *(const f32x4*)(lb + col); l1 = *(const f32x4*)(lb + col + 4); }
#pragma unroll
                for (int ai = 0; ai < 2; ++ai)
#pragma unroll
                    for (int m = 0; m < 4; ++m) {
                        const size_t off = (size_t)(row0 + ai * HALF + m * 16) * D + col;
                        f32x4 v0 = acc[ai][bj][m][0], v1 = acc[ai][bj][m][1];
                        if (type == 1) {
#pragma unroll
                            for (int e = 0; e < 4; ++e) { v0[e] = flog(l0[e] + (1.f - l0[e]) * fsigmoid(v0[e])); v1[e] = flog(l1[e] + (1.f - l1[e]) * fsigmoid(v1[e])); }
                            *(f32x4*)(logf + off) = v0; *(f32x4*)(logf + off + 4) = v1;
                        } else {
                            if (type == 3) {
#pragma unroll
                                for (int e = 0; e < 4; ++e) { v0[e] = fsilu(v0[e]); v1[e] = fsilu(v1[e]); }
                            }
                            u32x4 o; o.x = pk2(v0.x, v0.y); o.y = pk2(v0.z, v0.w); o.z = pk2(v1.x, v1.y); o.w = pk2(v1.z, v1.w);
                            bf16* dst = (bf16*)(wsb + (type == 0 ? WS_QB : (type == 2 ? WS_VB : WS_SG)));
                            *(u32x4*)(dst + off) = o;
                        }
                    }
            }
        }
    }
};

DI void gemm_phase(LAS unsigned char* lds, const Gemm g, const StaticOrder& S, const Epi& E, const int tid) {
    const int wid = __builtin_amdgcn_readfirstlane(tid >> 6), lane = tid & 63, wr = wid >> 2, wc = wid & 3, fr = lane & 15, fq = lane >> 4;
    const int K = g.K;
    const bool PERM = E.perm();
    unsigned voffA[2], voffB[2];
#pragma unroll
    for (int i = 0; i < 2; ++i) { int R, C; stage_rc(tid * 16 + i * 8192, R, C); const int Rb = PERM ? ((R & ~31) + perm32(R & 31)) : R;
        voffA[i] = (unsigned)(R * K + C) * 2u; voffB[i] = (unsigned)(Rb * K + C) * 2u; }
    const size_t kstep = (size_t)(BK * 2);
    const size_t hstep = (size_t)HALF * K * 2;
    const size_t tstep = 2 * hstep;
    const unsigned ldsw = (unsigned)wid * 1024u;
    const int aoff = lds_byte(wr * 64 + fr, fq * 8), boff = lds_byte(wc * 32 + fr, fq * 8);
#define PG8_SA(b, h) (((b) * 2 + (h)) * HTB)
#define PG8_SB(b, h) ((4 + (b) * 2 + (h)) * HTB)
#define PG8_STAGE(bufoff, gbase, voff) do { _Pragma("unroll") for (int _i = 0; _i < 2; ++_i) \
        __builtin_amdgcn_global_load_lds((const unsigned*)((const char*)(gbase) + (voff)[_i]), (LAS unsigned*)(lds + (bufoff) + ldsw + _i * 8192), 16, 0, 0); } while (0)
#define PG8_LDA(dst, b, h) do { _Pragma("unroll") for (int m = 0; m < 4; ++m) _Pragma("unroll") for (int k = 0; k < 2; ++k) dst[m][k] = *(const LAS bf16x8*)(lds + PG8_SA(b, h) + aoff + m * 2048 + k * 1024); } while (0)
#define PG8_LDB(dst, b, h) do { _Pragma("unroll") for (int n = 0; n < 2; ++n) _Pragma("unroll") for (int k = 0; k < 2; ++k) dst[n][k] = *(const LAS bf16x8*)(lds + PG8_SB(b, h) + boff + n * 2048 + k * 1024); } while (0)
#define PG8_MMA(ai, bj, At, Bt) do { __builtin_amdgcn_s_setprio(1); _Pragma("unroll") for (int m = 0; m < 4; ++m) _Pragma("unroll") for (int n = 0; n < 2; ++n) _Pragma("unroll") for (int k = 0; k < 2; ++k) \
        acc[ai][bj][m][n] = __builtin_amdgcn_mfma_f32_16x16x32_bf16(Bt[n][k], At[m][k], acc[ai][bj][m][n], 0, 0, 0); __builtin_amdgcn_s_setprio(0); } while (0)
#define PG8_WAIT_V(n) asm volatile("s_waitcnt vmcnt(" #n ")" ::: "memory")
#define PG8_WAIT_L(n) asm volatile("s_waitcnt lgkmcnt(" #n ")" ::: "memory")
#define PG8_BAR __builtin_amdgcn_s_barrier()
#define PG8_SCHED __builtin_amdgcn_sched_barrier(0)
    Unit cur, nxt; int ui = 0;
    if (!S.next(0, cur)) return;
    f32x4 acc[2][2][4][2];
#pragma unroll
    for (int a = 0; a < 2; ++a)
#pragma unroll
        for (int b = 0; b < 2; ++b)
#pragma unroll
            for (int m = 0; m < 4; ++m)
#pragma unroll
                for (int n = 0; n < 2; ++n) acc[a][b][m][n] = (f32x4){0.f, 0.f, 0.f, 0.f};
    bf16x8 At[4][2], B0[2][2], B1[2][2];
    const char* cA = (const char*)g.A + (size_t)cur.pm * tstep + (size_t)cur.kb0 * 256; const char* cB = (const char*)g.Bt + (size_t)cur.pn * tstep + (size_t)cur.kb0 * 256;
    PG8_STAGE(PG8_SB(0, 0), cB, voffB); PG8_STAGE(PG8_SA(0, 0), cA, voffA); PG8_STAGE(PG8_SB(0, 1), cB + hstep, voffB); PG8_STAGE(PG8_SA(0, 1), cA + hstep, voffA);
    if (wr == 1) PG8_BAR;
    PG8_WAIT_V(4); PG8_BAR;
    PG8_STAGE(PG8_SB(1, 0), cB + kstep, voffB); PG8_STAGE(PG8_SA(1, 0), cA + kstep, voffA); PG8_STAGE(PG8_SB(1, 1), cB + hstep + kstep, voffB);
    PG8_WAIT_V(6); PG8_BAR;
    for (;;) {
        const bool has_next = S.next(ui + 1, nxt);
        const char* nA = has_next ? (const char*)g.A + (size_t)nxt.pm * tstep + (size_t)nxt.kb0 * 256 : cA; const char* nB = has_next ? (const char*)g.Bt + (size_t)nxt.pn * tstep + (size_t)nxt.kb0 * 256 : cB;
        const int nt = cur.nkt;
        for (int t = 0; t < nt; t += 2) {
            const bool last = (t == nt - 2);
            const char* a1 = cA + (size_t)(t + 1) * kstep;
            const char* a2 = last ? nA : cA + (size_t)(t + 2) * kstep; const char* b2 = last ? nB : cB + (size_t)(t + 2) * kstep;
            const char* a3 = a2 + kstep; const char* b3 = b2 + kstep;
            PG8_LDB(B0, 0, 0); PG8_SCHED; PG8_LDA(At, 0, 0); PG8_STAGE(PG8_SA(1, 1), a1 + hstep, voffA);
            PG8_WAIT_L(8); PG8_BAR; PG8_WAIT_L(0); PG8_MMA(0, 0, At, B0); PG8_BAR; PG8_SCHED;
            PG8_LDB(B1, 0, 1); PG8_STAGE(PG8_SB(0, 0), b2, voffB);
            PG8_BAR; PG8_WAIT_L(0); PG8_MMA(0, 1, At, B1); PG8_BAR;
            PG8_LDA(At, 0, 1); PG8_STAGE(PG8_SA(0, 0), a2, voffA);
            PG8_BAR; PG8_WAIT_L(0); PG8_MMA(1, 0, At, B0); PG8_BAR; PG8_SCHED;
            PG8_STAGE(PG8_SB(0, 1), b2 + hstep, voffB);
            PG8_WAIT_V(6); PG8_BAR; PG8_MMA(1, 1, At, B1); PG8_BAR;
            PG8_LDB(B0, 1, 0); PG8_SCHED; PG8_LDA(At, 1, 0); PG8_STAGE(PG8_SA(0, 1), a2 + hstep, voffA);
            PG8_WAIT_L(8); PG8_BAR; PG8_WAIT_L(0); PG8_MMA(0, 0, At, B0); PG8_BAR; PG8_SCHED;
            PG8_LDB(B1, 1, 1); PG8_STAGE(PG8_SB(1, 0), b3, voffB);
            PG8_BAR; PG8_WAIT_L(0); PG8_MMA(0, 1, At, B1); PG8_BAR;
            PG8_LDA(At, 1, 1); PG8_STAGE(PG8_SA(1, 0), a3, voffA);
            PG8_BAR; PG8_WAIT_L(0); PG8_MMA(1, 0, At, B0); PG8_BAR; PG8_SCHED;
            PG8_STAGE(PG8_SB(1, 1), b3 + hstep, voffB);
            PG8_WAIT_V(6); PG8_BAR; PG8_MMA(1, 1, At, B1); PG8_BAR;
        }
        E(acc, cur, wr, wc, fr, fq);
        if (!has_next) break;
#pragma unroll
        for (int a = 0; a < 2; ++a)
#pragma unroll
            for (int b = 0; b < 2; ++b)
#pragma unroll
                for (int m = 0; m < 4; ++m)
#pragma unroll
                    for (int n = 0; n < 2; ++n) acc[a][b][m][n] = (f32x4){0.f, 0.f, 0.f, 0.f};
        cur = nxt; cA = nA; cB = nB; ++ui;
    }
    PG8_WAIT_V(0);
    if (wr == 0) PG8_BAR;
    PG8_BAR;
#undef PG8_SA
#undef PG8_SB
#undef PG8_STAGE
#undef PG8_LDA
#undef PG8_LDB
#undef PG8_MMA
#undef PG8_WAIT_V
#undef PG8_WAIT_L
#undef PG8_BAR
#undef PG8_SCHED
}
}

struct Frame {
    Params p; LAS unsigned char* lds; int tid, lane, wave, G, bid;
    bf16 *WinA, *WoA, *Wqkv, *WoB, *Fin0, *Fin1, *Fdn0, *Fdn1;
    float* LB; bf16 *HB, *QB;
    float* LOGF; bf16 *VB, *SG; float *OI, *LOCAL, *DEC;
    bf16 *QKV, *KN, *KS, *VT, *VTS, *UP, *ACT;
};

DI void transpose_item(const float* __restrict__ W, int K, int N, bf16* __restrict__ WT, LAS float* scr, int item, int lane, const bool ilv = false) {
    const int nblk = N / 64, kb = item / nblk, nb = item % nblk, k0 = 64 * kb, n0 = 64 * nb;
    const int lr = lane >> 4, lc = (lane & 15) * 4;
    f32x4 v[16];
    const float* src = W + (size_t)(k0 + lr) * N + n0 + lc;
#pragma unroll
    for (int i = 0; i < 16; ++i) v[i] = __builtin_nontemporal_load((const f32x4*)(src + (size_t)(4 * i) * N));
#pragma unroll
    for (int i = 0; i < 16; ++i) { LAS float* d = scr + (4 * i + lr) * 65 + lc; d[0] = v[i].x; d[1] = v[i].y; d[2] = v[i].z; d[3] = v[i].w; }
    asm volatile("s_waitcnt lgkmcnt(0)" ::: "memory");
    const int c = lane & 7;
#pragma unroll
    for (int j = 0; j < 8; ++j) { const int n = (lane >> 3) + 8 * j; const LAS float* s = scr + (8 * c) * 65 + n;
        u32x4 o; o.x = pk2(s[0 * 65], s[1 * 65]); o.y = pk2(s[2 * 65], s[3 * 65]); o.z = pk2(s[4 * 65], s[5 * 65]); o.w = pk2(s[6 * 65], s[7 * 65]);
        int nd = n0 + n; if (ilv) nd = (nd < FF) ? (((nd >> 7) << 8) + (nd & 127)) : ((((nd - FF) >> 7) << 8) + 128 + ((nd - FF) & 127));
        __builtin_nontemporal_store(o, (u32x4*)(WT + (size_t)nd * K + k0 + 8 * c)); }
    asm volatile("s_waitcnt lgkmcnt(0)" ::: "memory");
}
DI void rms_row(const float* __restrict__ xrow, const float* __restrict__ g, bf16* __restrict__ orow, int lane, const float* __restrict__ part, float* __restrict__ xdst) {
    const f32x4* xr = (const f32x4*)xrow + lane; const f32x4* gr = (const f32x4*)g + lane;
    f32x4 v[8]; float s = 0.f;
#pragma unroll
    for (int j = 0; j < 8; ++j) v[j] = xr[64 * j];
    if (part) {
#pragma unroll
        for (int sl = 0; sl < 8; ++sl) { const f32x4* pr = (const f32x4*)(part + (size_t)sl * TS * D) + lane;
#pragma unroll
            for (int j = 0; j < 8; ++j) v[j] += pr[64 * j]; }
#pragma unroll
        for (int j = 0; j < 8; ++j) ((f32x4*)xdst + lane)[64 * j] = v[j];
    }
#pragma unroll
    for (int j = 0; j < 8; ++j) s += (v[j].x * v[j].x + v[j].y * v[j].y) + (v[j].z * v[j].z + v[j].w * v[j].w);
    const float rstd = rsqrtf(wave_sum(s) * (1.f / D) + EPS);
    u32x2* o8 = (u32x2*)orow + lane;
#pragma unroll
    for (int j = 0; j < 8; ++j) { const f32x4 gg = gr[64 * j]; u32x2 o; o.x = pk2(v[j].x * rstd * gg.x, v[j].y * rstd * gg.y); o.y = pk2(v[j].z * rstd * gg.z, v[j].w * rstd * gg.w); o8[64 * j] = o; }
}
DI void rms_phase(Frame& F, const float* srcP, const float* srcS, const float* g, const float* part, float* xs) {
    const int gw = F.bid * NWAVES + F.wave, NGW = F.G * NWAVES;
    for (int m = gw; m < T; m += NGW) {
        if (m < TP) rms_row(srcP + (size_t)m * D, g, F.HB + (size_t)m * D, F.lane, nullptr, nullptr);
        else rms_row(srcS + (size_t)(m - TP) * D, g, F.HB + (size_t)m * D, F.lane, part ? part + (size_t)(m - TP) * D : nullptr, xs + (size_t)(m - TP) * D);
    }
}
DI void fin_phase(Frame& F, float* xs, const float* part) {
    const int gt = F.bid * NTHR + F.tid, NGT = F.G * NTHR;
    for (int it = gt; it < TS * D / 4; it += NGT) {
        f32x4 v = ((const f32x4*)xs)[it];
#pragma unroll
        for (int sl = 0; sl < 8; ++sl) v += ((const f32x4*)(part + (size_t)sl * TS * D))[it];
        ((f32x4*)xs)[it] = v;
    }
}
constexpr int I_WINA = (D / 64) * (NWIN / 64), I_WO = (D / 64) * (D / 64), I_QKV = (D / 64) * (NQKV / 64), I_FIN = (D / 64) * (NUP / 64), I_FDN = (FF / 64) * (D / 64);
constexpr int WC_EARLY = I_WINA + 2 * I_WO + I_QKV + I_FIN + I_FDN, WC_ALL = WC_EARLY + I_FIN + I_FDN;
DI void wconv_items(Frame& F, int it_lo, int it_hi, int widx, int nw) {
    const Params& p = F.p;
    LAS float* scr = (LAS float*)(F.lds + F.wave * 16640);
    for (int it = it_lo + widx * NWAVES + F.wave; it < it_hi; it += nw * NWAVES) {
        int r = it;
        if (r < I_WINA) { transpose_item(p.a_w_in, D, NWIN, F.WinA, scr, r, F.lane); continue; } r -= I_WINA;
        if (r < I_WO) { transpose_item(p.a_w_o, D, D, F.WoA, scr, r, F.lane); continue; } r -= I_WO;
        if (r < I_QKV) { transpose_item(p.b_w_qkv, D, NQKV, F.Wqkv, scr, r, F.lane); continue; } r -= I_QKV;
        if (r < I_WO) { transpose_item(p.b_w_o, D, D, F.WoB, scr, r, F.lane); continue; } r -= I_WO;
        if (r < I_FIN) { transpose_item(p.f_w_in, D, NUP, F.Fin0, scr, r, F.lane, true); continue; } r -= I_FIN;
        if (r < I_FDN) { transpose_item(p.f_w_down, FF, D, F.Fdn0, scr, r, F.lane); continue; } r -= I_FDN;
        if (r < I_FIN) { transpose_item(p.f_w_in + (size_t)D * NUP, D, NUP, F.Fin1, scr, r, F.lane, true); continue; } r -= I_FIN;
        transpose_item(p.f_w_down + (size_t)FF * D, FF, D, F.Fdn1, scr, r, F.lane);
    }
}
DI void p0_phase(Frame& F) {
    const Params& p = F.p;
    wconv_items(F, 0, WC_EARLY, F.bid, F.G);
    for (int c = F.bid * NTHR + F.tid; c < D; c += F.G * NTHR) {
        const float g0 = p.a_gamma[c], g1 = p.a_gamma[D + c], g2 = p.a_gamma[2 * D + c];
        const float mx = fmaxf(g0, fmaxf(g1, g2));
        const float e0 = __expf(g0 - mx), e1 = __expf(g1 - mx), e2 = __expf(g2 - mx);
        F.LB[c] = e0 / (e0 + e1 + e2);
    }
    rms_phase(F, p.x_prompt, p.x_sample, p.norm_mix, nullptr, nullptr);
}

constexpr int GLA_UNITS = 2048 + 512;
constexpr int QT_STRIDE = 136, TT_STRIDE = 72;
constexpr int L_BCUM = 0, L_QT = 32768, L_KT = L_QT + 64 * QT_STRIDE * 2, L_KHT = L_KT + 64 * QT_STRIDE * 2, L_VT = L_KHT + 128 * TT_STRIDE * 2, L_PM = L_VT + 128 * TT_STRIDE * 2, L_GLA_END = L_PM + 64 * TT_STRIDE * 2;
static_assert(L_GLA_END <= LDS_BYTES, "gla lds");

DI f32x16 mma_lds(const LAS bf16* A, int astride, int arow0, const LAS bf16* B, int bstride, int brow0, int nks, int lane) {
    f32x16 acc; for (int i = 0; i < 16; ++i) acc[i] = 0.f;
    const int r = lane & 31, hf = lane >> 5;
    const LAS bf16* ap = A + (arow0 + r) * astride + 8 * hf; const LAS bf16* bp = B + (brow0 + r) * bstride + 8 * hf;
    for (int ks = 0; ks < nks; ++ks) { const bf16x8 a = *(const LAS bf16x8*)(ap + 16 * ks), b = *(const LAS bf16x8*)(bp + 16 * ks); acc = MFMA32(a, b, acc); }
    return acc;
}

template <int BLK>
DI void gla_a_unit(Frame& F, int u, int row0, int h) {
    LAS float* bcum = (LAS float*)(F.lds + L_BCUM);
    LAS bf16* qt = (LAS bf16*)(F.lds + L_QT); LAS bf16* kt = (LAS bf16*)(F.lds + L_KT); LAS bf16* khT = (LAS bf16*)(F.lds + L_KHT);
    LAS bf16* vT = (LAS bf16*)(F.lds + L_VT); LAS bf16* Pm = (LAS bf16*)(F.lds + L_PM);
    const int tid = F.tid, lane = F.lane, w = F.wave;
    const size_t hoff = (size_t)h * HD;
    constexpr int SEG = BLK / 4;
    { const int seg = tid >> 7, kc = tid & 127; float a = 0.f;
      const float* lp = F.LOGF + (size_t)(row0 + seg * SEG) * D + hoff + kc;
#pragma unroll
      for (int t = 0; t < SEG; ++t) { a += lp[(size_t)t * D]; bcum[(seg * SEG + t) * 128 + kc] = a; }
      __syncthreads();
      float off = 0.f;
      for (int s = 0; s < seg; ++s) off += bcum[(s * SEG + SEG - 1) * 128 + kc];
      __syncthreads();
      if (seg > 0) {
#pragma unroll
          for (int t = 0; t < SEG; ++t) bcum[(seg * SEG + t) * 128 + kc] += off;
      }
      __syncthreads(); }
    for (int i = tid; i < BLK * 16; i += NTHR) {
        const int t = i >> 4, c0 = (i & 15) * 8;
        const size_t goff = (size_t)(row0 + t) * D + hoff + c0;
        const u32x4 qv = *(const u32x4*)(F.QB + goff);
        const u32x4 vv = *(const u32x4*)(F.VB + goff);
        const f32x4 lf0 = *(const f32x4*)(F.LOGF + goff), lf1 = *(const f32x4*)(F.LOGF + goff + 4);
        float q[8] = {bflo(qv.x), bfhi(qv.x), bflo(qv.y), bfhi(qv.y), bflo(qv.z), bfhi(qv.z), bflo(qv.w), bfhi(qv.w)};
        float lf[8] = {lf0.x, lf0.y, lf0.z, lf0.w, lf1.x, lf1.y, lf1.z, lf1.w};
        float qtv[8], ktv[8], qhv[8], khv[8];
#pragma unroll
        for (int e = 0; e < 8; ++e) {
            const float b = bcum[t * 128 + c0 + e], bmid = bcum[(BLK / 2 - 1) * 128 + c0 + e], bend = bcum[(BLK - 1) * 128 + c0 + e];
            const float kk = 1.f - __expf(lf[e]);
            qtv[e] = q[e] * __expf(b - bmid); ktv[e] = kk * __expf(bmid - b); qhv[e] = q[e] * __expf(b); khv[e] = kk * __expf(bend - b);
            if (t == BLK - 1) F.DEC[(size_t)u * 128 + c0 + e] = __expf(bend);
        }
        u32x4 o; o.x = pk2(qtv[0], qtv[1]); o.y = pk2(qtv[2], qtv[3]); o.z = pk2(qtv[4], qtv[5]); o.w = pk2(qtv[6], qtv[7]);
        *(LAS u32x4*)(qt + t * QT_STRIDE + c0) = o;
        o.x = pk2(ktv[0], ktv[1]); o.y = pk2(ktv[2], ktv[3]); o.z = pk2(ktv[4], ktv[5]); o.w = pk2(ktv[6], ktv[7]);
        *(LAS u32x4*)(kt + t * QT_STRIDE + c0) = o;
        o.x = pk2(qhv[0], qhv[1]); o.y = pk2(qhv[2], qhv[3]); o.z = pk2(qhv[4], qhv[5]); o.w = pk2(qhv[6], qhv[7]);
        *(u32x4*)(F.QB + goff) = o;
        const unsigned vw[4] = {vv.x, vv.y, vv.z, vv.w};
#pragma unroll
        for (int e = 0; e < 8; ++e) {
            khT[(c0 + e) * TT_STRIDE + t] = f2bf(khv[e]);
            vT[(c0 + e) * TT_STRIDE + t] = (bf16)((e & 1) ? (vw[e >> 1] >> 16) : (vw[e >> 1] & 0xffffu));
        }
    }
    __syncthreads();
    const int r = lane & 31, hf = lane >> 5;
#pragma unroll
    for (int q2 = 0; q2 < 2; ++q2) {
        const int tl = w * 2 + q2, mt = tl >> 2, nt = tl & 3;
        const f32x16 acc = mma_lds(khT, TT_STRIDE, 32 * mt, vT, TT_STRIDE, 32 * nt, BLK / 16, lane);
        float* lp = F.LOCAL + (size_t)u * 16384 + 32 * nt + r;
#pragma unroll
        for (int i = 0; i < 16; ++i) lp[(size_t)(32 * mt + crow(i, hf)) * 128] = acc[i];
    }
    constexpr int NT2 = BLK / 32;
    if (w < NT2 * NT2) {
        const int mt = w / NT2, nt = w % NT2;
        if (nt > mt) {
#pragma unroll
            for (int i = 0; i < 16; ++i) Pm[(32 * mt + crow(i, hf)) * TT_STRIDE + 32 * nt + r] = 0;
        } else {
            const f32x16 acc = mma_lds(qt, QT_STRIDE, 32 * mt, kt, QT_STRIDE, 32 * nt, 8, lane);
#pragma unroll
            for (int i = 0; i < 16; ++i) { const int t = 32 * mt + crow(i, hf), s = 32 * nt + r; Pm[t * TT_STRIDE + s] = (s <= t) ? f2bf(acc[i]) : (bf16)0; }
        }
    }
    __syncthreads();
    if (w < NT2 * 4) {
        const int mt = w >> 2, nt = w & 3;
        const f32x16 acc = mma_lds(Pm, TT_STRIDE, 32 * mt, vT, TT_STRIDE, 32 * nt, BLK / 16, lane);
        float* op = F.OI + (size_t)(row0 + 32 * mt) * D + hoff + 32 * nt + r;
#pragma unroll
        for (int i = 0; i < 16; ++i) op[(size_t)crow(i, hf) * D] = acc[i];
    }
    __syncthreads();
}
DI void gla_a_phase(Frame& F) {
    for (int u = F.bid; u < GLA_UNITS; u += F.G) {
        if (u < 2048) { const int b = u >> 10, h = (u >> 6) & 15, c = u & 63; gla_a_unit<64>(F, u, b * SEQ + c * 64, h); }
        else { const int su = u - 2048, b = su >> 4, h = su & 15; gla_a_unit<32>(F, u, TP + b * 32, h); }
    }
}
DI void scan_phase(Frame& F) {
    const int gt = F.bid * NTHR + F.tid, NGT = F.G * NTHR;
    for (int it = gt; it < 32 * 4096; it += NGT) {
        const int bh = it >> 12, e = (it & 4095) * 4, kc = e >> 7;
        f32x4 S = {0.f, 0.f, 0.f, 0.f};
        float* __restrict__ lp = F.LOCAL + (size_t)(bh * 64) * 16384 + e; const float* __restrict__ dp = F.DEC + (size_t)(bh * 64) * 128 + kc;
        for (int c0 = 0; c0 < 64; c0 += 8) {
            f32x4 loc[8]; float d[8];
#pragma unroll
            for (int j = 0; j < 8; ++j) { loc[j] = *(const f32x4*)(lp + (size_t)(c0 + j) * 16384); d[j] = dp[(c0 + j) * 128]; }
#pragma unroll
            for (int j = 0; j < 8; ++j) { *(f32x4*)(lp + (size_t)(c0 + j) * 16384) = S; S = S * d[j] + loc[j]; }
        }
        *(f32x4*)(F.p.out + O_SP + (size_t)bh * 16384 + e) = S;
    }
    for (int it0 = gt; it0 < 512 * 4096; it0 += 4 * NGT) {
        f32x4 S0[4], loc[4]; float d[4];
#pragma unroll
        for (int j = 0; j < 4; ++j) { const int it = it0 + j * NGT; if (it < 512 * 4096) { const int bh = it >> 12, e = (it & 4095) * 4, kc = e >> 7;
            S0[j] = *(const f32x4*)(F.p.state_a_S + (size_t)bh * 16384 + e); loc[j] = *(const f32x4*)(F.LOCAL + (size_t)(2048 + bh) * 16384 + e); d[j] = F.DEC[(size_t)(2048 + bh) * 128 + kc]; } }
#pragma unroll
        for (int j = 0; j < 4; ++j) { const int it = it0 + j * NGT; if (it < 512 * 4096) { const int bh = it >> 12, e = (it & 4095) * 4;
            *(f32x4*)(F.p.out + O_SS + (size_t)bh * 16384 + e) = S0[j] * d[j] + loc[j]; } }
    }
}
constexpr int OB_STRIDE = 132;
template <int BLK>
DI void gla_c_unit(Frame& F, const float* __restrict__ S, int row0, int h) {
    LAS float* ob = (LAS float*)F.lds;
    const int tid = F.tid, lane = F.lane, w = F.wave, r = lane & 31, hf = lane >> 5;
    const size_t hoff = (size_t)h * HD;
    constexpr int TPR_ = NTHR / BLK, CPT_ = 128 / TPR_;
    u32x4 sgv[CPT_ / 8];
    { const int t = tid / TPR_, c0 = (tid % TPR_) * CPT_;
#pragma unroll
      for (int e8 = 0; e8 < CPT_ / 8; ++e8) sgv[e8] = *(const u32x4*)(F.SG + (size_t)(row0 + t) * D + hoff + c0 + 8 * e8); }
    if (w < (BLK / 32) * 4) {
        const int mt = w >> 2, nt = w & 3;
        f32x16 acc; for (int i = 0; i < 16; ++i) acc[i] = 0.f;
        float oiv[16];
        { const float* oi = F.OI + (size_t)(row0 + 32 * mt) * D + hoff + 32 * nt + r;
#pragma unroll
          for (int i = 0; i < 16; ++i) oiv[i] = oi[(size_t)crow(i, hf) * D]; }
        const bf16* ap = F.QB + (size_t)(row0 + 32 * mt + r) * D + hoff + 8 * hf;
        const float* sp = S + (size_t)(8 * hf) * 128 + 32 * nt + r;
#pragma unroll
        for (int ks = 0; ks < 8; ++ks) {
            const bf16x8 a = *(const bf16x8*)(ap + 16 * ks);
            float sv[8];
#pragma unroll
            for (int e = 0; e < 8; ++e) sv[e] = sp[(size_t)(16 * ks + e) * 128];
            u32x4 bb; bb.x = pk2(sv[0], sv[1]); bb.y = pk2(sv[2], sv[3]); bb.z = pk2(sv[4], sv[5]); bb.w = pk2(sv[6], sv[7]);
            acc = MFMA32(a, __builtin_bit_cast(bf16x8, bb), acc);
        }
#pragma unroll
        for (int i = 0; i < 16; ++i) { const int t = crow(i, hf); ob[(32 * mt + t) * OB_STRIDE + 32 * nt + r] = acc[i] + oiv[i]; }
    }
    __syncthreads();
    {
        constexpr int TPR = NTHR / BLK;
        constexpr int CPT = 128 / TPR;
        const int t = tid / TPR, j = tid % TPR, c0 = j * CPT;
        float v[CPT]; float ss = 0.f;
#pragma unroll
        for (int e = 0; e < CPT; ++e) { v[e] = ob[t * OB_STRIDE + c0 + e]; ss += v[e] * v[e]; }
#pragma unroll
        for (int o = 1; o < TPR; o <<= 1) ss += __shfl_xor(ss, o);
        const float rstd = rsqrtf(ss * (1.f / HD) + EPS);
        const size_t goff = (size_t)(row0 + t) * D + hoff + c0;
#pragma unroll
        for (int e8 = 0; e8 < CPT / 8; ++e8) {
            const u32x4 sg = sgv[e8];
            const f32x4 n0 = *(const f32x4*)(F.p.a_norm_o + c0 + 8 * e8), n1 = *(const f32x4*)(F.p.a_norm_o + c0 + 8 * e8 + 4);
            const float* vv = v + 8 * e8;
            u32x4 o;
            o.x = pk2(vv[0] * rstd * n0.x * bflo(sg.x), vv[1] * rstd * n0.y * bfhi(sg.x));
            o.y = pk2(vv[2] * rstd * n0.z * bflo(sg.y), vv[3] * rstd * n0.w * bfhi(sg.y));
            o.z = pk2(vv[4] * rstd * n1.x * bflo(sg.z), vv[5] * rstd * n1.y * bfhi(sg.z));
            o.w = pk2(vv[6] * rstd * n1.z * bflo(sg.w), vv[7] * rstd * n1.w * bfhi(sg.w));
            *(u32x4*)(F.HB + goff + 8 * e8) = o;
        }
    }
    __syncthreads();
}
DI void gla_c_phase(Frame& F) {
    for (int u = F.bid; u < GLA_UNITS; u += F.G) {
        if (u < 2048) { const int b = u >> 10, h = (u >> 6) & 15, c = u & 63; gla_c_unit<64>(F, F.LOCAL + (size_t)u * 16384, b * SEQ + c * 64, h); }
        else { const int su = u - 2048, b = su >> 4, h = su & 15; gla_c_unit<32>(F, F.p.state_a_S + (size_t)su * 16384, TP + b * 32, h); }
    }
}
DI void convfix_phase(Frame& F, int layer, const float* edge) {
    const Params& p = F.p;
    const int gt = F.bid * NTHR + F.tid, NGT = F.G * NTHR;
    constexpr int NCG = FF / 8, NHB = T / 32;
    const float* cw = p.f_conv_w + (size_t)layer * 3 * FF; const float* cbp = p.f_conv_b + (size_t)layer * FF;
    const float* eu_first = edge; const float* eg_first = edge + (size_t)NHB * 2 * FF; const float* eu_last = edge + (size_t)NHB * 4 * FF;
    for (int it = gt; it < NHB * NCG; it += NGT) {
        const int hb = it / NCG, c0 = (it % NCG) * 8;
        const bool smp = hb >= 256; const bool first = smp || ((hb & 127) == 0), lastb = smp || ((hb & 127) == 127);
        float um2[8], um1[8], u0[8], u1[8], g0[8], g1[8], w0[8], w1[8], w2[8], bb[8];
#pragma unroll
        for (int e = 0; e < 8; ++e) { w0[e] = cw[c0 + e]; w1[e] = cw[FF + c0 + e]; w2[e] = cw[2 * FF + c0 + e]; bb[e] = cbp[c0 + e]; um2[e] = 0.f; um1[e] = 0.f;
            u0[e] = eu_first[((size_t)hb * 2) * FF + c0 + e]; u1[e] = eu_first[((size_t)hb * 2 + 1) * FF + c0 + e];
            g0[e] = eg_first[((size_t)hb * 2) * FF + c0 + e]; g1[e] = eg_first[((size_t)hb * 2 + 1) * FF + c0 + e]; }
        if (first) {
            if (smp) { const float* st = p.conv_state + ((size_t)(layer * 32 + (hb - 256)) * 2) * FF + c0;
#pragma unroll
                for (int e = 0; e < 8; ++e) { um2[e] = st[e]; um1[e] = st[FF + e]; } }
        } else {
#pragma unroll
            for (int e = 0; e < 8; ++e) { um2[e] = eu_last[((size_t)(hb - 1) * 2) * FF + c0 + e]; um1[e] = eu_last[((size_t)(hb - 1) * 2 + 1) * FF + c0 + e]; }
        }
        float a0[8], a1[8];
#pragma unroll
        for (int e = 0; e < 8; ++e) { a0[e] = fsilu(bb[e] + um2[e] * w0[e] + um1[e] * w1[e] + u0[e] * w2[e]) * g0[e]; a1[e] = fsilu(bb[e] + um1[e] * w0[e] + u0[e] * w1[e] + u1[e] * w2[e]) * g1[e]; }
        u32x4 o; o.x = pk2(a0[0], a0[1]); o.y = pk2(a0[2], a0[3]); o.z = pk2(a0[4], a0[5]); o.w = pk2(a0[6], a0[7]);
        *(u32x4*)(F.ACT + (size_t)(hb * 32) * FF + c0) = o;
        o.x = pk2(a1[0], a1[1]); o.y = pk2(a1[2], a1[3]); o.z = pk2(a1[4], a1[5]); o.w = pk2(a1[6], a1[7]);
        *(u32x4*)(F.ACT + (size_t)(hb * 32 + 1) * FF + c0) = o;
        if (lastb) {
            float* dst = smp ? p.out + O_CS + ((size_t)(layer * 32 + (hb - 256)) * 2) * FF + c0 : p.out + O_CP + ((size_t)(layer * 2 + (hb >> 7)) * 2) * FF + c0;
#pragma unroll
            for (int e = 0; e < 8; ++e) { dst[e] = eu_last[((size_t)hb * 2) * FF + c0 + e]; dst[FF + e] = eu_last[((size_t)hb * 2 + 1) * FF + c0 + e]; }
        }
    }
}
DI void cacheK_fill(Frame& F, int widx, int nw) {
    const Params& p = F.p;
    const int gt = widx * NTHR + F.tid, NGT = nw * NTHR;
    for (int it0 = gt; it0 < 32 * 512 * (D / 8); it0 += 4 * NGT) {
        f32x4 a[4], c[4];
#pragma unroll
        for (int j = 0; j < 4; ++j) { const int it = it0 + j * NGT; if (it < 32 * 512 * (D / 8)) { const int row = it >> 8, cc = (it & 255) * 8;
            a[j] = __builtin_nontemporal_load((const f32x4*)(p.cache_k + (size_t)row * D + cc)); c[j] = __builtin_nontemporal_load((const f32x4*)(p.cache_k + (size_t)row * D + cc + 4)); } }
#pragma unroll
        for (int j = 0; j < 4; ++j) { const int it = it0 + j * NGT; if (it < 32 * 512 * (D / 8)) { const int row = it >> 8, cc = (it & 255) * 8, b = row >> 9, jj = row & 511;
            u32x4 o; o.x = pk2(a[j].x, a[j].y); o.y = pk2(a[j].z, a[j].w); o.z = pk2(c[j].x, c[j].y); o.w = pk2(c[j].z, c[j].w);
            __builtin_nontemporal_store(o, (u32x4*)(F.KS + ((size_t)b * SROWS + jj) * D + cc)); } }
    }
}
constexpr int VT_NP = 2 * 64 * 16, VT_NN = 32 * 16, VT_NC = 32 * 16 * 8;
DI void vtrans_items(Frame& F, int it_lo, int it_hi, int widx, int nw) {
    const Params& p = F.p; const int lane = F.lane;
    LAS bf16* tile = (LAS bf16*)(F.lds + F.wave * 16640);
    for (int it = it_lo + widx * NWAVES + F.wave; it < it_hi; it += nw * NWAVES) {
        int nrows = 64; bf16* dst; int dstride;
        if (it < VT_NP) {
            const int h = it & 15, tb = (it >> 4) & 63, b = it >> 10;
            const bf16* src = F.QKV + (size_t)(b * SEQ + tb * 64) * NQKV + 2 * D + h * HD + 2 * lane;
            unsigned u[64];
#pragma unroll
            for (int i = 0; i < 64; ++i) u[i] = *(const unsigned*)(src + (size_t)i * NQKV);
#pragma unroll
            for (int i = 0; i < 64; ++i) *(LAS unsigned*)(tile + i * 130 + 2 * lane) = u[i];
            dst = F.VT + ((size_t)(b * 16 + h) * HD) * SEQ + tb * 64; dstride = SEQ;
        } else if (it < VT_NP + VT_NN) {
            const int r = it - VT_NP, h = r & 15, b = r >> 4;
            nrows = 32;
            const bf16* src = F.QKV + (size_t)(TP + b * 32) * NQKV + 2 * D + h * HD + 2 * lane;
            unsigned u[32];
#pragma unroll
            for (int i = 0; i < 32; ++i) u[i] = *(const unsigned*)(src + (size_t)i * NQKV);
#pragma unroll
            for (int i = 0; i < 32; ++i) *(LAS unsigned*)(tile + i * 130 + 2 * lane) = u[i];
            dst = F.VTS + ((size_t)(b * 16 + h) * HD) * SROWS + 512; dstride = SROWS;
        } else {
            const int r = it - VT_NP - VT_NN, h = r & 15, jb = (r >> 4) & 7, b = r >> 7;
            const float* src = p.cache_v + ((size_t)(b * 512 + jb * 64) * NH + h) * HD + 2 * lane;
#pragma unroll
            for (int hh = 0; hh < 2; ++hh) {
                f32x2 x[32];
#pragma unroll
                for (int i = 0; i < 32; ++i) x[i] = __builtin_nontemporal_load((const f32x2*)(src + (size_t)(32 * hh + i) * D));
#pragma unroll
                for (int i = 0; i < 32; ++i) *(LAS unsigned*)(tile + (32 * hh + i) * 130 + 2 * lane) = pk2(x[i].x, x[i].y);
            }
            dst = F.VTS + ((size_t)(b * 16 + h) * HD) * SROWS + jb * 64; dstride = SROWS;
        }
        asm volatile("s_waitcnt lgkmcnt(0)" ::: "memory");
        const int tp = lane & 31, dh = lane >> 5;
        if (2 * tp < nrows) {
#pragma unroll 8
            for (int pp = 0; pp < 64; ++pp) { const int dv = 2 * pp + dh;
                const unsigned lo = tile[(2 * tp) * 130 + dv], hi = tile[(2 * tp + 1) * 130 + dv];
                *(unsigned*)(dst + (size_t)dv * dstride + 2 * tp) = lo | (hi << 16); }
        }
        asm volatile("s_waitcnt lgkmcnt(0)" ::: "memory");
    }
}
DI void prep_phase(Frame& F) {
    const Params& p = F.p;
    const int gw = F.bid * NWAVES + F.wave, NGW = F.G * NWAVES, lane = F.lane;
    const float qscale = 0.08838834764831845f * 1.4426950408889634f;
    for (int m = gw; m < T; m += NGW) {
        const bf16* src = F.QKV + (size_t)m * NQKV + lane * 8;
        const bool smp = m >= TP; const int b = smp ? (m - TP) >> 5 : m >> 12, t = smp ? (m - TP) & 31 : m & 4095;
        const int hc = (lane & 15) * 8;
        u32x4 xq[4], xk[4], xv[4];
#pragma unroll
        for (int j = 0; j < 4; ++j) { xq[j] = *(const u32x4*)(src + j * 512); xk[j] = *(const u32x4*)(src + D + j * 512); xv[j] = *(const u32x4*)(src + 2 * D + j * 512); }
        float* ko = nullptr; float* vo = nullptr;
        if (smp) { ko = p.out + O_KSM + (size_t)(m - TP) * D + lane * 8; vo = p.out + O_VSM + (size_t)(m - TP) * D + lane * 8; }
        else if (t >= SEQ - 512) { ko = p.out + O_KP + ((size_t)b * 512 + (t - (SEQ - 512))) * D + lane * 8; vo = p.out + O_VP + ((size_t)b * 512 + (t - (SEQ - 512))) * D + lane * 8; }
        const f32x4 gq0 = *(const f32x4*)(p.b_q_norm + hc), gq1 = *(const f32x4*)(p.b_q_norm + hc + 4);
        const f32x4 gk0 = *(const f32x4*)(p.b_k_norm + hc), gk1 = *(const f32x4*)(p.b_k_norm + hc + 4);
        bf16* qdst = F.QB + (size_t)m * D + lane * 8;
        bf16* kdst = smp ? F.KS + ((size_t)b * SROWS + 512 + t) * D + lane * 8 : F.KN + (size_t)m * D + lane * 8;
#pragma unroll
        for (int j = 0; j < 4; ++j) {
            { const u32x4 x = xq[j]; const float v[8] = {bflo(x.x), bfhi(x.x), bflo(x.y), bfhi(x.y), bflo(x.z), bfhi(x.z), bflo(x.w), bfhi(x.w)};
              float ss = 0.f;
#pragma unroll
              for (int e = 0; e < 8; ++e) ss += v[e] * v[e];
              ss += __shfl_xor(ss, 1); ss += __shfl_xor(ss, 2); ss += __shfl_xor(ss, 4); ss += __shfl_xor(ss, 8);
              const float rstd = rsqrtf(ss * (1.f / HD) + EPS) * qscale;
              u32x4 o; o.x = pk2(v[0] * rstd * gq0.x, v[1] * rstd * gq0.y); o.y = pk2(v[2] * rstd * gq0.z, v[3] * rstd * gq0.w);
              o.z = pk2(v[4] * rstd * gq1.x, v[5] * rstd * gq1.y); o.w = pk2(v[6] * rstd * gq1.z, v[7] * rstd * gq1.w);
              *(u32x4*)(qdst + j * 512) = o; }
            { const u32x4 x = xk[j]; const float v[8] = {bflo(x.x), bfhi(x.x), bflo(x.y), bfhi(x.y), bflo(x.z), bfhi(x.z), bflo(x.w), bfhi(x.w)};
              float ss = 0.f;
#pragma unroll
              for (int e = 0; e < 8; ++e) ss += v[e] * v[e];
              ss += __shfl_xor(ss, 1); ss += __shfl_xor(ss, 2); ss += __shfl_xor(ss, 4); ss += __shfl_xor(ss, 8);
              const float rstd = rsqrtf(ss * (1.f / HD) + EPS);
              const f32x4 a = {v[0] * rstd * gk0.x, v[1] * rstd * gk0.y, v[2] * rstd * gk0.z, v[3] * rstd * gk0.w};
              const f32x4 c = {v[4] * rstd * gk1.x, v[5] * rstd * gk1.y, v[6] * rstd * gk1.z, v[7] * rstd * gk1.w};
              u32x4 o; o.x = pk2(a.x, a.y); o.y = pk2(a.z, a.w); o.z = pk2(c.x, c.y); o.w = pk2(c.z, c.w);
              *(u32x4*)(kdst + j * 512) = o;
              if (ko) { *(f32x4*)(ko + j * 512) = a; *(f32x4*)(ko + j * 512 + 4) = c; } }
            if (vo) { const u32x4 x = xv[j];
              const f32x4 a = {bflo(x.x), bfhi(x.x), bflo(x.y), bfhi(x.y)}, c = {bflo(x.z), bfhi(x.z), bflo(x.w), bfhi(x.w)};
              *(f32x4*)(vo + j * 512) = a; *(f32x4*)(vo + j * 512 + 4) = c; }
        }
    }
    vtrans_items(F, 0, VT_NP + VT_NN, F.bid, F.G);
}
DI void attn_scores(f32x16 (&oacc)[4], float& mrun, float& lsum, const bf16x8 (&qf)[8], const bf16x8 (&kf)[8], bf16x8 (&pfr)[2], int relb, const LAS float* bias, float bias0, int hf) {
    f32x16 s; for (int i = 0; i < 16; ++i) s[i] = 0.f;
#pragma unroll
    for (int kk = 0; kk < 8; ++kk) s = MFMA32(kf[kk], qf[kk], s);
    if (relb + 31 <= -128) {
#pragma unroll
        for (int i = 0; i < 16; ++i) s[i] += bias0;
    } else {
#pragma unroll
        for (int i = 0; i < 16; ++i) { int rel = relb + crow(i, hf); rel = rel < -128 ? -128 : (rel > 63 ? 63 : rel); s[i] += bias[rel + 128]; }
    }
    float mt = s[0];
#pragma unroll
    for (int i = 1; i < 16; ++i) mt = fmaxf(mt, s[i]);
    mt = fmaxf(mt, __shfl_xor(mt, 32));
    const float mnew = fmaxf(mrun, mt), alpha = __builtin_amdgcn_exp2f(mrun - mnew);
    mrun = mnew;
    float ps = 0.f; float pv[16];
#pragma unroll
    for (int i = 0; i < 16; ++i) { pv[i] = __builtin_amdgcn_exp2f(s[i] - mnew); ps += pv[i]; }
    lsum = lsum * alpha + ps;
#pragma unroll
    for (int bl = 0; bl < 4; ++bl)
#pragma unroll
        for (int i = 0; i < 16; ++i) oacc[bl][i] *= alpha;
#pragma unroll
    for (int kb = 0; kb < 2; ++kb) {
        u32x4 pb; pb.x = pk2(pv[8 * kb], pv[8 * kb + 1]); pb.y = pk2(pv[8 * kb + 2], pv[8 * kb + 3]); pb.z = pk2(pv[8 * kb + 4], pv[8 * kb + 5]); pb.w = pk2(pv[8 * kb + 6], pv[8 * kb + 7]);
        pfr[kb] = __builtin_bit_cast(bf16x8, pb);
    }
}
DI void attn_pv(f32x16 (&oacc)[4], const bf16x8 (&pfr)[2], const bf16x8 (&vf)[2][4]) {
#pragma unroll
    for (int kb = 0; kb < 2; ++kb)
#pragma unroll
        for (int bl = 0; bl < 4; ++bl) oacc[bl] = MFMA32(vf[kb][bl], pfr[kb], oacc[bl]);
}
DI void attn_step(f32x16 (&oacc)[4], float& mrun, float& lsum, const bf16x8 (&qf)[8], const bf16x8 (&kf)[8], const bf16x8 (&vf)[2][4], int relb, const LAS float* bias, float bias0, int hf) {
    bf16x8 pfr[2];
    attn_scores(oacc, mrun, lsum, qf, kf, pfr, relb, bias, bias0, hf);
    attn_pv(oacc, pfr, vf);
}
constexpr int AK_STRIDE = 136, AV_STRIDE = 72, A_KBYTES = 64 * AK_STRIDE * 2, A_VBYTES = 128 * AV_STRIDE * 2, A_BUF = A_KBYTES + A_VBYTES;
constexpr int A_BIAS_OFF = 135168;
static_assert(2 * A_BUF <= A_BIAS_OFF && 8 * 16384 + 8 * 256 <= A_BIAS_OFF && A_BIAS_OFF + 768 <= LDS_BYTES - 16, "attention lds");

DI void attn_phase(Frame& F) {
    const Params& p = F.p;
    const int lane = F.lane, w = F.wave, tid = F.tid, r = lane & 31, hf = lane >> 5;
    constexpr float L2E = 1.4426950408889634f;
    for (int su = F.bid; su < 512; su += F.G) {
        const int h = su & 15, b = su >> 4, qrow0 = TP + b * 32;
        const bf16* kbase = F.KS + (size_t)(b * SROWS) * D + h * HD; const bf16* vbase = F.VTS + ((size_t)(b * 16 + h) * HD) * SROWS;
        LAS float* bias = (LAS float*)(F.lds + A_BIAS_OFF);
        if (tid < 192) bias[tid] = p.b_rel_bias[tid * NH + h] * L2E;
        bf16x8 qf[8];
        { const bf16* qp = F.QB + (size_t)(qrow0 + r) * D + h * HD + 8 * hf;
#pragma unroll
          for (int kk = 0; kk < 8; ++kk) qf[kk] = *(const bf16x8*)(qp + 16 * kk); }
        f32x16 oacc[4];
#pragma unroll
        for (int bl = 0; bl < 4; ++bl) for (int i = 0; i < 16; ++i) oacc[bl][i] = 0.f;
        float mrun = -1e30f, lsum = 0.f;
        __syncthreads();
        const float bias0 = bias[0];
        for (int kt = w; kt < 17; kt += 8) {
            bf16x8 kf[8], vf[2][4];
            { const bf16* kp = kbase + (size_t)(32 * kt + r) * D + 8 * hf;
#pragma unroll
              for (int kk = 0; kk < 8; ++kk) kf[kk] = *(const bf16x8*)(kp + 16 * kk); }
#pragma unroll
            for (int kb = 0; kb < 2; ++kb)
#pragma unroll
                for (int bl = 0; bl < 4; ++bl) { const bf16* vp = vbase + (size_t)(32 * bl + r) * SROWS + 32 * kt + 16 * kb + 4 * hf;
                    const u32x2 v0 = *(const u32x2*)vp, v1 = *(const u32x2*)(vp + 8); u32x4 vv; vv.x = v0.x; vv.y = v0.y; vv.z = v1.x; vv.w = v1.y; vf[kb][bl] = __builtin_bit_cast(bf16x8, vv); }
            attn_step(oacc, mrun, lsum, qf, kf, vf, -512 + 32 * kt - r, bias, bias0, hf);
        }
        lsum += __shfl_xor(lsum, 32);
        LAS float* op = (LAS float*)(F.lds + w * 16384); LAS float* ml = (LAS float*)(F.lds + 8 * 16384 + w * 256);
#pragma unroll
        for (int bl = 0; bl < 4; ++bl)
#pragma unroll
            for (int i = 0; i < 16; ++i) op[(32 * bl + crow(i, hf)) * 32 + r] = oacc[bl][i];
        if (hf == 0) { ml[2 * r] = mrun; ml[2 * r + 1] = lsum; }
        __syncthreads();
        { const int q = tid & 31, dv0 = (tid >> 5) * 8;
          float mw[8], M = -1e30f;
#pragma unroll
          for (int ww = 0; ww < 8; ++ww) { mw[ww] = ((LAS float*)(F.lds + 8 * 16384 + ww * 256))[2 * q]; M = fmaxf(M, mw[ww]); }
          float o[8] = {0.f, 0.f, 0.f, 0.f, 0.f, 0.f, 0.f, 0.f}, L = 0.f;
#pragma unroll
          for (int ww = 0; ww < 8; ++ww) { const float sc = __builtin_amdgcn_exp2f(mw[ww] - M); L += sc * ((LAS float*)(F.lds + 8 * 16384 + ww * 256))[2 * q + 1];
              const LAS float* pp = (LAS float*)(F.lds + ww * 16384) + dv0 * 32 + q;
#pragma unroll
              for (int e = 0; e < 8; ++e) o[e] += sc * pp[e * 32]; }
          const float inv = 1.f / L;
          u32x4 ov; ov.x = pk2(o[0] * inv, o[1] * inv); ov.y = pk2(o[2] * inv, o[3] * inv); ov.z = pk2(o[4] * inv, o[5] * inv); ov.w = pk2(o[6] * inv, o[7] * inv);
          *(u32x4*)(F.HB + (size_t)(qrow0 + q) * D + h * HD + dv0) = ov; }
        __syncthreads();
    }
    const int vbid = (F.G % 8 == 0) ? (F.bid & 7) * (F.G >> 3) + (F.bid >> 3) : F.bid;
    for (int unit = vbid; unit < 512; unit += F.G) {
        const int cq = unit & 15, h = (unit >> 4) & 15, b = unit >> 8;
        const int cw = 4 * cq + (w >> 1), qrow0 = b * SEQ + cw * 64 + (w & 1) * 32;
        const int kc_lo = (4 * cq - 8) > 0 ? 4 * cq - 8 : 0, kc_hi = 4 * cq + 3;
        LAS float* bias = (LAS float*)(F.lds + A_BIAS_OFF);
        if (tid < 192) bias[tid] = p.b_rel_bias[tid * NH + h] * L2E;
        const bf16* kg = F.KN + (size_t)(b * SEQ) * D + h * HD;
        const bf16* vg = F.VT + ((size_t)(b * 16 + h) * HD) * SEQ;
        const int kr0 = tid >> 4, ks0 = tid & 15, vr0 = tid >> 3, vs0 = tid & 7;
        u32x4 stA[4], stB[4];
#define A_GLOAD(kc, st) do { st[0] = *(const u32x4*)(kg + (size_t)((kc) * 64 + kr0) * D + ks0 * 8); st[1] = *(const u32x4*)(kg + (size_t)((kc) * 64 + kr0 + 32) * D + ks0 * 8); \
                         st[2] = *(const u32x4*)(vg + (size_t)vr0 * SEQ + (kc) * 64 + vs0 * 8); st[3] = *(const u32x4*)(vg + (size_t)(vr0 + 64) * SEQ + (kc) * 64 + vs0 * 8); } while (0)
#define A_LWRITE(buf, st) do { LAS bf16* kb_ = (LAS bf16*)(F.lds + (buf) * A_BUF); LAS bf16* vb_ = (LAS bf16*)(F.lds + (buf) * A_BUF + A_KBYTES); \
                         *(LAS u32x4*)(kb_ + kr0 * AK_STRIDE + ks0 * 8) = st[0]; *(LAS u32x4*)(kb_ + (kr0 + 32) * AK_STRIDE + ks0 * 8) = st[1]; \
                         *(LAS u32x4*)(vb_ + vr0 * AV_STRIDE + vs0 * 8) = st[2]; *(LAS u32x4*)(vb_ + (vr0 + 64) * AV_STRIDE + vs0 * 8) = st[3]; } while (0)
#define A_COMPUTE(kc, cur) do { if ((kc) >= cw - 8 && (kc) <= cw) { \
                const LAS bf16* Kb = (const LAS bf16*)(F.lds + (cur) * A_BUF); const LAS bf16* Vb = (const LAS bf16*)(F.lds + (cur) * A_BUF + A_KBYTES); \
                _Pragma("unroll 1") for (int t = 0; t < 2; ++t) { \
                    bf16x8 pfr[2]; \
                    { bf16x8 kf[8]; \
                      _Pragma("unroll") for (int kk = 0; kk < 8; ++kk) kf[kk] = *(const LAS bf16x8*)(Kb + (32 * t + r) * AK_STRIDE + 16 * kk + 8 * hf); \
                      attn_scores(oacc, mrun, lsum, qf, kf, pfr, ((kc) * 64 + 32 * t) - (cw * 64 + (w & 1) * 32) - r, bias, bias0, hf); } \
                    { bf16x8 vf[2][4]; \
                      _Pragma("unroll") for (int kb = 0; kb < 2; ++kb) _Pragma("unroll") for (int bl = 0; bl < 4; ++bl) { const LAS bf16* vp = Vb + (32 * bl + r) * AV_STRIDE + 32 * t + 16 * kb + 4 * hf; \
                            const u32x2 v0 = *(const LAS u32x2*)vp, v1 = *(const LAS u32x2*)(vp + 8); u32x4 vv; vv.x = v0.x; vv.y = v0.y; vv.z = v1.x; vv.w = v1.y; vf[kb][bl] = __builtin_bit_cast(bf16x8, vv); } \
                      attn_pv(oacc, pfr, vf); } } } } while (0)
        A_GLOAD(kc_lo, stA);
        A_GLOAD(kc_lo + 1, stB);
        bf16x8 qf[8];
        { const bf16* qp = F.QB + (size_t)(qrow0 + r) * D + h * HD + 8 * hf;
#pragma unroll
          for (int kk = 0; kk < 8; ++kk) qf[kk] = *(const bf16x8*)(qp + 16 * kk); }
        f32x16 oacc[4];
#pragma unroll
        for (int bl = 0; bl < 4; ++bl) for (int i = 0; i < 16; ++i) oacc[bl][i] = 0.f;
        float mrun = -1e30f, lsum = 0.f;
        A_LWRITE(0, stA);
        __syncthreads();
        const float bias0 = bias[0];
        for (int kc = kc_lo; kc <= kc_hi; kc += 2) {
            if (kc + 2 <= kc_hi) A_GLOAD(kc + 2, stA);
            A_COMPUTE(kc, 0);
            A_LWRITE(1, stB);
            __syncthreads();
            if (kc + 3 <= kc_hi) A_GLOAD(kc + 3, stB);
            A_COMPUTE(kc + 1, 1);
            if (kc + 2 <= kc_hi) A_LWRITE(0, stA);
            __syncthreads();
        }
#undef A_GLOAD
#undef A_LWRITE
#undef A_COMPUTE
        lsum += __shfl_xor(lsum, 32);
        const float inv = 1.f / lsum;
        bf16* op = F.HB + (size_t)(qrow0 + r) * D + h * HD;
#pragma unroll
        for (int bl = 0; bl < 4; ++bl)
#pragma unroll
            for (int g4 = 0; g4 < 4; ++g4) {
                u32x2 o; o.x = pk2(oacc[bl][4 * g4] * inv, oacc[bl][4 * g4 + 1] * inv); o.y = pk2(oacc[bl][4 * g4 + 2] * inv, oacc[bl][4 * g4 + 3] * inv);
                *(u32x2*)(op + 32 * bl + 8 * g4 + 4 * hf) = o;
            }
    }
}

#define XB_TMO      128
#define XB_XCNT(j)  (256  + 64 * (j))
#define XB_XSUB(j)  (1280 + 64 * (j))
#define XB_XGEN(j)  (2304 + 64 * (j))
#define XB_TOP      3328
#define XB_TOPGEN   3392
#define XCD_BAR_WORDS 3456
#define XB_SPIN_CAP (1u << 18)
DI unsigned xb_ld(unsigned* p)              { return __hip_atomic_load(p, __ATOMIC_RELAXED, __HIP_MEMORY_SCOPE_AGENT); }
DI unsigned xb_add(unsigned* p, unsigned v) { return __hip_atomic_fetch_add(p, v, __ATOMIC_RELAXED, __HIP_MEMORY_SCOPE_AGENT); }
DI unsigned xb_xcc_id() { return (unsigned)__builtin_amdgcn_s_getreg((3 << 11) | 20) & 0xFu; }
#define XB_SPIN(cond, bar) do { unsigned _sp = 0; while (cond) { __builtin_amdgcn_s_sleep(1); \
    if ((++_sp & 255u) == 0u) { if (xb_ld(&(bar)[XB_TMO])) break; if (_sp > XB_SPIN_CAP) { atomicAdd(&(bar)[XB_TMO], 1u); break; } } } } while (0)
struct XcdBarrier { unsigned* bar; unsigned x; volatile LAS unsigned* st; };
DI XcdBarrier xcd_barrier_post(unsigned* bar, volatile LAS unsigned* st) {
    XcdBarrier b; b.bar = bar; b.x = xb_xcc_id(); b.st = st;
    if (threadIdx.x == 0) (void)xb_add(&bar[XB_XCNT(b.x)], 1u);
    return b;
}
DI void xcd_barrier_complete(unsigned* bar, unsigned x, unsigned& nloc, unsigned& nx) {
    const unsigned G = gridDim.x * gridDim.y * gridDim.z;
    unsigned sum, cnt, mine, sp = 0u;
    for (;;) {
        sum = 0u; cnt = 0u; mine = 0u;
#pragma unroll
        for (unsigned j = 0; j < 16; ++j) { const unsigned c = xb_ld(&bar[XB_XCNT(j)]); sum += c; cnt += (c > 0u) ? 1u : 0u; mine = (j == x) ? c : mine; }
        if (sum == G) break;
        __builtin_amdgcn_s_sleep(1);
        if ((++sp & 255u) == 0u) { if (xb_ld(&bar[XB_TMO])) break; if (sp > XB_SPIN_CAP) { atomicAdd(&bar[XB_TMO], 1u); break; } }
    }
    nloc = mine > 0u ? mine : 1u; nx = cnt > 0u ? cnt : 1u;
}
DI void xcd_barrier(const XcdBarrier& b) {
    asm volatile("s_waitcnt vmcnt(0)" ::: "memory");
    __syncthreads();
    if (threadIdx.x == 0) {
        unsigned* bar = b.bar;
        __builtin_amdgcn_s_waitcnt(0);
        unsigned nloc = b.st[0], nx = b.st[1];
        if (nloc == 0u) { xcd_barrier_complete(bar, b.x, nloc, nx); b.st[0] = nloc; b.st[1] = nx; }
        const unsigned old = xb_add(&bar[XB_XSUB(b.x)], 1u);
        const unsigned gen = old / nloc;
        if (old + 1u == (gen + 1u) * nloc) {
            __builtin_amdgcn_fence(__ATOMIC_RELEASE, "agent");
            asm volatile("s_waitcnt vmcnt(0)" ::: "memory");
            const unsigned og = xb_add(&bar[XB_TOP], 1u);
            const unsigned tg = og / nx;
            if (og + 1u == (tg + 1u) * nx) xb_add(&bar[XB_TOPGEN], 1u);
            else XB_SPIN(xb_ld(&bar[XB_TOPGEN]) == tg, bar);
            __builtin_amdgcn_fence(__ATOMIC_ACQUIRE, "agent");
            xb_add(&bar[XB_XGEN(b.x)], 1u);
            asm volatile("s_waitcnt vmcnt(0)" ::: "memory");
        } else {
            XB_SPIN(xb_ld(&bar[XB_XGEN(b.x)]) == gen, bar);
            __builtin_amdgcn_fence(__ATOMIC_ACQUIRE, "agent");
            asm volatile("s_waitcnt vmcnt(0)" ::: "memory");
        }
    }
    __syncthreads();
}

enum { PH_P0, PH_G1, PH_GLA_A, PH_SCAN, PH_GLA_C, PH_G2, PH_RMS_F0, PH_G3_0, PH_CONV0, PH_G4_0, PH_RMS_M1, PH_G5, PH_PREP, PH_ATTN, PH_G6, PH_RMS_F1, PH_G3_1, PH_CONV1, PH_G4_1, PH_FIN, NPH };

__global__ void __launch_bounds__(NTHR, 2) fwd_megakernel(Params prm) {
    extern __shared__ __attribute__((aligned(16))) unsigned char lds_raw[];
    cg::grid_group grid = cg::this_grid();
    float* const X0 = prm.out;
    volatile LAS unsigned* bst = (volatile LAS unsigned*)((LAS unsigned char*)lds_raw + (LDS_BYTES - 16));
    if (threadIdx.x < 4) bst[threadIdx.x] = 0u;
    __syncthreads();
    XcdBarrier xbar = xcd_barrier_post((unsigned*)(prm.ws + WS_BAR), bst);
    for (int ph = prm.ph_lo; ph < prm.ph_hi; ++ph) {
      for (int rep = 0, nrep = 1 + ((REP_MASK >> ph) & 1); rep < nrep; ++rep) {
        int tid_ = threadIdx.x; asm volatile("" : "+v"(tid_));
        size_t zoff = 0; asm volatile("" : "+s"(zoff));
        unsigned char* ws = prm.ws + zoff;
        float* X = X0 + zoff;
        Frame F;
        F.p = prm; F.lds = (LAS unsigned char*)lds_raw;
        F.tid = tid_; F.lane = F.tid & 63; F.wave = __builtin_amdgcn_readfirstlane(F.tid >> 6); F.G = gridDim.x; F.bid = blockIdx.x;
        F.WinA = (bf16*)(ws + WS_WINA); F.WoA = (bf16*)(ws + WS_WOA); F.Wqkv = (bf16*)(ws + WS_WQKV); F.WoB = (bf16*)(ws + WS_WOB);
        F.Fin0 = (bf16*)(ws + WS_FIN0); F.Fin1 = (bf16*)(ws + WS_FIN1); F.Fdn0 = (bf16*)(ws + WS_FDN0); F.Fdn1 = (bf16*)(ws + WS_FDN1);
        F.LB = (float*)(ws + WS_LB); F.HB = (bf16*)(ws + WS_HB); F.QB = (bf16*)(ws + WS_QB);
        F.LOGF = (float*)(ws + WS_LOGF); F.VB = (bf16*)(ws + WS_VB); F.SG = (bf16*)(ws + WS_SG); F.OI = (float*)(ws + WS_OI); F.LOCAL = (float*)(ws + WS_LOCAL); F.DEC = (float*)(ws + WS_DEC);
        F.QKV = (bf16*)(ws + WS_QKV); F.KN = (bf16*)(ws + WS_KN); F.KS = (bf16*)(ws + WS_KS); F.VT = (bf16*)(ws + WS_VT); F.VTS = (bf16*)(ws + WS_VTS);
        F.UP = (bf16*)(ws + WS_UP); F.ACT = (bf16*)(ws + WS_ACT);
        switch (ph) {
        case PH_P0: if (EN_MASK & 1) p0_phase(F); break;
        case PH_GLA_A: if (EN_MASK & 2) gla_a_phase(F); break;
        case PH_SCAN: if (EN_MASK & 4) scan_phase(F); break;
        case PH_GLA_C: if (EN_MASK & 8) gla_c_phase(F); break;
        case PH_RMS_F0: if (EN_MASK & 16) rms_phase(F, X, prm.x_sample, prm.norm_ffn, (const float*)(ws + WS_PART), X + (size_t)TP * D); break;
        case PH_RMS_M1: if (EN_MASK & 16) rms_phase(F, X, X + (size_t)TP * D, prm.norm_mix + D, (const float*)(ws + WS_PART), X + (size_t)TP * D); break;
        case PH_RMS_F1: if (EN_MASK & 16) rms_phase(F, X, X + (size_t)TP * D, prm.norm_ffn + D, (const float*)(ws + WS_PART), X + (size_t)TP * D); break;
        case PH_FIN: fin_phase(F, X + (size_t)TP * D, (const float*)(ws + WS_PART)); break;
        case PH_CONV0: if (EN_MASK & 32) convfix_phase(F, 0, (const float*)(ws + WS_PART)); break;
        case PH_CONV1: if (EN_MASK & 32) convfix_phase(F, 1, (const float*)(ws + WS_PART)); break;
        case PH_PREP: if (EN_MASK & 64) prep_phase(F); break;
        case PH_ATTN: if (EN_MASK & 128) attn_phase(F); break;
        default: if (EN_MASK & 256) {
            pg8::Gemm g; pg8::Epi E; E.mode = 2; E.cw = nullptr; E.cbias = nullptr; E.ldo = D; E.ob = nullptr; E.of = X; E.resP = X; E.resS = X + (size_t)TP * D;
            E.lb = F.LB; E.logf = F.LOGF; E.wsb = ws;
            g.A = F.HB; g.M = T; g.K = D; g.N = D; g.Bt = F.WoA;
            if (ph == PH_G1) { g.Bt = F.WinA; g.N = NWIN; E.mode = 0; }
            else if (ph == PH_G2) { g.Bt = F.WoA; E.resP = prm.x_prompt; E.resS = prm.x_sample; }
            else if (ph == PH_G3_0 || ph == PH_G3_1) { const int l = (ph == PH_G3_1); g.Bt = l ? F.Fin1 : F.Fin0; g.N = NUP; E.mode = 3; E.cw = prm.f_conv_w + (size_t)l * 3 * FF; E.cbias = prm.f_conv_b + (size_t)l * FF; }
            else if (ph == PH_G4_0 || ph == PH_G4_1) { g.A = F.ACT; g.Bt = (ph == PH_G4_1) ? F.Fdn1 : F.Fdn0; g.K = FF; }
            else if (ph == PH_G5) { g.Bt = F.Wqkv; g.N = NQKV; E.mode = 1; E.ob = F.QKV; E.ldo = NQKV; }
            else { g.Bt = F.WoB; }
            E.part = (float*)(ws + WS_PART); E.act = F.ACT; E.edge = (float*)(ws + WS_PART);
            pg8::StaticOrder S; S.init(g.M, g.N, g.K, F.G, F.bid, E.mode == 2);
            pg8::gemm_phase(F.lds, g, S, E, F.tid);
            if (ph == PH_G1 || ph == PH_G3_0 || ph == PH_G5) {
                const int rem = S.nitems % F.G;
                if (rem == 0 || F.bid >= rem) {
                    const int widx = rem ? F.bid - rem : F.bid, nw = rem ? F.G - rem : F.G;
                    if (ph == PH_G1) wconv_items(F, WC_EARLY, WC_ALL, widx, nw);
                    else if (ph == PH_G3_0) cacheK_fill(F, widx, nw);
                    else vtrans_items(F, VT_NP + VT_NN, VT_NP + VT_NN + VT_NC, widx, nw);
                }
            }
        } break;
        }
      }
        if (prm.ph_hi > 1000) grid.sync();
        if (ph + 1 < prm.ph_hi) xcd_barrier(xbar);
    }
}

extern "C" void kernel_launch(void* const* d_in, const int* in_sizes, int n_in, void* d_out, int out_size, void* d_ws, size_t ws_size, hipStream_t stream) {
    static int grid_blocks = 0;
    if (!grid_blocks) {
        int dev = 0, cus = 0, per_cu = 0;
        hipGetDevice(&dev);
        hipDeviceGetAttribute(&cus, hipDeviceAttributeMultiprocessorCount, dev);
        if (hipFuncSetAttribute((const void*)fwd_megakernel, hipFuncAttributeMaxDynamicSharedMemorySize, LDS_BYTES) != hipSuccess) fprintf(stderr, "kernel_launch: hipFuncSetAttribute failed\n");
        hipOccupancyMaxActiveBlocksPerMultiprocessor(&per_cu, (const void*)fwd_megakernel, NTHR, LDS_BYTES);
        if (per_cu < 1) per_cu = 1;
        if (per_cu > 1) per_cu = 1;
        grid_blocks = cus * per_cu;
        if (n_in != 21 || (size_t)out_size != O_END || ws_size < WS_END) fprintf(stderr, "kernel_launch: unexpected sizes n_in %d out %d ws %zu (need %zu)\n", n_in, out_size, ws_size, (size_t)WS_END);
    }
    Params p{};
    p.x_prompt = (const float*)d_in[0]; p.x_sample = (const float*)d_in[1]; p.state_a_S = (const float*)d_in[2]; p.cache_k = (const float*)d_in[3]; p.cache_v = (const float*)d_in[4];
    p.conv_state = (const float*)d_in[5]; p.norm_mix = (const float*)d_in[6]; p.norm_ffn = (const float*)d_in[7]; p.a_w_in = (const float*)d_in[8]; p.a_gamma = (const float*)d_in[9];
    p.a_norm_o = (const float*)d_in[10]; p.a_w_o = (const float*)d_in[11]; p.b_w_qkv = (const float*)d_in[12]; p.b_q_norm = (const float*)d_in[13]; p.b_k_norm = (const float*)d_in[14];
    p.b_rel_bias = (const float*)d_in[15]; p.b_w_o = (const float*)d_in[16]; p.f_w_in = (const float*)d_in[17]; p.f_conv_w = (const float*)d_in[18]; p.f_conv_b = (const float*)d_in[19];
    p.f_w_down = (const float*)d_in[20];
    p.out = (float*)d_out; p.ws = (unsigned char*)d_ws;
#if MK_N_LAUNCHES == 1
    p.ph_lo = 0; p.ph_hi = NPH;
    if (hipMemsetAsync((char*)d_ws + WS_BAR, 0, 16384, stream) != hipSuccess) fprintf(stderr, "kernel_launch: memset of barrier words failed\n");
    void* args[] = {&p};
    hipError_t e = hipLaunchCooperativeKernel((const void*)fwd_megakernel, dim3(grid_blocks), dim3(NTHR), args, LDS_BYTES, stream);
    if (e != hipSuccess) fprintf(stderr, "cooperative launch failed: %s (grid %d)\n", hipGetErrorString(e), grid_blocks);
#else
    for (int ph = 0; ph < NPH; ++ph) {
        p.ph_lo = ph; p.ph_hi = ph + 1;
        hipLaunchKernelGGL(fwd_megakernel, dim3(grid_blocks), dim3(NTHR), LDS_BYTES, stream, p);
    }
#endif
}
```

```cpp
#include <hip/hip_runtime.h>
#include <hip/hip_cooperative_groups.h>
#include <cstdio>
#include <cstdint>
namespace cg = cooperative_groups;

#define DI __device__ __forceinline__
#define LAS __attribute__((address_space(3)))
#define GAS __attribute__((address_space(1)))
typedef unsigned short bf16;
typedef short bf16x8 __attribute__((ext_vector_type(8)));
typedef float f32x2 __attribute__((ext_vector_type(2)));
typedef float f32x4 __attribute__((ext_vector_type(4)));
typedef float f32x16 __attribute__((ext_vector_type(16)));
typedef unsigned u32x2 __attribute__((ext_vector_type(2)));
typedef unsigned u32x4 __attribute__((ext_vector_type(4)));
typedef __bf16 bf16x2_t __attribute__((ext_vector_type(2)));

#ifndef EN_MASK
#define EN_MASK 0xffffu
#endif
#ifndef REP_MASK
#define REP_MASK 0
#endif
#ifndef MK_N_LAUNCHES
#define MK_N_LAUNCHES 1
#endif

constexpr int D = 2048, TP = 8192, TS = 1024, T = TP + TS, SEQ = 4096, NH = 16, HD = 128, FF = 5632;
constexpr int NQKV = 3 * D, NWIN = 4 * D, NUP = 2 * FF;
constexpr int SROWS = 544;
constexpr float EPS = 1e-6f;
constexpr int NWAVES = 8, NTHR = 512;
constexpr int LDS_BYTES = 147456;

constexpr size_t MiB = 1u << 20;
constexpr size_t WS_WINA = 0, WS_WOA = 32 * MiB, WS_WQKV = 40 * MiB, WS_WOB = 64 * MiB, WS_FIN0 = 72 * MiB, WS_FIN1 = 116 * MiB, WS_FDN0 = 160 * MiB, WS_FDN1 = 182 * MiB;
constexpr size_t WS_LB = 204 * MiB, WS_HB = 205 * MiB, WS_QB = 241 * MiB, WS_MIX = 277 * MiB;
constexpr size_t WS_LOGF = WS_MIX, WS_VB = WS_MIX + 72 * MiB, WS_SG = WS_MIX + 108 * MiB, WS_OI = WS_MIX + 144 * MiB, WS_LOCAL = WS_MIX + 216 * MiB, WS_DEC = WS_MIX + 376 * MiB;
constexpr size_t WS_KS = WS_MIX, WS_VTS = WS_MIX + 68 * MiB, WS_QKV = WS_MIX + 136 * MiB, WS_KN = WS_MIX + 244 * MiB, WS_VT = WS_MIX + 276 * MiB;
constexpr size_t WS_UP = WS_MIX + 136 * MiB, WS_ACT = WS_MIX + 136 * MiB;
constexpr size_t WS_PART = WS_MIX + 236 * MiB;
constexpr size_t WS_BAR = WS_LB + 64 * 1024;
constexpr size_t WS_END = WS_MIX + 378 * MiB;

constexpr size_t O_YP = 0, O_YS = O_YP + (size_t)TP * D, O_SP = O_YS + (size_t)TS * D, O_SS = O_SP + 2 * 16 * 128 * 128, O_KP = O_SS + 32 * 16 * 128 * 128,
                 O_VP = O_KP + 2 * 512 * 2048, O_KSM = O_VP + 2 * 512 * 2048, O_VSM = O_KSM + 32 * 32 * 2048, O_CP = O_VSM + 32 * 32 * 2048, O_CS = O_CP + 2 * 2 * 2 * FF,
                 O_END = O_CS + 2 * 32 * 2 * FF;

struct Params {
    const float* x_prompt; const float* x_sample; const float* state_a_S; const float* cache_k; const float* cache_v; const float* conv_state;
    const float* norm_mix; const float* norm_ffn; const float* a_w_in; const float* a_gamma; const float* a_norm_o; const float* a_w_o;
    const float* b_w_qkv; const float* b_q_norm; const float* b_k_norm; const float* b_rel_bias; const float* b_w_o;
    const float* f_w_in; const float* f_conv_w; const float* f_conv_b; const float* f_w_down;
    float* out; unsigned char* ws; int ph_lo, ph_hi;
};

DI unsigned pk2(float lo, float hi) { f32x2 v = {lo, hi}; return __builtin_bit_cast(unsigned, __builtin_convertvector(v, bf16x2_t)); }
DI bf16 f2bf(float f) { return (bf16)(pk2(f, 0.f) & 0xffffu); }
DI float bflo(unsigned p) { return __uint_as_float(p << 16); }
DI float bfhi(unsigned p) { return __uint_as_float(p & 0xffff0000u); }
DI float wave_sum(float v) {
#pragma unroll
    for (int o = 1; o < 64; o <<= 1) v += __shfl_xor(v, o);
    return v;
}
DI float fexp(float x) { return __builtin_amdgcn_exp2f(x * 1.4426950408889634f); }
DI float fsigmoid(float z) { return __builtin_amdgcn_rcpf(1.f + fexp(-z)); }
DI float fsilu(float z) { return z * __builtin_amdgcn_rcpf(1.f + fexp(-z)); }
DI float flog(float x) { return __builtin_amdgcn_logf(x) * 0.6931471805599453f; }
DI int crow(int reg, int h) { return (reg & 3) + 8 * (reg >> 2) + 4 * h; }
#define MFMA32(a, b, c) __builtin_amdgcn_mfma_f32_32x32x16_bf16((a), (b), (c), 0, 0, 0)

namespace pg8 {
constexpr int BM = 256, BK = 64, HALF = 128, HTB = HALF * BK * 2, STAGE_BYTES = 8 * HTB, NXCD = 8, WGM = 8;
DI int lds_byte(int r, int c) { const int st = (r >> 4) * 2 + (c >> 5), rr = r & 15, cc = c & 31, ob = rr * 64 + cc * 2; return st * 1024 + (ob ^ (((ob >> 9) & 1) << 5)); }
DI void stage_rc(int b, int& R, int& C) { const int st = b / 1024, sb = b % 1024, swz = sb ^ (((sb >> 9) & 1) << 5); R = (st >> 1) * 16 + swz / 64; C = (st & 1) * 32 + (swz % 64) / 2; }
DI int perm32(int rho) { const int n = rho >> 4, i = rho & 15; return 8 * (i >> 2) + 4 * n + (i & 3); }
struct Unit { int pm, pn, kb0, nkt, slice; };
struct Gemm { const bf16* A; const bf16* Bt; int M, N, K; };
struct StaticOrder {
    int nM, nN, nwg, G, c, tail, nblk, nitems;
    DI void init(int M, int N, int K, int G_, int c_, int tail_) { tail = tail_; nM = tail ? TP / BM : M / BM; nN = N / BM; nwg = nM * nN; G = G_; c = c_; nblk = K / 128; nitems = nwg + (tail ? 256 : 0); }
    DI bool next(int i, Unit& u) const {
        const long L = (long)i * G + c; if (L >= nitems) return false;
        u.slice = -1; u.kb0 = 0; u.nkt = nblk * 2;
        if (L >= nwg) { const int j = (int)L - nwg, uu = j & 31; u.slice = j >> 5; u.pm = TP / BM + (uu >> 3); u.pn = uu & 7;
            const int base = nblk / 8, rem = nblk % 8; u.kb0 = u.slice * base + (u.slice < rem ? u.slice : rem); u.nkt = 2 * (base + (u.slice < rem ? 1 : 0)); return true; }
        int wgid = (int)L; { const int q = nwg / NXCD, r = nwg % NXCD, xcd = wgid % NXCD, off = wgid / NXCD; wgid = (xcd < r ? xcd * (q + 1) : r * (q + 1) + (xcd - r) * q) + off; }
        const int nig = WGM * nN, gid = wgid / nig, fm = gid * WGM, gsz = (nM - fm) < WGM ? (nM - fm) : WGM;
        u.pm = fm + ((wgid % nig) % gsz); u.pn = (wgid % nig) / gsz; return true;
    }
};

struct Epi {
    int mode;
    int ldo;
    bf16* ob;
    float* of; const float* resP; const float* resS;
    const float* lb; float* logf; unsigned char* wsb;
    float* part;
    const float* cw; const float* cbias; bf16* act; float* edge;
    DI bool perm() const { return mode != 2; }
    DI void operator()(const f32x4 (&acc)[2][2][4][2], const Unit& u, int wr, int wc, int fr, int fq) const {
        const int row0 = u.pm * BM + wr * 64 + fr;
        if (mode == 2 && u.slice >= 0) {
            const int col0 = u.pn * BM + wc * 32 + 4 * fq;
#pragma unroll
            for (int ai = 0; ai < 2; ++ai)
#pragma unroll
                for (int m = 0; m < 4; ++m) {
                    float* op = part + ((size_t)u.slice * TS + (row0 + ai * HALF + m * 16 - TP)) * D + col0;
#pragma unroll
                    for (int bj = 0; bj < 2; ++bj)
#pragma unroll
                        for (int n = 0; n < 2; ++n) *(f32x4*)(op + bj * HALF + n * 16) = acc[ai][bj][m][n];
                }
        } else if (mode == 2) {
            const int col0 = u.pn * BM + wc * 32 + 4 * fq;
#pragma unroll
            for (int ai = 0; ai < 2; ++ai) {
                f32x4 rr[4][2][2];
#pragma unroll
                for (int m = 0; m < 4; ++m) {
                    const int row = row0 + ai * HALF + m * 16;
                    const float* rp = (row < TP ? resP + (size_t)row * D : resS + (size_t)(row - TP) * D) + col0;
#pragma unroll
                    for (int bj = 0; bj < 2; ++bj)
#pragma unroll
                        for (int n = 0; n < 2; ++n) rr[m][bj][n] = *(const f32x4*)(rp + bj * HALF + n * 16);
                }
#pragma unroll
                for (int m = 0; m < 4; ++m) {
                    float* op = of + (size_t)(row0 + ai * HALF + m * 16) * D + col0;
#pragma unroll
                    for (int bj = 0; bj < 2; ++bj)
#pragma unroll
                        for (int n = 0; n < 2; ++n) *(f32x4*)(op + bj * HALF + n * 16) = rr[m][bj][n] + acc[ai][bj][m][n];
                }
            }
        } else if (mode == 3) {
            const int cc0 = u.pn * HALF + wc * 32 + 8 * fq;
            float w0[8], w1[8], w2[8], cb[8];
            { const f32x4 a0 = *(const f32x4*)(cw + cc0), a1 = *(const f32x4*)(cw + cc0 + 4), b0 = *(const f32x4*)(cw + FF + cc0), b1 = *(const f32x4*)(cw + FF + cc0 + 4);
              const f32x4 c0 = *(const f32x4*)(cw + 2 * FF + cc0), c1 = *(const f32x4*)(cw + 2 * FF + cc0 + 4), d0 = *(const f32x4*)(cbias + cc0), d1 = *(const f32x4*)(cbias + cc0 + 4);
#pragma unroll
              for (int e = 0; e < 4; ++e) { w0[e] = a0[e]; w0[4 + e] = a1[e]; w1[e] = b0[e]; w1[4 + e] = b1[e]; w2[e] = c0[e]; w2[4 + e] = c1[e]; cb[e] = d0[e]; cb[4 + e] = d1[e]; } }
            float* const eu_first = edge; float* const eg_first = edge + (size_t)(T / 32) * 2 * FF; float* const eu_last = edge + (size_t)(T / 32) * 4 * FF;
#pragma unroll
            for (int ai = 0; ai < 2; ++ai)
#pragma unroll
                for (int m = 0; m < 4; ++m) {
                    const int row = row0 + ai * HALF + m * 16, hb = row >> 5;
                    float a[8];
#pragma unroll
                    for (int n = 0; n < 2; ++n)
#pragma unroll
                        for (int e = 0; e < 4; ++e) {
                            const float cur = acc[ai][0][m][n][e];
                            const float prv = (m & 1) ? acc[ai][0][m - 1][n][e] : 0.f;
                            const int ci = __float_as_int(cur), pi = __float_as_int(prv);
                            const int r1 = __builtin_amdgcn_update_dpp(0, pi, 0x121, 0xf, 0xf, false), r2 = __builtin_amdgcn_update_dpp(0, pi, 0x122, 0xf, 0xf, false);
                            const float p1 = __int_as_float(__builtin_amdgcn_update_dpp(r1, ci, 0x111, 0xf, 0xf, false));
                            const float p2 = __int_as_float(__builtin_amdgcn_update_dpp(r2, ci, 0x112, 0xf, 0xf, false));
                            const int k = 4 * n + e;
                            a[k] = fsilu(cb[k] + p2 * w0[k] + p1 * w1[k] + cur * w2[k]) * acc[ai][1][m][n][e];
                        }
                    const bool first2 = ((m & 1) == 0) && (fr < 2), last2 = ((m & 1) == 1) && (fr >= 14);
                    if (!first2) { u32x4 o; o.x = pk2(a[0], a[1]); o.y = pk2(a[2], a[3]); o.z = pk2(a[4], a[5]); o.w = pk2(a[6], a[7]); *(u32x4*)(act + (size_t)row * FF + cc0) = o; }
                    else { float* du = eu_first + ((size_t)hb * 2 + fr) * FF + cc0; float* dg = eg_first + ((size_t)hb * 2 + fr) * FF + cc0;
                        *(f32x4*)du = acc[ai][0][m][0]; *(f32x4*)(du + 4) = acc[ai][0][m][1]; *(f32x4*)dg = acc[ai][1][m][0]; *(f32x4*)(dg + 4) = acc[ai][1][m][1]; }
                    if (last2) { float* du = eu_last + ((size_t)hb * 2 + (fr - 14)) * FF + cc0; *(f32x4*)du = acc[ai][0][m][0]; *(f32x4*)(du + 4) = acc[ai][0][m][1]; }
                }
        } else if (mode == 1) {
            const int col0 = u.pn * BM + wc * 32 + 8 * fq;
#pragma unroll
            for (int ai = 0; ai < 2; ++ai)
#pragma unroll
                for (int m = 0; m < 4; ++m) {
                    bf16* op = ob + (size_t)(row0 + ai * HALF + m * 16) * ldo + col0;
#pragma unroll
                    for (int bj = 0; bj < 2; ++bj) { const f32x4 v0 = acc[ai][bj][m][0], v1 = acc[ai][bj][m][1];
                        u32x4 o; o.x = pk2(v0.x, v0.y); o.y = pk2(v0.z, v0.w); o.z = pk2(v1.x, v1.y); o.w = pk2(v1.z, v1.w);
                        *(u32x4*)(op + bj * HALF) = o; }
                }
        } else {
            const int type = u.pn >> 3, col0 = (u.pn & 7) * BM + wc * 32 + 8 * fq;
#pragma unroll
            for (int bj = 0; bj < 2; ++bj) {
                const int col = col0 + bj * HALF;
                f32x4 l0 = {0.f, 0.f, 0.f, 0.f}, l1 = l0;
                if (type == 1) { l0 = *(const f32x4*)(lb + col); l1 = *(const f32x4*)(lb + col + 4); }
#pragma unroll
                for (int ai = 0; ai < 2; ++ai)
#pragma unroll
                    for (int m = 0; m < 4; ++m) {
                        const size_t off = (size_t)(row0 + ai * HALF + m * 16) * D + col;
                        f32x4 v0 = acc[ai][bj][m][0], v1 = acc[ai][bj][m][1];
                        if (type == 1) {
#pragma unroll
                            for (int e = 0; e < 4; ++e) { v0[e] = flog(l0[e] + (1.f - l0[e]) * fsigmoid(v0[e])); v1[e] = flog(l1[e] + (1.f - l1[e]) * fsigmoid(v1[e])); }
                            *(f32x4*)(logf + off) = v0; *(f32x4*)(logf + off + 4) = v1;
                        } else {
                            if (type == 3) {
#pragma unroll
                                for (int e = 0; e < 4; ++e) { v0[e] = fsilu(v0[e]); v1[e] = fsilu(v1[e]); }
                            }
                            u32x4 o; o.x = pk2(v0.x, v0.y); o.y = pk2(v0.z, v0.w); o.z = pk2(v1.x, v1.y); o.w = pk2(v1.z, v1.w);
                            bf16* dst = (bf16*)(wsb + (type == 0 ? WS_QB : (type == 2 ? WS_VB : WS_SG)));
                            *(u32x4*)(dst + off) = o;
                        }
                    }
            }
        }
    }
};

DI void gemm_phase(LAS unsigned char* lds, const Gemm g, const StaticOrder& S, const Epi& E, const int tid) {
    const int wid = __builtin_amdgcn_readfirstlane(tid >> 6), lane = tid & 63, wr = wid >> 2, wc = wid & 3, fr = lane & 15, fq = lane >> 4;
    const int K = g.K;
    const bool PERM = E.perm();
    unsigned voffA[2], voffB[2];
#pragma unroll
    for (int i = 0; i < 2; ++i) { int R, C; stage_rc(tid * 16 + i * 8192, R, C); const int Rb = PERM ? ((R & ~31) + perm32(R & 31)) : R;
        voffA[i] = (unsigned)(R * K + C) * 2u; voffB[i] = (unsigned)(Rb * K + C) * 2u; }
    const size_t kstep = (size_t)(BK * 2);
    const size_t hstep = (size_t)HALF * K * 2;
    const size_t tstep = 2 * hstep;
    const unsigned ldsw = (unsigned)wid * 1024u;
    const int aoff = lds_byte(wr * 64 + fr, fq * 8), boff = lds_byte(wc * 32 + fr, fq * 8);
#define PG8_SA(b, h) (((b) * 2 + (h)) * HTB)
#define PG8_SB(b, h) ((4 + (b) * 2 + (h)) * HTB)
#define PG8_STAGE(bufoff, gbase, voff) do { _Pragma("unroll") for (int _i = 0; _i < 2; ++_i) \
        __builtin_amdgcn_global_load_lds((const unsigned*)((const char*)(gbase) + (voff)[_i]), (LAS unsigned*)(lds + (bufoff) + ldsw + _i * 8192), 16, 0, 0); } while (0)
#define PG8_LDA(dst, b, h) do { _Pragma("unroll") for (int m = 0; m < 4; ++m) _Pragma("unroll") for (int k = 0; k < 2; ++k) dst[m][k] = *(const LAS bf16x8*)(lds + PG8_SA(b, h) + aoff + m * 2048 + k * 1024); } while (0)
#define PG8_LDB(dst, b, h) do { _Pragma("unroll") for (int n = 0; n < 2; ++n) _Pragma("unroll") for (int k = 0; k < 2; ++k) dst[n][k] = *(const LAS bf16x8*)(lds + PG8_SB(b, h) + boff + n * 2048 + k * 1024); } while (0)
#define PG8_MMA(ai, bj, At, Bt) do { __builtin_amdgcn_s_setprio(1); _Pragma("unroll") for (int m = 0; m < 4; ++m) _Pragma("unroll") for (int n = 0; n < 2; ++n) _Pragma("unroll") for (int k = 0; k < 2; ++k) \
        acc[ai][bj][m][n] = __builtin_amdgcn_mfma_f32_16x16x32_bf16(Bt[n][k], At[m][k], acc[ai][bj][m][n], 0, 0, 0); __builtin_amdgcn_s_setprio(0); } while (0)
#define PG8_WAIT_V(n) asm volatile("s_waitcnt vmcnt(" #n ")" ::: "memory")
#define PG8_WAIT_L(n) asm volatile("s_waitcnt lgkmcnt(" #n ")" ::: "memory")
#define PG8_BAR __builtin_amdgcn_s_barrier()
#define PG8_SCHED __builtin_amdgcn_sched_barrier(0)
    Unit cur, nxt; int ui = 0;
    if (!S.next(0, cur)) return;
    f32x4 acc[2][2][4][2];
#pragma unroll
    for (int a = 0; a < 2; ++a)
#pragma unroll
        for (int b = 0; b < 2; ++b)
#pragma unroll
            for (int m = 0; m < 4; ++m)
#pragma unroll
                for (int n = 0; n < 2; ++n) acc[a][b][m][n] = (f32x4){0.f, 0.f, 0.f, 0.f};
    bf16x8 At[4][2], B0[2][2], B1[2][2];
    const char* cA = (const char*)g.A + (size_t)cur.pm * tstep + (size_t)cur.kb0 * 256; const char* cB = (const char*)g.Bt + (size_t)cur.pn * tstep + (size_t)cur.kb0 * 256;
    PG8_STAGE(PG8_SB(0, 0), cB, voffB); PG8_STAGE(PG8_SB(0, 1), cB + hstep, voffB); PG8_STAGE(PG8_SA(0, 0), cA, voffA); PG8_STAGE(PG8_SA(0, 1), cA + hstep, voffA);
    if (wr == 1) PG8_BAR;
    PG8_WAIT_V(2); PG8_BAR;
    PG8_STAGE(PG8_SB(1, 0), cB + kstep, voffB); PG8_STAGE(PG8_SA(1, 0), cA + kstep, voffA); PG8_STAGE(PG8_SB(1, 1), cB + hstep + kstep, voffB);
    PG8_WAIT_V(6); PG8_BAR;
    for (;;) {
        const bool has_next = S.next(ui + 1, nxt);
        const char* nA = has_next ? (const char*)g.A + (size_t)nxt.pm * tstep + (size_t)nxt.kb0 * 256 : cA; const char* nB = has_next ? (const char*)g.Bt + (size_t)nxt.pn * tstep + (size_t)nxt.kb0 * 256 : cB;
        const int nt = cur.nkt;
        for (int t = 0; t < nt; t += 2) {
            const bool last = (t == nt - 2);
            const char* a1 = cA + (size_t)(t + 1) * kstep;
            const char* a2 = last ? nA : cA + (size_t)(t + 2) * kstep; const char* b2 = last ? nB : cB + (size_t)(t + 2) * kstep;
            const char* a3 = a2 + kstep; const char* b3 = b2 + kstep;
            PG8_LDB(B0, 0, 0); PG8_LDB(B1, 0, 1); PG8_SCHED; PG8_LDA(At, 0, 0); PG8_STAGE(PG8_SA(1, 1), a1 + hstep, voffA);
            PG8_WAIT_V(8); PG8_WAIT_L(0); PG8_BAR; PG8_MMA(0, 0, At, B0); PG8_MMA(0, 1, At, B1); PG8_BAR; PG8_SCHED;
            PG8_LDA(At, 0, 1); PG8_STAGE(PG8_SB(0, 0), b2, voffB); PG8_STAGE(PG8_SB(0, 1), b2 + hstep, voffB); PG8_STAGE(PG8_SA(0, 0), a2, voffA);
            PG8_WAIT_V(8); PG8_WAIT_L(0); PG8_BAR; PG8_MMA(1, 0, At, B0); PG8_MMA(1, 1, At, B1); PG8_BAR; PG8_SCHED;
            PG8_LDB(B0, 1, 0); PG8_LDB(B1, 1, 1); PG8_SCHED; PG8_LDA(At, 1, 0); PG8_STAGE(PG8_SA(0, 1), a2 + hstep, voffA);
            PG8_WAIT_V(8); PG8_WAIT_L(0); PG8_BAR; PG8_MMA(0, 0, At, B0); PG8_MMA(0, 1, At, B1); PG8_BAR; PG8_SCHED;
            PG8_LDA(At, 1, 1); PG8_STAGE(PG8_SB(1, 0), b3, voffB); PG8_STAGE(PG8_SB(1, 1), b3 + hstep, voffB); PG8_STAGE(PG8_SA(1, 0), a3, voffA);
            PG8_WAIT_V(8); PG8_WAIT_L(0); PG8_BAR; PG8_MMA(1, 0, At, B0); PG8_MMA(1, 1, At, B1); PG8_BAR; PG8_SCHED;
        }
        if (wr == 0) PG8_BAR;
        E(acc, cur, wr, wc, fr, fq);
        if (!has_next) break;
#pragma unroll
        for (int a = 0; a < 2; ++a)
#pragma unroll
            for (int b = 0; b < 2; ++b)
#pragma unroll
                for (int m = 0; m < 4; ++m)
#pragma unroll
                    for (int n = 0; n < 2; ++n) acc[a][b][m][n] = (f32x4){0.f, 0.f, 0.f, 0.f};
        cur = nxt; cA = nA; cB = nB; ++ui;
        if (wr == 1) PG8_BAR;
    }
    PG8_WAIT_V(0);
    PG8_BAR;
#undef PG8_SA
#undef PG8_SB
#undef PG8_STAGE
#undef PG8_LDA
#undef PG8_LDB
#undef PG8_MMA
#undef PG8_WAIT_V
#undef PG8_WAIT_L
#undef PG8_BAR
#undef PG8_SCHED
}
}

struct Frame {
    Params p; LAS unsigned char* lds; int tid, lane, wave, G, bid;
    bf16 *WinA, *WoA, *Wqkv, *WoB, *Fin0, *Fin1, *Fdn0, *Fdn1;
    float* LB; bf16 *HB, *QB;
    float* LOGF; bf16 *VB, *SG; float *OI, *LOCAL, *DEC;
    bf16 *QKV, *KN, *KS, *VT, *VTS, *UP, *ACT;
};

DI void transpose_item(const float* __restrict__ W, int K, int N, bf16* __restrict__ WT, LAS float* scr, int item, int lane, const bool ilv = false) {
    const int nblk = N / 64, kb = item / nblk, nb = item % nblk, k0 = 64 * kb, n0 = 64 * nb;
    const int lr = lane >> 4, lc = (lane & 15) * 4;
    f32x4 v[16];
    const float* src = W + (size_t)(k0 + lr) * N + n0 + lc;
#pragma unroll
    for (int i = 0; i < 16; ++i) v[i] = __builtin_nontemporal_load((const f32x4*)(src + (size_t)(4 * i) * N));
#pragma unroll
    for (int i = 0; i < 16; ++i) { LAS float* d = scr + (4 * i + lr) * 65 + lc; d[0] = v[i].x; d[1] = v[i].y; d[2] = v[i].z; d[3] = v[i].w; }
    asm volatile("s_waitcnt lgkmcnt(0)" ::: "memory");
    const int c = lane & 7;
#pragma unroll
    for (int j = 0; j < 8; ++j) { const int n = (lane >> 3) + 8 * j; const LAS float* s = scr + (8 * c) * 65 + n;
        u32x4 o; o.x = pk2(s[0 * 65], s[1 * 65]); o.y = pk2(s[2 * 65], s[3 * 65]); o.z = pk2(s[4 * 65], s[5 * 65]); o.w = pk2(s[6 * 65], s[7 * 65]);
        int nd = n0 + n; if (ilv) nd = (nd < FF) ? (((nd >> 7) << 8) + (nd & 127)) : ((((nd - FF) >> 7) << 8) + 128 + ((nd - FF) & 127));
        __builtin_nontemporal_store(o, (u32x4*)(WT + (size_t)nd * K + k0 + 8 * c)); }
    asm volatile("s_waitcnt lgkmcnt(0)" ::: "memory");
}
DI void rms_row(const float* __restrict__ xrow, const float* __restrict__ g, bf16* __restrict__ orow, int lane, const float* __restrict__ part, float* __restrict__ xdst) {
    const f32x4* xr = (const f32x4*)xrow + lane; const f32x4* gr = (const f32x4*)g + lane;
    f32x4 v[8]; float s = 0.f;
#pragma unroll
    for (int j = 0; j < 8; ++j) v[j] = xr[64 * j];
    if (part) {
#pragma unroll
        for (int sl = 0; sl < 8; ++sl) { const f32x4* pr = (const f32x4*)(part + (size_t)sl * TS * D) + lane;
#pragma unroll
            for (int j = 0; j < 8; ++j) v[j] += pr[64 * j]; }
#pragma unroll
        for (int j = 0; j < 8; ++j) ((f32x4*)xdst + lane)[64 * j] = v[j];
    }
#pragma unroll
    for (int j = 0; j < 8; ++j) s += (v[j].x * v[j].x + v[j].y * v[j].y) + (v[j].z * v[j].z + v[j].w * v[j].w);
    const float rstd = rsqrtf(wave_sum(s) * (1.f / D) + EPS);
    u32x2* o8 = (u32x2*)orow + lane;
#pragma unroll
    for (int j = 0; j < 8; ++j) { const f32x4 gg = gr[64 * j]; u32x2 o; o.x = pk2(v[j].x * rstd * gg.x, v[j].y * rstd * gg.y); o.y = pk2(v[j].z * rstd * gg.z, v[j].w * rstd * gg.w); o8[64 * j] = o; }
}
DI void rms_phase(Frame& F, const float* srcP, const float* srcS, const float* g, const float* part, float* xs) {
    const int gw = F.bid * NWAVES + F.wave, NGW = F.G * NWAVES;
    for (int m = gw; m < T; m += NGW) {
        if (m < TP) rms_row(srcP + (size_t)m * D, g, F.HB + (size_t)m * D, F.lane, nullptr, nullptr);
        else rms_row(srcS + (size_t)(m - TP) * D, g, F.HB + (size_t)m * D, F.lane, part ? part + (size_t)(m - TP) * D : nullptr, xs + (size_t)(m - TP) * D);
    }
}
DI void fin_phase(Frame& F, float* xs, const float* part) {
    const int gt = F.bid * NTHR + F.tid, NGT = F.G * NTHR;
    for (int it = gt; it < TS * D / 4; it += NGT) {
        f32x4 v = ((const f32x4*)xs)[it];
#pragma unroll
        for (int sl = 0; sl < 8; ++sl) v += ((const f32x4*)(part + (size_t)sl * TS * D))[it];
        ((f32x4*)xs)[it] = v;
    }
}
constexpr int I_WINA = (D / 64) * (NWIN / 64), I_WO = (D / 64) * (D / 64), I_QKV = (D / 64) * (NQKV / 64), I_FIN = (D / 64) * (NUP / 64), I_FDN = (FF / 64) * (D / 64);
constexpr int WC_EARLY = I_WINA + 2 * I_WO + I_QKV + I_FIN + I_FDN, WC_ALL = WC_EARLY + I_FIN + I_FDN;
DI void wconv_items(Frame& F, int it_lo, int it_hi, int widx, int nw) {
    const Params& p = F.p;
    LAS float* scr = (LAS float*)(F.lds + F.wave * 16640);
    for (int it = it_lo + widx * NWAVES + F.wave; it < it_hi; it += nw * NWAVES) {
        int r = it;
        if (r < I_WINA) { transpose_item(p.a_w_in, D, NWIN, F.WinA, scr, r, F.lane); continue; } r -= I_WINA;
        if (r < I_WO) { transpose_item(p.a_w_o, D, D, F.WoA, scr, r, F.lane); continue; } r -= I_WO;
        if (r < I_QKV) { transpose_item(p.b_w_qkv, D, NQKV, F.Wqkv, scr, r, F.lane); continue; } r -= I_QKV;
        if (r < I_WO) { transpose_item(p.b_w_o, D, D, F.WoB, scr, r, F.lane); continue; } r -= I_WO;
        if (r < I_FIN) { transpose_item(p.f_w_in, D, NUP, F.Fin0, scr, r, F.lane, true); continue; } r -= I_FIN;
        if (r < I_FDN) { transpose_item(p.f_w_down, FF, D, F.Fdn0, scr, r, F.lane); continue; } r -= I_FDN;
        if (r < I_FIN) { transpose_item(p.f_w_in + (size_t)D * NUP, D, NUP, F.Fin1, scr, r, F.lane, true); continue; } r -= I_FIN;
        transpose_item(p.f_w_down + (size_t)FF * D, FF, D, F.Fdn1, scr, r, F.lane);
    }
}
DI void p0_phase(Frame& F) {
    const Params& p = F.p;
    wconv_items(F, 0, WC_EARLY, F.bid, F.G);
    for (int c = F.bid * NTHR + F.tid; c < D; c += F.G * NTHR) {
        const float g0 = p.a_gamma[c], g1 = p.a_gamma[D + c], g2 = p.a_gamma[2 * D + c];
        const float mx = fmaxf(g0, fmaxf(g1, g2));
        const float e0 = __expf(g0 - mx), e1 = __expf(g1 - mx), e2 = __expf(g2 - mx);
        F.LB[c] = e0 / (e0 + e1 + e2);
    }
    rms_phase(F, p.x_prompt, p.x_sample, p.norm_mix, nullptr, nullptr);
}

constexpr int GLA_UNITS = 2048 + 512;
constexpr int QT_STRIDE = 136, TT_STRIDE = 72;
constexpr int L_BCUM = 0, L_QT = 32768, L_KT = L_QT + 64 * QT_STRIDE * 2, L_KHT = L_KT + 64 * QT_STRIDE * 2, L_VT = L_KHT + 128 * TT_STRIDE * 2, L_PM = L_VT + 128 * TT_STRIDE * 2, L_GLA_END = L_PM + 64 * TT_STRIDE * 2;
static_assert(L_GLA_END <= LDS_BYTES, "gla lds");

DI f32x16 mma_lds(const LAS bf16* A, int astride, int arow0, const LAS bf16* B, int bstride, int brow0, int nks, int lane) {
    f32x16 acc; for (int i = 0; i < 16; ++i) acc[i] = 0.f;
    const int r = lane & 31, hf = lane >> 5;
    const LAS bf16* ap = A + (arow0 + r) * astride + 8 * hf; const LAS bf16* bp = B + (brow0 + r) * bstride + 8 * hf;
    for (int ks = 0; ks < nks; ++ks) { const bf16x8 a = *(const LAS bf16x8*)(ap + 16 * ks), b = *(const LAS bf16x8*)(bp + 16 * ks); acc = MFMA32(a, b, acc); }
    return acc;
}

template <int BLK>
DI void gla_a_unit(Frame& F, int u, int row0, int h) {
    LAS float* bcum = (LAS float*)(F.lds + L_BCUM);
    LAS bf16* qt = (LAS bf16*)(F.lds + L_QT); LAS bf16* kt = (LAS bf16*)(F.lds + L_KT); LAS bf16* khT = (LAS bf16*)(F.lds + L_KHT);
    LAS bf16* vT = (LAS bf16*)(F.lds + L_VT); LAS bf16* Pm = (LAS bf16*)(F.lds + L_PM);
    const int tid = F.tid, lane = F.lane, w = F.wave;
    const size_t hoff = (size_t)h * HD;
    constexpr int SEG = BLK / 4;
    { const int seg = tid >> 7, kc = tid & 127; float a = 0.f;
      const float* lp = F.LOGF + (size_t)(row0 + seg * SEG) * D + hoff + kc;
#pragma unroll
      for (int t = 0; t < SEG; ++t) { a += lp[(size_t)t * D]; bcum[(seg * SEG + t) * 128 + kc] = a; }
      __syncthreads();
      float off = 0.f;
      for (int s = 0; s < seg; ++s) off += bcum[(s * SEG + SEG - 1) * 128 + kc];
      __syncthreads();
      if (seg > 0) {
#pragma unroll
          for (int t = 0; t < SEG; ++t) bcum[(seg * SEG + t) * 128 + kc] += off;
      }
      __syncthreads(); }
    for (int i = tid; i < BLK * 16; i += NTHR) {
        const int t = i >> 4, c0 = (i & 15) * 8;
        const size_t goff = (size_t)(row0 + t) * D + hoff + c0;
        const u32x4 qv = *(const u32x4*)(F.QB + goff);
        const u32x4 vv = *(const u32x4*)(F.VB + goff);
        const f32x4 lf0 = *(const f32x4*)(F.LOGF + goff), lf1 = *(const f32x4*)(F.LOGF + goff + 4);
        float q[8] = {bflo(qv.x), bfhi(qv.x), bflo(qv.y), bfhi(qv.y), bflo(qv.z), bfhi(qv.z), bflo(qv.w), bfhi(qv.w)};
        float lf[8] = {lf0.x, lf0.y, lf0.z, lf0.w, lf1.x, lf1.y, lf1.z, lf1.w};
        float qtv[8], ktv[8], qhv[8], khv[8];
#pragma unroll
        for (int e = 0; e < 8; ++e) {
            const float b = bcum[t * 128 + c0 + e], bmid = bcum[(BLK / 2 - 1) * 128 + c0 + e], bend = bcum[(BLK - 1) * 128 + c0 + e];
            const float kk = 1.f - __expf(lf[e]);
            qtv[e] = q[e] * __expf(b - bmid); ktv[e] = kk * __expf(bmid - b); qhv[e] = q[e] * __expf(b); khv[e] = kk * __expf(bend - b);
            if (t == BLK - 1) F.DEC[(size_t)u * 128 + c0 + e] = __expf(bend);
        }
        u32x4 o; o.x = pk2(qtv[0], qtv[1]); o.y = pk2(qtv[2], qtv[3]); o.z = pk2(qtv[4], qtv[5]); o.w = pk2(qtv[6], qtv[7]);
        *(LAS u32x4*)(qt + t * QT_STRIDE + c0) = o;
        o.x = pk2(ktv[0], ktv[1]); o.y = pk2(ktv[2], ktv[3]); o.z = pk2(ktv[4], ktv[5]); o.w = pk2(ktv[6], ktv[7]);
        *(LAS u32x4*)(kt + t * QT_STRIDE + c0) = o;
        o.x = pk2(qhv[0], qhv[1]); o.y = pk2(qhv[2], qhv[3]); o.z = pk2(qhv[4], qhv[5]); o.w = pk2(qhv[6], qhv[7]);
        *(u32x4*)(F.QB + goff) = o;
        const unsigned vw[4] = {vv.x, vv.y, vv.z, vv.w};
#pragma unroll
        for (int e = 0; e < 8; ++e) {
            khT[(c0 + e) * TT_STRIDE + t] = f2bf(khv[e]);
            vT[(c0 + e) * TT_STRIDE + t] = (bf16)((e & 1) ? (vw[e >> 1] >> 16) : (vw[e >> 1] & 0xffffu));
        }
    }
    __syncthreads();
    const int r = lane & 31, hf = lane >> 5;
#pragma unroll
    for (int q2 = 0; q2 < 2; ++q2) {
        const int tl = w * 2 + q2, mt = tl >> 2, nt = tl & 3;
        const f32x16 acc = mma_lds(khT, TT_STRIDE, 32 * mt, vT, TT_STRIDE, 32 * nt, BLK / 16, lane);
        float* lp = F.LOCAL + (size_t)u * 16384 + 32 * nt + r;
#pragma unroll
        for (int i = 0; i < 16; ++i) lp[(size_t)(32 * mt + crow(i, hf)) * 128] = acc[i];
    }
    constexpr int NT2 = BLK / 32;
    if (w < NT2 * NT2) {
        const int mt = w / NT2, nt = w % NT2;
        if (nt > mt) {
#pragma unroll
            for (int i = 0; i < 16; ++i) Pm[(32 * mt + crow(i, hf)) * TT_STRIDE + 32 * nt + r] = 0;
        } else {
            const f32x16 acc = mma_lds(qt, QT_STRIDE, 32 * mt, kt, QT_STRIDE, 32 * nt, 8, lane);
#pragma unroll
            for (int i = 0; i < 16; ++i) { const int t = 32 * mt + crow(i, hf), s = 32 * nt + r; Pm[t * TT_STRIDE + s] = (s <= t) ? f2bf(acc[i]) : (bf16)0; }
        }
    }
    __syncthreads();
    if (w < NT2 * 4) {
        const int mt = w >> 2, nt = w & 3;
        const f32x16 acc = mma_lds(Pm, TT_STRIDE, 32 * mt, vT, TT_STRIDE, 32 * nt, BLK / 16, lane);
        float* op = F.OI + (size_t)(row0 + 32 * mt) * D + hoff + 32 * nt + r;
#pragma unroll
        for (int i = 0; i < 16; ++i) op[(size_t)crow(i, hf) * D] = acc[i];
    }
    __syncthreads();
}
DI void gla_a_phase(Frame& F) {
    for (int u = F.bid; u < GLA_UNITS; u += F.G) {
        if (u < 2048) { const int b = u >> 10, h = (u >> 6) & 15, c = u & 63; gla_a_unit<64>(F, u, b * SEQ + c * 64, h); }
        else { const int su = u - 2048, b = su >> 4, h = su & 15; gla_a_unit<32>(F, u, TP + b * 32, h); }
    }
}
DI void scan_phase(Frame& F) {
    const int gt = F.bid * NTHR + F.tid, NGT = F.G * NTHR;
    for (int it = gt; it < 32 * 4096; it += NGT) {
        const int bh = it >> 12, e = (it & 4095) * 4, kc = e >> 7;
        f32x4 S = {0.f, 0.f, 0.f, 0.f};
        float* __restrict__ lp = F.LOCAL + (size_t)(bh * 64) * 16384 + e; const float* __restrict__ dp = F.DEC + (size_t)(bh * 64) * 128 + kc;
        for (int c0 = 0; c0 < 64; c0 += 8) {
            f32x4 loc[8]; float d[8];
#pragma unroll
            for (int j = 0; j < 8; ++j) { loc[j] = *(const f32x4*)(lp + (size_t)(c0 + j) * 16384); d[j] = dp[(c0 + j) * 128]; }
#pragma unroll
            for (int j = 0; j < 8; ++j) { *(f32x4*)(lp + (size_t)(c0 + j) * 16384) = S; S = S * d[j] + loc[j]; }
        }
        *(f32x4*)(F.p.out + O_SP + (size_t)bh * 16384 + e) = S;
    }
    for (int it0 = gt; it0 < 512 * 4096; it0 += 4 * NGT) {
        f32x4 S0[4], loc[4]; float d[4];
#pragma unroll
        for (int j = 0; j < 4; ++j) { const int it = it0 + j * NGT; if (it < 512 * 4096) { const int bh = it >> 12, e = (it & 4095) * 4, kc = e >> 7;
            S0[j] = *(const f32x4*)(F.p.state_a_S + (size_t)bh * 16384 + e); loc[j] = *(const f32x4*)(F.LOCAL + (size_t)(2048 + bh) * 16384 + e); d[j] = F.DEC[(size_t)(2048 + bh) * 128 + kc]; } }
#pragma unroll
        for (int j = 0; j < 4; ++j) { const int it = it0 + j * NGT; if (it < 512 * 4096) { const int bh = it >> 12, e = (it & 4095) * 4;
            *(f32x4*)(F.p.out + O_SS + (size_t)bh * 16384 + e) = S0[j] * d[j] + loc[j]; } }
    }
}
constexpr int OB_STRIDE = 132;
template <int BLK>
DI void gla_c_unit(Frame& F, const float* __restrict__ S, int row0, int h) {
    LAS float* ob = (LAS float*)F.lds;
    const int tid = F.tid, lane = F.lane, w = F.wave, r = lane & 31, hf = lane >> 5;
    const size_t hoff = (size_t)h * HD;
    constexpr int TPR_ = NTHR / BLK, CPT_ = 128 / TPR_;
    u32x4 sgv[CPT_ / 8];
    { const int t = tid / TPR_, c0 = (tid % TPR_) * CPT_;
#pragma unroll
      for (int e8 = 0; e8 < CPT_ / 8; ++e8) sgv[e8] = *(const u32x4*)(F.SG + (size_t)(row0 + t) * D + hoff + c0 + 8 * e8); }
    if (w < (BLK / 32) * 4) {
        const int mt = w >> 2, nt = w & 3;
        f32x16 acc; for (int i = 0; i < 16; ++i) acc[i] = 0.f;
        float oiv[16];
        { const float* oi = F.OI + (size_t)(row0 + 32 * mt) * D + hoff + 32 * nt + r;
#pragma unroll
          for (int i = 0; i < 16; ++i) oiv[i] = oi[(size_t)crow(i, hf) * D]; }
        const bf16* ap = F.QB + (size_t)(row0 + 32 * mt + r) * D + hoff + 8 * hf;
        const float* sp = S + (size_t)(8 * hf) * 128 + 32 * nt + r;
#pragma unroll
        for (int ks = 0; ks < 8; ++ks) {
            const bf16x8 a = *(const bf16x8*)(ap + 16 * ks);
            float sv[8];
#pragma unroll
            for (int e = 0; e < 8; ++e) sv[e] = sp[(size_t)(16 * ks + e) * 128];
            u32x4 bb; bb.x = pk2(sv[0], sv[1]); bb.y = pk2(sv[2], sv[3]); bb.z = pk2(sv[4], sv[5]); bb.w = pk2(sv[6], sv[7]);
            acc = MFMA32(a, __builtin_bit_cast(bf16x8, bb), acc);
        }
#pragma unroll
        for (int i = 0; i < 16; ++i) { const int t = crow(i, hf); ob[(32 * mt + t) * OB_STRIDE + 32 * nt + r] = acc[i] + oiv[i]; }
    }
    __syncthreads();
    {
        constexpr int TPR = NTHR / BLK;
        constexpr int CPT = 128 / TPR;
        const int t = tid / TPR, j = tid % TPR, c0 = j * CPT;
        float v[CPT]; float ss = 0.f;
#pragma unroll
        for (int e = 0; e < CPT; ++e) { v[e] = ob[t * OB_STRIDE + c0 + e]; ss += v[e] * v[e]; }
#pragma unroll
        for (int o = 1; o < TPR; o <<= 1) ss += __shfl_xor(ss, o);
        const float rstd = rsqrtf(ss * (1.f / HD) + EPS);
        const size_t goff = (size_t)(row0 + t) * D + hoff + c0;
#pragma unroll
        for (int e8 = 0; e8 < CPT / 8; ++e8) {
            const u32x4 sg = sgv[e8];
            const f32x4 n0 = *(const f32x4*)(F.p.a_norm_o + c0 + 8 * e8), n1 = *(const f32x4*)(F.p.a_norm_o + c0 + 8 * e8 + 4);
            const float* vv = v + 8 * e8;
            u32x4 o;
            o.x = pk2(vv[0] * rstd * n0.x * bflo(sg.x), vv[1] * rstd * n0.y * bfhi(sg.x));
            o.y = pk2(vv[2] * rstd * n0.z * bflo(sg.y), vv[3] * rstd * n0.w * bfhi(sg.y));
            o.z = pk2(vv[4] * rstd * n1.x * bflo(sg.z), vv[5] * rstd * n1.y * bfhi(sg.z));
            o.w = pk2(vv[6] * rstd * n1.z * bflo(sg.w), vv[7] * rstd * n1.w * bfhi(sg.w));
            *(u32x4*)(F.HB + goff + 8 * e8) = o;
        }
    }
    __syncthreads();
}
DI void gla_c_phase(Frame& F) {
    for (int u = F.bid; u < GLA_UNITS; u += F.G) {
        if (u < 2048) { const int b = u >> 10, h = (u >> 6) & 15, c = u & 63; gla_c_unit<64>(F, F.LOCAL + (size_t)u * 16384, b * SEQ + c * 64, h); }
        else { const int su = u - 2048, b = su >> 4, h = su & 15; gla_c_unit<32>(F, F.p.state_a_S + (size_t)su * 16384, TP + b * 32, h); }
    }
}
DI void convfix_phase(Frame& F, int layer, const float* edge) {
    const Params& p = F.p;
    const int gt = F.bid * NTHR + F.tid, NGT = F.G * NTHR;
    constexpr int NCG = FF / 8, NHB = T / 32;
    const float* cw = p.f_conv_w + (size_t)layer * 3 * FF; const float* cbp = p.f_conv_b + (size_t)layer * FF;
    const float* eu_first = edge; const float* eg_first = edge + (size_t)NHB * 2 * FF; const float* eu_last = edge + (size_t)NHB * 4 * FF;
    for (int it = gt; it < NHB * NCG; it += NGT) {
        const int hb = it / NCG, c0 = (it % NCG) * 8;
        const bool smp = hb >= 256; const bool first = smp || ((hb & 127) == 0), lastb = smp || ((hb & 127) == 127);
        float um2[8], um1[8], u0[8], u1[8], g0[8], g1[8], w0[8], w1[8], w2[8], bb[8];
#pragma unroll
        for (int e = 0; e < 8; ++e) { w0[e] = cw[c0 + e]; w1[e] = cw[FF + c0 + e]; w2[e] = cw[2 * FF + c0 + e]; bb[e] = cbp[c0 + e]; um2[e] = 0.f; um1[e] = 0.f;
            u0[e] = eu_first[((size_t)hb * 2) * FF + c0 + e]; u1[e] = eu_first[((size_t)hb * 2 + 1) * FF + c0 + e];
            g0[e] = eg_first[((size_t)hb * 2) * FF + c0 + e]; g1[e] = eg_first[((size_t)hb * 2 + 1) * FF + c0 + e]; }
        if (first) {
            if (smp) { const float* st = p.conv_state + ((size_t)(layer * 32 + (hb - 256)) * 2) * FF + c0;
#pragma unroll
                for (int e = 0; e < 8; ++e) { um2[e] = st[e]; um1[e] = st[FF + e]; } }
        } else {
#pragma unroll
            for (int e = 0; e < 8; ++e) { um2[e] = eu_last[((size_t)(hb - 1) * 2) * FF + c0 + e]; um1[e] = eu_last[((size_t)(hb - 1) * 2 + 1) * FF + c0 + e]; }
        }
        float a0[8], a1[8];
#pragma unroll
        for (int e = 0; e < 8; ++e) { a0[e] = fsilu(bb[e] + um2[e] * w0[e] + um1[e] * w1[e] + u0[e] * w2[e]) * g0[e]; a1[e] = fsilu(bb[e] + um1[e] * w0[e] + u0[e] * w1[e] + u1[e] * w2[e]) * g1[e]; }
        u32x4 o; o.x = pk2(a0[0], a0[1]); o.y = pk2(a0[2], a0[3]); o.z = pk2(a0[4], a0[5]); o.w = pk2(a0[6], a0[7]);
        *(u32x4*)(F.ACT + (size_t)(hb * 32) * FF + c0) = o;
        o.x = pk2(a1[0], a1[1]); o.y = pk2(a1[2], a1[3]); o.z = pk2(a1[4], a1[5]); o.w = pk2(a1[6], a1[7]);
        *(u32x4*)(F.ACT + (size_t)(hb * 32 + 1) * FF + c0) = o;
        if (lastb) {
            float* dst = smp ? p.out + O_CS + ((size_t)(layer * 32 + (hb - 256)) * 2) * FF + c0 : p.out + O_CP + ((size_t)(layer * 2 + (hb >> 7)) * 2) * FF + c0;
#pragma unroll
            for (int e = 0; e < 8; ++e) { dst[e] = eu_last[((size_t)hb * 2) * FF + c0 + e]; dst[FF + e] = eu_last[((size_t)hb * 2 + 1) * FF + c0 + e]; }
        }
    }
}
DI void cacheK_fill(Frame& F, int widx, int nw) {
    const Params& p = F.p;
    const int gt = widx * NTHR + F.tid, NGT = nw * NTHR;
    for (int it0 = gt; it0 < 32 * 512 * (D / 8); it0 += 4 * NGT) {
        f32x4 a[4], c[4];
#pragma unroll
        for (int j = 0; j < 4; ++j) { const int it = it0 + j * NGT; if (it < 32 * 512 * (D / 8)) { const int row = it >> 8, cc = (it & 255) * 8;
            a[j] = __builtin_nontemporal_load((const f32x4*)(p.cache_k + (size_t)row * D + cc)); c[j] = __builtin_nontemporal_load((const f32x4*)(p.cache_k + (size_t)row * D + cc + 4)); } }
#pragma unroll
        for (int j = 0; j < 4; ++j) { const int it = it0 + j * NGT; if (it < 32 * 512 * (D / 8)) { const int row = it >> 8, cc = (it & 255) * 8, b = row >> 9, jj = row & 511;
            u32x4 o; o.x = pk2(a[j].x, a[j].y); o.y = pk2(a[j].z, a[j].w); o.z = pk2(c[j].x, c[j].y); o.w = pk2(c[j].z, c[j].w);
            __builtin_nontemporal_store(o, (u32x4*)(F.KS + ((size_t)b * SROWS + jj) * D + cc)); } }
    }
}
constexpr int VT_NP = 2 * 64 * 16, VT_NN = 32 * 16, VT_NC = 32 * 16 * 8;
DI void vtrans_items(Frame& F, int it_lo, int it_hi, int widx, int nw) {
    const Params& p = F.p; const int lane = F.lane;
    LAS bf16* tile = (LAS bf16*)(F.lds + F.wave * 16640);
    for (int it = it_lo + widx * NWAVES + F.wave; it < it_hi; it += nw * NWAVES) {
        int nrows = 64; bf16* dst; int dstride;
        if (it < VT_NP) {
            const int h = it & 15, tb = (it >> 4) & 63, b = it >> 10;
            const bf16* src = F.QKV + (size_t)(b * SEQ + tb * 64) * NQKV + 2 * D + h * HD + 2 * lane;
            unsigned u[64];
#pragma unroll
            for (int i = 0; i < 64; ++i) u[i] = *(const unsigned*)(src + (size_t)i * NQKV);
#pragma unroll
            for (int i = 0; i < 64; ++i) *(LAS unsigned*)(tile + i * 130 + 2 * lane) = u[i];
            dst = F.VT + ((size_t)(b * 16 + h) * HD) * SEQ + tb * 64; dstride = SEQ;
        } else if (it < VT_NP + VT_NN) {
            const int r = it - VT_NP, h = r & 15, b = r >> 4;
            nrows = 32;
            const bf16* src = F.QKV + (size_t)(TP + b * 32) * NQKV + 2 * D + h * HD + 2 * lane;
            unsigned u[32];
#pragma unroll
            for (int i = 0; i < 32; ++i) u[i] = *(const unsigned*)(src + (size_t)i * NQKV);
#pragma unroll
            for (int i = 0; i < 32; ++i) *(LAS unsigned*)(tile + i * 130 + 2 * lane) = u[i];
            dst = F.VTS + ((size_t)(b * 16 + h) * HD) * SROWS + 512; dstride = SROWS;
        } else {
            const int r = it - VT_NP - VT_NN, h = r & 15, jb = (r >> 4) & 7, b = r >> 7;
            const float* src = p.cache_v + ((size_t)(b * 512 + jb * 64) * NH + h) * HD + 2 * lane;
#pragma unroll
            for (int hh = 0; hh < 2; ++hh) {
                f32x2 x[32];
#pragma unroll
                for (int i = 0; i < 32; ++i) x[i] = __builtin_nontemporal_load((const f32x2*)(src + (size_t)(32 * hh + i) * D));
#pragma unroll
                for (int i = 0; i < 32; ++i) *(LAS unsigned*)(tile + (32 * hh + i) * 130 + 2 * lane) = pk2(x[i].x, x[i].y);
            }
            dst = F.VTS + ((size_t)(b * 16 + h) * HD) * SROWS + jb * 64; dstride = SROWS;
        }
        asm volatile("s_waitcnt lgkmcnt(0)" ::: "memory");
        const int tp = lane & 31, dh = lane >> 5;
        if (2 * tp < nrows) {
#pragma unroll 8
            for (int pp = 0; pp < 64; ++pp) { const int dv = 2 * pp + dh;
                const unsigned lo = tile[(2 * tp) * 130 + dv], hi = tile[(2 * tp + 1) * 130 + dv];
                *(unsigned*)(dst + (size_t)dv * dstride + 2 * tp) = lo | (hi << 16); }
        }
        asm volatile("s_waitcnt lgkmcnt(0)" ::: "memory");
    }
}
DI void prep_phase(Frame& F) {
    const Params& p = F.p;
    const int gw = F.bid * NWAVES + F.wave, NGW = F.G * NWAVES, lane = F.lane;
    const float qscale = 0.08838834764831845f * 1.4426950408889634f;
    for (int m = gw; m < T; m += NGW) {
        const bf16* src = F.QKV + (size_t)m * NQKV + lane * 8;
        const bool smp = m >= TP; const int b = smp ? (m - TP) >> 5 : m >> 12, t = smp ? (m - TP) & 31 : m & 4095;
        const int hc = (lane & 15) * 8;
        u32x4 xq[4], xk[4], xv[4];
#pragma unroll
        for (int j = 0; j < 4; ++j) { xq[j] = *(const u32x4*)(src + j * 512); xk[j] = *(const u32x4*)(src + D + j * 512); xv[j] = *(const u32x4*)(src + 2 * D + j * 512); }
        float* ko = nullptr; float* vo = nullptr;
        if (smp) { ko = p.out + O_KSM + (size_t)(m - TP) * D + lane * 8; vo = p.out + O_VSM + (size_t)(m - TP) * D + lane * 8; }
        else if (t >= SEQ - 512) { ko = p.out + O_KP + ((size_t)b * 512 + (t - (SEQ - 512))) * D + lane * 8; vo = p.out + O_VP + ((size_t)b * 512 + (t - (SEQ - 512))) * D + lane * 8; }
        const f32x4 gq0 = *(const f32x4*)(p.b_q_norm + hc), gq1 = *(const f32x4*)(p.b_q_norm + hc + 4);
        const f32x4 gk0 = *(const f32x4*)(p.b_k_norm + hc), gk1 = *(const f32x4*)(p.b_k_norm + hc + 4);
        bf16* qdst = F.QB + (size_t)m * D + lane * 8;
        bf16* kdst = smp ? F.KS + ((size_t)b * SROWS + 512 + t) * D + lane * 8 : F.KN + (size_t)m * D + lane * 8;
#pragma unroll
        for (int j = 0; j < 4; ++j) {
            { const u32x4 x = xq[j]; const float v[8] = {bflo(x.x), bfhi(x.x), bflo(x.y), bfhi(x.y), bflo(x.z), bfhi(x.z), bflo(x.w), bfhi(x.w)};
              float ss = 0.f;
#pragma unroll
              for (int e = 0; e < 8; ++e) ss += v[e] * v[e];
              ss += __shfl_xor(ss, 1); ss += __shfl_xor(ss, 2); ss += __shfl_xor(ss, 4); ss += __shfl_xor(ss, 8);
              const float rstd = rsqrtf(ss * (1.f / HD) + EPS) * qscale;
              u32x4 o; o.x = pk2(v[0] * rstd * gq0.x, v[1] * rstd * gq0.y); o.y = pk2(v[2] * rstd * gq0.z, v[3] * rstd * gq0.w);
              o.z = pk2(v[4] * rstd * gq1.x, v[5] * rstd * gq1.y); o.w = pk2(v[6] * rstd * gq1.z, v[7] * rstd * gq1.w);
              *(u32x4*)(qdst + j * 512) = o; }
            { const u32x4 x = xk[j]; const float v[8] = {bflo(x.x), bfhi(x.x), bflo(x.y), bfhi(x.y), bflo(x.z), bfhi(x.z), bflo(x.w), bfhi(x.w)};
              float ss = 0.f;
#pragma unroll
              for (int e = 0; e < 8; ++e) ss += v[e] * v[e];
              ss += __shfl_xor(ss, 1); ss += __shfl_xor(ss, 2); ss += __shfl_xor(ss, 4); ss += __shfl_xor(ss, 8);
              const float rstd = rsqrtf(ss * (1.f / HD) + EPS);
              const f32x4 a = {v[0] * rstd * gk0.x, v[1] * rstd * gk0.y, v[2] * rstd * gk0.z, v[3] * rstd * gk0.w};
              const f32x4 c = {v[4] * rstd * gk1.x, v[5] * rstd * gk1.y, v[6] * rstd * gk1.z, v[7] * rstd * gk1.w};
              u32x4 o; o.x = pk2(a.x, a.y); o.y = pk2(a.z, a.w); o.z = pk2(c.x, c.y); o.w = pk2(c.z, c.w);
              *(u32x4*)(kdst + j * 512) = o;
              if (ko) { *(f32x4*)(ko + j * 512) = a; *(f32x4*)(ko + j * 512 + 4) = c; } }
            if (vo) { const u32x4 x = xv[j];
              const f32x4 a = {bflo(x.x), bfhi(x.x), bflo(x.y), bfhi(x.y)}, c = {bflo(x.z), bfhi(x.z), bflo(x.w), bfhi(x.w)};
              *(f32x4*)(vo + j * 512) = a; *(f32x4*)(vo + j * 512 + 4) = c; }
        }
    }
    vtrans_items(F, 0, VT_NP + VT_NN, F.bid, F.G);
}
DI void attn_scores(f32x16 (&oacc)[4], float& mrun, float& lsum, const bf16x8 (&qf)[8], const bf16x8 (&kf)[8], bf16x8 (&pfr)[2], int relb, const LAS float* bias, float bias0, int hf) {
    f32x16 s; for (int i = 0; i < 16; ++i) s[i] = 0.f;
#pragma unroll
    for (int kk = 0; kk < 8; ++kk) s = MFMA32(kf[kk], qf[kk], s);
    if (relb + 31 <= -128) {
#pragma unroll
        for (int i = 0; i < 16; ++i) s[i] += bias0;
    } else {
#pragma unroll
        for (int i = 0; i < 16; ++i) { int rel = relb + crow(i, hf); rel = rel < -128 ? -128 : (rel > 63 ? 63 : rel); s[i] += bias[rel + 128]; }
    }
    float mt = s[0];
#pragma unroll
    for (int i = 1; i < 16; ++i) mt = fmaxf(mt, s[i]);
    mt = fmaxf(mt, __shfl_xor(mt, 32));
    const float mnew = fmaxf(mrun, mt), alpha = __builtin_amdgcn_exp2f(mrun - mnew);
    mrun = mnew;
    float ps = 0.f; float pv[16];
#pragma unroll
    for (int i = 0; i < 16; ++i) { pv[i] = __builtin_amdgcn_exp2f(s[i] - mnew); ps += pv[i]; }
    lsum = lsum * alpha + ps;
#pragma unroll
    for (int bl = 0; bl < 4; ++bl)
#pragma unroll
        for (int i = 0; i < 16; ++i) oacc[bl][i] *= alpha;
#pragma unroll
    for (int kb = 0; kb < 2; ++kb) {
        u32x4 pb; pb.x = pk2(pv[8 * kb], pv[8 * kb + 1]); pb.y = pk2(pv[8 * kb + 2], pv[8 * kb + 3]); pb.z = pk2(pv[8 * kb + 4], pv[8 * kb + 5]); pb.w = pk2(pv[8 * kb + 6], pv[8 * kb + 7]);
        pfr[kb] = __builtin_bit_cast(bf16x8, pb);
    }
}
DI void attn_pv(f32x16 (&oacc)[4], const bf16x8 (&pfr)[2], const bf16x8 (&vf)[2][4]) {
#pragma unroll
    for (int kb = 0; kb < 2; ++kb)
#pragma unroll
        for (int bl = 0; bl < 4; ++bl) oacc[bl] = MFMA32(vf[kb][bl], pfr[kb], oacc[bl]);
}
DI void attn_step(f32x16 (&oacc)[4], float& mrun, float& lsum, const bf16x8 (&qf)[8], const bf16x8 (&kf)[8], const bf16x8 (&vf)[2][4], int relb, const LAS float* bias, float bias0, int hf) {
    bf16x8 pfr[2];
    attn_scores(oacc, mrun, lsum, qf, kf, pfr, relb, bias, bias0, hf);
    attn_pv(oacc, pfr, vf);
}
constexpr int AK_STRIDE = 136, AV_STRIDE = 72, A_KBYTES = 64 * AK_STRIDE * 2, A_VBYTES = 128 * AV_STRIDE * 2, A_BUF = A_KBYTES + A_VBYTES;
constexpr int A_BIAS_OFF = 135168;
static_assert(2 * A_BUF <= A_BIAS_OFF && 8 * 16384 + 8 * 256 <= A_BIAS_OFF && A_BIAS_OFF + 768 <= LDS_BYTES - 16, "attention lds");

DI void attn_phase(Frame& F) {
    const Params& p = F.p;
    const int lane = F.lane, w = F.wave, tid = F.tid, r = lane & 31, hf = lane >> 5;
    constexpr float L2E = 1.4426950408889634f;
    for (int su = F.bid; su < 512; su += F.G) {
        const int h = su & 15, b = su >> 4, qrow0 = TP + b * 32;
        const bf16* kbase = F.KS + (size_t)(b * SROWS) * D + h * HD; const bf16* vbase = F.VTS + ((size_t)(b * 16 + h) * HD) * SROWS;
        LAS float* bias = (LAS float*)(F.lds + A_BIAS_OFF);
        if (tid < 192) bias[tid] = p.b_rel_bias[tid * NH + h] * L2E;
        bf16x8 qf[8];
        { const bf16* qp = F.QB + (size_t)(qrow0 + r) * D + h * HD + 8 * hf;
#pragma unroll
          for (int kk = 0; kk < 8; ++kk) qf[kk] = *(const bf16x8*)(qp + 16 * kk); }
        f32x16 oacc[4];
#pragma unroll
        for (int bl = 0; bl < 4; ++bl) for (int i = 0; i < 16; ++i) oacc[bl][i] = 0.f;
        float mrun = -1e30f, lsum = 0.f;
        __syncthreads();
        const float bias0 = bias[0];
        for (int kt = w; kt < 17; kt += 8) {
            bf16x8 kf[8], vf[2][4];
            { const bf16* kp = kbase + (size_t)(32 * kt + r) * D + 8 * hf;
#pragma unroll
              for (int kk = 0; kk < 8; ++kk) kf[kk] = *(const bf16x8*)(kp + 16 * kk); }
#pragma unroll
            for (int kb = 0; kb < 2; ++kb)
#pragma unroll
                for (int bl = 0; bl < 4; ++bl) { const bf16* vp = vbase + (size_t)(32 * bl + r) * SROWS + 32 * kt + 16 * kb + 4 * hf;
                    const u32x2 v0 = *(const u32x2*)vp, v1 = *(const u32x2*)(vp + 8); u32x4 vv; vv.x = v0.x; vv.y = v0.y; vv.z = v1.x; vv.w = v1.y; vf[kb][bl] = __builtin_bit_cast(bf16x8, vv); }
            attn_step(oacc, mrun, lsum, qf, kf, vf, -512 + 32 * kt - r, bias, bias0, hf);
        }
        lsum += __shfl_xor(lsum, 32);
        LAS float* op = (LAS float*)(F.lds + w * 16384); LAS float* ml = (LAS float*)(F.lds + 8 * 16384 + w * 256);
#pragma unroll
        for (int bl = 0; bl < 4; ++bl)
#pragma unroll
            for (int i = 0; i < 16; ++i) op[(32 * bl + crow(i, hf)) * 32 + r] = oacc[bl][i];
        if (hf == 0) { ml[2 * r] = mrun; ml[2 * r + 1] = lsum; }
        __syncthreads();
        { const int q = tid & 31, dv0 = (tid >> 5) * 8;
          float mw[8], M = -1e30f;
#pragma unroll
          for (int ww = 0; ww < 8; ++ww) { mw[ww] = ((LAS float*)(F.lds + 8 * 16384 + ww * 256))[2 * q]; M = fmaxf(M, mw[ww]); }
          float o[8] = {0.f, 0.f, 0.f, 0.f, 0.f, 0.f, 0.f, 0.f}, L = 0.f;
#pragma unroll
          for (int ww = 0; ww < 8; ++ww) { const float sc = __builtin_amdgcn_exp2f(mw[ww] - M); L += sc * ((LAS float*)(F.lds + 8 * 16384 + ww * 256))[2 * q + 1];
              const LAS float* pp = (LAS float*)(F.lds + ww * 16384) + dv0 * 32 + q;
#pragma unroll
              for (int e = 0; e < 8; ++e) o[e] += sc * pp[e * 32]; }
          const float inv = 1.f / L;
          u32x4 ov; ov.x = pk2(o[0] * inv, o[1] * inv); ov.y = pk2(o[2] * inv, o[3] * inv); ov.z = pk2(o[4] * inv, o[5] * inv); ov.w = pk2(o[6] * inv, o[7] * inv);
          *(u32x4*)(F.HB + (size_t)(qrow0 + q) * D + h * HD + dv0) = ov; }
        __syncthreads();
    }
    const int vbid = (F.G % 8 == 0) ? (F.bid & 7) * (F.G >> 3) + (F.bid >> 3) : F.bid;
    for (int unit = vbid; unit < 512; unit += F.G) {
        const int cq = unit & 15, h = (unit >> 4) & 15, b = unit >> 8;
        const int cw = 4 * cq + (w >> 1), qrow0 = b * SEQ + cw * 64 + (w & 1) * 32;
        const int kc_lo = (4 * cq - 8) > 0 ? 4 * cq - 8 : 0, kc_hi = 4 * cq + 3;
        LAS float* bias = (LAS float*)(F.lds + A_BIAS_OFF);
        if (tid < 192) bias[tid] = p.b_rel_bias[tid * NH + h] * L2E;
        const bf16* kg = F.KN + (size_t)(b * SEQ) * D + h * HD;
        const bf16* vg = F.VT + ((size_t)(b * 16 + h) * HD) * SEQ;
        const int kr0 = tid >> 4, ks0 = tid & 15, vr0 = tid >> 3, vs0 = tid & 7;
        u32x4 stA[4], stB[4];
#define A_GLOAD(kc, st) do { st[0] = *(const u32x4*)(kg + (size_t)((kc) * 64 + kr0) * D + ks0 * 8); st[1] = *(const u32x4*)(kg + (size_t)((kc) * 64 + kr0 + 32) * D + ks0 * 8); \
                         st[2] = *(const u32x4*)(vg + (size_t)vr0 * SEQ + (kc) * 64 + vs0 * 8); st[3] = *(const u32x4*)(vg + (size_t)(vr0 + 64) * SEQ + (kc) * 64 + vs0 * 8); } while (0)
#define A_LWRITE(buf, st) do { LAS bf16* kb_ = (LAS bf16*)(F.lds + (buf) * A_BUF); LAS bf16* vb_ = (LAS bf16*)(F.lds + (buf) * A_BUF + A_KBYTES); \
                         *(LAS u32x4*)(kb_ + kr0 * AK_STRIDE + ks0 * 8) = st[0]; *(LAS u32x4*)(kb_ + (kr0 + 32) * AK_STRIDE + ks0 * 8) = st[1]; \
                         *(LAS u32x4*)(vb_ + vr0 * AV_STRIDE + vs0 * 8) = st[2]; *(LAS u32x4*)(vb_ + (vr0 + 64) * AV_STRIDE + vs0 * 8) = st[3]; } while (0)
#define A_COMPUTE(kc, cur) do { if ((kc) >= cw - 8 && (kc) <= cw) { \
                const LAS bf16* Kb = (const LAS bf16*)(F.lds + (cur) * A_BUF); const LAS bf16* Vb = (const LAS bf16*)(F.lds + (cur) * A_BUF + A_KBYTES); \
                _Pragma("unroll 1") for (int t = 0; t < 2; ++t) { \
                    bf16x8 pfr[2]; \
                    { bf16x8 kf[8]; \
                      _Pragma("unroll") for (int kk = 0; kk < 8; ++kk) kf[kk] = *(const LAS bf16x8*)(Kb + (32 * t + r) * AK_STRIDE + 16 * kk + 8 * hf); \
                      attn_scores(oacc, mrun, lsum, qf, kf, pfr, ((kc) * 64 + 32 * t) - (cw * 64 + (w & 1) * 32) - r, bias, bias0, hf); } \
                    { bf16x8 vf[2][4]; \
                      _Pragma("unroll") for (int kb = 0; kb < 2; ++kb) _Pragma("unroll") for (int bl = 0; bl < 4; ++bl) { const LAS bf16* vp = Vb + (32 * bl + r) * AV_STRIDE + 32 * t + 16 * kb + 4 * hf; \
                            const u32x2 v0 = *(const LAS u32x2*)vp, v1 = *(const LAS u32x2*)(vp + 8); u32x4 vv; vv.x = v0.x; vv.y = v0.y; vv.z = v1.x; vv.w = v1.y; vf[kb][bl] = __builtin_bit_cast(bf16x8, vv); } \
                      attn_pv(oacc, pfr, vf); } } } } while (0)
        A_GLOAD(kc_lo, stA);
        A_GLOAD(kc_lo + 1, stB);
        bf16x8 qf[8];
        { const bf16* qp = F.QB + (size_t)(qrow0 + r) * D + h * HD + 8 * hf;
#pragma unroll
          for (int kk = 0; kk < 8; ++kk) qf[kk] = *(const bf16x8*)(qp + 16 * kk); }
        f32x16 oacc[4];
#pragma unroll
        for (int bl = 0; bl < 4; ++bl) for (int i = 0; i < 16; ++i) oacc[bl][i] = 0.f;
        float mrun = -1e30f, lsum = 0.f;
        A_LWRITE(0, stA);
        __syncthreads();
        const float bias0 = bias[0];
        for (int kc = kc_lo; kc <= kc_hi; kc += 2) {
            if (kc + 2 <= kc_hi) A_GLOAD(kc + 2, stA);
            A_COMPUTE(kc, 0);
            A_LWRITE(1, stB);
            __syncthreads();
            if (kc + 3 <= kc_hi) A_GLOAD(kc + 3, stB);
            A_COMPUTE(kc + 1, 1);
            if (kc + 2 <= kc_hi) A_LWRITE(0, stA);
            __syncthreads();
        }
#undef A_GLOAD
#undef A_LWRITE
#undef A_COMPUTE
        lsum += __shfl_xor(lsum, 32);
        const float inv = 1.f / lsum;
        bf16* op = F.HB + (size_t)(qrow0 + r) * D + h * HD;
#pragma unroll
        for (int bl = 0; bl < 4; ++bl)
#pragma unroll
            for (int g4 = 0; g4 < 4; ++g4) {
                u32x2 o; o.x = pk2(oacc[bl][4 * g4] * inv, oacc[bl][4 * g4 + 1] * inv); o.y = pk2(oacc[bl][4 * g4 + 2] * inv, oacc[bl][4 * g4 + 3] * inv);
                *(u32x2*)(op + 32 * bl + 8 * g4 + 4 * hf) = o;
            }
    }
}

#define XB_TMO      128
#define XB_XCNT(j)  (256  + 64 * (j))
#define XB_XSUB(j)  (1280 + 64 * (j))
#define XB_XGEN(j)  (2304 + 64 * (j))
#define XB_TOP      3328
#define XB_TOPGEN   3392
#define XCD_BAR_WORDS 3456
#define XB_SPIN_CAP (1u << 18)
DI unsigned xb_ld(unsigned* p)              { return __hip_atomic_load(p, __ATOMIC_RELAXED, __HIP_MEMORY_SCOPE_AGENT); }
DI unsigned xb_add(unsigned* p, unsigned v) { return __hip_atomic_fetch_add(p, v, __ATOMIC_RELAXED, __HIP_MEMORY_SCOPE_AGENT); }
DI unsigned xb_xcc_id() { return (unsigned)__builtin_amdgcn_s_getreg((3 << 11) | 20) & 0xFu; }
#define XB_SPIN(cond, bar) do { unsigned _sp = 0; while (cond) { __builtin_amdgcn_s_sleep(1); \
    if ((++_sp & 255u) == 0u) { if (xb_ld(&(bar)[XB_TMO])) break; if (_sp > XB_SPIN_CAP) { atomicAdd(&(bar)[XB_TMO], 1u); break; } } } } while (0)
struct XcdBarrier { unsigned* bar; unsigned x; volatile LAS unsigned* st; };
DI XcdBarrier xcd_barrier_post(unsigned* bar, volatile LAS unsigned* st) {
    XcdBarrier b; b.bar = bar; b.x = xb_xcc_id(); b.st = st;
    if (threadIdx.x == 0) (void)xb_add(&bar[XB_XCNT(b.x)], 1u);
    return b;
}
DI void xcd_barrier_complete(unsigned* bar, unsigned x, unsigned& nloc, unsigned& nx) {
    const unsigned G = gridDim.x * gridDim.y * gridDim.z;
    unsigned sum, cnt, mine, sp = 0u;
    for (;;) {
        sum = 0u; cnt = 0u; mine = 0u;
#pragma unroll
        for (unsigned j = 0; j < 16; ++j) { const unsigned c = xb_ld(&bar[XB_XCNT(j)]); sum += c; cnt += (c > 0u) ? 1u : 0u; mine = (j == x) ? c : mine; }
        if (sum == G) break;
        __builtin_amdgcn_s_sleep(1);
        if ((++sp & 255u) == 0u) { if (xb_ld(&bar[XB_TMO])) break; if (sp > XB_SPIN_CAP) { atomicAdd(&bar[XB_TMO], 1u); break; } }
    }
    nloc = mine > 0u ? mine : 1u; nx = cnt > 0u ? cnt : 1u;
}
DI void xcd_barrier(const XcdBarrier& b) {
    asm volatile("s_waitcnt vmcnt(0)" ::: "memory");
    __syncthreads();
    if (threadIdx.x == 0) {
        unsigned* bar = b.bar;
        __builtin_amdgcn_s_waitcnt(0);
        unsigned nloc = b.st[0], nx = b.st[1];
        if (nloc == 0u) { xcd_barrier_complete(bar, b.x, nloc, nx); b.st[0] = nloc; b.st[1] = nx; }
        const unsigned old = xb_add(&bar[XB_XSUB(b.x)], 1u);
        const unsigned gen = old / nloc;
        if (old + 1u == (gen + 1u) * nloc) {
            __builtin_amdgcn_fence(__ATOMIC_RELEASE, "agent");
            asm volatile("s_waitcnt vmcnt(0)" ::: "memory");
            const unsigned og = xb_add(&bar[XB_TOP], 1u);
            const unsigned tg = og / nx;
            if (og + 1u == (tg + 1u) * nx) xb_add(&bar[XB_TOPGEN], 1u);
            else XB_SPIN(xb_ld(&bar[XB_TOPGEN]) == tg, bar);
            __builtin_amdgcn_fence(__ATOMIC_ACQUIRE, "agent");
            xb_add(&bar[XB_XGEN(b.x)], 1u);
            asm volatile("s_waitcnt vmcnt(0)" ::: "memory");
        } else {
            XB_SPIN(xb_ld(&bar[XB_XGEN(b.x)]) == gen, bar);
            __builtin_amdgcn_fence(__ATOMIC_ACQUIRE, "agent");
            asm volatile("s_waitcnt vmcnt(0)" ::: "memory");
        }
    }
    __syncthreads();
}

enum { PH_P0, PH_G1, PH_GLA_A, PH_SCAN, PH_GLA_C, PH_G2, PH_RMS_F0, PH_G3_0, PH_CONV0, PH_G4_0, PH_RMS_M1, PH_G5, PH_PREP, PH_ATTN, PH_G6, PH_RMS_F1, PH_G3_1, PH_CONV1, PH_G4_1, PH_FIN, NPH };

__global__ void __launch_bounds__(NTHR, 2) fwd_megakernel(Params prm) {
    extern __shared__ __attribute__((aligned(16))) unsigned char lds_raw[];
    cg::grid_group grid = cg::this_grid();
    float* const X0 = prm.out;
    volatile LAS unsigned* bst = (volatile LAS unsigned*)((LAS unsigned char*)lds_raw + (LDS_BYTES - 16));
    if (threadIdx.x < 4) bst[threadIdx.x] = 0u;
    __syncthreads();
    XcdBarrier xbar = xcd_barrier_post((unsigned*)(prm.ws + WS_BAR), bst);
    for (int ph = prm.ph_lo; ph < prm.ph_hi; ++ph) {
      for (int rep = 0, nrep = 1 + ((REP_MASK >> ph) & 1); rep < nrep; ++rep) {
        int tid_ = threadIdx.x; asm volatile("" : "+v"(tid_));
        size_t zoff = 0; asm volatile("" : "+s"(zoff));
        unsigned char* ws = prm.ws + zoff;
        float* X = X0 + zoff;
        Frame F;
        F.p = prm; F.lds = (LAS unsigned char*)lds_raw;
        F.tid = tid_; F.lane = F.tid & 63; F.wave = __builtin_amdgcn_readfirstlane(F.tid >> 6); F.G = gridDim.x; F.bid = blockIdx.x;
        F.WinA = (bf16*)(ws + WS_WINA); F.WoA = (bf16*)(ws + WS_WOA); F.Wqkv = (bf16*)(ws + WS_WQKV); F.WoB = (bf16*)(ws + WS_WOB);
        F.Fin0 = (bf16*)(ws + WS_FIN0); F.Fin1 = (bf16*)(ws + WS_FIN1); F.Fdn0 = (bf16*)(ws + WS_FDN0); F.Fdn1 = (bf16*)(ws + WS_FDN1);
        F.LB = (float*)(ws + WS_LB); F.HB = (bf16*)(ws + WS_HB); F.QB = (bf16*)(ws + WS_QB);
        F.LOGF = (float*)(ws + WS_LOGF); F.VB = (bf16*)(ws + WS_VB); F.SG = (bf16*)(ws + WS_SG); F.OI = (float*)(ws + WS_OI); F.LOCAL = (float*)(ws + WS_LOCAL); F.DEC = (float*)(ws + WS_DEC);
        F.QKV = (bf16*)(ws + WS_QKV); F.KN = (bf16*)(ws + WS_KN); F.KS = (bf16*)(ws + WS_KS); F.VT = (bf16*)(ws + WS_VT); F.VTS = (bf16*)(ws + WS_VTS);
        F.UP = (bf16*)(ws + WS_UP); F.ACT = (bf16*)(ws + WS_ACT);
        switch (ph) {
        case PH_P0: if (EN_MASK & 1) p0_phase(F); break;
        case PH_GLA_A: if (EN_MASK & 2) gla_a_phase(F); break;
        case PH_SCAN: if (EN_MASK & 4) scan_phase(F); break;
        case PH_GLA_C: if (EN_MASK & 8) gla_c_phase(F); break;
        case PH_RMS_F0: if (EN_MASK & 16) rms_phase(F, X, prm.x_sample, prm.norm_ffn, (const float*)(ws + WS_PART), X + (size_t)TP * D); break;
        case PH_RMS_M1: if (EN_MASK & 16) rms_phase(F, X, X + (size_t)TP * D, prm.norm_mix + D, (const float*)(ws + WS_PART), X + (size_t)TP * D); break;
        case PH_RMS_F1: if (EN_MASK & 16) rms_phase(F, X, X + (size_t)TP * D, prm.norm_ffn + D, (const float*)(ws + WS_PART), X + (size_t)TP * D); break;
        case PH_FIN: fin_phase(F, X + (size_t)TP * D, (const float*)(ws + WS_PART)); break;
        case PH_CONV0: if (EN_MASK & 32) convfix_phase(F, 0, (const float*)(ws + WS_PART)); break;
        case PH_CONV1: if (EN_MASK & 32) convfix_phase(F, 1, (const float*)(ws + WS_PART)); break;
        case PH_PREP: if (EN_MASK & 64) prep_phase(F); break;
        case PH_ATTN: if (EN_MASK & 128) attn_phase(F); break;
        default: if (EN_MASK & 256) {
            pg8::Gemm g; pg8::Epi E; E.mode = 2; E.cw = nullptr; E.cbias = nullptr; E.ldo = D; E.ob = nullptr; E.of = X; E.resP = X; E.resS = X + (size_t)TP * D;
            E.lb = F.LB; E.logf = F.LOGF; E.wsb = ws;
            g.A = F.HB; g.M = T; g.K = D; g.N = D; g.Bt = F.WoA;
            if (ph == PH_G1) { g.Bt = F.WinA; g.N = NWIN; E.mode = 0; }
            else if (ph == PH_G2) { g.Bt = F.WoA; E.resP = prm.x_prompt; E.resS = prm.x_sample; }
            else if (ph == PH_G3_0 || ph == PH_G3_1) { const int l = (ph == PH_G3_1); g.Bt = l ? F.Fin1 : F.Fin0; g.N = NUP; E.mode = 3; E.cw = prm.f_conv_w + (size_t)l * 3 * FF; E.cbias = prm.f_conv_b + (size_t)l * FF; }
            else if (ph == PH_G4_0 || ph == PH_G4_1) { g.A = F.ACT; g.Bt = (ph == PH_G4_1) ? F.Fdn1 : F.Fdn0; g.K = FF; }
            else if (ph == PH_G5) { g.Bt = F.Wqkv; g.N = NQKV; E.mode = 1; E.ob = F.QKV; E.ldo = NQKV; }
            else { g.Bt = F.WoB; }
            E.part = (float*)(ws + WS_PART); E.act = F.ACT; E.edge = (float*)(ws + WS_PART);
            pg8::StaticOrder S; S.init(g.M, g.N, g.K, F.G, F.bid, E.mode == 2);
            pg8::gemm_phase(F.lds, g, S, E, F.tid);
            if (ph == PH_G1 || ph == PH_G3_0 || ph == PH_G5) {
                const int rem = S.nitems % F.G;
                if (rem == 0 || F.bid >= rem) {
                    const int widx = rem ? F.bid - rem : F.bid, nw = rem ? F.G - rem : F.G;
                    if (ph == PH_G1) wconv_items(F, WC_EARLY, WC_ALL, widx, nw);
                    else if (ph == PH_G3_0) cacheK_fill(F, widx, nw);
                    else vtrans_items(F, VT_NP + VT_NN, VT_NP + VT_NN + VT_NC, widx, nw);
                }
            }
        } break;
        }
      }
        if (prm.ph_hi > 1000) grid.sync();
        if (ph + 1 < prm.ph_hi) xcd_barrier(xbar);
    }
}

extern "C" void kernel_launch(void* const* d_in, const int* in_sizes, int n_in, void* d_out, int out_size, void* d_ws, size_t ws_size, hipStream_t stream) {
    static int grid_blocks = 0;
    if (!grid_blocks) {
        int dev = 0, cus = 0, per_cu = 0;
        hipGetDevice(&dev);
        hipDeviceGetAttribute(&cus, hipDeviceAttributeMultiprocessorCount, dev);
        if (hipFuncSetAttribute((const void*)fwd_megakernel, hipFuncAttributeMaxDynamicSharedMemorySize, LDS_BYTES) != hipSuccess) fprintf(stderr, "kernel_launch: hipFuncSetAttribute failed\n");
        hipOccupancyMaxActiveBlocksPerMultiprocessor(&per_cu, (const void*)fwd_megakernel, NTHR, LDS_BYTES);
        if (per_cu < 1) per_cu = 1;
        if (per_cu > 1) per_cu = 1;
        grid_blocks = cus * per_cu;
        if (n_in != 21 || (size_t)out_size != O_END || ws_size < WS_END) fprintf(stderr, "kernel_launch: unexpected sizes n_in %d out %d ws %zu (need %zu)\n", n_in, out_size, ws_size, (size_t)WS_END);
    }
    Params p{};
    p.x_prompt = (const float*)d_in[0]; p.x_sample = (const float*)d_in[1]; p.state_a_S = (const float*)d_in[2]; p.cache_k = (const float*)d_in[3]; p.cache_v = (const float*)d_in[4];
    p.conv_state = (const float*)d_in[5]; p.norm_mix = (const float*)d_in[6]; p.norm_ffn = (const float*)d_in[7]; p.a_w_in = (const float*)d_in[8]; p.a_gamma = (const float*)d_in[9];
    p.a_norm_o = (const float*)d_in[10]; p.a_w_o = (const float*)d_in[11]; p.b_w_qkv = (const float*)d_in[12]; p.b_q_norm = (const float*)d_in[13]; p.b_k_norm = (const float*)d_in[14];
    p.b_rel_bias = (const float*)d_in[15]; p.b_w_o = (const float*)d_in[16]; p.f_w_in = (const float*)d_in[17]; p.f_conv_w = (const float*)d_in[18]; p.f_conv_b = (const float*)d_in[19];
    p.f_w_down = (const float*)d_in[20];
    p.out = (float*)d_out; p.ws = (unsigned char*)d_ws;
#if MK_N_LAUNCHES == 1
    p.ph_lo = 0; p.ph_hi = NPH;
    if (hipMemsetAsync((char*)d_ws + WS_BAR, 0, 16384, stream) != hipSuccess) fprintf(stderr, "kernel_launch: memset of barrier words failed\n");
    void* args[] = {&p};
    hipError_t e = hipLaunchCooperativeKernel((const void*)fwd_megakernel, dim3(grid_blocks), dim3(NTHR), args, LDS_BYTES, stream);
    if (e != hipSuccess) fprintf(stderr, "cooperative launch failed: %s (grid %d)\n", hipGetErrorString(e), grid_blocks);
#else
    for (int ph = 0; ph < NPH; ++ph) {
        p.ph_lo = ph; p.ph_hi = ph + 1;
        hipLaunchKernelGGL(fwd_megakernel, dim3(grid_blocks), dim3(NTHR), LDS_BYTES, stream, p);
    }
#endif
}
```

```cpp
#include <hip/hip_runtime.h>
#include <hip/hip_cooperative_groups.h>
#include <cstdio>
#include <cstdint>
namespace cg = cooperative_groups;

#define DI __device__ __forceinline__
#define LAS __attribute__((address_space(3)))
#define GAS __attribute__((address_space(1)))
typedef unsigned short bf16;
typedef short bf16x8 __attribute__((ext_vector_type(8)));
typedef float f32x2 __attribute__((ext_vector_type(2)));
typedef float f32x4 __attribute__((ext_vector_type(4)));
typedef float f32x16 __attribute__((ext_vector_type(16)));
typedef unsigned u32x2 __attribute__((ext_vector_type(2)));
typedef unsigned u32x4 __attribute__((ext_vector_type(4)));
typedef __bf16 bf16x2_t __attribute__((ext_vector_type(2)));

#ifndef EN_MASK
#define EN_MASK 0xffffu
#endif
#ifndef REP_MASK
#define REP_MASK 0
#endif
#ifndef MK_N_LAUNCHES
#define MK_N_LAUNCHES 1
#endif

constexpr int D = 2048, TP = 8192, TS = 1024, T = TP + TS, SEQ = 4096, NH = 16, HD = 128, FF = 5632;
constexpr int NQKV = 3 * D, NWIN = 4 * D, NUP = 2 * FF;
constexpr int SROWS = 544;
constexpr float EPS = 1e-6f;
constexpr int NWAVES = 8, NTHR = 512;
constexpr int LDS_BYTES = 147456;

constexpr size_t MiB = 1u << 20;
constexpr size_t WS_WINA = 0, WS_WOA = 32 * MiB, WS_WQKV = 40 * MiB, WS_WOB = 64 * MiB, WS_FIN0 = 72 * MiB, WS_FIN1 = 116 * MiB, WS_FDN0 = 160 * MiB, WS_FDN1 = 182 * MiB;
constexpr size_t WS_LB = 204 * MiB, WS_HB = 205 * MiB, WS_QB = 241 * MiB, WS_MIX = 277 * MiB;
constexpr size_t WS_LOGF = WS_MIX, WS_VB = WS_MIX + 72 * MiB, WS_SG = WS_MIX + 108 * MiB, WS_OI = WS_MIX + 144 * MiB, WS_LOCAL = WS_MIX + 216 * MiB, WS_DEC = WS_MIX + 376 * MiB;
constexpr size_t WS_KS = WS_MIX, WS_VTS = WS_MIX + 68 * MiB, WS_QKV = WS_MIX + 136 * MiB, WS_KN = WS_MIX + 244 * MiB, WS_VT = WS_MIX + 276 * MiB;
constexpr size_t WS_UP = WS_MIX + 136 * MiB, WS_ACT = WS_MIX + 136 * MiB;
constexpr size_t WS_PART = WS_MIX + 236 * MiB;
constexpr size_t WS_BAR = WS_LB + 64 * 1024;
constexpr size_t WS_END = WS_MIX + 378 * MiB;

constexpr size_t O_YP = 0, O_YS = O_YP + (size_t)TP * D, O_SP = O_YS + (size_t)TS * D, O_SS = O_SP + 2 * 16 * 128 * 128, O_KP = O_SS + 32 * 16 * 128 * 128,
                 O_VP = O_KP + 2 * 512 * 2048, O_KSM = O_VP + 2 * 512 * 2048, O_VSM = O_KSM + 32 * 32 * 2048, O_CP = O_VSM + 32 * 32 * 2048, O_CS = O_CP + 2 * 2 * 2 * FF,
                 O_END = O_CS + 2 * 32 * 2 * FF;

struct Params {
    const float* x_prompt; const float* x_sample; const float* state_a_S; const float* cache_k; const float* cache_v; const float* conv_state;
    const float* norm_mix; const float* norm_ffn; const float* a_w_in; const float* a_gamma; const float* a_norm_o; const float* a_w_o;
    const float* b_w_qkv; const float* b_q_norm; const float* b_k_norm; const float* b_rel_bias; const float* b_w_o;
    const float* f_w_in; const float* f_conv_w; const float* f_conv_b; const float* f_w_down;
    float* out; unsigned char* ws; int ph_lo, ph_hi;
};

DI unsigned pk2(float lo, float hi) { f32x2 v = {lo, hi}; return __builtin_bit_cast(unsigned, __builtin_convertvector(v, bf16x2_t)); }
DI bf16 f2bf(float f) { return (bf16)(pk2(f, 0.f) & 0xffffu); }
DI float bflo(unsigned p) { return __uint_as_float(p << 16); }
DI float bfhi(unsigned p) { return __uint_as_float(p & 0xffff0000u); }
DI float wave_sum(float v) {
#pragma unroll
    for (int o = 1; o < 64; o <<= 1) v += __shfl_xor(v, o);
    return v;
}
DI float fexp(float x) { return __builtin_amdgcn_exp2f(x * 1.4426950408889634f); }
DI float fsigmoid(float z) { return __builtin_amdgcn_rcpf(1.f + fexp(-z)); }
DI float fsilu(float z) { return z * __builtin_amdgcn_rcpf(1.f + fexp(-z)); }
DI float flog(float x) { return __builtin_amdgcn_logf(x) * 0.6931471805599453f; }
DI int crow(int reg, int h) { return (reg & 3) + 8 * (reg >> 2) + 4 * h; }
#define MFMA32(a, b, c) __builtin_amdgcn_mfma_f32_32x32x16_bf16((a), (b), (c), 0, 0, 0)

namespace pg8 {
constexpr int BM = 256, BK = 64, HALF = 128, HTB = HALF * BK * 2, STAGE_BYTES = 8 * HTB, NXCD = 8, WGM = 8;
DI int lds_byte(int r, int c) { const int st = (r >> 4) * 2 + (c >> 5), rr = r & 15, cc = c & 31, ob = rr * 64 + cc * 2; return st * 1024 + (ob ^ (((ob >> 9) & 1) << 5)); }
DI void stage_rc(int b, int& R, int& C) { const int st = b / 1024, sb = b % 1024, swz = sb ^ (((sb >> 9) & 1) << 5); R = (st >> 1) * 16 + swz / 64; C = (st & 1) * 32 + (swz % 64) / 2; }
DI int perm32(int rho) { const int n = rho >> 4, i = rho & 15; return 8 * (i >> 2) + 4 * n + (i & 3); }
struct Unit { int pm, pn, kb0, nkt, slice; };
struct Gemm { const bf16* A; const bf16* Bt; int M, N, K; };
struct StaticOrder {
    int nM, nN, nwg, G, c, tail, nblk, nitems;
    DI void init(int M, int N, int K, int G_, int c_, int tail_) { tail = tail_; nM = tail ? TP / BM : M / BM; nN = N / BM; nwg = nM * nN; G = G_; c = c_; nblk = K / 128; nitems = nwg + (tail ? 256 : 0); }
    DI bool next(int i, Unit& u) const {
        const long L = (long)i * G + c; if (L >= nitems) return false;
        u.slice = -1; u.kb0 = 0; u.nkt = nblk * 2;
        if (L >= nwg) { const int j = (int)L - nwg, uu = j & 31; u.slice = j >> 5; u.pm = TP / BM + (uu >> 3); u.pn = uu & 7;
            const int base = nblk / 8, rem = nblk % 8; u.kb0 = u.slice * base + (u.slice < rem ? u.slice : rem); u.nkt = 2 * (base + (u.slice < rem ? 1 : 0)); return true; }
        int wgid = (int)L; { const int q = nwg / NXCD, r = nwg % NXCD, xcd = wgid % NXCD, off = wgid / NXCD; wgid = (xcd < r ? xcd * (q + 1) : r * (q + 1) + (xcd - r) * q) + off; }
        const int nig = WGM * nN, gid = wgid / nig, fm = gid * WGM, gsz = (nM - fm) < WGM ? (nM - fm) : WGM;
        u.pm = fm + ((wgid % nig) % gsz); u.pn = (wgid % nig) / gsz; return true;
    }
};

struct Epi {
    int mode;
    int ldo;
    bf16* ob;
    float* of; const float* resP; const float* resS;
    const float* lb; float* logf; unsigned char* wsb;
    float* part;
    const float* cw; const float* cbias; bf16* act; float* edge;
    DI bool perm() const { return mode != 2; }
    DI void operator()(const f32x4 (&acc)[2][2][4][2], const Unit& u, int wr, int wc, int fr, int fq) const {
        const int row0 = u.pm * BM + wr * 64 + fr;
        if (mode == 2 && u.slice >= 0) {
            const int col0 = u.pn * BM + wc * 32 + 4 * fq;
#pragma unroll
            for (int ai = 0; ai < 2; ++ai)
#pragma unroll
                for (int m = 0; m < 4; ++m) {
                    float* op = part + ((size_t)u.slice * TS + (row0 + ai * HALF + m * 16 - TP)) * D + col0;
#pragma unroll
                    for (int bj = 0; bj < 2; ++bj)
#pragma unroll
                        for (int n = 0; n < 2; ++n) *(f32x4*)(op + bj * HALF + n * 16) = acc[ai][bj][m][n];
                }
        } else if (mode == 2) {
            const int col0 = u.pn * BM + wc * 32 + 4 * fq;
#pragma unroll
            for (int ai = 0; ai < 2; ++ai) {
                f32x4 rr[4][2][2];
#pragma unroll
                for (int m = 0; m < 4; ++m) {
                    const int row = row0 + ai * HALF + m * 16;
                    const float* rp = (row < TP ? resP + (size_t)row * D : resS + (size_t)(row - TP) * D) + col0;
#pragma unroll
                    for (int bj = 0; bj < 2; ++bj)
#pragma unroll
                        for (int n = 0; n < 2; ++n) rr[m][bj][n] = *(const f32x4*)(rp + bj * HALF + n * 16);
                }
#pragma unroll
                for (int m = 0; m < 4; ++m) {
                    float* op = of + (size_t)(row0 + ai * HALF + m * 16) * D + col0;
#pragma unroll
                    for (int bj = 0; bj < 2; ++bj)
#pragma unroll
                        for (int n = 0; n < 2; ++n) *(f32x4*)(op + bj * HALF + n * 16) = rr[m][bj][n] + acc[ai][bj][m][n];
                }
            }
        } else if (mode == 3) {
            const int cc0 = u.pn * HALF + wc * 32 + 8 * fq;
            float w0[8], w1[8], w2[8], cb[8];
            { const f32x4 a0 = *(const f32x4*)(cw + cc0), a1 = *(const f32x4*)(cw + cc0 + 4), b0 = *(const f32x4*)(cw + FF + cc0), b1 = *(const f32x4*)(cw + FF + cc0 + 4);
              const f32x4 c0 = *(const f32x4*)(cw + 2 * FF + cc0), c1 = *(const f32x4*)(cw + 2 * FF + cc0 + 4), d0 = *(const f32x4*)(cbias + cc0), d1 = *(const f32x4*)(cbias + cc0 + 4);
#pragma unroll
              for (int e = 0; e < 4; ++e) { w0[e] = a0[e]; w0[4 + e] = a1[e]; w1[e] = b0[e]; w1[4 + e] = b1[e]; w2[e] = c0[e]; w2[4 + e] = c1[e]; cb[e] = d0[e]; cb[4 + e] = d1[e]; } }
            float* const eu_first = edge; float* const eg_first = edge + (size_t)(T / 32) * 2 * FF; float* const eu_last = edge + (size_t)(T / 32) * 4 * FF;
#pragma unroll
            for (int ai = 0; ai < 2; ++ai)
#pragma unroll
                for (int m = 0; m < 4; ++m) {
                    const int row = row0 + ai * HALF + m * 16, hb = row >> 5;
                    float a[8];
#pragma unroll
                    for (int n = 0; n < 2; ++n)
#pragma unroll
                        for (int e = 0; e < 4; ++e) {
                            const float cur = acc[ai][0][m][n][e];
                            const float prv = (m & 1) ? acc[ai][0][m - 1][n][e] : 0.f;
                            const int ci = __float_as_int(cur), pi = __float_as_int(prv);
                            const int r1 = __builtin_amdgcn_update_dpp(0, pi, 0x121, 0xf, 0xf, false), r2 = __builtin_amdgcn_update_dpp(0, pi, 0x122, 0xf, 0xf, false);
                            const float p1 = __int_as_float(__builtin_amdgcn_update_dpp(r1, ci, 0x111, 0xf, 0xf, false));
                            const float p2 = __int_as_float(__builtin_amdgcn_update_dpp(r2, ci, 0x112, 0xf, 0xf, false));
                            const int k = 4 * n + e;
                            a[k] = fsilu(cb[k] + p2 * w0[k] + p1 * w1[k] + cur * w2[k]) * acc[ai][1][m][n][e];
                        }
                    const bool first2 = ((m & 1) == 0) && (fr < 2), last2 = ((m & 1) == 1) && (fr >= 14);
                    if (!first2) { u32x4 o; o.x = pk2(a[0], a[1]); o.y = pk2(a[2], a[3]); o.z = pk2(a[4], a[5]); o.w = pk2(a[6], a[7]); *(u32x4*)(act + (size_t)row * FF + cc0) = o; }
                    else { float* du = eu_first + ((size_t)hb * 2 + fr) * FF + cc0; float* dg = eg_first + ((size_t)hb * 2 + fr) * FF + cc0;
                        *(f32x4*)du = acc[ai][0][m][0]; *(f32x4*)(du + 4) = acc[ai][0][m][1]; *(f32x4*)dg = acc[ai][1][m][0]; *(f32x4*)(dg + 4) = acc[ai][1][m][1]; }
                    if (last2) { float* du = eu_last + ((size_t)hb * 2 + (fr - 14)) * FF + cc0; *(f32x4*)du = acc[ai][0][m][0]; *(f32x4*)(du + 4) = acc[ai][0][m][1]; }
                }
        } else if (mode == 1) {
            const int col0 = u.pn * BM + wc * 32 + 8 * fq;
#pragma unroll
            for (int ai = 0; ai < 2; ++ai)
#pragma unroll
                for (int m = 0; m < 4; ++m) {
                    bf16* op = ob + (size_t)(row0 + ai * HALF + m * 16) * ldo + col0;
#pragma unroll
                    for (int bj = 0; bj < 2; ++bj) { const f32x4 v0 = acc[ai][bj][m][0], v1 = acc[ai][bj][m][1];
                        u32x4 o; o.x = pk2(v0.x, v0.y); o.y = pk2(v0.z, v0.w); o.z = pk2(v1.x, v1.y); o.w = pk2(v1.z, v1.w);
                        *(u32x4*)(op + bj * HALF) = o; }
                }
        } else {
            const int type = u.pn >> 3, col0 = (u.pn & 7) * BM + wc * 32 + 8 * fq;
#pragma unroll
            for (int bj = 0; bj < 2; ++bj) {
                const int col = col0 + bj * HALF;
                f32x4 l0 = {0.f, 0.f, 0.f, 0.f}, l1 = l0;
                if (type == 1) { l0 = *(const f32x4*)(lb + col); l1 = *(const f32x4*)(lb + col + 4); }
#pragma unroll
                for (int ai = 0; ai < 2; ++ai)
#pragma unroll
                    for (int m = 0; m < 4; ++m) {
                        const size_t off = (size_t)(row0 + ai * HALF + m * 16) * D + col;
                        f32x4 v0 = acc[ai][bj][m][0], v1 = acc[ai][bj][m][1];
                        if (type == 1) {
#pragma unroll
                            for (int e = 0; e < 4; ++e) { v0[e] = flog(l0[e] + (1.f - l0[e]) * fsigmoid(v0[e])); v1[e] = flog(l1[e] + (1.f - l1[e]) * fsigmoid(v1[e])); }
                            *(f32x4*)(logf + off) = v0; *(f32x4*)(logf + off + 4) = v1;
                        } else {
                            if (type == 3) {
#pragma unroll
                                for (int e = 0; e < 4; ++e) { v0[e] = fsilu(v0[e]); v1[e] = fsilu(v1[e]); }
                            }
                            u32x4 o; o.x = pk2(v0.x, v0.y); o.y = pk2(v0.z, v0.w); o.z = pk2(v1.x, v1.y); o.w = pk2(v1.z, v1.w);
                            bf16* dst = (bf16*)(wsb + (type == 0 ? WS_QB : (type == 2 ? WS_VB : WS_SG)));
                            *(u32x4*)(dst + off) = o;
                        }
                    }
            }
        }
    }
};

DI void gemm_phase(LAS unsigned char* lds, const Gemm g, const StaticOrder& S, const Epi& E, const int tid) {
    const int wid = __builtin_amdgcn_readfirstlane(tid >> 6), lane = tid & 63, wr = wid >> 2, wc = wid & 3, fr = lane & 15, fq = lane >> 4;
    const int K = g.K;
    const bool PERM = E.perm();
    unsigned voffA[2], voffB[2];
#pragma unroll
    for (int i = 0; i < 2; ++i) { int R, C; stage_rc(tid * 16 + i * 8192, R, C); const int Rb = PERM ? ((R & ~31) + perm32(R & 31)) : R;
        voffA[i] = (unsigned)(R * K + C) * 2u; voffB[i] = (unsigned)(Rb * K + C) * 2u; }
    const size_t kstep = (size_t)(BK * 2);
    const size_t hstep = (size_t)HALF * K * 2;
    const size_t tstep = 2 * hstep;
    const unsigned ldsw = (unsigned)wid * 1024u;
    const int aoff = lds_byte(wr * 64 + fr, fq * 8), boff = lds_byte(wc * 32 + fr, fq * 8);
#define PG8_SA(b, h) (((b) * 2 + (h)) * HTB)
#define PG8_SB(b, h) ((4 + (b) * 2 + (h)) * HTB)
#define PG8_STAGE(bufoff, gbase, voff) do { _Pragma("unroll") for (int _i = 0; _i < 2; ++_i) \
        __builtin_amdgcn_global_load_lds((const unsigned*)((const char*)(gbase) + (voff)[_i]), (LAS unsigned*)(lds + (bufoff) + ldsw + _i * 8192), 16, 0, 0); } while (0)
#define PG8_LDA(dst, b, h) do { _Pragma("unroll") for (int m = 0; m < 4; ++m) _Pragma("unroll") for (int k = 0; k < 2; ++k) dst[m][k] = *(const LAS bf16x8*)(lds + PG8_SA(b, h) + aoff + m * 2048 + k * 1024); } while (0)
#define PG8_LDB(dst, b, h) do { _Pragma("unroll") for (int n = 0; n < 2; ++n) _Pragma("unroll") for (int k = 0; k < 2; ++k) dst[n][k] = *(const LAS bf16x8*)(lds + PG8_SB(b, h) + boff + n * 2048 + k * 1024); } while (0)
#define PG8_MMA(ai, bj, At, Bt) do { __builtin_amdgcn_s_setprio(1); _Pragma("unroll") for (int m = 0; m < 4; ++m) _Pragma("unroll") for (int n = 0; n < 2; ++n) _Pragma("unroll") for (int k = 0; k < 2; ++k) \
        acc[ai][bj][m][n] = __builtin_amdgcn_mfma_f32_16x16x32_bf16(Bt[n][k], At[m][k], acc[ai][bj][m][n], 0, 0, 0); __builtin_amdgcn_s_setprio(0); } while (0)
#define PG8_WAIT_V(n) asm volatile("s_waitcnt vmcnt(" #n ")" ::: "memory")
#define PG8_WAIT_L(n) asm volatile("s_waitcnt lgkmcnt(" #n ")" ::: "memory")
#define PG8_BAR __builtin_amdgcn_s_barrier()
#define PG8_SCHED __builtin_amdgcn_sched_barrier(0)
    Unit cur, nxt; int ui = 0;
    if (!S.next(0, cur)) return;
    f32x4 acc[2][2][4][2];
#pragma unroll
    for (int a = 0; a < 2; ++a)
#pragma unroll
        for (int b = 0; b < 2; ++b)
#pragma unroll
            for (int m = 0; m < 4; ++m)
#pragma unroll
                for (int n = 0; n < 2; ++n) acc[a][b][m][n] = (f32x4){0.f, 0.f, 0.f, 0.f};
    bf16x8 At[4][2], B0[2][2], B1[2][2];
    const char* cA = (const char*)g.A + (size_t)cur.pm * tstep + (size_t)cur.kb0 * 256; const char* cB = (const char*)g.Bt + (size_t)cur.pn * tstep + (size_t)cur.kb0 * 256;
    PG8_STAGE(PG8_SB(0, 0), cB, voffB); PG8_STAGE(PG8_SB(0, 1), cB + hstep, voffB); PG8_STAGE(PG8_SA(0, 0), cA, voffA); PG8_STAGE(PG8_SA(0, 1), cA + hstep, voffA);
    if (wr == 1) PG8_BAR;
    PG8_WAIT_V(2); PG8_BAR;
    PG8_STAGE(PG8_SB(1, 0), cB + kstep, voffB); PG8_STAGE(PG8_SA(1, 0), cA + kstep, voffA); PG8_STAGE(PG8_SB(1, 1), cB + hstep + kstep, voffB);
    PG8_WAIT_V(6); PG8_BAR;
    for (;;) {
        const bool has_next = S.next(ui + 1, nxt);
        const char* nA = has_next ? (const char*)g.A + (size_t)nxt.pm * tstep + (size_t)nxt.kb0 * 256 : cA; const char* nB = has_next ? (const char*)g.Bt + (size_t)nxt.pn * tstep + (size_t)nxt.kb0 * 256 : cB;
        const int nt = cur.nkt;
        for (int t = 0; t < nt; t += 2) {
            const bool last = (t == nt - 2);
            const char* a1 = cA + (size_t)(t + 1) * kstep;
            const char* a2 = last ? nA : cA + (size_t)(t + 2) * kstep; const char* b2 = last ? nB : cB + (size_t)(t + 2) * kstep;
            const char* a3 = a2 + kstep; const char* b3 = b2 + kstep;
            PG8_LDB(B0, 0, 0); PG8_LDB(B1, 0, 1); PG8_SCHED; PG8_LDA(At, 0, 0); PG8_STAGE(PG8_SA(1, 1), a1 + hstep, voffA);
            PG8_WAIT_V(8); PG8_WAIT_L(0); PG8_BAR; PG8_MMA(0, 0, At, B0); PG8_MMA(0, 1, At, B1); PG8_BAR; PG8_SCHED;
            PG8_LDA(At, 0, 1); PG8_STAGE(PG8_SB(0, 0), b2, voffB); PG8_STAGE(PG8_SB(0, 1), b2 + hstep, voffB); PG8_STAGE(PG8_SA(0, 0), a2, voffA);
            PG8_WAIT_V(8); PG8_WAIT_L(0); PG8_BAR; PG8_MMA(1, 0, At, B0); PG8_MMA(1, 1, At, B1); PG8_BAR; PG8_SCHED;
            PG8_LDB(B0, 1, 0); PG8_LDB(B1, 1, 1); PG8_SCHED; PG8_LDA(At, 1, 0); PG8_STAGE(PG8_SA(0, 1), a2 + hstep, voffA);
            PG8_WAIT_V(8); PG8_WAIT_L(0); PG8_BAR; PG8_MMA(0, 0, At, B0); PG8_MMA(0, 1, At, B1); PG8_BAR; PG8_SCHED;
            PG8_LDA(At, 1, 1); PG8_STAGE(PG8_SB(1, 0), b3, voffB); PG8_STAGE(PG8_SB(1, 1), b3 + hstep, voffB); PG8_STAGE(PG8_SA(1, 0), a3, voffA);
            PG8_WAIT_V(8); PG8_WAIT_L(0); PG8_BAR; PG8_MMA(1, 0, At, B0); PG8_MMA(1, 1, At, B1); PG8_BAR; PG8_SCHED;
        }
        if (wr == 0) PG8_BAR;
        E(acc, cur, wr, wc, fr, fq);
        if (!has_next) break;
#pragma unroll
        for (int a = 0; a < 2; ++a)
#pragma unroll
            for (int b = 0; b < 2; ++b)
#pragma unroll
                for (int m = 0; m < 4; ++m)
#pragma unroll
                    for (int n = 0; n < 2; ++n) acc[a][b][m][n] = (f32x4){0.f, 0.f, 0.f, 0.f};
        cur = nxt; cA = nA; cB = nB; ++ui;
        if (wr == 1) PG8_BAR;
    }
    PG8_WAIT_V(0);
    PG8_BAR;
#undef PG8_SA
#undef PG8_SB
#undef PG8_STAGE
#undef PG8_LDA
#undef PG8_LDB
#undef PG8_MMA
#undef PG8_WAIT_V
#undef PG8_WAIT_L
#undef PG8_BAR
#undef PG8_SCHED
}
}

struct Frame {
    Params p; LAS unsigned char* lds; int tid, lane, wave, G, bid;
    bf16 *WinA, *WoA, *Wqkv, *WoB, *Fin0, *Fin1, *Fdn0, *Fdn1;
    float* LB; bf16 *HB, *QB;
    float* LOGF; bf16 *VB, *SG; float *OI, *LOCAL, *DEC;
    bf16 *QKV, *KN, *KS, *VT, *VTS, *UP, *ACT;
};

DI void transpose_item(const float* __restrict__ W, int K, int N, bf16* __restrict__ WT, LAS float* scr, int item, int lane, const bool ilv = false) {
    const int nblk = N / 64, kb = item / nblk, nb = item % nblk, k0 = 64 * kb, n0 = 64 * nb;
    const int lr = lane >> 4, lc = (lane & 15) * 4;
    f32x4 v[16];
    const float* src = W + (size_t)(k0 + lr) * N + n0 + lc;
#pragma unroll
    for (int i = 0; i < 16; ++i) v[i] = __builtin_nontemporal_load((const f32x4*)(src + (size_t)(4 * i) * N));
#pragma unroll
    for (int i = 0; i < 16; ++i) { LAS float* d = scr + (4 * i + lr) * 65 + lc; d[0] = v[i].x; d[1] = v[i].y; d[2] = v[i].z; d[3] = v[i].w; }
    asm volatile("s_waitcnt lgkmcnt(0)" ::: "memory");
    const int c = lane & 7;
#pragma unroll
    for (int j = 0; j < 8; ++j) { const int n = (lane >> 3) + 8 * j; const LAS float* s = scr + (8 * c) * 65 + n;
        u32x4 o; o.x = pk2(s[0 * 65], s[1 * 65]); o.y = pk2(s[2 * 65], s[3 * 65]); o.z = pk2(s[4 * 65], s[5 * 65]); o.w = pk2(s[6 * 65], s[7 * 65]);
        int nd = n0 + n; if (ilv) nd = (nd < FF) ? (((nd >> 7) << 8) + (nd & 127)) : ((((nd - FF) >> 7) << 8) + 128 + ((nd - FF) & 127));
        __builtin_nontemporal_store(o, (u32x4*)(WT + (size_t)nd * K + k0 + 8 * c)); }
    asm volatile("s_waitcnt lgkmcnt(0)" ::: "memory");
}
DI void rms_row(const float* __restrict__ xrow, const float* __restrict__ g, bf16* __restrict__ orow, int lane, const float* __restrict__ part, float* __restrict__ xdst) {
    const f32x4* xr = (const f32x4*)xrow + lane; const f32x4* gr = (const f32x4*)g + lane;
    f32x4 v[8]; float s = 0.f;
#pragma unroll
    for (int j = 0; j < 8; ++j) v[j] = xr[64 * j];
    if (part) {
#pragma unroll
        for (int sl = 0; sl < 8; ++sl) { const f32x4* pr = (const f32x4*)(part + (size_t)sl * TS * D) + lane;
#pragma unroll
            for (int j = 0; j < 8; ++j) v[j] += pr[64 * j]; }
#pragma unroll
        for (int j = 0; j < 8; ++j) ((f32x4*)xdst + lane)[64 * j] = v[j];
    }
#pragma unroll
    for (int j = 0; j < 8; ++j) s += (v[j].x * v[j].x + v[j].y * v[j].y) + (v[j].z * v[j].z + v[j].w * v[j].w);
    const float rstd = rsqrtf(wave_sum(s) * (1.f / D) + EPS);
    u32x2* o8 = (u32x2*)orow + lane;
#pragma unroll
    for (int j = 0; j < 8; ++j) { const f32x4 gg = gr[64 * j]; u32x2 o; o.x = pk2(v[j].x * rstd * gg.x, v[j].y * rstd * gg.y); o.y = pk2(v[j].z * rstd * gg.z, v[j].w * rstd * gg.w); o8[64 * j] = o; }
}
DI void rms_phase(Frame& F, const float* srcP, const float* srcS, const float* g, const float* part, float* xs) {
    const int gw = F.bid * NWAVES + F.wave, NGW = F.G * NWAVES;
    for (int m = gw; m < T; m += NGW) {
        if (m < TP) rms_row(srcP + (size_t)m * D, g, F.HB + (size_t)m * D, F.lane, nullptr, nullptr);
        else rms_row(srcS + (size_t)(m - TP) * D, g, F.HB + (size_t)m * D, F.lane, part ? part + (size_t)(m - TP) * D : nullptr, xs + (size_t)(m - TP) * D);
    }
}
DI void fin_phase(Frame& F, float* xs, const float* part) {
    const int gt = F.bid * NTHR + F.tid, NGT = F.G * NTHR;
    for (int it = gt; it < TS * D / 4; it += NGT) {
        f32x4 v = ((const f32x4*)xs)[it];
#pragma unroll
        for (int sl = 0; sl < 8; ++sl) v += ((const f32x4*)(part + (size_t)sl * TS * D))[it];
        ((f32x4*)xs)[it] = v;
    }
}
constexpr int I_WINA = (D / 64) * (NWIN / 64), I_WO = (D / 64) * (D / 64), I_QKV = (D / 64) * (NQKV / 64), I_FIN = (D / 64) * (NUP / 64), I_FDN = (FF / 64) * (D / 64);
constexpr int WC_EARLY = I_WINA + 2 * I_WO + I_QKV + I_FIN + I_FDN, WC_ALL = WC_EARLY + I_FIN + I_FDN;
DI void wconv_items(Frame& F, int it_lo, int it_hi, int widx, int nw) {
    const Params& p = F.p;
    LAS float* scr = (LAS float*)(F.lds + F.wave * 16640);
    for (int it = it_lo + widx * NWAVES + F.wave; it < it_hi; it += nw * NWAVES) {
        int r = it;
        if (r < I_WINA) { transpose_item(p.a_w_in, D, NWIN, F.WinA, scr, r, F.lane); continue; } r -= I_WINA;
        if (r < I_WO) { transpose_item(p.a_w_o, D, D, F.WoA, scr, r, F.lane); continue; } r -= I_WO;
        if (r < I_QKV) { transpose_item(p.b_w_qkv, D, NQKV, F.Wqkv, scr, r, F.lane); continue; } r -= I_QKV;
        if (r < I_WO) { transpose_item(p.b_w_o, D, D, F.WoB, scr, r, F.lane); continue; } r -= I_WO;
        if (r < I_FIN) { transpose_item(p.f_w_in, D, NUP, F.Fin0, scr, r, F.lane, true); continue; } r -= I_FIN;
        if (r < I_FDN) { transpose_item(p.f_w_down, FF, D, F.Fdn0, scr, r, F.lane); continue; } r -= I_FDN;
        if (r < I_FIN) { transpose_item(p.f_w_in + (size_t)D * NUP, D, NUP, F.Fin1, scr, r, F.lane, true); continue; } r -= I_FIN;
        transpose_item(p.f_w_down + (size_t)FF * D, FF, D, F.Fdn1, scr, r, F.lane);
    }
}
DI void p0_phase(Frame& F) {
    const Params& p = F.p;
    wconv_items(F, 0, WC_EARLY, F.bid, F.G);
    for (int c = F.bid * NTHR + F.tid; c < D; c += F.G * NTHR) {
        const float g0 = p.a_gamma[c], g1 = p.a_gamma[D + c], g2 = p.a_gamma[2 * D + c];
        const float mx = fmaxf(g0, fmaxf(g1, g2));
        const float e0 = __expf(g0 - mx), e1 = __expf(g1 - mx), e2 = __expf(g2 - mx);
        F.LB[c] = e0 / (e0 + e1 + e2);
    }
    rms_phase(F, p.x_prompt, p.x_sample, p.norm_mix, nullptr, nullptr);
}

constexpr int GLA_UNITS = 2048 + 512;
constexpr int QT_STRIDE = 136, TT_STRIDE = 72;
constexpr int L_BCUM = 0, L_QT = 32768, L_KT = L_QT + 64 * QT_STRIDE * 2, L_KHT = L_KT + 64 * QT_STRIDE * 2, L_VT = L_KHT + 128 * TT_STRIDE * 2, L_PM = L_VT + 128 * TT_STRIDE * 2, L_GLA_END = L_PM + 64 * TT_STRIDE * 2;
static_assert(L_GLA_END <= LDS_BYTES, "gla lds");

DI f32x16 mma_lds(const LAS bf16* A, int astride, int arow0, const LAS bf16* B, int bstride, int brow0, int nks, int lane) {
    f32x16 acc; for (int i = 0; i < 16; ++i) acc[i] = 0.f;
    const int r = lane & 31, hf = lane >> 5;
    const LAS bf16* ap = A + (arow0 + r) * astride + 8 * hf; const LAS bf16* bp = B + (brow0 + r) * bstride + 8 * hf;
    for (int ks = 0; ks < nks; ++ks) { const bf16x8 a = *(const LAS bf16x8*)(ap + 16 * ks), b = *(const LAS bf16x8*)(bp + 16 * ks); acc = MFMA32(a, b, acc); }
    return acc;
}

template <int BLK>
DI void gla_a_unit(Frame& F, int u, int row0, int h) {
    LAS float* bcum = (LAS float*)(F.lds + L_BCUM);
    LAS bf16* qt = (LAS bf16*)(F.lds + L_QT); LAS bf16* kt = (LAS bf16*)(F.lds + L_KT); LAS bf16* khT = (LAS bf16*)(F.lds + L_KHT);
    LAS bf16* vT = (LAS bf16*)(F.lds + L_VT); LAS bf16* Pm = (LAS bf16*)(F.lds + L_PM);
    const int tid = F.tid, lane = F.lane, w = F.wave;
    const size_t hoff = (size_t)h * HD;
    constexpr int SEG = BLK / 4;
    { const int seg = tid >> 7, kc = tid & 127; float a = 0.f;
      const float* lp = F.LOGF + (size_t)(row0 + seg * SEG) * D + hoff + kc;
#pragma unroll
      for (int t = 0; t < SEG; ++t) { a += lp[(size_t)t * D]; bcum[(seg * SEG + t) * 128 + kc] = a; }
      __syncthreads();
      float off = 0.f;
      for (int s = 0; s < seg; ++s) off += bcum[(s * SEG + SEG - 1) * 128 + kc];
      __syncthreads();
      if (seg > 0) {
#pragma unroll
          for (int t = 0; t < SEG; ++t) bcum[(seg * SEG + t) * 128 + kc] += off;
      }
      __syncthreads(); }
    for (int i = tid; i < BLK * 16; i += NTHR) {
        const int t = i >> 4, c0 = (i & 15) * 8;
        const size_t goff = (size_t)(row0 + t) * D + hoff + c0;
        const u32x4 qv = *(const u32x4*)(F.QB + goff);
        const u32x4 vv = *(const u32x4*)(F.VB + goff);
        const f32x4 lf0 = *(const f32x4*)(F.LOGF + goff), lf1 = *(const f32x4*)(F.LOGF + goff + 4);
        float q[8] = {bflo(qv.x), bfhi(qv.x), bflo(qv.y), bfhi(qv.y), bflo(qv.z), bfhi(qv.z), bflo(qv.w), bfhi(qv.w)};
        float lf[8] = {lf0.x, lf0.y, lf0.z, lf0.w, lf1.x, lf1.y, lf1.z, lf1.w};
        float qtv[8], ktv[8], qhv[8], khv[8];
#pragma unroll
        for (int e = 0; e < 8; ++e) {
            const float b = bcum[t * 128 + c0 + e], bmid = bcum[(BLK / 2 - 1) * 128 + c0 + e], bend = bcum[(BLK - 1) * 128 + c0 + e];
            const float kk = 1.f - __expf(lf[e]);
            qtv[e] = q[e] * __expf(b - bmid); ktv[e] = kk * __expf(bmid - b); qhv[e] = q[e] * __expf(b); khv[e] = kk * __expf(bend - b);
            if (t == BLK - 1) F.DEC[(size_t)u * 128 + c0 + e] = __expf(bend);
        }
        u32x4 o; o.x = pk2(qtv[0], qtv[1]); o.y = pk2(qtv[2], qtv[3]); o.z = pk2(qtv[4], qtv[5]); o.w = pk2(qtv[6], qtv[7]);
        *(LAS u32x4*)(qt + t * QT_STRIDE + c0) = o;
        o.x = pk2(ktv[0], ktv[1]); o.y = pk2(ktv[2], ktv[3]); o.z = pk2(ktv[4], ktv[5]); o.w = pk2(ktv[6], ktv[7]);
        *(LAS u32x4*)(kt + t * QT_STRIDE + c0) = o;
        o.x = pk2(qhv[0], qhv[1]); o.y = pk2(qhv[2], qhv[3]); o.z = pk2(qhv[4], qhv[5]); o.w = pk2(qhv[6], qhv[7]);
        *(u32x4*)(F.QB + goff) = o;
        const unsigned vw[4] = {vv.x, vv.y, vv.z, vv.w};
#pragma unroll
        for (int e = 0; e < 8; ++e) {
            khT[(c0 + e) * TT_STRIDE + t] = f2bf(khv[e]);
            vT[(c0 + e) * TT_STRIDE + t] = (bf16)((e & 1) ? (vw[e >> 1] >> 16) : (vw[e >> 1] & 0xffffu));
        }
    }
    __syncthreads();
    const int r = lane & 31, hf = lane >> 5;
#pragma unroll
    for (int q2 = 0; q2 < 2; ++q2) {
        const int tl = w * 2 + q2, mt = tl >> 2, nt = tl & 3;
        const f32x16 acc = mma_lds(khT, TT_STRIDE, 32 * mt, vT, TT_STRIDE, 32 * nt, BLK / 16, lane);
        float* lp = F.LOCAL + (size_t)u * 16384 + 32 * nt + r;
#pragma unroll
        for (int i = 0; i < 16; ++i) lp[(size_t)(32 * mt + crow(i, hf)) * 128] = acc[i];
    }
    constexpr int NT2 = BLK / 32;
    if (w < NT2 * NT2) {
        const int mt = w / NT2, nt = w % NT2;
        if (nt > mt) {
#pragma unroll
            for (int i = 0; i < 16; ++i) Pm[(32 * mt + crow(i, hf)) * TT_STRIDE + 32 * nt + r] = 0;
        } else {
            const f32x16 acc = mma_lds(qt, QT_STRIDE, 32 * mt, kt, QT_STRIDE, 32 * nt, 8, lane);
#pragma unroll
            for (int i = 0; i < 16; ++i) { const int t = 32 * mt + crow(i, hf), s = 32 * nt + r; Pm[t * TT_STRIDE + s] = (s <= t) ? f2bf(acc[i]) : (bf16)0; }
        }
    }
    __syncthreads();
    if (w < NT2 * 4) {
        const int mt = w >> 2, nt = w & 3;
        const f32x16 acc = mma_lds(Pm, TT_STRIDE, 32 * mt, vT, TT_STRIDE, 32 * nt, BLK / 16, lane);
        float* op = F.OI + (size_t)(row0 + 32 * mt) * D + hoff + 32 * nt + r;
#pragma unroll
        for (int i = 0; i < 16; ++i) op[(size_t)crow(i, hf) * D] = acc[i];
    }
    __syncthreads();
}
DI void gla_a_phase(Frame& F) {
    for (int u = F.bid; u < GLA_UNITS; u += F.G) {
        if (u < 2048) { const int b = u >> 10, h = (u >> 6) & 15, c = u & 63; gla_a_unit<64>(F, u, b * SEQ + c * 64, h); }
        else { const int su = u - 2048, b = su >> 4, h = su & 15; gla_a_unit<32>(F, u, TP + b * 32, h); }
    }
}
DI void scan_phase(Frame& F) {
    const int gt = F.bid * NTHR + F.tid, NGT = F.G * NTHR;
    for (int it = gt; it < 32 * 4096; it += NGT) {
        const int bh = it >> 12, e = (it & 4095) * 4, kc = e >> 7;
        f32x4 S = {0.f, 0.f, 0.f, 0.f};
        float* __restrict__ lp = F.LOCAL + (size_t)(bh * 64) * 16384 + e; const float* __restrict__ dp = F.DEC + (size_t)(bh * 64) * 128 + kc;
        for (int c0 = 0; c0 < 64; c0 += 8) {
            f32x4 loc[8]; float d[8];
#pragma unroll
            for (int j = 0; j < 8; ++j) { loc[j] = *(const f32x4*)(lp + (size_t)(c0 + j) * 16384); d[j] = dp[(c0 + j) * 128]; }
#pragma unroll
            for (int j = 0; j < 8; ++j) { *(f32x4*)(lp + (size_t)(c0 + j) * 16384) = S; S = S * d[j] + loc[j]; }
        }
        *(f32x4*)(F.p.out + O_SP + (size_t)bh * 16384 + e) = S;
    }
    for (int it0 = gt; it0 < 512 * 4096; it0 += 4 * NGT) {
        f32x4 S0[4], loc[4]; float d[4];
#pragma unroll
        for (int j = 0; j < 4; ++j) { const int it = it0 + j * NGT; if (it < 512 * 4096) { const int bh = it >> 12, e = (it & 4095) * 4, kc = e >> 7;
            S0[j] = *(const f32x4*)(F.p.state_a_S + (size_t)bh * 16384 + e); loc[j] = *(const f32x4*)(F.LOCAL + (size_t)(2048 + bh) * 16384 + e); d[j] = F.DEC[(size_t)(2048 + bh) * 128 + kc]; } }
#pragma unroll
        for (int j = 0; j < 4; ++j) { const int it = it0 + j * NGT; if (it < 512 * 4096) { const int bh = it >> 12, e = (it & 4095) * 4;
            *(f32x4*)(F.p.out + O_SS + (size_t)bh * 16384 + e) = S0[j] * d[j] + loc[j]; } }
    }
}
constexpr int OB_STRIDE = 132;
template <int BLK>
DI void gla_c_unit(Frame& F, const float* __restrict__ S, int row0, int h) {
    LAS float* ob = (LAS float*)F.lds;
    const int tid = F.tid, lane = F.lane, w = F.wave, r = lane & 31, hf = lane >> 5;
    const size_t hoff = (size_t)h * HD;
    constexpr int TPR_ = NTHR / BLK, CPT_ = 128 / TPR_;
    u32x4 sgv[CPT_ / 8];
    { const int t = tid / TPR_, c0 = (tid % TPR_) * CPT_;
#pragma unroll
      for (int e8 = 0; e8 < CPT_ / 8; ++e8) sgv[e8] = *(const u32x4*)(F.SG + (size_t)(row0 + t) * D + hoff + c0 + 8 * e8); }
    if (w < (BLK / 32) * 4) {
        const int mt = w >> 2, nt = w & 3;
        f32x16 acc; for (int i = 0; i < 16; ++i) acc[i] = 0.f;
        float oiv[16];
        { const float* oi = F.OI + (size_t)(row0 + 32 * mt) * D + hoff + 32 * nt + r;
#pragma unroll
          for (int i = 0; i < 16; ++i) oiv[i] = oi[(size_t)crow(i, hf) * D]; }
        const bf16* ap = F.QB + (size_t)(row0 + 32 * mt + r) * D + hoff + 8 * hf;
        const float* sp = S + (size_t)(8 * hf) * 128 + 32 * nt + r;
#pragma unroll
        for (int ks = 0; ks < 8; ++ks) {
            const bf16x8 a = *(const bf16x8*)(ap + 16 * ks);
            float sv[8];
#pragma unroll
            for (int e = 0; e < 8; ++e) sv[e] = sp[(size_t)(16 * ks + e) * 128];
            u32x4 bb; bb.x = pk2(sv[0], sv[1]); bb.y = pk2(sv[2], sv[3]); bb.z = pk2(sv[4], sv[5]); bb.w = pk2(sv[6], sv[7]);
            acc = MFMA32(a, __builtin_bit_cast(bf16x8, bb), acc);
        }
#pragma unroll
        for (int i = 0; i < 16; ++i) { const int t = crow(i, hf); ob[(32 * mt + t) * OB_STRIDE + 32 * nt + r] = acc[i] + oiv[i]; }
    }
    __syncthreads();
    {
        constexpr int TPR = NTHR / BLK;
        constexpr int CPT = 128 / TPR;
        const int t = tid / TPR, j = tid % TPR, c0 = j * CPT;
        float v[CPT]; float ss = 0.f;
#pragma unroll
        for (int e = 0; e < CPT; ++e) { v[e] = ob[t * OB_STRIDE + c0 + e]; ss += v[e] * v[e]; }
#pragma unroll
        for (int o = 1; o < TPR; o <<= 1) ss += __shfl_xor(ss, o);
        const float rstd = rsqrtf(ss * (1.f / HD) + EPS);
        const size_t goff = (size_t)(row0 + t) * D + hoff + c0;
#pragma unroll
        for (int e8 = 0; e8 < CPT / 8; ++e8) {
            const u32x4 sg = sgv[e8];
            const f32x4 n0 = *(const f32x4*)(F.p.a_norm_o + c0 + 8 * e8), n1 = *(const f32x4*)(F.p.a_norm_o + c0 + 8 * e8 + 4);
            const float* vv = v + 8 * e8;
            u32x4 o;
            o.x = pk2(vv[0] * rstd * n0.x * bflo(sg.x), vv[1] * rstd * n0.y * bfhi(sg.x));
            o.y = pk2(vv[2] * rstd * n0.z * bflo(sg.y), vv[3] * rstd * n0.w * bfhi(sg.y));
            o.z = pk2(vv[4] * rstd * n1.x * bflo(sg.z), vv[5] * rstd * n1.y * bfhi(sg.z));
            o.w = pk2(vv[6] * rstd * n1.z * bflo(sg.w), vv[7] * rstd * n1.w * bfhi(sg.w));
            *(u32x4*)(F.HB + goff + 8 * e8) = o;
        }
    }
    __syncthreads();
}
DI void gla_c_phase(Frame& F) {
    for (int u = F.bid; u < GLA_UNITS; u += F.G) {
        if (u < 2048) { const int b = u >> 10, h = (u >> 6) & 15, c = u & 63; gla_c_unit<64>(F, F.LOCAL + (size_t)u * 16384, b * SEQ + c * 64, h); }
        else { const int su = u - 2048, b = su >> 4, h = su & 15; gla_c_unit<32>(F, F.p.state_a_S + (size_t)su * 16384, TP + b * 32, h); }
    }
}
DI void convfix_phase(Frame& F, int layer, const float* edge) {
    const Params& p = F.p;
    const int gt = F.bid * NTHR + F.tid, NGT = F.G * NTHR;
    constexpr int NCG = FF / 8, NHB = T / 32;
    const float* cw = p.f_conv_w + (size_t)layer * 3 * FF; const float* cbp = p.f_conv_b + (size_t)layer * FF;
    const float* eu_first = edge; const float* eg_first = edge + (size_t)NHB * 2 * FF; const float* eu_last = edge + (size_t)NHB * 4 * FF;
    for (int it = gt; it < NHB * NCG; it += NGT) {
        const int hb = it / NCG, c0 = (it % NCG) * 8;
        const bool smp = hb >= 256; const bool first = smp || ((hb & 127) == 0), lastb = smp || ((hb & 127) == 127);
        float um2[8], um1[8], u0[8], u1[8], g0[8], g1[8], w0[8], w1[8], w2[8], bb[8];
#pragma unroll
        for (int e = 0; e < 8; ++e) { w0[e] = cw[c0 + e]; w1[e] = cw[FF + c0 + e]; w2[e] = cw[2 * FF + c0 + e]; bb[e] = cbp[c0 + e]; um2[e] = 0.f; um1[e] = 0.f;
            u0[e] = eu_first[((size_t)hb * 2) * FF + c0 + e]; u1[e] = eu_first[((size_t)hb * 2 + 1) * FF + c0 + e];
            g0[e] = eg_first[((size_t)hb * 2) * FF + c0 + e]; g1[e] = eg_first[((size_t)hb * 2 + 1) * FF + c0 + e]; }
        if (first) {
            if (smp) { const float* st = p.conv_state + ((size_t)(layer * 32 + (hb - 256)) * 2) * FF + c0;
#pragma unroll
                for (int e = 0; e < 8; ++e) { um2[e] = st[e]; um1[e] = st[FF + e]; } }
        } else {
#pragma unroll
            for (int e = 0; e < 8; ++e) { um2[e] = eu_last[((size_t)(hb - 1) * 2) * FF + c0 + e]; um1[e] = eu_last[((size_t)(hb - 1) * 2 + 1) * FF + c0 + e]; }
        }
        float a0[8], a1[8];
#pragma unroll
        for (int e = 0; e < 8; ++e) { a0[e] = fsilu(bb[e] + um2[e] * w0[e] + um1[e] * w1[e] + u0[e] * w2[e]) * g0[e]; a1[e] = fsilu(bb[e] + um1[e] * w0[e] + u0[e] * w1[e] + u1[e] * w2[e]) * g1[e]; }
        u32x4 o; o.x = pk2(a0[0], a0[1]); o.y = pk2(a0[2], a0[3]); o.z = pk2(a0[4], a0[5]); o.w = pk2(a0[6], a0[7]);
        *(u32x4*)(F.ACT + (size_t)(hb * 32) * FF + c0) = o;
        o.x = pk2(a1[0], a1[1]); o.y = pk2(a1[2], a1[3]); o.z = pk2(a1[4], a1[5]); o.w = pk2(a1[6], a1[7]);
        *(u32x4*)(F.ACT + (size_t)(hb * 32 + 1) * FF + c0) = o;
        if (lastb) {
            float* dst = smp ? p.out + O_CS + ((size_t)(layer * 32 + (hb - 256)) * 2) * FF + c0 : p.out + O_CP + ((size_t)(layer * 2 + (hb >> 7)) * 2) * FF + c0;
#pragma unroll
            for (int e = 0; e < 8; ++e) { dst[e] = eu_last[((size_t)hb * 2) * FF + c0 + e]; dst[FF + e] = eu_last[((size_t)hb * 2 + 1) * FF + c0 + e]; }
        }
    }
}
DI void cacheK_fill(Frame& F, int widx, int nw) {
    const Params& p = F.p;
    const int gt = widx * NTHR + F.tid, NGT = nw * NTHR;
    for (int it0 = gt; it0 < 32 * 512 * (D / 8); it0 += 4 * NGT) {
        f32x4 a[4], c[4];
#pragma unroll
        for (int j = 0; j < 4; ++j) { const int it = it0 + j * NGT; if (it < 32 * 512 * (D / 8)) { const int row = it >> 8, cc = (it & 255) * 8;
            a[j] = __builtin_nontemporal_load((const f32x4*)(p.cache_k + (size_t)row * D + cc)); c[j] = __builtin_nontemporal_load((const f32x4*)(p.cache_k + (size_t)row * D + cc + 4)); } }
#pragma unroll
        for (int j = 0; j < 4; ++j) { const int it = it0 + j * NGT; if (it < 32 * 512 * (D / 8)) { const int row = it >> 8, cc = (it & 255) * 8, b = row >> 9, jj = row & 511;
            u32x4 o; o.x = pk2(a[j].x, a[j].y); o.y = pk2(a[j].z, a[j].w); o.z = pk2(c[j].x, c[j].y); o.w = pk2(c[j].z, c[j].w);
            __builtin_nontemporal_store(o, (u32x4*)(F.KS + ((size_t)b * SROWS + jj) * D + cc)); } }
    }
}
constexpr int VT_NP = 2 * 64 * 16, VT_NN = 32 * 16, VT_NC = 32 * 16 * 8;
DI void vtrans_items(Frame& F, int it_lo, int it_hi, int widx, int nw) {
    const Params& p = F.p; const int lane = F.lane;
    LAS bf16* tile = (LAS bf16*)(F.lds + F.wave * 16640);
    for (int it = it_lo + widx * NWAVES + F.wave; it < it_hi; it += nw * NWAVES) {
        int nrows = 64; bf16* dst; int dstride;
        if (it < VT_NP) {
            const int h = it & 15, tb = (it >> 4) & 63, b = it >> 10;
            const bf16* src = F.QKV + (size_t)(b * SEQ + tb * 64) * NQKV + 2 * D + h * HD + 2 * lane;
            unsigned u[64];
#pragma unroll
            for (int i = 0; i < 64; ++i) u[i] = *(const unsigned*)(src + (size_t)i * NQKV);
#pragma unroll
            for (int i = 0; i < 64; ++i) *(LAS unsigned*)(tile + i * 130 + 2 * lane) = u[i];
            dst = F.VT + ((size_t)(b * 16 + h) * HD) * SEQ + tb * 64; dstride = SEQ;
        } else if (it < VT_NP + VT_NN) {
            const int r = it - VT_NP, h = r & 15, b = r >> 4;
            nrows = 32;
            const bf16* src = F.QKV + (size_t)(TP + b * 32) * NQKV + 2 * D + h * HD + 2 * lane;
            unsigned u[32];
#pragma unroll
            for (int i = 0; i < 32; ++i) u[i] = *(const unsigned*)(src + (size_t)i * NQKV);
#pragma unroll
            for (int i = 0; i < 32; ++i) *(LAS unsigned*)(tile + i * 130 + 2 * lane) = u[i];
            dst = F.VTS + ((size_t)(b * 16 + h) * HD) * SROWS + 512; dstride = SROWS;
        } else {
            const int r = it - VT_NP - VT_NN, h = r & 15, jb = (r >> 4) & 7, b = r >> 7;
            const float* src = p.cache_v + ((size_t)(b * 512 + jb * 64) * NH + h) * HD + 2 * lane;
#pragma unroll
            for (int hh = 0; hh < 2; ++hh) {
                f32x2 x[32];
#pragma unroll
                for (int i = 0; i < 32; ++i) x[i] = __builtin_nontemporal_load((const f32x2*)(src + (size_t)(32 * hh + i) * D));
#pragma unroll
                for (int i = 0; i < 32; ++i) *(LAS unsigned*)(tile + (32 * hh + i) * 130 + 2 * lane) = pk2(x[i].x, x[i].y);
            }
            dst = F.VTS + ((size_t)(b * 16 + h) * HD) * SROWS + jb * 64; dstride = SROWS;
        }
        asm volatile("s_waitcnt lgkmcnt(0)" ::: "memory");
        const int tp = lane & 31, dh = lane >> 5;
        if (2 * tp < nrows) {
#pragma unroll 8
            for (int pp = 0; pp < 64; ++pp) { const int dv = 2 * pp + dh;
                const unsigned lo = tile[(2 * tp) * 130 + dv], hi = tile[(2 * tp + 1) * 130 + dv];
                *(unsigned*)(dst + (size_t)dv * dstride + 2 * tp) = lo | (hi << 16); }
        }
        asm volatile("s_waitcnt lgkmcnt(0)" ::: "memory");
    }
}
DI void prep_phase(Frame& F) {
    const Params& p = F.p;
    const int gw = F.bid * NWAVES + F.wave, NGW = F.G * NWAVES, lane = F.lane;
    const float qscale = 0.08838834764831845f * 1.4426950408889634f;
    for (int m = gw; m < T; m += NGW) {
        const bf16* src = F.QKV + (size_t)m * NQKV + lane * 8;
        const bool smp = m >= TP; const int b = smp ? (m - TP) >> 5 : m >> 12, t = smp ? (m - TP) & 31 : m & 4095;
        const int hc = (lane & 15) * 8;
        u32x4 xq[4], xk[4], xv[4];
#pragma unroll
        for (int j = 0; j < 4; ++j) { xq[j] = *(const u32x4*)(src + j * 512); xk[j] = *(const u32x4*)(src + D + j * 512); xv[j] = *(const u32x4*)(src + 2 * D + j * 512); }
        float* ko = nullptr; float* vo = nullptr;
        if (smp) { ko = p.out + O_KSM + (size_t)(m - TP) * D + lane * 8; vo = p.out + O_VSM + (size_t)(m - TP) * D + lane * 8; }
        else if (t >= SEQ - 512) { ko = p.out + O_KP + ((size_t)b * 512 + (t - (SEQ - 512))) * D + lane * 8; vo = p.out + O_VP + ((size_t)b * 512 + (t - (SEQ - 512))) * D + lane * 8; }
        const f32x4 gq0 = *(const f32x4*)(p.b_q_norm + hc), gq1 = *(const f32x4*)(p.b_q_norm + hc + 4);
        const f32x4 gk0 = *(const f32x4*)(p.b_k_norm + hc), gk1 = *(const f32x4*)(p.b_k_norm + hc + 4);
        bf16* qdst = F.QB + (size_t)m * D + lane * 8;
        bf16* kdst = smp ? F.KS + ((size_t)b * SROWS + 512 + t) * D + lane * 8 : F.KN + (size_t)m * D + lane * 8;
#pragma unroll
        for (int j = 0; j < 4; ++j) {
            { const u32x4 x = xq[j]; const float v[8] = {bflo(x.x), bfhi(x.x), bflo(x.y), bfhi(x.y), bflo(x.z), bfhi(x.z), bflo(x.w), bfhi(x.w)};
              float ss = 0.f;
#pragma unroll
              for (int e = 0; e < 8; ++e) ss += v[e] * v[e];
              ss += __shfl_xor(ss, 1); ss += __shfl_xor(ss, 2); ss += __shfl_xor(ss, 4); ss += __shfl_xor(ss, 8);
              const float rstd = rsqrtf(ss * (1.f / HD) + EPS) * qscale;
              u32x4 o; o.x = pk2(v[0] * rstd * gq0.x, v[1] * rstd * gq0.y); o.y = pk2(v[2] * rstd * gq0.z, v[3] * rstd * gq0.w);
              o.z = pk2(v[4] * rstd * gq1.x, v[5] * rstd * gq1.y); o.w = pk2(v[6] * rstd * gq1.z, v[7] * rstd * gq1.w);
              *(u32x4*)(qdst + j * 512) = o; }
            { const u32x4 x = xk[j]; const float v[8] = {bflo(x.x), bfhi(x.x), bflo(x.y), bfhi(x.y), bflo(x.z), bfhi(x.z), bflo(x.w), bfhi(x.w)};
              float ss = 0.f;
#pragma unroll
              for (int e = 0; e < 8; ++e) ss += v[e] * v[e];
              ss += __shfl_xor(ss, 1); ss += __shfl_xor(ss, 2); ss += __shfl_xor(ss, 4); ss += __shfl_xor(ss, 8);
              const float rstd = rsqrtf(ss * (1.f / HD) + EPS);
              const f32x4 a = {v[0] * rstd * gk0.x, v[1] * rstd * gk0.y, v[2] * rstd * gk0.z, v[3] * rstd * gk0.w};
              const f32x4 c = {v[4] * rstd * gk1.x, v[5] * rstd * gk1.y, v[6] * rstd * gk1.z, v[7] * rstd * gk1.w};
              u32x4 o; o.x = pk2(a.x, a.y); o.y = pk2(a.z, a.w); o.z = pk2(c.x, c.y); o.w = pk2(c.z, c.w);
              *(u32x4*)(kdst + j * 512) = o;
              if (ko) { *(f32x4*)(ko + j * 512) = a; *(f32x4*)(ko + j * 512 + 4) = c; } }
            if (vo) { const u32x4 x = xv[j];
              const f32x4 a = {bflo(x.x), bfhi(x.x), bflo(x.y), bfhi(x.y)}, c = {bflo(x.z), bfhi(x.z), bflo(x.w), bfhi(x.w)};
              *(f32x4*)(vo + j * 512) = a; *(f32x4*)(vo + j * 512 + 4) = c; }
        }
    }
    vtrans_items(F, 0, VT_NP + VT_NN, F.bid, F.G);
}
DI void attn_scores(f32x16 (&oacc)[4], float& mrun, float& lsum, const bf16x8 (&qf)[8], const bf16x8 (&kf)[8], bf16x8 (&pfr)[2], int relb, const LAS float* bias, float bias0, int hf) {
    f32x16 s; for (int i = 0; i < 16; ++i) s[i] = 0.f;
#pragma unroll
    for (int kk = 0; kk < 8; ++kk) s = MFMA32(kf[kk], qf[kk], s);
    if (relb + 31 <= -128) {
#pragma unroll
        for (int i = 0; i < 16; ++i) s[i] += bias0;
    } else {
#pragma unroll
        for (int i = 0; i < 16; ++i) { int rel = relb + crow(i, hf); rel = rel < -128 ? -128 : (rel > 63 ? 63 : rel); s[i] += bias[rel + 128]; }
    }
    float mt = s[0];
#pragma unroll
    for (int i = 1; i < 16; ++i) mt = fmaxf(mt, s[i]);
    mt = fmaxf(mt, __shfl_xor(mt, 32));
    constexpr float DEFER_THR = 8.f;
    if (__any(mt - mrun > DEFER_THR)) {
        const float mnew = fmaxf(mrun, mt), alpha = __builtin_amdgcn_exp2f(mrun - mnew);
        mrun = mnew; lsum *= alpha;
#pragma unroll
        for (int bl = 0; bl < 4; ++bl)
#pragma unroll
            for (int i = 0; i < 16; ++i) oacc[bl][i] *= alpha;
    }
    float ps = 0.f; float pv[16];
#pragma unroll
    for (int i = 0; i < 16; ++i) { pv[i] = __builtin_amdgcn_exp2f(s[i] - mrun); ps += pv[i]; }
    lsum += ps;
#pragma unroll
    for (int kb = 0; kb < 2; ++kb) {
        u32x4 pb; pb.x = pk2(pv[8 * kb], pv[8 * kb + 1]); pb.y = pk2(pv[8 * kb + 2], pv[8 * kb + 3]); pb.z = pk2(pv[8 * kb + 4], pv[8 * kb + 5]); pb.w = pk2(pv[8 * kb + 6], pv[8 * kb + 7]);
        pfr[kb] = __builtin_bit_cast(bf16x8, pb);
    }
}
DI void attn_pv(f32x16 (&oacc)[4], const bf16x8 (&pfr)[2], const bf16x8 (&vf)[2][4]) {
#pragma unroll
    for (int kb = 0; kb < 2; ++kb)
#pragma unroll
        for (int bl = 0; bl < 4; ++bl) oacc[bl] = MFMA32(vf[kb][bl], pfr[kb], oacc[bl]);
}
DI void attn_step(f32x16 (&oacc)[4], float& mrun, float& lsum, const bf16x8 (&qf)[8], const bf16x8 (&kf)[8], const bf16x8 (&vf)[2][4], int relb, const LAS float* bias, float bias0, int hf) {
    bf16x8 pfr[2];
    attn_scores(oacc, mrun, lsum, qf, kf, pfr, relb, bias, bias0, hf);
    attn_pv(oacc, pfr, vf);
}
constexpr int AK_STRIDE = 136, AV_STRIDE = 72, A_KBYTES = 64 * AK_STRIDE * 2, A_VBYTES = 128 * AV_STRIDE * 2, A_BUF = A_KBYTES + A_VBYTES;
constexpr int A_BIAS_OFF = 135168;
static_assert(2 * A_BUF <= A_BIAS_OFF && 8 * 16384 + 8 * 256 <= A_BIAS_OFF && A_BIAS_OFF + 768 <= LDS_BYTES - 16, "attention lds");

DI void attn_phase(Frame& F) {
    const Params& p = F.p;
    const int lane = F.lane, w = F.wave, tid = F.tid, r = lane & 31, hf = lane >> 5;
    constexpr float L2E = 1.4426950408889634f;
    for (int su = F.bid; su < 512; su += F.G) {
        const int h = su & 15, b = su >> 4, qrow0 = TP + b * 32;
        const bf16* kbase = F.KS + (size_t)(b * SROWS) * D + h * HD; const bf16* vbase = F.VTS + ((size_t)(b * 16 + h) * HD) * SROWS;
        LAS float* bias = (LAS float*)(F.lds + A_BIAS_OFF);
        if (tid < 192) bias[tid] = p.b_rel_bias[tid * NH + h] * L2E;
        bf16x8 qf[8];
        { const bf16* qp = F.QB + (size_t)(qrow0 + r) * D + h * HD + 8 * hf;
#pragma unroll
          for (int kk = 0; kk < 8; ++kk) qf[kk] = *(const bf16x8*)(qp + 16 * kk); }
        f32x16 oacc[4];
#pragma unroll
        for (int bl = 0; bl < 4; ++bl) for (int i = 0; i < 16; ++i) oacc[bl][i] = 0.f;
        float mrun = -1e30f, lsum = 0.f;
        __syncthreads();
        const float bias0 = bias[0];
        for (int kt = w; kt < 17; kt += 8) {
            bf16x8 kf[8], vf[2][4];
            { const bf16* kp = kbase + (size_t)(32 * kt + r) * D + 8 * hf;
#pragma unroll
              for (int kk = 0; kk < 8; ++kk) kf[kk] = *(const bf16x8*)(kp + 16 * kk); }
#pragma unroll
            for (int kb = 0; kb < 2; ++kb)
#pragma unroll
                for (int bl = 0; bl < 4; ++bl) { const bf16* vp = vbase + (size_t)(32 * bl + r) * SROWS + 32 * kt + 16 * kb + 4 * hf;
                    const u32x2 v0 = *(const u32x2*)vp, v1 = *(const u32x2*)(vp + 8); u32x4 vv; vv.x = v0.x; vv.y = v0.y; vv.z = v1.x; vv.w = v1.y; vf[kb][bl] = __builtin_bit_cast(bf16x8, vv); }
            attn_step(oacc, mrun, lsum, qf, kf, vf, -512 + 32 * kt - r, bias, bias0, hf);
        }
        lsum += __shfl_xor(lsum, 32);
        LAS float* op = (LAS float*)(F.lds + w * 16384); LAS float* ml = (LAS float*)(F.lds + 8 * 16384 + w * 256);
#pragma unroll
        for (int bl = 0; bl < 4; ++bl)
#pragma unroll
            for (int i = 0; i < 16; ++i) op[(32 * bl + crow(i, hf)) * 32 + r] = oacc[bl][i];
        if (hf == 0) { ml[2 * r] = mrun; ml[2 * r + 1] = lsum; }
        __syncthreads();
        { const int q = tid & 31, dv0 = (tid >> 5) * 8;
          float mw[8], M = -1e30f;
#pragma unroll
          for (int ww = 0; ww < 8; ++ww) { mw[ww] = ((LAS float*)(F.lds + 8 * 16384 + ww * 256))[2 * q]; M = fmaxf(M, mw[ww]); }
          float o[8] = {0.f, 0.f, 0.f, 0.f, 0.f, 0.f, 0.f, 0.f}, L = 0.f;
#pragma unroll
          for (int ww = 0; ww < 8; ++ww) { const float sc = __builtin_amdgcn_exp2f(mw[ww] - M); L += sc * ((LAS float*)(F.lds + 8 * 16384 + ww * 256))[2 * q + 1];
              const LAS float* pp = (LAS float*)(F.lds + ww * 16384) + dv0 * 32 + q;
#pragma unroll
              for (int e = 0; e < 8; ++e) o[e] += sc * pp[e * 32]; }
          const float inv = 1.f / L;
          u32x4 ov; ov.x = pk2(o[0] * inv, o[1] * inv); ov.y = pk2(o[2] * inv, o[3] * inv); ov.z = pk2(o[4] * inv, o[5] * inv); ov.w = pk2(o[6] * inv, o[7] * inv);
          *(u32x4*)(F.HB + (size_t)(qrow0 + q) * D + h * HD + dv0) = ov; }
        __syncthreads();
    }
    const int vbid = (F.G % 8 == 0) ? (F.bid & 7) * (F.G >> 3) + (F.bid >> 3) : F.bid;
    for (int unit = vbid; unit < 512; unit += F.G) {
        const int cq = unit & 15, h = (unit >> 4) & 15, b = unit >> 8;
        const int cw = 4 * cq + (w >> 1), qrow0 = b * SEQ + cw * 64 + (w & 1) * 32;
        const int kc_lo = (4 * cq - 8) > 0 ? 4 * cq - 8 : 0, kc_hi = 4 * cq + 3;
        LAS float* bias = (LAS float*)(F.lds + A_BIAS_OFF);
        if (tid < 192) bias[tid] = p.b_rel_bias[tid * NH + h] * L2E;
        const bf16* kg = F.KN + (size_t)(b * SEQ) * D + h * HD;
        const bf16* vg = F.VT + ((size_t)(b * 16 + h) * HD) * SEQ;
        const int kr0 = tid >> 4, ks0 = tid & 15, vr0 = tid >> 3, vs0 = tid & 7;
        u32x4 stA[4], stB[4];
#define A_GLOAD(kc, st) do { st[0] = *(const u32x4*)(kg + (size_t)((kc) * 64 + kr0) * D + ks0 * 8); st[1] = *(const u32x4*)(kg + (size_t)((kc) * 64 + kr0 + 32) * D + ks0 * 8); \
                         st[2] = *(const u32x4*)(vg + (size_t)vr0 * SEQ + (kc) * 64 + vs0 * 8); st[3] = *(const u32x4*)(vg + (size_t)(vr0 + 64) * SEQ + (kc) * 64 + vs0 * 8); } while (0)
#define A_LWRITE(buf, st) do { LAS bf16* kb_ = (LAS bf16*)(F.lds + (buf) * A_BUF); LAS bf16* vb_ = (LAS bf16*)(F.lds + (buf) * A_BUF + A_KBYTES); \
                         *(LAS u32x4*)(kb_ + kr0 * AK_STRIDE + ks0 * 8) = st[0]; *(LAS u32x4*)(kb_ + (kr0 + 32) * AK_STRIDE + ks0 * 8) = st[1]; \
                         *(LAS u32x4*)(vb_ + vr0 * AV_STRIDE + vs0 * 8) = st[2]; *(LAS u32x4*)(vb_ + (vr0 + 64) * AV_STRIDE + vs0 * 8) = st[3]; } while (0)
#define A_COMPUTE(kc, cur) do { if ((kc) >= cw - 8 && (kc) <= cw) { \
                const LAS bf16* Kb = (const LAS bf16*)(F.lds + (cur) * A_BUF); const LAS bf16* Vb = (const LAS bf16*)(F.lds + (cur) * A_BUF + A_KBYTES); \
                _Pragma("unroll 1") for (int t = 0; t < 2; ++t) { \
                    bf16x8 pfr[2]; \
                    { bf16x8 kf[8]; \
                      _Pragma("unroll") for (int kk = 0; kk < 8; ++kk) kf[kk] = *(const LAS bf16x8*)(Kb + (32 * t + r) * AK_STRIDE + 16 * kk + 8 * hf); \
                      attn_scores(oacc, mrun, lsum, qf, kf, pfr, ((kc) * 64 + 32 * t) - (cw * 64 + (w & 1) * 32) - r, bias, bias0, hf); } \
                    { bf16x8 vf[2][4]; \
                      _Pragma("unroll") for (int kb = 0; kb < 2; ++kb) _Pragma("unroll") for (int bl = 0; bl < 4; ++bl) { const LAS bf16* vp = Vb + (32 * bl + r) * AV_STRIDE + 32 * t + 16 * kb + 4 * hf; \
                            const u32x2 v0 = *(const LAS u32x2*)vp, v1 = *(const LAS u32x2*)(vp + 8); u32x4 vv; vv.x = v0.x; vv.y = v0.y; vv.z = v1.x; vv.w = v1.y; vf[kb][bl] = __builtin_bit_cast(bf16x8, vv); } \
                      attn_pv(oacc, pfr, vf); } } } } while (0)
        A_GLOAD(kc_lo, stA);
        A_GLOAD(kc_lo + 1, stB);
        bf16x8 qf[8];
        { const bf16* qp = F.QB + (size_t)(qrow0 + r) * D + h * HD + 8 * hf;
#pragma unroll
          for (int kk = 0; kk < 8; ++kk) qf[kk] = *(const bf16x8*)(qp + 16 * kk); }
        f32x16 oacc[4];
#pragma unroll
        for (int bl = 0; bl < 4; ++bl) for (int i = 0; i < 16; ++i) oacc[bl][i] = 0.f;
        float mrun = -1e30f, lsum = 0.f;
        A_LWRITE(0, stA);
        __syncthreads();
        const float bias0 = bias[0];
        for (int kc = kc_lo; kc <= kc_hi; kc += 2) {
            if (kc + 2 <= kc_hi) A_GLOAD(kc + 2, stA);
            A_COMPUTE(kc, 0);
            A_LWRITE(1, stB);
            __syncthreads();
            if (kc + 3 <= kc_hi) A_GLOAD(kc + 3, stB);
            A_COMPUTE(kc + 1, 1);
            if (kc + 2 <= kc_hi) A_LWRITE(0, stA);
            __syncthreads();
        }
#undef A_GLOAD
#undef A_LWRITE
#undef A_COMPUTE
        lsum += __shfl_xor(lsum, 32);
        const float inv = 1.f / lsum;
        bf16* op = F.HB + (size_t)(qrow0 + r) * D + h * HD;
#pragma unroll
        for (int bl = 0; bl < 4; ++bl)
#pragma unroll
            for (int g4 = 0; g4 < 4; ++g4) {
                u32x2 o; o.x = pk2(oacc[bl][4 * g4] * inv, oacc[bl][4 * g4 + 1] * inv); o.y = pk2(oacc[bl][4 * g4 + 2] * inv, oacc[bl][4 * g4 + 3] * inv);
                *(u32x2*)(op + 32 * bl + 8 * g4 + 4 * hf) = o;
            }
    }
}

#define XB_TMO      128
#define XB_XCNT(j)  (256  + 64 * (j))
#define XB_XSUB(j)  (1280 + 64 * (j))
#define XB_XGEN(j)  (2304 + 64 * (j))
#define XB_TOP      3328
#define XB_TOPGEN   3392
#define XCD_BAR_WORDS 3456
#define XB_SPIN_CAP (1u << 18)
DI unsigned xb_ld(unsigned* p)              { return __hip_atomic_load(p, __ATOMIC_RELAXED, __HIP_MEMORY_SCOPE_AGENT); }
DI unsigned xb_add(unsigned* p, unsigned v) { return __hip_atomic_fetch_add(p, v, __ATOMIC_RELAXED, __HIP_MEMORY_SCOPE_AGENT); }
DI unsigned xb_xcc_id() { return (unsigned)__builtin_amdgcn_s_getreg((3 << 11) | 20) & 0xFu; }
#define XB_SPIN(cond, bar) do { unsigned _sp = 0; while (cond) { __builtin_amdgcn_s_sleep(1); \
    if ((++_sp & 255u) == 0u) { if (xb_ld(&(bar)[XB_TMO])) break; if (_sp > XB_SPIN_CAP) { atomicAdd(&(bar)[XB_TMO], 1u); break; } } } } while (0)
struct XcdBarrier { unsigned* bar; unsigned x; volatile LAS unsigned* st; };
DI XcdBarrier xcd_barrier_post(unsigned* bar, volatile LAS unsigned* st) {
    XcdBarrier b; b.bar = bar; b.x = xb_xcc_id(); b.st = st;
    if (threadIdx.x == 0) (void)xb_add(&bar[XB_XCNT(b.x)], 1u);
    return b;
}
DI void xcd_barrier_complete(unsigned* bar, unsigned x, unsigned& nloc, unsigned& nx) {
    const unsigned G = gridDim.x * gridDim.y * gridDim.z;
    unsigned sum, cnt, mine, sp = 0u;
    for (;;) {
        sum = 0u; cnt = 0u; mine = 0u;
#pragma unroll
        for (unsigned j = 0; j < 16; ++j) { const unsigned c = xb_ld(&bar[XB_XCNT(j)]); sum += c; cnt += (c > 0u) ? 1u : 0u; mine = (j == x) ? c : mine; }
        if (sum == G) break;
        __builtin_amdgcn_s_sleep(1);
        if ((++sp & 255u) == 0u) { if (xb_ld(&bar[XB_TMO])) break; if (sp > XB_SPIN_CAP) { atomicAdd(&bar[XB_TMO], 1u); break; } }
    }
    nloc = mine > 0u ? mine : 1u; nx = cnt > 0u ? cnt : 1u;
}
DI void xcd_barrier(const XcdBarrier& b) {
    asm volatile("s_waitcnt vmcnt(0)" ::: "memory");
    __syncthreads();
    if (threadIdx.x == 0) {
        unsigned* bar = b.bar;
        __builtin_amdgcn_s_waitcnt(0);
        unsigned nloc = b.st[0], nx = b.st[1];
        if (nloc == 0u) { xcd_barrier_complete(bar, b.x, nloc, nx); b.st[0] = nloc; b.st[1] = nx; }
        const unsigned old = xb_add(&bar[XB_XSUB(b.x)], 1u);
        const unsigned gen = old / nloc;
        if (old + 1u == (gen + 1u) * nloc) {
            __builtin_amdgcn_fence(__ATOMIC_RELEASE, "agent");
            asm volatile("s_waitcnt vmcnt(0)" ::: "memory");
            const unsigned og = xb_add(&bar[XB_TOP], 1u);
            const unsigned tg = og / nx;
            if (og + 1u == (tg + 1u) * nx) xb_add(&bar[XB_TOPGEN], 1u);
            else XB_SPIN(xb_ld(&bar[XB_TOPGEN]) == tg, bar);
            __builtin_amdgcn_fence(__ATOMIC_ACQUIRE, "agent");
            xb_add(&bar[XB_XGEN(b.x)], 1u);
            asm volatile("s_waitcnt vmcnt(0)" ::: "memory");
        } else {
            XB_SPIN(xb_ld(&bar[XB_XGEN(b.x)]) == gen, bar);
            __builtin_amdgcn_fence(__ATOMIC_ACQUIRE, "agent");
            asm volatile("s_waitcnt vmcnt(0)" ::: "memory");
        }
    }
    __syncthreads();
}

enum { PH_P0, PH_G1, PH_GLA_A, PH_SCAN, PH_GLA_C, PH_G2, PH_RMS_F0, PH_G3_0, PH_CONV0, PH_G4_0, PH_RMS_M1, PH_G5, PH_PREP, PH_ATTN, PH_G6, PH_RMS_F1, PH_G3_1, PH_CONV1, PH_G4_1, PH_FIN, NPH };

__global__ void __launch_bounds__(NTHR, 2) fwd_megakernel(Params prm) {
    extern __shared__ __attribute__((aligned(16))) unsigned char lds_raw[];
    cg::grid_group grid = cg::this_grid();
    float* const X0 = prm.out;
    volatile LAS unsigned* bst = (volatile LAS unsigned*)((LAS unsigned char*)lds_raw + (LDS_BYTES - 16));
    if (threadIdx.x < 4) bst[threadIdx.x] = 0u;
    __syncthreads();
    XcdBarrier xbar = xcd_barrier_post((unsigned*)(prm.ws + WS_BAR), bst);
    for (int ph = prm.ph_lo; ph < prm.ph_hi; ++ph) {
      for (int rep = 0, nrep = 1 + ((REP_MASK >> ph) & 1); rep < nrep; ++rep) {
        int tid_ = threadIdx.x; asm volatile("" : "+v"(tid_));
        size_t zoff = 0; asm volatile("" : "+s"(zoff));
        unsigned char* ws = prm.ws + zoff;
        float* X = X0 + zoff;
        Frame F;
        F.p = prm; F.lds = (LAS unsigned char*)lds_raw;
        F.tid = tid_; F.lane = F.tid & 63; F.wave = __builtin_amdgcn_readfirstlane(F.tid >> 6); F.G = gridDim.x; F.bid = blockIdx.x;
        F.WinA = (bf16*)(ws + WS_WINA); F.WoA = (bf16*)(ws + WS_WOA); F.Wqkv = (bf16*)(ws + WS_WQKV); F.WoB = (bf16*)(ws + WS_WOB);
        F.Fin0 = (bf16*)(ws + WS_FIN0); F.Fin1 = (bf16*)(ws + WS_FIN1); F.Fdn0 = (bf16*)(ws + WS_FDN0); F.Fdn1 = (bf16*)(ws + WS_FDN1);
        F.LB = (float*)(ws + WS_LB); F.HB = (bf16*)(ws + WS_HB); F.QB = (bf16*)(ws + WS_QB);
        F.LOGF = (float*)(ws + WS_LOGF); F.VB = (bf16*)(ws + WS_VB); F.SG = (bf16*)(ws + WS_SG); F.OI = (float*)(ws + WS_OI); F.LOCAL = (float*)(ws + WS_LOCAL); F.DEC = (float*)(ws + WS_DEC);
        F.QKV = (bf16*)(ws + WS_QKV); F.KN = (bf16*)(ws + WS_KN); F.KS = (bf16*)(ws + WS_KS); F.VT = (bf16*)(ws + WS_VT); F.VTS = (bf16*)(ws + WS_VTS);
        F.UP = (bf16*)(ws + WS_UP); F.ACT = (bf16*)(ws + WS_ACT);
        switch (ph) {
        case PH_P0: if (EN_MASK & 1) p0_phase(F); break;
        case PH_GLA_A: if (EN_MASK & 2) gla_a_phase(F); break;
        case PH_SCAN: if (EN_MASK & 4) scan_phase(F); break;
        case PH_GLA_C: if (EN_MASK & 8) gla_c_phase(F); break;
        case PH_RMS_F0: if (EN_MASK & 16) rms_phase(F, X, prm.x_sample, prm.norm_ffn, (const float*)(ws + WS_PART), X + (size_t)TP * D); break;
        case PH_RMS_M1: if (EN_MASK & 16) rms_phase(F, X, X + (size_t)TP * D, prm.norm_mix + D, (const float*)(ws + WS_PART), X + (size_t)TP * D); break;
        case PH_RMS_F1: if (EN_MASK & 16) rms_phase(F, X, X + (size_t)TP * D, prm.norm_ffn + D, (const float*)(ws + WS_PART), X + (size_t)TP * D); break;
        case PH_FIN: fin_phase(F, X + (size_t)TP * D, (const float*)(ws + WS_PART)); break;
        case PH_CONV0: if (EN_MASK & 32) convfix_phase(F, 0, (const float*)(ws + WS_PART)); break;
        case PH_CONV1: if (EN_MASK & 32) convfix_phase(F, 1, (const float*)(ws + WS_PART)); break;
        case PH_PREP: if (EN_MASK & 64) prep_phase(F); break;
        case PH_ATTN: if (EN_MASK & 128) attn_phase(F); break;
        default: if (EN_MASK & 256) {
            pg8::Gemm g; pg8::Epi E; E.mode = 2; E.cw = nullptr; E.cbias = nullptr; E.ldo = D; E.ob = nullptr; E.of = X; E.resP = X; E.resS = X + (size_t)TP * D;
            E.lb = F.LB; E.logf = F.LOGF; E.wsb = ws;
            g.A = F.HB; g.M = T; g.K = D; g.N = D; g.Bt = F.WoA;
            if (ph == PH_G1) { g.Bt = F.WinA; g.N = NWIN; E.mode = 0; }
            else if (ph == PH_G2) { g.Bt = F.WoA; E.resP = prm.x_prompt; E.resS = prm.x_sample; }
            else if (ph == PH_G3_0 || ph == PH_G3_1) { const int l = (ph == PH_G3_1); g.Bt = l ? F.Fin1 : F.Fin0; g.N = NUP; E.mode = 3; E.cw = prm.f_conv_w + (size_t)l * 3 * FF; E.cbias = prm.f_conv_b + (size_t)l * FF; }
            else if (ph == PH_G4_0 || ph == PH_G4_1) { g.A = F.ACT; g.Bt = (ph == PH_G4_1) ? F.Fdn1 : F.Fdn0; g.K = FF; }
            else if (ph == PH_G5) { g.Bt = F.Wqkv; g.N = NQKV; E.mode = 1; E.ob = F.QKV; E.ldo = NQKV; }
            else { g.Bt = F.WoB; }
            E.part = (float*)(ws + WS_PART); E.act = F.ACT; E.edge = (float*)(ws + WS_PART);
            pg8::StaticOrder S; S.init(g.M, g.N, g.K, F.G, F.bid, E.mode == 2);
            pg8::gemm_phase(F.lds, g, S, E, F.tid);
            if (ph == PH_G1 || ph == PH_G3_0 || ph == PH_G5) {
                const int rem = S.nitems % F.G;
                if (rem == 0 || F.bid >= rem) {
                    const int widx = rem ? F.bid - rem : F.bid, nw = rem ? F.G - rem : F.G;
                    if (ph == PH_G1) wconv_items(F, WC_EARLY, WC_ALL, widx, nw);
                    else if (ph == PH_G3_0) cacheK_fill(F, widx, nw);
                    else vtrans_items(F, VT_NP + VT_NN, VT_NP + VT_NN + VT_NC, widx, nw);
                }
            }
        } break;
        }
      }
        if (prm.ph_hi > 1000) grid.sync();
        if (ph + 1 < prm.ph_hi) xcd_barrier(xbar);
    }
}

extern "C" void kernel_launch(void* const* d_in, const int* in_sizes, int n_in, void* d_out, int out_size, void* d_ws, size_t ws_size, hipStream_t stream) {
    static int grid_blocks = 0;
    if (!grid_blocks) {
        int dev = 0, cus = 0, per_cu = 0;
        hipGetDevice(&dev);
        hipDeviceGetAttribute(&cus, hipDeviceAttributeMultiprocessorCount, dev);
        if (hipFuncSetAttribute((const void*)fwd_megakernel, hipFuncAttributeMaxDynamicSharedMemorySize, LDS_BYTES) != hipSuccess) fprintf(stderr, "kernel_launch: hipFuncSetAttribute failed\n");
        hipOccupancyMaxActiveBlocksPerMultiprocessor(&per_cu, (const void*)fwd_megakernel, NTHR, LDS_BYTES);
        if (per_cu < 1) per_cu = 1;
        if (per_cu > 1) per_cu = 1;
        grid_blocks = cus * per_cu;
        if (n_in != 21 || (size_t)out_size != O_END || ws_size < WS_END) fprintf(stderr, "kernel_launch: unexpected sizes n_in %d out %d ws %zu (need %zu)\n", n_in, out_size, ws_size, (size_t)WS_END);
    }
    Params p{};
    p.x_prompt = (const float*)d_in[0]; p.x_sample = (const float*)d_in[1]; p.state_a_S = (const float*)d_in[2]; p.cache_k = (const float*)d_in[3]; p.cache_v = (const float*)d_in[4];
    p.conv_state = (const float*)d_in[5]; p.norm_mix = (const float*)d_in[6]; p.norm_ffn = (const float*)d_in[7]; p.a_w_in = (const float*)d_in[8]; p.a_gamma = (const float*)d_in[9];
    p.a_norm_o = (const float*)d_in[10]; p.a_w_o = (const float*)d_in[11]; p.b_w_qkv = (const float*)d_in[12]; p.b_q_norm = (const float*)d_in[13]; p.b_k_norm = (const float*)d_in[14];
    p.b_rel_bias = (const float*)d_in[15]; p.b_w_o = (const float*)d_in[16]; p.f_w_in = (const float*)d_in[17]; p.f_conv_w = (const float*)d_in[18]; p.f_conv_b = (const float*)d_in[19];
    p.f_w_down = (const float*)d_in[20];
    p.out = (float*)d_out; p.ws = (unsigned char*)d_ws;
#if MK_N_LAUNCHES == 1
    p.ph_lo = 0; p.ph_hi = NPH;
    if (hipMemsetAsync((char*)d_ws + WS_BAR, 0, 16384, stream) != hipSuccess) fprintf(stderr, "kernel_launch: memset of barrier words failed\n");
    void* args[] = {&p};
    hipError_t e = hipLaunchCooperativeKernel((const void*)fwd_megakernel, dim3(grid_blocks), dim3(NTHR), args, LDS_BYTES, stream);
    if (e != hipSuccess) fprintf(stderr, "cooperative launch failed: %s (grid %d)\n", hipGetErrorString(e), grid_blocks);
#else
    for (int ph = 0; ph < NPH; ++ph) {
        p.ph_lo = ph; p.ph_hi = ph + 1;
        hipLaunchKernelGGL(fwd_megakernel, dim3(grid_blocks), dim3(NTHR), LDS_BYTES, stream, p);
    }
#endif
}
```

```cpp
#include <hip/hip_runtime.h>
#include <hip/hip_cooperative_groups.h>
#include <cstdio>
#include <cstdint>
namespace cg = cooperative_groups;

#define DI __device__ __forceinline__
#define LAS __attribute__((address_space(3)))
#define GAS __attribute__((address_space(1)))
typedef unsigned short bf16;
typedef short bf16x8 __attribute__((ext_vector_type(8)));
typedef float f32x2 __attribute__((ext_vector_type(2)));
typedef float f32x4 __attribute__((ext_vector_type(4)));
typedef float f32x16 __attribute__((ext_vector_type(16)));
typedef unsigned u32x2 __attribute__((ext_vector_type(2)));
typedef unsigned u32x4 __attribute__((ext_vector_type(4)));
typedef __bf16 bf16x2_t __attribute__((ext_vector_type(2)));

#ifndef EN_MASK
#define EN_MASK 0xffffu
#endif
#ifndef REP_MASK
#define REP_MASK 0
#endif
#ifndef MK_N_LAUNCHES
#define MK_N_LAUNCHES 1
#endif

constexpr int D = 2048, TP = 8192, TS = 1024, T = TP + TS, SEQ = 4096, NH = 16, HD = 128, FF = 5632;
constexpr int NQKV = 3 * D, NWIN = 4 * D, NUP = 2 * FF;
constexpr int SROWS = 544;
constexpr float EPS = 1e-6f;
constexpr int NWAVES = 8, NTHR = 512;
constexpr int LDS_BYTES = 147456;

constexpr size_t MiB = 1u << 20;
constexpr size_t WS_WINA = 0, WS_WOA = 32 * MiB, WS_WQKV = 40 * MiB, WS_WOB = 64 * MiB, WS_FIN0 = 72 * MiB, WS_FIN1 = 116 * MiB, WS_FDN0 = 160 * MiB, WS_FDN1 = 182 * MiB;
constexpr size_t WS_LB = 204 * MiB, WS_HB = 205 * MiB, WS_QB = 241 * MiB, WS_MIX = 277 * MiB;
constexpr size_t WS_LOGF = WS_MIX, WS_VB = WS_MIX + 72 * MiB, WS_SG = WS_MIX + 108 * MiB, WS_OI = WS_MIX + 144 * MiB, WS_LOCAL = WS_MIX + 216 * MiB, WS_DEC = WS_MIX + 376 * MiB;
constexpr size_t WS_KS = WS_MIX, WS_VTS = WS_MIX + 68 * MiB, WS_QKV = WS_MIX + 136 * MiB, WS_KN = WS_MIX + 244 * MiB, WS_VT = WS_MIX + 276 * MiB;
constexpr size_t WS_UP = WS_MIX + 136 * MiB, WS_ACT = WS_MIX + 136 * MiB;
constexpr size_t WS_PART = WS_MIX + 236 * MiB;
constexpr size_t WS_BAR = WS_LB + 64 * 1024;
constexpr size_t WS_END = WS_MIX + 378 * MiB;

constexpr size_t O_YP = 0, O_YS = O_YP + (size_t)TP * D, O_SP = O_YS + (size_t)TS * D, O_SS = O_SP + 2 * 16 * 128 * 128, O_KP = O_SS + 32 * 16 * 128 * 128,
                 O_VP = O_KP + 2 * 512 * 2048, O_KSM = O_VP + 2 * 512 * 2048, O_VSM = O_KSM + 32 * 32 * 2048, O_CP = O_VSM + 32 * 32 * 2048, O_CS = O_CP + 2 * 2 * 2 * FF,
                 O_END = O_CS + 2 * 32 * 2 * FF;

struct Params {
    const float* x_prompt; const float* x_sample; const float* state_a_S; const float* cache_k; const float* cache_v; const float* conv_state;
    const float* norm_mix; const float* norm_ffn; const float* a_w_in; const float* a_gamma; const float* a_norm_o; const float* a_w_o;
    const float* b_w_qkv; const float* b_q_norm; const float* b_k_norm; const float* b_rel_bias; const float* b_w_o;
    const float* f_w_in; const float* f_conv_w; const float* f_conv_b; const float* f_w_down;
    float* out; unsigned char* ws; int ph_lo, ph_hi;
};

DI unsigned pk2(float lo, float hi) { f32x2 v = {lo, hi}; return __builtin_bit_cast(unsigned, __builtin_convertvector(v, bf16x2_t)); }
DI bf16 f2bf(float f) { return (bf16)(pk2(f, 0.f) & 0xffffu); }
DI float bflo(unsigned p) { return __uint_as_float(p << 16); }
DI float bfhi(unsigned p) { return __uint_as_float(p & 0xffff0000u); }
DI float wave_sum(float v) {
#pragma unroll
    for (int o = 1; o < 64; o <<= 1) v += __shfl_xor(v, o);
    return v;
}
DI float fexp(float x) { return __builtin_amdgcn_exp2f(x * 1.4426950408889634f); }
DI float fsigmoid(float z) { return __builtin_amdgcn_rcpf(1.f + fexp(-z)); }
DI float fsilu(float z) { return z * __builtin_amdgcn_rcpf(1.f + fexp(-z)); }
DI float flog(float x) { return __builtin_amdgcn_logf(x) * 0.6931471805599453f; }
DI int crow(int reg, int h) { return (reg & 3) + 8 * (reg >> 2) + 4 * h; }
#define MFMA32(a, b, c) __builtin_amdgcn_mfma_f32_32x32x16_bf16((a), (b), (c), 0, 0, 0)

namespace pg8 {
constexpr int BM = 256, BK = 64, HALF = 128, HTB = HALF * BK * 2, STAGE_BYTES = 8 * HTB, NXCD = 8, WGM = 8;
DI int lds_byte(int r, int c) { const int st = (r >> 4) * 2 + (c >> 5), rr = r & 15, cc = c & 31, ob = rr * 64 + cc * 2; return st * 1024 + (ob ^ (((ob >> 9) & 1) << 5)); }
DI void stage_rc(int b, int& R, int& C) { const int st = b / 1024, sb = b % 1024, swz = sb ^ (((sb >> 9) & 1) << 5); R = (st >> 1) * 16 + swz / 64; C = (st & 1) * 32 + (swz % 64) / 2; }
DI int perm32(int rho) { const int n = rho >> 4, i = rho & 15; return 8 * (i >> 2) + 4 * n + (i & 3); }
struct Unit { int pm, pn, kb0, nkt, slice; };
struct Gemm { const bf16* A; const bf16* Bt; int M, N, K; };
struct StaticOrder {
    int nM, nN, nwg, G, c, tail, nblk, nitems;
    DI void init(int M, int N, int K, int G_, int c_, int tail_) { tail = tail_; nM = tail ? TP / BM : M / BM; nN = N / BM; nwg = nM * nN; G = G_; c = c_; nblk = K / 128; nitems = nwg + (tail ? 256 : 0); }
    DI bool next(int i, Unit& u) const {
        const long L = (long)i * G + c; if (L >= nitems) return false;
        u.slice = -1; u.kb0 = 0; u.nkt = nblk * 2;
        if (L >= nwg) { const int j = (int)L - nwg, uu = j & 31; u.slice = j >> 5; u.pm = TP / BM + (uu >> 3); u.pn = uu & 7;
            const int base = nblk / 8, rem = nblk % 8; u.kb0 = u.slice * base + (u.slice < rem ? u.slice : rem); u.nkt = 2 * (base + (u.slice < rem ? 1 : 0)); return true; }
        int wgid = (int)L; { const int q = nwg / NXCD, r = nwg % NXCD, xcd = wgid % NXCD, off = wgid / NXCD; wgid = (xcd < r ? xcd * (q + 1) : r * (q + 1) + (xcd - r) * q) + off; }
        const int nig = WGM * nN, gid = wgid / nig, fm = gid * WGM, gsz = (nM - fm) < WGM ? (nM - fm) : WGM;
        u.pm = fm + ((wgid % nig) % gsz); u.pn = (wgid % nig) / gsz; return true;
    }
};

struct Epi {
    int mode;
    int ldo;
    bf16* ob;
    float* of; const float* resP; const float* resS;
    const float* lb; float* logf; unsigned char* wsb;
    float* part;
    const float* cw; const float* cbias; bf16* act; float* edge;
    DI bool perm() const { return mode != 2; }
    DI void operator()(const f32x4 (&acc)[2][2][4][2], const Unit& u, int wr, int wc, int fr, int fq) const {
        const int row0 = u.pm * BM + wr * 64 + fr;
        if (mode == 2 && u.slice >= 0) {
            const int col0 = u.pn * BM + wc * 32 + 4 * fq;
#pragma unroll
            for (int ai = 0; ai < 2; ++ai)
#pragma unroll
                for (int m = 0; m < 4; ++m) {
                    float* op = part + ((size_t)u.slice * TS + (row0 + ai * HALF + m * 16 - TP)) * D + col0;
#pragma unroll
                    for (int bj = 0; bj < 2; ++bj)
#pragma unroll
                        for (int n = 0; n < 2; ++n) *(f32x4*)(op + bj * HALF + n * 16) = acc[ai][bj][m][n];
                }
        } else if (mode == 2) {
            const int col0 = u.pn * BM + wc * 32 + 4 * fq;
#pragma unroll
            for (int ai = 0; ai < 2; ++ai) {
                f32x4 rr[4][2][2];
#pragma unroll
                for (int m = 0; m < 4; ++m) {
                    const int row = row0 + ai * HALF + m * 16;
                    const float* rp = (row < TP ? resP + (size_t)row * D : resS + (size_t)(row - TP) * D) + col0;
#pragma unroll
                    for (int bj = 0; bj < 2; ++bj)
#pragma unroll
                        for (int n = 0; n < 2; ++n) rr[m][bj][n] = *(const f32x4*)(rp + bj * HALF + n * 16);
                }
#pragma unroll
                for (int m = 0; m < 4; ++m) {
                    float* op = of + (size_t)(row0 + ai * HALF + m * 16) * D + col0;
#pragma unroll
                    for (int bj = 0; bj < 2; ++bj)
#pragma unroll
                        for (int n = 0; n < 2; ++n) *(f32x4*)(op + bj * HALF + n * 16) = rr[m][bj][n] + acc[ai][bj][m][n];
                }
            }
        } else if (mode == 3) {
            const int cc0 = u.pn * HALF + wc * 32 + 8 * fq;
            float w0[8], w1[8], w2[8], cb[8];
            { const f32x4 a0 = *(const f32x4*)(cw + cc0), a1 = *(const f32x4*)(cw + cc0 + 4), b0 = *(const f32x4*)(cw + FF + cc0), b1 = *(const f32x4*)(cw + FF + cc0 + 4);
              const f32x4 c0 = *(const f32x4*)(cw + 2 * FF + cc0), c1 = *(const f32x4*)(cw + 2 * FF + cc0 + 4), d0 = *(const f32x4*)(cbias + cc0), d1 = *(const f32x4*)(cbias + cc0 + 4);
#pragma unroll
              for (int e = 0; e < 4; ++e) { w0[e] = a0[e]; w0[4 + e] = a1[e]; w1[e] = b0[e]; w1[4 + e] = b1[e]; w2[e] = c0[e]; w2[4 + e] = c1[e]; cb[e] = d0[e]; cb[4 + e] = d1[e]; } }
            float* const eu_first = edge; float* const eg_first = edge + (size_t)(T / 32) * 2 * FF; float* const eu_last = edge + (size_t)(T / 32) * 4 * FF;
            const bool prm_unit = u.pm < TP / BM;
#pragma unroll
            for (int ai = 0; ai < 2; ++ai)
#pragma unroll
                for (int m = 0; m < 4; ++m) {
                    const int row = row0 + ai * HALF + m * 16, hb = row >> 5;
                    float a[8];
#pragma unroll
                    for (int n = 0; n < 2; ++n)
#pragma unroll
                        for (int e = 0; e < 4; ++e) {
                            const float cur = acc[ai][0][m][n][e];
                            const float prv = ((m & 1) || (prm_unit && m == 2)) ? acc[ai][0][m > 0 ? m - 1 : 0][n][e] : 0.f;
                            const int ci = __float_as_int(cur), pi = __float_as_int(prv);
                            const int r1 = __builtin_amdgcn_update_dpp(0, pi, 0x121, 0xf, 0xf, false), r2 = __builtin_amdgcn_update_dpp(0, pi, 0x122, 0xf, 0xf, false);
                            const float p1 = __int_as_float(__builtin_amdgcn_update_dpp(r1, ci, 0x111, 0xf, 0xf, false));
                            const float p2 = __int_as_float(__builtin_amdgcn_update_dpp(r2, ci, 0x112, 0xf, 0xf, false));
                            const int k = 4 * n + e;
                            a[k] = fsilu(cb[k] + p2 * w0[k] + p1 * w1[k] + cur * w2[k]) * acc[ai][1][m][n][e];
                        }
                    const bool first2 = (fr < 2) && (prm_unit ? (m == 0) : ((m & 1) == 0)), last2 = (fr >= 14) && (prm_unit ? (m == 3) : ((m & 1) == 1));
                    if (!first2) { u32x4 o; o.x = pk2(a[0], a[1]); o.y = pk2(a[2], a[3]); o.z = pk2(a[4], a[5]); o.w = pk2(a[6], a[7]); *(u32x4*)(act + (size_t)row * FF + cc0) = o; }
                    else { float* du = eu_first + ((size_t)hb * 2 + fr) * FF + cc0; float* dg = eg_first + ((size_t)hb * 2 + fr) * FF + cc0;
                        *(f32x4*)du = acc[ai][0][m][0]; *(f32x4*)(du + 4) = acc[ai][0][m][1]; *(f32x4*)dg = acc[ai][1][m][0]; *(f32x4*)(dg + 4) = acc[ai][1][m][1]; }
                    if (last2) { float* du = eu_last + ((size_t)hb * 2 + (fr - 14)) * FF + cc0; *(f32x4*)du = acc[ai][0][m][0]; *(f32x4*)(du + 4) = acc[ai][0][m][1]; }
                }
        } else if (mode == 1) {
            const int col0 = u.pn * BM + wc * 32 + 8 * fq;
#pragma unroll
            for (int ai = 0; ai < 2; ++ai)
#pragma unroll
                for (int m = 0; m < 4; ++m) {
                    bf16* op = ob + (size_t)(row0 + ai * HALF + m * 16) * ldo + col0;
#pragma unroll
                    for (int bj = 0; bj < 2; ++bj) { const f32x4 v0 = acc[ai][bj][m][0], v1 = acc[ai][bj][m][1];
                        u32x4 o; o.x = pk2(v0.x, v0.y); o.y = pk2(v0.z, v0.w); o.z = pk2(v1.x, v1.y); o.w = pk2(v1.z, v1.w);
                        *(u32x4*)(op + bj * HALF) = o; }
                }
        } else {
            const int type = u.pn >> 3, col0 = (u.pn & 7) * BM + wc * 32 + 8 * fq;
#pragma unroll
            for (int bj = 0; bj < 2; ++bj) {
                const int col = col0 + bj * HALF;
                f32x4 l0 = {0.f, 0.f, 0.f, 0.f}, l1 = l0;
                if (type == 1) { l0 = *(const f32x4*)(lb + col); l1 = *(const f32x4*)(lb + col + 4); }
#pragma unroll
                for (int ai = 0; ai < 2; ++ai)
#pragma unroll
                    for (int m = 0; m < 4; ++m) {
                        const size_t off = (size_t)(row0 + ai * HALF + m * 16) * D + col;
                        f32x4 v0 = acc[ai][bj][m][0], v1 = acc[ai][bj][m][1];
                        if (type == 1) {
#pragma unroll
                            for (int e = 0; e < 4; ++e) { v0[e] = flog(l0[e] + (1.f - l0[e]) * fsigmoid(v0[e])); v1[e] = flog(l1[e] + (1.f - l1[e]) * fsigmoid(v1[e])); }
                            *(f32x4*)(logf + off) = v0; *(f32x4*)(logf + off + 4) = v1;
                        } else {
                            if (type == 3) {
#pragma unroll
                                for (int e = 0; e < 4; ++e) { v0[e] = fsilu(v0[e]); v1[e] = fsilu(v1[e]); }
                            }
                            u32x4 o; o.x = pk2(v0.x, v0.y); o.y = pk2(v0.z, v0.w); o.z = pk2(v1.x, v1.y); o.w = pk2(v1.z, v1.w);
                            bf16* dst = (bf16*)(wsb + (type == 0 ? WS_QB : (type == 2 ? WS_VB : WS_SG)));
                            *(u32x4*)(dst + off) = o;
                        }
                    }
            }
        }
    }
};

DI void gemm_phase(LAS unsigned char* lds, const Gemm g, const StaticOrder& S, const Epi& E, const int tid) {
    const int wid = __builtin_amdgcn_readfirstlane(tid >> 6), lane = tid & 63, wr = wid >> 2, wc = wid & 3, fr = lane & 15, fq = lane >> 4;
    const int K = g.K;
    const bool PERM = E.perm();
    unsigned voffA[2], voffB[2];
#pragma unroll
    for (int i = 0; i < 2; ++i) { int R, C; stage_rc(tid * 16 + i * 8192, R, C); const int Rb = PERM ? ((R & ~31) + perm32(R & 31)) : R;
        voffA[i] = (unsigned)(R * K + C) * 2u; voffB[i] = (unsigned)(Rb * K + C) * 2u; }
    const size_t kstep = (size_t)(BK * 2);
    const size_t hstep = (size_t)HALF * K * 2;
    const size_t tstep = 2 * hstep;
    const unsigned ldsw = (unsigned)wid * 1024u;
    const int aoff = lds_byte(wr * 64 + fr, fq * 8), boff = lds_byte(wc * 32 + fr, fq * 8);
#define PG8_SA(b, h) (((b) * 2 + (h)) * HTB)
#define PG8_SB(b, h) ((4 + (b) * 2 + (h)) * HTB)
#define PG8_STAGE(bufoff, gbase, voff) do { _Pragma("unroll") for (int _i = 0; _i < 2; ++_i) \
        __builtin_amdgcn_global_load_lds((const unsigned*)((const char*)(gbase) + (voff)[_i]), (LAS unsigned*)(lds + (bufoff) + ldsw + _i * 8192), 16, 0, 0); } while (0)
#define PG8_LDA(dst, b, h) do { _Pragma("unroll") for (int m = 0; m < 4; ++m) _Pragma("unroll") for (int k = 0; k < 2; ++k) dst[m][k] = *(const LAS bf16x8*)(lds + PG8_SA(b, h) + aoff + m * 2048 + k * 1024); } while (0)
#define PG8_LDB(dst, b, h) do { _Pragma("unroll") for (int n = 0; n < 2; ++n) _Pragma("unroll") for (int k = 0; k < 2; ++k) dst[n][k] = *(const LAS bf16x8*)(lds + PG8_SB(b, h) + boff + n * 2048 + k * 1024); } while (0)
#define PG8_MMA(ai, bj, At, Bt) do { __builtin_amdgcn_s_setprio(1); _Pragma("unroll") for (int m = 0; m < 4; ++m) _Pragma("unroll") for (int n = 0; n < 2; ++n) _Pragma("unroll") for (int k = 0; k < 2; ++k) \
        acc[ai][bj][m][n] = __builtin_amdgcn_mfma_f32_16x16x32_bf16(Bt[n][k], At[m][k], acc[ai][bj][m][n], 0, 0, 0); __builtin_amdgcn_s_setprio(0); } while (0)
#define PG8_WAIT_V(n) asm volatile("s_waitcnt vmcnt(" #n ")" ::: "memory")
#define PG8_WAIT_L(n) asm volatile("s_waitcnt lgkmcnt(" #n ")" ::: "memory")
#define PG8_BAR __builtin_amdgcn_s_barrier()
#define PG8_SCHED __builtin_amdgcn_sched_barrier(0)
    Unit cur, nxt; int ui = 0;
    if (!S.next(0, cur)) return;
    f32x4 acc[2][2][4][2];
#pragma unroll
    for (int a = 0; a < 2; ++a)
#pragma unroll
        for (int b = 0; b < 2; ++b)
#pragma unroll
            for (int m = 0; m < 4; ++m)
#pragma unroll
                for (int n = 0; n < 2; ++n) acc[a][b][m][n] = (f32x4){0.f, 0.f, 0.f, 0.f};
    bf16x8 At[4][2], B0[2][2], B1[2][2];
    const char* cA = (const char*)g.A + (size_t)cur.pm * tstep + (size_t)cur.kb0 * 256; const char* cB = (const char*)g.Bt + (size_t)cur.pn * tstep + (size_t)cur.kb0 * 256;
    PG8_STAGE(PG8_SB(0, 0), cB, voffB); PG8_STAGE(PG8_SB(0, 1), cB + hstep, voffB); PG8_STAGE(PG8_SA(0, 0), cA, voffA); PG8_STAGE(PG8_SA(0, 1), cA + hstep, voffA);
    if (wr == 1) PG8_BAR;
    PG8_WAIT_V(2); PG8_BAR;
    PG8_STAGE(PG8_SB(1, 0), cB + kstep, voffB); PG8_STAGE(PG8_SA(1, 0), cA + kstep, voffA); PG8_STAGE(PG8_SB(1, 1), cB + hstep + kstep, voffB);
    PG8_WAIT_V(6); PG8_BAR;
    for (;;) {
        const bool has_next = S.next(ui + 1, nxt);
        const char* nA = has_next ? (const char*)g.A + (size_t)nxt.pm * tstep + (size_t)nxt.kb0 * 256 : cA; const char* nB = has_next ? (const char*)g.Bt + (size_t)nxt.pn * tstep + (size_t)nxt.kb0 * 256 : cB;
        const int nt = cur.nkt;
        for (int t = 0; t < nt; t += 2) {
            const bool last = (t == nt - 2);
            const char* a1 = cA + (size_t)(t + 1) * kstep;
            const char* a2 = last ? nA : cA + (size_t)(t + 2) * kstep; const char* b2 = last ? nB : cB + (size_t)(t + 2) * kstep;
            const char* a3 = a2 + kstep; const char* b3 = b2 + kstep;
            PG8_LDB(B0, 0, 0); PG8_LDB(B1, 0, 1); PG8_SCHED; PG8_LDA(At, 0, 0); PG8_STAGE(PG8_SA(1, 1), a1 + hstep, voffA);
            PG8_WAIT_V(8); PG8_WAIT_L(0); PG8_BAR; PG8_MMA(0, 0, At, B0); PG8_MMA(0, 1, At, B1); PG8_BAR; PG8_SCHED;
            PG8_LDA(At, 0, 1); PG8_STAGE(PG8_SB(0, 0), b2, voffB); PG8_STAGE(PG8_SB(0, 1), b2 + hstep, voffB); PG8_STAGE(PG8_SA(0, 0), a2, voffA);
            PG8_WAIT_V(8); PG8_WAIT_L(0); PG8_BAR; PG8_MMA(1, 0, At, B0); PG8_MMA(1, 1, At, B1); PG8_BAR; PG8_SCHED;
            PG8_LDB(B0, 1, 0); PG8_LDB(B1, 1, 1); PG8_SCHED; PG8_LDA(At, 1, 0); PG8_STAGE(PG8_SA(0, 1), a2 + hstep, voffA);
            PG8_WAIT_V(8); PG8_WAIT_L(0); PG8_BAR; PG8_MMA(0, 0, At, B0); PG8_MMA(0, 1, At, B1); PG8_BAR; PG8_SCHED;
            PG8_LDA(At, 1, 1); PG8_STAGE(PG8_SB(1, 0), b3, voffB); PG8_STAGE(PG8_SB(1, 1), b3 + hstep, voffB); PG8_STAGE(PG8_SA(1, 0), a3, voffA);
            PG8_WAIT_V(8); PG8_WAIT_L(0); PG8_BAR; PG8_MMA(1, 0, At, B0); PG8_MMA(1, 1, At, B1); PG8_BAR; PG8_SCHED;
        }
        if (wr == 0) PG8_BAR;
        E(acc, cur, wr, wc, fr, fq);
        if (!has_next) break;
#pragma unroll
        for (int a = 0; a < 2; ++a)
#pragma unroll
            for (int b = 0; b < 2; ++b)
#pragma unroll
                for (int m = 0; m < 4; ++m)
#pragma unroll
                    for (int n = 0; n < 2; ++n) acc[a][b][m][n] = (f32x4){0.f, 0.f, 0.f, 0.f};
        cur = nxt; cA = nA; cB = nB; ++ui;
        if (wr == 1) PG8_BAR;
    }
    PG8_WAIT_V(0);
    PG8_BAR;
#undef PG8_SA
#undef PG8_SB
#undef PG8_STAGE
#undef PG8_LDA
#undef PG8_LDB
#undef PG8_MMA
#undef PG8_WAIT_V
#undef PG8_WAIT_L
#undef PG8_BAR
#undef PG8_SCHED
}
}

struct Frame {
    Params p; LAS unsigned char* lds; int tid, lane, wave, G, bid;
    bf16 *WinA, *WoA, *Wqkv, *WoB, *Fin0, *Fin1, *Fdn0, *Fdn1;
    float* LB; bf16 *HB, *QB;
    float* LOGF; bf16 *VB, *SG; float *OI, *LOCAL, *DEC;
    bf16 *QKV, *KN, *KS, *VT, *VTS, *UP, *ACT;
};

DI void transpose_item(const float* __restrict__ W, int K, int N, bf16* __restrict__ WT, LAS float* scr, int item, int lane, const bool ilv = false) {
    const int nblk = N / 64, kb = item / nblk, nb = item % nblk, k0 = 64 * kb, n0 = 64 * nb;
    const int lr = lane >> 4, lc = (lane & 15) * 4;
    f32x4 v[16];
    const float* src = W + (size_t)(k0 + lr) * N + n0 + lc;
#pragma unroll
    for (int i = 0; i < 16; ++i) v[i] = __builtin_nontemporal_load((const f32x4*)(src + (size_t)(4 * i) * N));
#pragma unroll
    for (int i = 0; i < 16; ++i) { LAS float* d = scr + (4 * i + lr) * 65 + lc; d[0] = v[i].x; d[1] = v[i].y; d[2] = v[i].z; d[3] = v[i].w; }
    asm volatile("s_waitcnt lgkmcnt(0)" ::: "memory");
    const int c = lane & 7;
#pragma unroll
    for (int j = 0; j < 8; ++j) { const int n = (lane >> 3) + 8 * j; const LAS float* s = scr + (8 * c) * 65 + n;
        u32x4 o; o.x = pk2(s[0 * 65], s[1 * 65]); o.y = pk2(s[2 * 65], s[3 * 65]); o.z = pk2(s[4 * 65], s[5 * 65]); o.w = pk2(s[6 * 65], s[7 * 65]);
        int nd = n0 + n; if (ilv) nd = (nd < FF) ? (((nd >> 7) << 8) + (nd & 127)) : ((((nd - FF) >> 7) << 8) + 128 + ((nd - FF) & 127));
        __builtin_nontemporal_store(o, (u32x4*)(WT + (size_t)nd * K + k0 + 8 * c)); }
    asm volatile("s_waitcnt lgkmcnt(0)" ::: "memory");
}
DI void rms_row(const float* __restrict__ xrow, const float* __restrict__ g, bf16* __restrict__ orow, int lane, const float* __restrict__ part, float* __restrict__ xdst) {
    const f32x4* xr = (const f32x4*)xrow + lane; const f32x4* gr = (const f32x4*)g + lane;
    f32x4 v[8]; float s = 0.f;
#pragma unroll
    for (int j = 0; j < 8; ++j) v[j] = xr[64 * j];
    if (part) {
#pragma unroll
        for (int sl = 0; sl < 8; ++sl) { const f32x4* pr = (const f32x4*)(part + (size_t)sl * TS * D) + lane;
#pragma unroll
            for (int j = 0; j < 8; ++j) v[j] += pr[64 * j]; }
#pragma unroll
        for (int j = 0; j < 8; ++j) ((f32x4*)xdst + lane)[64 * j] = v[j];
    }
#pragma unroll
    for (int j = 0; j < 8; ++j) s += (v[j].x * v[j].x + v[j].y * v[j].y) + (v[j].z * v[j].z + v[j].w * v[j].w);
    const float rstd = rsqrtf(wave_sum(s) * (1.f / D) + EPS);
    u32x2* o8 = (u32x2*)orow + lane;
#pragma unroll
    for (int j = 0; j < 8; ++j) { const f32x4 gg = gr[64 * j]; u32x2 o; o.x = pk2(v[j].x * rstd * gg.x, v[j].y * rstd * gg.y); o.y = pk2(v[j].z * rstd * gg.z, v[j].w * rstd * gg.w); o8[64 * j] = o; }
}
DI void rms_phase(Frame& F, const float* srcP, const float* srcS, const float* g, const float* part, float* xs) {
    const int gw = F.bid * NWAVES + F.wave, NGW = F.G * NWAVES;
    for (int m = gw; m < T; m += NGW) {
        if (m < TP) rms_row(srcP + (size_t)m * D, g, F.HB + (size_t)m * D, F.lane, nullptr, nullptr);
        else rms_row(srcS + (size_t)(m - TP) * D, g, F.HB + (size_t)m * D, F.lane, part ? part + (size_t)(m - TP) * D : nullptr, xs + (size_t)(m - TP) * D);
    }
}
DI void fin_phase(Frame& F, float* xs, const float* part) {
    const int gt = F.bid * NTHR + F.tid, NGT = F.G * NTHR;
    for (int it = gt; it < TS * D / 4; it += NGT) {
        f32x4 v = ((const f32x4*)xs)[it];
#pragma unroll
        for (int sl = 0; sl < 8; ++sl) v += ((const f32x4*)(part + (size_t)sl * TS * D))[it];
        ((f32x4*)xs)[it] = v;
    }
}
constexpr int I_WINA = (D / 64) * (NWIN / 64), I_WO = (D / 64) * (D / 64), I_QKV = (D / 64) * (NQKV / 64), I_FIN = (D / 64) * (NUP / 64), I_FDN = (FF / 64) * (D / 64);
constexpr int WC_EARLY = I_WINA + 2 * I_WO + I_QKV + I_FIN + I_FDN, WC_ALL = WC_EARLY + I_FIN + I_FDN;
DI void wconv_items(Frame& F, int it_lo, int it_hi, int widx, int nw) {
    const Params& p = F.p;
    LAS float* scr = (LAS float*)(F.lds + F.wave * 16640);
    for (int it = it_lo + widx * NWAVES + F.wave; it < it_hi; it += nw * NWAVES) {
        int r = it;
        if (r < I_WINA) { transpose_item(p.a_w_in, D, NWIN, F.WinA, scr, r, F.lane); continue; } r -= I_WINA;
        if (r < I_WO) { transpose_item(p.a_w_o, D, D, F.WoA, scr, r, F.lane); continue; } r -= I_WO;
        if (r < I_QKV) { transpose_item(p.b_w_qkv, D, NQKV, F.Wqkv, scr, r, F.lane); continue; } r -= I_QKV;
        if (r < I_WO) { transpose_item(p.b_w_o, D, D, F.WoB, scr, r, F.lane); continue; } r -= I_WO;
        if (r < I_FIN) { transpose_item(p.f_w_in, D, NUP, F.Fin0, scr, r, F.lane, true); continue; } r -= I_FIN;
        if (r < I_FDN) { transpose_item(p.f_w_down, FF, D, F.Fdn0, scr, r, F.lane); continue; } r -= I_FDN;
        if (r < I_FIN) { transpose_item(p.f_w_in + (size_t)D * NUP, D, NUP, F.Fin1, scr, r, F.lane, true); continue; } r -= I_FIN;
        transpose_item(p.f_w_down + (size_t)FF * D, FF, D, F.Fdn1, scr, r, F.lane);
    }
}
DI void p0_phase(Frame& F) {
    const Params& p = F.p;
    wconv_items(F, 0, WC_EARLY, F.bid, F.G);
    for (int c = F.bid * NTHR + F.tid; c < D; c += F.G * NTHR) {
        const float g0 = p.a_gamma[c], g1 = p.a_gamma[D + c], g2 = p.a_gamma[2 * D + c];
        const float mx = fmaxf(g0, fmaxf(g1, g2));
        const float e0 = __expf(g0 - mx), e1 = __expf(g1 - mx), e2 = __expf(g2 - mx);
        F.LB[c] = e0 / (e0 + e1 + e2);
    }
    rms_phase(F, p.x_prompt, p.x_sample, p.norm_mix, nullptr, nullptr);
}

constexpr int GLA_UNITS = 2048 + 512;
constexpr int QT_STRIDE = 136, TT_STRIDE = 72;
constexpr int L_BCUM = 0, L_QT = 32768, L_KT = L_QT + 64 * QT_STRIDE * 2, L_KHT = L_KT + 64 * QT_STRIDE * 2, L_VT = L_KHT + 128 * TT_STRIDE * 2, L_PM = L_VT + 128 * TT_STRIDE * 2, L_GLA_END = L_PM + 64 * TT_STRIDE * 2;
static_assert(L_GLA_END <= LDS_BYTES, "gla lds");

DI f32x16 mma_lds(const LAS bf16* A, int astride, int arow0, const LAS bf16* B, int bstride, int brow0, int nks, int lane) {
    f32x16 acc; for (int i = 0; i < 16; ++i) acc[i] = 0.f;
    const int r = lane & 31, hf = lane >> 5;
    const LAS bf16* ap = A + (arow0 + r) * astride + 8 * hf; const LAS bf16* bp = B + (brow0 + r) * bstride + 8 * hf;
    for (int ks = 0; ks < nks; ++ks) { const bf16x8 a = *(const LAS bf16x8*)(ap + 16 * ks), b = *(const LAS bf16x8*)(bp + 16 * ks); acc = MFMA32(a, b, acc); }
    return acc;
}

template <int BLK>
DI void gla_a_unit(Frame& F, int u, int row0, int h) {
    LAS float* bcum = (LAS float*)(F.lds + L_BCUM);
    LAS bf16* qt = (LAS bf16*)(F.lds + L_QT); LAS bf16* kt = (LAS bf16*)(F.lds + L_KT); LAS bf16* khT = (LAS bf16*)(F.lds + L_KHT);
    LAS bf16* vT = (LAS bf16*)(F.lds + L_VT); LAS bf16* Pm = (LAS bf16*)(F.lds + L_PM);
    const int tid = F.tid, lane = F.lane, w = F.wave;
    const size_t hoff = (size_t)h * HD;
    constexpr int SEG = BLK / 4;
    { const int seg = tid >> 7, kc = tid & 127; float a = 0.f;
      const float* lp = F.LOGF + (size_t)(row0 + seg * SEG) * D + hoff + kc;
#pragma unroll
      for (int t = 0; t < SEG; ++t) { a += lp[(size_t)t * D]; bcum[(seg * SEG + t) * 128 + kc] = a; }
      __syncthreads();
      float off = 0.f;
      for (int s = 0; s < seg; ++s) off += bcum[(s * SEG + SEG - 1) * 128 + kc];
      __syncthreads();
      if (seg > 0) {
#pragma unroll
          for (int t = 0; t < SEG; ++t) bcum[(seg * SEG + t) * 128 + kc] += off;
      }
      __syncthreads(); }
    for (int i = tid; i < BLK * 16; i += NTHR) {
        const int t = i >> 4, c0 = (i & 15) * 8;
        const size_t goff = (size_t)(row0 + t) * D + hoff + c0;
        const u32x4 qv = *(const u32x4*)(F.QB + goff);
        const u32x4 vv = *(const u32x4*)(F.VB + goff);
        const f32x4 lf0 = *(const f32x4*)(F.LOGF + goff), lf1 = *(const f32x4*)(F.LOGF + goff + 4);
        float q[8] = {bflo(qv.x), bfhi(qv.x), bflo(qv.y), bfhi(qv.y), bflo(qv.z), bfhi(qv.z), bflo(qv.w), bfhi(qv.w)};
        float lf[8] = {lf0.x, lf0.y, lf0.z, lf0.w, lf1.x, lf1.y, lf1.z, lf1.w};
        float qtv[8], ktv[8], qhv[8], khv[8];
#pragma unroll
        for (int e = 0; e < 8; ++e) {
            const float b = bcum[t * 128 + c0 + e], bmid = bcum[(BLK / 2 - 1) * 128 + c0 + e], bend = bcum[(BLK - 1) * 128 + c0 + e];
            const float kk = 1.f - __expf(lf[e]);
            qtv[e] = q[e] * __expf(b - bmid); ktv[e] = kk * __expf(bmid - b); qhv[e] = q[e] * __expf(b); khv[e] = kk * __expf(bend - b);
            if (t == BLK - 1) F.DEC[(size_t)u * 128 + c0 + e] = __expf(bend);
        }
        u32x4 o; o.x = pk2(qtv[0], qtv[1]); o.y = pk2(qtv[2], qtv[3]); o.z = pk2(qtv[4], qtv[5]); o.w = pk2(qtv[6], qtv[7]);
        *(LAS u32x4*)(qt + t * QT_STRIDE + c0) = o;
        o.x = pk2(ktv[0], ktv[1]); o.y = pk2(ktv[2], ktv[3]); o.z = pk2(ktv[4], ktv[5]); o.w = pk2(ktv[6], ktv[7]);
        *(LAS u32x4*)(kt + t * QT_STRIDE + c0) = o;
        o.x = pk2(qhv[0], qhv[1]); o.y = pk2(qhv[2], qhv[3]); o.z = pk2(qhv[4], qhv[5]); o.w = pk2(qhv[6], qhv[7]);
        *(u32x4*)(F.QB + goff) = o;
        const unsigned vw[4] = {vv.x, vv.y, vv.z, vv.w};
#pragma unroll
        for (int e = 0; e < 8; ++e) {
            khT[(c0 + e) * TT_STRIDE + t] = f2bf(khv[e]);
            vT[(c0 + e) * TT_STRIDE + t] = (bf16)((e & 1) ? (vw[e >> 1] >> 16) : (vw[e >> 1] & 0xffffu));
        }
    }
    __syncthreads();
    const int r = lane & 31, hf = lane >> 5;
#pragma unroll
    for (int q2 = 0; q2 < 2; ++q2) {
        const int tl = w * 2 + q2, mt = tl >> 2, nt = tl & 3;
        const f32x16 acc = mma_lds(khT, TT_STRIDE, 32 * mt, vT, TT_STRIDE, 32 * nt, BLK / 16, lane);
        float* lp = F.LOCAL + (size_t)u * 16384 + 32 * nt + r;
#pragma unroll
        for (int i = 0; i < 16; ++i) lp[(size_t)(32 * mt + crow(i, hf)) * 128] = acc[i];
    }
    constexpr int NT2 = BLK / 32;
    if (w < NT2 * NT2) {
        const int mt = w / NT2, nt = w % NT2;
        if (nt > mt) {
#pragma unroll
            for (int i = 0; i < 16; ++i) Pm[(32 * mt + crow(i, hf)) * TT_STRIDE + 32 * nt + r] = 0;
        } else {
            const f32x16 acc = mma_lds(qt, QT_STRIDE, 32 * mt, kt, QT_STRIDE, 32 * nt, 8, lane);
#pragma unroll
            for (int i = 0; i < 16; ++i) { const int t = 32 * mt + crow(i, hf), s = 32 * nt + r; Pm[t * TT_STRIDE + s] = (s <= t) ? f2bf(acc[i]) : (bf16)0; }
        }
    }
    __syncthreads();
    if (w < NT2 * 4) {
        const int mt = w >> 2, nt = w & 3;
        const f32x16 acc = mma_lds(Pm, TT_STRIDE, 32 * mt, vT, TT_STRIDE, 32 * nt, BLK / 16, lane);
        float* op = F.OI + (size_t)(row0 + 32 * mt) * D + hoff + 32 * nt + r;
#pragma unroll
        for (int i = 0; i < 16; ++i) op[(size_t)crow(i, hf) * D] = acc[i];
    }
    __syncthreads();
}
DI void gla_a_phase(Frame& F) {
    for (int u = F.bid; u < GLA_UNITS; u += F.G) {
        if (u < 2048) { const int b = u >> 10, h = (u >> 6) & 15, c = u & 63; gla_a_unit<64>(F, u, b * SEQ + c * 64, h); }
        else { const int su = u - 2048, b = su >> 4, h = su & 15; gla_a_unit<32>(F, u, TP + b * 32, h); }
    }
}
DI void scan_phase(Frame& F) {
    const int gt = F.bid * NTHR + F.tid, NGT = F.G * NTHR;
    for (int it = gt; it < 32 * 4096; it += NGT) {
        const int bh = it >> 12, e = (it & 4095) * 4, kc = e >> 7;
        f32x4 S = {0.f, 0.f, 0.f, 0.f};
        float* __restrict__ lp = F.LOCAL + (size_t)(bh * 64) * 16384 + e; const float* __restrict__ dp = F.DEC + (size_t)(bh * 64) * 128 + kc;
        for (int c0 = 0; c0 < 64; c0 += 8) {
            f32x4 loc[8]; float d[8];
#pragma unroll
            for (int j = 0; j < 8; ++j) { loc[j] = *(const f32x4*)(lp + (size_t)(c0 + j) * 16384); d[j] = dp[(c0 + j) * 128]; }
#pragma unroll
            for (int j = 0; j < 8; ++j) { *(f32x4*)(lp + (size_t)(c0 + j) * 16384) = S; S = S * d[j] + loc[j]; }
        }
        *(f32x4*)(F.p.out + O_SP + (size_t)bh * 16384 + e) = S;
    }
    for (int it0 = gt; it0 < 512 * 4096; it0 += 4 * NGT) {
        f32x4 S0[4], loc[4]; float d[4];
#pragma unroll
        for (int j = 0; j < 4; ++j) { const int it = it0 + j * NGT; if (it < 512 * 4096) { const int bh = it >> 12, e = (it & 4095) * 4, kc = e >> 7;
            S0[j] = *(const f32x4*)(F.p.state_a_S + (size_t)bh * 16384 + e); loc[j] = *(const f32x4*)(F.LOCAL + (size_t)(2048 + bh) * 16384 + e); d[j] = F.DEC[(size_t)(2048 + bh) * 128 + kc]; } }
#pragma unroll
        for (int j = 0; j < 4; ++j) { const int it = it0 + j * NGT; if (it < 512 * 4096) { const int bh = it >> 12, e = (it & 4095) * 4;
            *(f32x4*)(F.p.out + O_SS + (size_t)bh * 16384 + e) = S0[j] * d[j] + loc[j]; } }
    }
}
constexpr int OB_STRIDE = 132;
template <int BLK>
DI void gla_c_unit(Frame& F, const float* __restrict__ S, int row0, int h) {
    LAS float* ob = (LAS float*)F.lds;
    const int tid = F.tid, lane = F.lane, w = F.wave, r = lane & 31, hf = lane >> 5;
    const size_t hoff = (size_t)h * HD;
    constexpr int TPR_ = NTHR / BLK, CPT_ = 128 / TPR_;
    u32x4 sgv[CPT_ / 8];
    { const int t = tid / TPR_, c0 = (tid % TPR_) * CPT_;
#pragma unroll
      for (int e8 = 0; e8 < CPT_ / 8; ++e8) sgv[e8] = *(const u32x4*)(F.SG + (size_t)(row0 + t) * D + hoff + c0 + 8 * e8); }
    if (w < (BLK / 32) * 4) {
        const int mt = w >> 2, nt = w & 3;
        f32x16 acc; for (int i = 0; i < 16; ++i) acc[i] = 0.f;
        float oiv[16];
        { const float* oi = F.OI + (size_t)(row0 + 32 * mt) * D + hoff + 32 * nt + r;
#pragma unroll
          for (int i = 0; i < 16; ++i) oiv[i] = oi[(size_t)crow(i, hf) * D]; }
        const bf16* ap = F.QB + (size_t)(row0 + 32 * mt + r) * D + hoff + 8 * hf;
        const float* sp = S + (size_t)(8 * hf) * 128 + 32 * nt + r;
#pragma unroll
        for (int ks = 0; ks < 8; ++ks) {
            const bf16x8 a = *(const bf16x8*)(ap + 16 * ks);
            float sv[8];
#pragma unroll
            for (int e = 0; e < 8; ++e) sv[e] = sp[(size_t)(16 * ks + e) * 128];
            u32x4 bb; bb.x = pk2(sv[0], sv[1]); bb.y = pk2(sv[2], sv[3]); bb.z = pk2(sv[4], sv[5]); bb.w = pk2(sv[6], sv[7]);
            acc = MFMA32(a, __builtin_bit_cast(bf16x8, bb), acc);
        }
#pragma unroll
        for (int i = 0; i < 16; ++i) { const int t = crow(i, hf); ob[(32 * mt + t) * OB_STRIDE + 32 * nt + r] = acc[i] + oiv[i]; }
    }
    __syncthreads();
    {
        constexpr int TPR = NTHR / BLK;
        constexpr int CPT = 128 / TPR;
        const int t = tid / TPR, j = tid % TPR, c0 = j * CPT;
        float v[CPT]; float ss = 0.f;
#pragma unroll
        for (int e = 0; e < CPT; ++e) { v[e] = ob[t * OB_STRIDE + c0 + e]; ss += v[e] * v[e]; }
#pragma unroll
        for (int o = 1; o < TPR; o <<= 1) ss += __shfl_xor(ss, o);
        const float rstd = rsqrtf(ss * (1.f / HD) + EPS);
        const size_t goff = (size_t)(row0 + t) * D + hoff + c0;
#pragma unroll
        for (int e8 = 0; e8 < CPT / 8; ++e8) {
            const u32x4 sg = sgv[e8];
            const f32x4 n0 = *(const f32x4*)(F.p.a_norm_o + c0 + 8 * e8), n1 = *(const f32x4*)(F.p.a_norm_o + c0 + 8 * e8 + 4);
            const float* vv = v + 8 * e8;
            u32x4 o;
            o.x = pk2(vv[0] * rstd * n0.x * bflo(sg.x), vv[1] * rstd * n0.y * bfhi(sg.x));
            o.y = pk2(vv[2] * rstd * n0.z * bflo(sg.y), vv[3] * rstd * n0.w * bfhi(sg.y));
            o.z = pk2(vv[4] * rstd * n1.x * bflo(sg.z), vv[5] * rstd * n1.y * bfhi(sg.z));
            o.w = pk2(vv[6] * rstd * n1.z * bflo(sg.w), vv[7] * rstd * n1.w * bfhi(sg.w));
            *(u32x4*)(F.HB + goff + 8 * e8) = o;
        }
    }
    __syncthreads();
}
DI void gla_c_phase(Frame& F) {
    for (int u = F.bid; u < GLA_UNITS; u += F.G) {
        if (u < 2048) { const int b = u >> 10, h = (u >> 6) & 15, c = u & 63; gla_c_unit<64>(F, F.LOCAL + (size_t)u * 16384, b * SEQ + c * 64, h); }
        else { const int su = u - 2048, b = su >> 4, h = su & 15; gla_c_unit<32>(F, F.p.state_a_S + (size_t)su * 16384, TP + b * 32, h); }
    }
}
DI void convfix_phase(Frame& F, int layer, const float* edge) {
    const Params& p = F.p;
    const int gt = F.bid * NTHR + F.tid, NGT = F.G * NTHR;
    constexpr int NCG = FF / 8, NHB = T / 32;
    const float* cw = p.f_conv_w + (size_t)layer * 3 * FF; const float* cbp = p.f_conv_b + (size_t)layer * FF;
    const float* eu_first = edge; const float* eg_first = edge + (size_t)NHB * 2 * FF; const float* eu_last = edge + (size_t)NHB * 4 * FF;
    for (int it = gt; it < (128 + 32) * NCG; it += NGT) {
        const int blk = it / NCG, c0 = (it % NCG) * 8, hb = blk < 128 ? 2 * blk : 256 + (blk - 128);
        const bool smp = hb >= 256; const bool first = smp || ((hb & 127) == 0), lastb = smp || ((hb & 127) == 126);
        const int hbl = smp ? hb : hb + 1;
        float um2[8], um1[8], u0[8], u1[8], g0[8], g1[8], w0[8], w1[8], w2[8], bb[8];
#pragma unroll
        for (int e = 0; e < 8; ++e) { w0[e] = cw[c0 + e]; w1[e] = cw[FF + c0 + e]; w2[e] = cw[2 * FF + c0 + e]; bb[e] = cbp[c0 + e]; um2[e] = 0.f; um1[e] = 0.f;
            u0[e] = eu_first[((size_t)hb * 2) * FF + c0 + e]; u1[e] = eu_first[((size_t)hb * 2 + 1) * FF + c0 + e];
            g0[e] = eg_first[((size_t)hb * 2) * FF + c0 + e]; g1[e] = eg_first[((size_t)hb * 2 + 1) * FF + c0 + e]; }
        if (first) {
            if (smp) { const float* st = p.conv_state + ((size_t)(layer * 32 + (hb - 256)) * 2) * FF + c0;
#pragma unroll
                for (int e = 0; e < 8; ++e) { um2[e] = st[e]; um1[e] = st[FF + e]; } }
        } else {
#pragma unroll
            for (int e = 0; e < 8; ++e) { um2[e] = eu_last[((size_t)(hb - 1) * 2) * FF + c0 + e]; um1[e] = eu_last[((size_t)(hb - 1) * 2 + 1) * FF + c0 + e]; }
        }
        float a0[8], a1[8];
#pragma unroll
        for (int e = 0; e < 8; ++e) { a0[e] = fsilu(bb[e] + um2[e] * w0[e] + um1[e] * w1[e] + u0[e] * w2[e]) * g0[e]; a1[e] = fsilu(bb[e] + um1[e] * w0[e] + u0[e] * w1[e] + u1[e] * w2[e]) * g1[e]; }
        u32x4 o; o.x = pk2(a0[0], a0[1]); o.y = pk2(a0[2], a0[3]); o.z = pk2(a0[4], a0[5]); o.w = pk2(a0[6], a0[7]);
        *(u32x4*)(F.ACT + (size_t)(hb * 32) * FF + c0) = o;
        o.x = pk2(a1[0], a1[1]); o.y = pk2(a1[2], a1[3]); o.z = pk2(a1[4], a1[5]); o.w = pk2(a1[6], a1[7]);
        *(u32x4*)(F.ACT + (size_t)(hb * 32 + 1) * FF + c0) = o;
        if (lastb) {
            float* dst = smp ? p.out + O_CS + ((size_t)(layer * 32 + (hb - 256)) * 2) * FF + c0 : p.out + O_CP + ((size_t)(layer * 2 + (hb >> 7)) * 2) * FF + c0;
#pragma unroll
            for (int e = 0; e < 8; ++e) { dst[e] = eu_last[((size_t)hbl * 2) * FF + c0 + e]; dst[FF + e] = eu_last[((size_t)hbl * 2 + 1) * FF + c0 + e]; }
        }
    }
}
DI void cacheK_fill(Frame& F, int widx, int nw) {
    const Params& p = F.p;
    const int gt = widx * NTHR + F.tid, NGT = nw * NTHR;
    for (int it0 = gt; it0 < 32 * 512 * (D / 8); it0 += 4 * NGT) {
        f32x4 a[4], c[4];
#pragma unroll
        for (int j = 0; j < 4; ++j) { const int it = it0 + j * NGT; if (it < 32 * 512 * (D / 8)) { const int row = it >> 8, cc = (it & 255) * 8;
            a[j] = __builtin_nontemporal_load((const f32x4*)(p.cache_k + (size_t)row * D + cc)); c[j] = __builtin_nontemporal_load((const f32x4*)(p.cache_k + (size_t)row * D + cc + 4)); } }
#pragma unroll
        for (int j = 0; j < 4; ++j) { const int it = it0 + j * NGT; if (it < 32 * 512 * (D / 8)) { const int row = it >> 8, cc = (it & 255) * 8, b = row >> 9, jj = row & 511;
            u32x4 o; o.x = pk2(a[j].x, a[j].y); o.y = pk2(a[j].z, a[j].w); o.z = pk2(c[j].x, c[j].y); o.w = pk2(c[j].z, c[j].w);
            __builtin_nontemporal_store(o, (u32x4*)(F.KS + ((size_t)b * SROWS + jj) * D + cc)); } }
    }
}
constexpr int VT_NP = 2 * 64 * 16, VT_NN = 32 * 16, VT_NC = 32 * 16 * 8;
DI void vtrans_items(Frame& F, int it_lo, int it_hi, int widx, int nw) {
    const Params& p = F.p; const int lane = F.lane;
    LAS bf16* tile = (LAS bf16*)(F.lds + F.wave * 16640);
    for (int it = it_lo + widx * NWAVES + F.wave; it < it_hi; it += nw * NWAVES) {
        int nrows = 64; bf16* dst; int dstride;
        if (it < VT_NP) {
            const int h = it & 15, tb = (it >> 4) & 63, b = it >> 10;
            const bf16* src = F.QKV + (size_t)(b * SEQ + tb * 64) * NQKV + 2 * D + h * HD + 2 * lane;
            unsigned u[64];
#pragma unroll
            for (int i = 0; i < 64; ++i) u[i] = *(const unsigned*)(src + (size_t)i * NQKV);
#pragma unroll
            for (int i = 0; i < 64; ++i) *(LAS unsigned*)(tile + i * 130 + 2 * lane) = u[i];
            dst = F.VT + ((size_t)(b * 16 + h) * HD) * SEQ + tb * 64; dstride = SEQ;
        } else if (it < VT_NP + VT_NN) {
            const int r = it - VT_NP, h = r & 15, b = r >> 4;
            nrows = 32;
            const bf16* src = F.QKV + (size_t)(TP + b * 32) * NQKV + 2 * D + h * HD + 2 * lane;
            unsigned u[32];
#pragma unroll
            for (int i = 0; i < 32; ++i) u[i] = *(const unsigned*)(src + (size_t)i * NQKV);
#pragma unroll
            for (int i = 0; i < 32; ++i) *(LAS unsigned*)(tile + i * 130 + 2 * lane) = u[i];
            dst = F.VTS + ((size_t)(b * 16 + h) * HD) * SROWS + 512; dstride = SROWS;
        } else {
            const int r = it - VT_NP - VT_NN, h = r & 15, jb = (r >> 4) & 7, b = r >> 7;
            const float* src = p.cache_v + ((size_t)(b * 512 + jb * 64) * NH + h) * HD + 2 * lane;
#pragma unroll
            for (int hh = 0; hh < 2; ++hh) {
                f32x2 x[32];
#pragma unroll
                for (int i = 0; i < 32; ++i) x[i] = __builtin_nontemporal_load((const f32x2*)(src + (size_t)(32 * hh + i) * D));
#pragma unroll
                for (int i = 0; i < 32; ++i) *(LAS unsigned*)(tile + (32 * hh + i) * 130 + 2 * lane) = pk2(x[i].x, x[i].y);
            }
            dst = F.VTS + ((size_t)(b * 16 + h) * HD) * SROWS + jb * 64; dstride = SROWS;
        }
        asm volatile("s_waitcnt lgkmcnt(0)" ::: "memory");
        const int tp = lane & 31, dh = lane >> 5;
        if (2 * tp < nrows) {
#pragma unroll 8
            for (int pp = 0; pp < 64; ++pp) { const int dv = 2 * pp + dh;
                const unsigned lo = tile[(2 * tp) * 130 + dv], hi = tile[(2 * tp + 1) * 130 + dv];
                *(unsigned*)(dst + (size_t)dv * dstride + 2 * tp) = lo | (hi << 16); }
        }
        asm volatile("s_waitcnt lgkmcnt(0)" ::: "memory");
    }
}
DI void prep_phase(Frame& F) {
    const Params& p = F.p;
    const int gw = F.bid * NWAVES + F.wave, NGW = F.G * NWAVES, lane = F.lane;
    const float qscale = 0.08838834764831845f * 1.4426950408889634f;
    for (int m = gw; m < T; m += NGW) {
        const bf16* src = F.QKV + (size_t)m * NQKV + lane * 8;
        const bool smp = m >= TP; const int b = smp ? (m - TP) >> 5 : m >> 12, t = smp ? (m - TP) & 31 : m & 4095;
        const int hc = (lane & 15) * 8;
        u32x4 xq[4], xk[4], xv[4];
#pragma unroll
        for (int j = 0; j < 4; ++j) { xq[j] = *(const u32x4*)(src + j * 512); xk[j] = *(const u32x4*)(src + D + j * 512); xv[j] = *(const u32x4*)(src + 2 * D + j * 512); }
        float* ko = nullptr; float* vo = nullptr;
        if (smp) { ko = p.out + O_KSM + (size_t)(m - TP) * D + lane * 8; vo = p.out + O_VSM + (size_t)(m - TP) * D + lane * 8; }
        else if (t >= SEQ - 512) { ko = p.out + O_KP + ((size_t)b * 512 + (t - (SEQ - 512))) * D + lane * 8; vo = p.out + O_VP + ((size_t)b * 512 + (t - (SEQ - 512))) * D + lane * 8; }
        const f32x4 gq0 = *(const f32x4*)(p.b_q_norm + hc), gq1 = *(const f32x4*)(p.b_q_norm + hc + 4);
        const f32x4 gk0 = *(const f32x4*)(p.b_k_norm + hc), gk1 = *(const f32x4*)(p.b_k_norm + hc + 4);
        bf16* qdst = F.QB + (size_t)m * D + lane * 8;
        bf16* kdst = smp ? F.KS + ((size_t)b * SROWS + 512 + t) * D + lane * 8 : F.KN + (size_t)m * D + lane * 8;
#pragma unroll
        for (int j = 0; j < 4; ++j) {
            { const u32x4 x = xq[j]; const float v[8] = {bflo(x.x), bfhi(x.x), bflo(x.y), bfhi(x.y), bflo(x.z), bfhi(x.z), bflo(x.w), bfhi(x.w)};
              float ss = 0.f;
#pragma unroll
              for (int e = 0; e < 8; ++e) ss += v[e] * v[e];
              ss += __shfl_xor(ss, 1); ss += __shfl_xor(ss, 2); ss += __shfl_xor(ss, 4); ss += __shfl_xor(ss, 8);
              const float rstd = rsqrtf(ss * (1.f / HD) + EPS) * qscale;
              u32x4 o; o.x = pk2(v[0] * rstd * gq0.x, v[1] * rstd * gq0.y); o.y = pk2(v[2] * rstd * gq0.z, v[3] * rstd * gq0.w);
              o.z = pk2(v[4] * rstd * gq1.x, v[5] * rstd * gq1.y); o.w = pk2(v[6] * rstd * gq1.z, v[7] * rstd * gq1.w);
              *(u32x4*)(qdst + j * 512) = o; }
            { const u32x4 x = xk[j]; const float v[8] = {bflo(x.x), bfhi(x.x), bflo(x.y), bfhi(x.y), bflo(x.z), bfhi(x.z), bflo(x.w), bfhi(x.w)};
              float ss = 0.f;
#pragma unroll
              for (int e = 0; e < 8; ++e) ss += v[e] * v[e];
              ss += __shfl_xor(ss, 1); ss += __shfl_xor(ss, 2); ss += __shfl_xor(ss, 4); ss += __shfl_xor(ss, 8);
              const float rstd = rsqrtf(ss * (1.f / HD) + EPS);
              const f32x4 a = {v[0] * rstd * gk0.x, v[1] * rstd * gk0.y, v[2] * rstd * gk0.z, v[3] * rstd * gk0.w};
              const f32x4 c = {v[4] * rstd * gk1.x, v[5] * rstd * gk1.y, v[6] * rstd * gk1.z, v[7] * rstd * gk1.w};
              u32x4 o; o.x = pk2(a.x, a.y); o.y = pk2(a.z, a.w); o.z = pk2(c.x, c.y); o.w = pk2(c.z, c.w);
              *(u32x4*)(kdst + j * 512) = o;
              if (ko) { *(f32x4*)(ko + j * 512) = a; *(f32x4*)(ko + j * 512 + 4) = c; } }
            if (vo) { const u32x4 x = xv[j];
              const f32x4 a = {bflo(x.x), bfhi(x.x), bflo(x.y), bfhi(x.y)}, c = {bflo(x.z), bfhi(x.z), bflo(x.w), bfhi(x.w)};
              *(f32x4*)(vo + j * 512) = a; *(f32x4*)(vo + j * 512 + 4) = c; }
        }
    }
    vtrans_items(F, 0, VT_NP + VT_NN, F.bid, F.G);
}
DI void attn_scores(f32x16 (&oacc)[4], float& mrun, float& lsum, const bf16x8 (&qf)[8], const bf16x8 (&kf)[8], bf16x8 (&pfr)[2], int relb, const LAS float* bias, float bias0, int hf) {
    f32x16 s; for (int i = 0; i < 16; ++i) s[i] = 0.f;
#pragma unroll
    for (int kk = 0; kk < 8; ++kk) s = MFMA32(kf[kk], qf[kk], s);
    if (relb + 31 <= -128) {
#pragma unroll
        for (int i = 0; i < 16; ++i) s[i] += bias0;
    } else {
#pragma unroll
        for (int i = 0; i < 16; ++i) { int rel = relb + crow(i, hf); rel = rel < -128 ? -128 : (rel > 63 ? 63 : rel); s[i] += bias[rel + 128]; }
    }
    float mt = s[0];
#pragma unroll
    for (int i = 1; i < 16; ++i) mt = fmaxf(mt, s[i]);
    mt = fmaxf(mt, __shfl_xor(mt, 32));
    constexpr float DEFER_THR = 8.f;
    if (__any(mt - mrun > DEFER_THR)) {
        const float mnew = fmaxf(mrun, mt), alpha = __builtin_amdgcn_exp2f(mrun - mnew);
        mrun = mnew; lsum *= alpha;
#pragma unroll
        for (int bl = 0; bl < 4; ++bl)
#pragma unroll
            for (int i = 0; i < 16; ++i) oacc[bl][i] *= alpha;
    }
    float ps = 0.f; float pv[16];
#pragma unroll
    for (int i = 0; i < 16; ++i) { pv[i] = __builtin_amdgcn_exp2f(s[i] - mrun); ps += pv[i]; }
    lsum += ps;
#pragma unroll
    for (int kb = 0; kb < 2; ++kb) {
        u32x4 pb; pb.x = pk2(pv[8 * kb], pv[8 * kb + 1]); pb.y = pk2(pv[8 * kb + 2], pv[8 * kb + 3]); pb.z = pk2(pv[8 * kb + 4], pv[8 * kb + 5]); pb.w = pk2(pv[8 * kb + 6], pv[8 * kb + 7]);
        pfr[kb] = __builtin_bit_cast(bf16x8, pb);
    }
}
DI void attn_pv(f32x16 (&oacc)[4], const bf16x8 (&pfr)[2], const bf16x8 (&vf)[2][4]) {
#pragma unroll
    for (int kb = 0; kb < 2; ++kb)
#pragma unroll
        for (int bl = 0; bl < 4; ++bl) oacc[bl] = MFMA32(vf[kb][bl], pfr[kb], oacc[bl]);
}
DI void attn_step(f32x16 (&oacc)[4], float& mrun, float& lsum, const bf16x8 (&qf)[8], const bf16x8 (&kf)[8], const bf16x8 (&vf)[2][4], int relb, const LAS float* bias, float bias0, int hf) {
    bf16x8 pfr[2];
    attn_scores(oacc, mrun, lsum, qf, kf, pfr, relb, bias, bias0, hf);
    attn_pv(oacc, pfr, vf);
}
constexpr int AK_STRIDE = 136, AV_STRIDE = 72, A_KBYTES = 64 * AK_STRIDE * 2, A_VBYTES = 128 * AV_STRIDE * 2, A_BUF = A_KBYTES + A_VBYTES;
constexpr int A_BIAS_OFF = 135168;
static_assert(2 * A_BUF <= A_BIAS_OFF && 8 * 16384 + 8 * 256 <= A_BIAS_OFF && A_BIAS_OFF + 768 <= LDS_BYTES - 16, "attention lds");

DI void attn_phase(Frame& F) {
    const Params& p = F.p;
    const int lane = F.lane, w = F.wave, tid = F.tid, r = lane & 31, hf = lane >> 5;
    constexpr float L2E = 1.4426950408889634f;
    for (int su = F.bid; su < 512; su += F.G) {
        const int h = su & 15, b = su >> 4, qrow0 = TP + b * 32;
        const bf16* kbase = F.KS + (size_t)(b * SROWS) * D + h * HD; const bf16* vbase = F.VTS + ((size_t)(b * 16 + h) * HD) * SROWS;
        LAS float* bias = (LAS float*)(F.lds + A_BIAS_OFF);
        if (tid < 192) bias[tid] = p.b_rel_bias[tid * NH + h] * L2E;
        bf16x8 qf[8];
        { const bf16* qp = F.QB + (size_t)(qrow0 + r) * D + h * HD + 8 * hf;
#pragma unroll
          for (int kk = 0; kk < 8; ++kk) qf[kk] = *(const bf16x8*)(qp + 16 * kk); }
        f32x16 oacc[4];
#pragma unroll
        for (int bl = 0; bl < 4; ++bl) for (int i = 0; i < 16; ++i) oacc[bl][i] = 0.f;
        float mrun = -1e30f, lsum = 0.f;
        __syncthreads();
        const float bias0 = bias[0];
        for (int kt = w; kt < 17; kt += 8) {
            bf16x8 kf[8], vf[2][4];
            { const bf16* kp = kbase + (size_t)(32 * kt + r) * D + 8 * hf;
#pragma unroll
              for (int kk = 0; kk < 8; ++kk) kf[kk] = *(const bf16x8*)(kp + 16 * kk); }
#pragma unroll
            for (int kb = 0; kb < 2; ++kb)
#pragma unroll
                for (int bl = 0; bl < 4; ++bl) { const bf16* vp = vbase + (size_t)(32 * bl + r) * SROWS + 32 * kt + 16 * kb + 4 * hf;
                    const u32x2 v0 = *(const u32x2*)vp, v1 = *(const u32x2*)(vp + 8); u32x4 vv; vv.x = v0.x; vv.y = v0.y; vv.z = v1.x; vv.w = v1.y; vf[kb][bl] = __builtin_bit_cast(bf16x8, vv); }
            attn_step(oacc, mrun, lsum, qf, kf, vf, -512 + 32 * kt - r, bias, bias0, hf);
        }
        lsum += __shfl_xor(lsum, 32);
        LAS float* op = (LAS float*)(F.lds + w * 16384); LAS float* ml = (LAS float*)(F.lds + 8 * 16384 + w * 256);
#pragma unroll
        for (int bl = 0; bl < 4; ++bl)
#pragma unroll
            for (int i = 0; i < 16; ++i) op[(32 * bl + crow(i, hf)) * 32 + r] = oacc[bl][i];
        if (hf == 0) { ml[2 * r] = mrun; ml[2 * r + 1] = lsum; }
        __syncthreads();
        { const int q = tid & 31, dv0 = (tid >> 5) * 8;
          float mw[8], M = -1e30f;
#pragma unroll
          for (int ww = 0; ww < 8; ++ww) { mw[ww] = ((LAS float*)(F.lds + 8 * 16384 + ww * 256))[2 * q]; M = fmaxf(M, mw[ww]); }
          float o[8] = {0.f, 0.f, 0.f, 0.f, 0.f, 0.f, 0.f, 0.f}, L = 0.f;
#pragma unroll
          for (int ww = 0; ww < 8; ++ww) { const float sc = __builtin_amdgcn_exp2f(mw[ww] - M); L += sc * ((LAS float*)(F.lds + 8 * 16384 + ww * 256))[2 * q + 1];
              const LAS float* pp = (LAS float*)(F.lds + ww * 16384) + dv0 * 32 + q;
#pragma unroll
              for (int e = 0; e < 8; ++e) o[e] += sc * pp[e * 32]; }
          const float inv = 1.f / L;
          u32x4 ov; ov.x = pk2(o[0] * inv, o[1] * inv); ov.y = pk2(o[2] * inv, o[3] * inv); ov.z = pk2(o[4] * inv, o[5] * inv); ov.w = pk2(o[6] * inv, o[7] * inv);
          *(u32x4*)(F.HB + (size_t)(qrow0 + q) * D + h * HD + dv0) = ov; }
        __syncthreads();
    }
    const int vbid = (F.G % 8 == 0) ? (F.bid & 7) * (F.G >> 3) + (F.bid >> 3) : F.bid;
    for (int unit = vbid; unit < 512; unit += F.G) {
        const int cq = unit & 15, h = (unit >> 4) & 15, b = unit >> 8;
        const int cw = 4 * cq + (w >> 1), qrow0 = b * SEQ + cw * 64 + (w & 1) * 32;
        const int kc_lo = (4 * cq - 8) > 0 ? 4 * cq - 8 : 0, kc_hi = 4 * cq + 3;
        LAS float* bias = (LAS float*)(F.lds + A_BIAS_OFF);
        if (tid < 192) bias[tid] = p.b_rel_bias[tid * NH + h] * L2E;
        const bf16* kg = F.KN + (size_t)(b * SEQ) * D + h * HD;
        const bf16* vg = F.VT + ((size_t)(b * 16 + h) * HD) * SEQ;
        const int kr0 = tid >> 4, ks0 = tid & 15, vr0 = tid >> 3, vs0 = tid & 7;
        u32x4 stA[4], stB[4];
#define A_GLOAD(kc, st) do { st[0] = *(const u32x4*)(kg + (size_t)((kc) * 64 + kr0) * D + ks0 * 8); st[1] = *(const u32x4*)(kg + (size_t)((kc) * 64 + kr0 + 32) * D + ks0 * 8); \
                         st[2] = *(const u32x4*)(vg + (size_t)vr0 * SEQ + (kc) * 64 + vs0 * 8); st[3] = *(const u32x4*)(vg + (size_t)(vr0 + 64) * SEQ + (kc) * 64 + vs0 * 8); } while (0)
#define A_LWRITE(buf, st) do { LAS bf16* kb_ = (LAS bf16*)(F.lds + (buf) * A_BUF); LAS bf16* vb_ = (LAS bf16*)(F.lds + (buf) * A_BUF + A_KBYTES); \
                         *(LAS u32x4*)(kb_ + kr0 * AK_STRIDE + ks0 * 8) = st[0]; *(LAS u32x4*)(kb_ + (kr0 + 32) * AK_STRIDE + ks0 * 8) = st[1]; \
                         *(LAS u32x4*)(vb_ + vr0 * AV_STRIDE + vs0 * 8) = st[2]; *(LAS u32x4*)(vb_ + (vr0 + 64) * AV_STRIDE + vs0 * 8) = st[3]; } while (0)
#define A_COMPUTE(kc, cur) do { if ((kc) >= cw - 8 && (kc) <= cw) { \
                const LAS bf16* Kb = (const LAS bf16*)(F.lds + (cur) * A_BUF); const LAS bf16* Vb = (const LAS bf16*)(F.lds + (cur) * A_BUF + A_KBYTES); \
                _Pragma("unroll 1") for (int t = 0; t < 2; ++t) { \
                    bf16x8 pfr[2]; \
                    { bf16x8 kf[8]; \
                      _Pragma("unroll") for (int kk = 0; kk < 8; ++kk) kf[kk] = *(const LAS bf16x8*)(Kb + (32 * t + r) * AK_STRIDE + 16 * kk + 8 * hf); \
                      attn_scores(oacc, mrun, lsum, qf, kf, pfr, ((kc) * 64 + 32 * t) - (cw * 64 + (w & 1) * 32) - r, bias, bias0, hf); } \
                    { bf16x8 vf[2][4]; \
                      _Pragma("unroll") for (int kb = 0; kb < 2; ++kb) _Pragma("unroll") for (int bl = 0; bl < 4; ++bl) { const LAS bf16* vp = Vb + (32 * bl + r) * AV_STRIDE + 32 * t + 16 * kb + 4 * hf; \
                            const u32x2 v0 = *(const LAS u32x2*)vp, v1 = *(const LAS u32x2*)(vp + 8); u32x4 vv; vv.x = v0.x; vv.y = v0.y; vv.z = v1.x; vv.w = v1.y; vf[kb][bl] = __builtin_bit_cast(bf16x8, vv); } \
                      attn_pv(oacc, pfr, vf); } } } } while (0)
        A_GLOAD(kc_lo, stA);
        A_GLOAD(kc_lo + 1, stB);
        bf16x8 qf[8];
        { const bf16* qp = F.QB + (size_t)(qrow0 + r) * D + h * HD + 8 * hf;
#pragma unroll
          for (int kk = 0; kk < 8; ++kk) qf[kk] = *(const bf16x8*)(qp + 16 * kk); }
        f32x16 oacc[4];
#pragma unroll
        for (int bl = 0; bl < 4; ++bl) for (int i = 0; i < 16; ++i) oacc[bl][i] = 0.f;
        float mrun = -1e30f, lsum = 0.f;
        A_LWRITE(0, stA);
        __syncthreads();
        const float bias0 = bias[0];
        for (int kc = kc_lo; kc <= kc_hi; kc += 2) {
            if (kc + 2 <= kc_hi) A_GLOAD(kc + 2, stA);
            A_COMPUTE(kc, 0);
            A_LWRITE(1, stB);
            __syncthreads();
            if (kc + 3 <= kc_hi) A_GLOAD(kc + 3, stB);
            A_COMPUTE(kc + 1, 1);
            if (kc + 2 <= kc_hi) A_LWRITE(0, stA);
            __syncthreads();
        }
#undef A_GLOAD
#undef A_LWRITE
#undef A_COMPUTE
        lsum += __shfl_xor(lsum, 32);
        const float inv = 1.f / lsum;
        bf16* op = F.HB + (size_t)(qrow0 + r) * D + h * HD;
#pragma unroll
        for (int bl = 0; bl < 4; ++bl)
#pragma unroll
            for (int g4 = 0; g4 < 4; ++g4) {
                u32x2 o; o.x = pk2(oacc[bl][4 * g4] * inv, oacc[bl][4 * g4 + 1] * inv); o.y = pk2(oacc[bl][4 * g4 + 2] * inv, oacc[bl][4 * g4 + 3] * inv);
                *(u32x2*)(op + 32 * bl + 8 * g4 + 4 * hf) = o;
            }
    }
}

#define XB_TMO      128
#define XB_XCNT(j)  (256  + 64 * (j))
#define XB_XSUB(j)  (1280 + 64 * (j))
#define XB_XGEN(j)  (2304 + 64 * (j))
#define XB_TOP      3328
#define XB_TOPGEN   3392
#define XCD_BAR_WORDS 3456
#define XB_SPIN_CAP (1u << 18)
DI unsigned xb_ld(unsigned* p)              { return __hip_atomic_load(p, __ATOMIC_RELAXED, __HIP_MEMORY_SCOPE_AGENT); }
DI unsigned xb_add(unsigned* p, unsigned v) { return __hip_atomic_fetch_add(p, v, __ATOMIC_RELAXED, __HIP_MEMORY_SCOPE_AGENT); }
DI unsigned xb_xcc_id() { return (unsigned)__builtin_amdgcn_s_getreg((3 << 11) | 20) & 0xFu; }
#define XB_SPIN(cond, bar) do { unsigned _sp = 0; while (cond) { __builtin_amdgcn_s_sleep(1); \
    if ((++_sp & 255u) == 0u) { if (xb_ld(&(bar)[XB_TMO])) break; if (_sp > XB_SPIN_CAP) { atomicAdd(&(bar)[XB_TMO], 1u); break; } } } } while (0)
struct XcdBarrier { unsigned* bar; unsigned x; volatile LAS unsigned* st; };
DI XcdBarrier xcd_barrier_post(unsigned* bar, volatile LAS unsigned* st) {
    XcdBarrier b; b.bar = bar; b.x = xb_xcc_id(); b.st = st;
    if (threadIdx.x == 0) (void)xb_add(&bar[XB_XCNT(b.x)], 1u);
    return b;
}
DI void xcd_barrier_complete(unsigned* bar, unsigned x, unsigned& nloc, unsigned& nx) {
    const unsigned G = gridDim.x * gridDim.y * gridDim.z;
    unsigned sum, cnt, mine, sp = 0u;
    for (;;) {
        sum = 0u; cnt = 0u; mine = 0u;
#pragma unroll
        for (unsigned j = 0; j < 16; ++j) { const unsigned c = xb_ld(&bar[XB_XCNT(j)]); sum += c; cnt += (c > 0u) ? 1u : 0u; mine = (j == x) ? c : mine; }
        if (sum == G) break;
        __builtin_amdgcn_s_sleep(1);
        if ((++sp & 255u) == 0u) { if (xb_ld(&bar[XB_TMO])) break; if (sp > XB_SPIN_CAP) { atomicAdd(&bar[XB_TMO], 1u); break; } }
    }
    nloc = mine > 0u ? mine : 1u; nx = cnt > 0u ? cnt : 1u;
}
DI void xcd_barrier(const XcdBarrier& b) {
    asm volatile("s_waitcnt vmcnt(0)" ::: "memory");
    __syncthreads();
    if (threadIdx.x == 0) {
        unsigned* bar = b.bar;
        __builtin_amdgcn_s_waitcnt(0);
        unsigned nloc = b.st[0], nx = b.st[1];
        if (nloc == 0u) { xcd_barrier_complete(bar, b.x, nloc, nx); b.st[0] = nloc; b.st[1] = nx; }
        const unsigned old = xb_add(&bar[XB_XSUB(b.x)], 1u);
        const unsigned gen = old / nloc;
        if (old + 1u == (gen + 1u) * nloc) {
            __builtin_amdgcn_fence(__ATOMIC_RELEASE, "agent");
            asm volatile("s_waitcnt vmcnt(0)" ::: "memory");
            const unsigned og = xb_add(&bar[XB_TOP], 1u);
            const unsigned tg = og / nx;
            if (og + 1u == (tg + 1u) * nx) xb_add(&bar[XB_TOPGEN], 1u);
            else XB_SPIN(xb_ld(&bar[XB_TOPGEN]) == tg, bar);
            __builtin_amdgcn_fence(__ATOMIC_ACQUIRE, "agent");
            xb_add(&bar[XB_XGEN(b.x)], 1u);
            asm volatile("s_waitcnt vmcnt(0)" ::: "memory");
        } else {
            XB_SPIN(xb_ld(&bar[XB_XGEN(b.x)]) == gen, bar);
            __builtin_amdgcn_fence(__ATOMIC_ACQUIRE, "agent");
            asm volatile("s_waitcnt vmcnt(0)" ::: "memory");
        }
    }
    __syncthreads();
}

enum { PH_P0, PH_G1, PH_GLA_A, PH_SCAN, PH_GLA_C, PH_G2, PH_RMS_F0, PH_G3_0, PH_CONV0, PH_G4_0, PH_RMS_M1, PH_G5, PH_PREP, PH_ATTN, PH_G6, PH_RMS_F1, PH_G3_1, PH_CONV1, PH_G4_1, PH_FIN, NPH };

__global__ void __launch_bounds__(NTHR, 2) fwd_megakernel(Params prm) {
    extern __shared__ __attribute__((aligned(16))) unsigned char lds_raw[];
    cg::grid_group grid = cg::this_grid();
    float* const X0 = prm.out;
    volatile LAS unsigned* bst = (volatile LAS unsigned*)((LAS unsigned char*)lds_raw + (LDS_BYTES - 16));
    if (threadIdx.x < 4) bst[threadIdx.x] = 0u;
    __syncthreads();
    XcdBarrier xbar = xcd_barrier_post((unsigned*)(prm.ws + WS_BAR), bst);
    for (int ph = prm.ph_lo; ph < prm.ph_hi; ++ph) {
      for (int rep = 0, nrep = 1 + ((REP_MASK >> ph) & 1); rep < nrep; ++rep) {
        int tid_ = threadIdx.x; asm volatile("" : "+v"(tid_));
        size_t zoff = 0; asm volatile("" : "+s"(zoff));
        unsigned char* ws = prm.ws + zoff;
        float* X = X0 + zoff;
        Frame F;
        F.p = prm; F.lds = (LAS unsigned char*)lds_raw;
        F.tid = tid_; F.lane = F.tid & 63; F.wave = __builtin_amdgcn_readfirstlane(F.tid >> 6); F.G = gridDim.x; F.bid = blockIdx.x;
        F.WinA = (bf16*)(ws + WS_WINA); F.WoA = (bf16*)(ws + WS_WOA); F.Wqkv = (bf16*)(ws + WS_WQKV); F.WoB = (bf16*)(ws + WS_WOB);
        F.Fin0 = (bf16*)(ws + WS_FIN0); F.Fin1 = (bf16*)(ws + WS_FIN1); F.Fdn0 = (bf16*)(ws + WS_FDN0); F.Fdn1 = (bf16*)(ws + WS_FDN1);
        F.LB = (float*)(ws + WS_LB); F.HB = (bf16*)(ws + WS_HB); F.QB = (bf16*)(ws + WS_QB);
        F.LOGF = (float*)(ws + WS_LOGF); F.VB = (bf16*)(ws + WS_VB); F.SG = (bf16*)(ws + WS_SG); F.OI = (float*)(ws + WS_OI); F.LOCAL = (float*)(ws + WS_LOCAL); F.DEC = (float*)(ws + WS_DEC);
        F.QKV = (bf16*)(ws + WS_QKV); F.KN = (bf16*)(ws + WS_KN); F.KS = (bf16*)(ws + WS_KS); F.VT = (bf16*)(ws + WS_VT); F.VTS = (bf16*)(ws + WS_VTS);
        F.UP = (bf16*)(ws + WS_UP); F.ACT = (bf16*)(ws + WS_ACT);
        switch (ph) {
        case PH_P0: if (EN_MASK & 1) p0_phase(F); break;
        case PH_GLA_A: if (EN_MASK & 2) gla_a_phase(F); break;
        case PH_SCAN: if (EN_MASK & 4) scan_phase(F); break;
        case PH_GLA_C: if (EN_MASK & 8) gla_c_phase(F); break;
        case PH_RMS_F0: if (EN_MASK & 16) rms_phase(F, X, prm.x_sample, prm.norm_ffn, (const float*)(ws + WS_PART), X + (size_t)TP * D); break;
        case PH_RMS_M1: if (EN_MASK & 16) rms_phase(F, X, X + (size_t)TP * D, prm.norm_mix + D, (const float*)(ws + WS_PART), X + (size_t)TP * D); break;
        case PH_RMS_F1: if (EN_MASK & 16) rms_phase(F, X, X + (size_t)TP * D, prm.norm_ffn + D, (const float*)(ws + WS_PART), X + (size_t)TP * D); break;
        case PH_FIN: fin_phase(F, X + (size_t)TP * D, (const float*)(ws + WS_PART)); break;
        case PH_CONV0: if (EN_MASK & 32) convfix_phase(F, 0, (const float*)(ws + WS_PART)); break;
        case PH_CONV1: if (EN_MASK & 32) convfix_phase(F, 1, (const float*)(ws + WS_PART)); break;
        case PH_PREP: if (EN_MASK & 64) prep_phase(F); break;
        case PH_ATTN: if (EN_MASK & 128) attn_phase(F); break;
        default: if (EN_MASK & 256) {
            pg8::Gemm g; pg8::Epi E; E.mode = 2; E.cw = nullptr; E.cbias = nullptr; E.ldo = D; E.ob = nullptr; E.of = X; E.resP = X; E.resS = X + (size_t)TP * D;
            E.lb = F.LB; E.logf = F.LOGF; E.wsb = ws;
            g.A = F.HB; g.M = T; g.K = D; g.N = D; g.Bt = F.WoA;
            if (ph == PH_G1) { g.Bt = F.WinA; g.N = NWIN; E.mode = 0; }
            else if (ph == PH_G2) { g.Bt = F.WoA; E.resP = prm.x_prompt; E.resS = prm.x_sample; }
            else if (ph == PH_G3_0 || ph == PH_G3_1) { const int l = (ph == PH_G3_1); g.Bt = l ? F.Fin1 : F.Fin0; g.N = NUP; E.mode = 3; E.cw = prm.f_conv_w + (size_t)l * 3 * FF; E.cbias = prm.f_conv_b + (size_t)l * FF; }
            else if (ph == PH_G4_0 || ph == PH_G4_1) { g.A = F.ACT; g.Bt = (ph == PH_G4_1) ? F.Fdn1 : F.Fdn0; g.K = FF; }
            else if (ph == PH_G5) { g.Bt = F.Wqkv; g.N = NQKV; E.mode = 1; E.ob = F.QKV; E.ldo = NQKV; }
            else { g.Bt = F.WoB; }
            E.part = (float*)(ws + WS_PART); E.act = F.ACT; E.edge = (float*)(ws + WS_PART);
            pg8::StaticOrder S; S.init(g.M, g.N, g.K, F.G, F.bid, E.mode == 2);
            pg8::gemm_phase(F.lds, g, S, E, F.tid);
            if (ph == PH_G1 || ph == PH_G3_0 || ph == PH_G5) {
                const int rem = S.nitems % F.G;
                if (rem == 0 || F.bid >= rem) {
                    const int widx = rem ? F.bid - rem : F.bid, nw = rem ? F.G - rem : F.G;
                    if (ph == PH_G1) wconv_items(F, WC_EARLY, WC_ALL, widx, nw);
                    else if (ph == PH_G3_0) cacheK_fill(F, widx, nw);
                    else vtrans_items(F, VT_NP + VT_NN, VT_NP + VT_NN + VT_NC, widx, nw);
                }
            }
        } break;
        }
      }
        if (prm.ph_hi > 1000) grid.sync();
        if (ph + 1 < prm.ph_hi) xcd_barrier(xbar);
    }
}

extern "C" void kernel_launch(void* const* d_in, const int* in_sizes, int n_in, void* d_out, int out_size, void* d_ws, size_t ws_size, hipStream_t stream) {
    static int grid_blocks = 0;
    if (!grid_blocks) {
        int dev = 0, cus = 0, per_cu = 0;
        hipGetDevice(&dev);
        hipDeviceGetAttribute(&cus, hipDeviceAttributeMultiprocessorCount, dev);
        if (hipFuncSetAttribute((const void*)fwd_megakernel, hipFuncAttributeMaxDynamicSharedMemorySize, LDS_BYTES) != hipSuccess) fprintf(stderr, "kernel_launch: hipFuncSetAttribute failed\n");
        hipOccupancyMaxActiveBlocksPerMultiprocessor(&per_cu, (const void*)fwd_megakernel, NTHR, LDS_BYTES);
        if (per_cu < 1) per_cu = 1;
        if (per_cu > 1) per_cu = 1;
        grid_blocks = cus * per_cu;
        if (n_in != 21 || (size_t)out_size != O_END || ws_size < WS_END) fprintf(stderr, "kernel_launch: unexpected sizes n_in %d out %d ws %zu (need %zu)\n", n_in, out_size, ws_size, (size_t)WS_END);
    }
    Params p{};
    p.x_prompt = (const float*)d_in[0]; p.x_sample = (const float*)d_in[1]; p.state_a_S = (const float*)d_in[2]; p.cache_k = (const float*)d_in[3]; p.cache_v = (const float*)d_in[4];
    p.conv_state = (const float*)d_in[5]; p.norm_mix = (const float*)d_in[6]; p.norm_ffn = (const float*)d_in[7]; p.a_w_in = (const float*)d_in[8]; p.a_gamma = (const float*)d_in[9];
    p.a_norm_o = (const float*)d_in[10]; p.a_w_o = (const float*)d_in[11]; p.b_w_qkv = (const float*)d_in[12]; p.b_q_norm = (const float*)d_in[13]; p.b_k_norm = (const float*)d_in[14];
    p.b_rel_bias = (const float*)d_in[15]; p.b_w_o = (const float*)d_in[16]; p.f_w_in = (const float*)d_in[17]; p.f_conv_w = (const float*)d_in[18]; p.f_conv_b = (const float*)d_in[19];
    p.f_w_down = (const float*)d_in[20];
    p.out = (float*)d_out; p.ws = (unsigned char*)d_ws;
#if MK_N_LAUNCHES == 1
    p.ph_lo = 0; p.ph_hi = NPH;
    if (hipMemsetAsync((char*)d_ws + WS_BAR, 0, 16384, stream) != hipSuccess) fprintf(stderr, "kernel_launch: memset of barrier words failed\n");
    void* args[] = {&p};
    hipError_t e = hipLaunchCooperativeKernel((const void*)fwd_megakernel, dim3(grid_blocks), dim3(NTHR), args, LDS_BYTES, stream);
    if (e != hipSuccess) fprintf(stderr, "cooperative launch failed: %s (grid %d)\n", hipGetErrorString(e), grid_blocks);
#else
    for (int ph = 0; ph < NPH; ++ph) {
        p.ph_lo = ph; p.ph_hi = ph + 1;
        hipLaunchKernelGGL(fwd_megakernel, dim3(grid_blocks), dim3(NTHR), LDS_BYTES, stream, p);
    }
#endif
}
```

```cpp
#include <hip/hip_runtime.h>
#include <hip/hip_cooperative_groups.h>
#include <cstdio>
#include <cstdint>
namespace cg = cooperative_groups;

#define DI __device__ __forceinline__
#define LAS __attribute__((address_space(3)))
#define GAS __attribute__((address_space(1)))
typedef unsigned short bf16;
typedef short bf16x8 __attribute__((ext_vector_type(8)));
typedef float f32x2 __attribute__((ext_vector_type(2)));
typedef float f32x4 __attribute__((ext_vector_type(4)));
typedef float f32x16 __attribute__((ext_vector_type(16)));
typedef unsigned u32x2 __attribute__((ext_vector_type(2)));
typedef unsigned u32x4 __attribute__((ext_vector_type(4)));
typedef __bf16 bf16x2_t __attribute__((ext_vector_type(2)));

#ifndef EN_MASK
#define EN_MASK 0xffffu
#endif
#ifndef REP_MASK
#define REP_MASK 0
#endif
#ifndef MK_N_LAUNCHES
#define MK_N_LAUNCHES 1
#endif

constexpr int D = 2048, TP = 8192, TS = 1024, T = TP + TS, SEQ = 4096, NH = 16, HD = 128, FF = 5632;
constexpr int NQKV = 3 * D, NWIN = 4 * D, NUP = 2 * FF;
constexpr int SROWS = 544;
constexpr float EPS = 1e-6f;
constexpr int NWAVES = 8, NTHR = 512;
constexpr int LDS_BYTES = 147456;

constexpr size_t MiB = 1u << 20;
constexpr size_t WS_WINA = 0, WS_WOA = 32 * MiB, WS_WQKV = 40 * MiB, WS_WOB = 64 * MiB, WS_FIN0 = 72 * MiB, WS_FIN1 = 116 * MiB, WS_FDN0 = 160 * MiB, WS_FDN1 = 182 * MiB;
constexpr size_t WS_LB = 204 * MiB, WS_HB = 205 * MiB, WS_QB = 241 * MiB, WS_MIX = 277 * MiB;
constexpr size_t WS_LOGF = WS_MIX, WS_VB = WS_MIX + 72 * MiB, WS_SG = WS_MIX + 108 * MiB, WS_OI = WS_MIX + 144 * MiB, WS_LOCAL = WS_MIX + 216 * MiB, WS_DEC = WS_MIX + 376 * MiB;
constexpr size_t WS_KS = WS_MIX, WS_VTS = WS_MIX + 68 * MiB, WS_QKV = WS_MIX + 136 * MiB, WS_KN = WS_MIX + 244 * MiB, WS_VT = WS_MIX + 276 * MiB;
constexpr size_t WS_UP = WS_MIX + 136 * MiB, WS_ACT = WS_MIX + 136 * MiB;
constexpr size_t WS_PART = WS_MIX + 236 * MiB;
constexpr size_t WS_BAR = WS_LB + 64 * 1024;
constexpr size_t WS_END = WS_MIX + 378 * MiB;

constexpr size_t O_YP = 0, O_YS = O_YP + (size_t)TP * D, O_SP = O_YS + (size_t)TS * D, O_SS = O_SP + 2 * 16 * 128 * 128, O_KP = O_SS + 32 * 16 * 128 * 128,
                 O_VP = O_KP + 2 * 512 * 2048, O_KSM = O_VP + 2 * 512 * 2048, O_VSM = O_KSM + 32 * 32 * 2048, O_CP = O_VSM + 32 * 32 * 2048, O_CS = O_CP + 2 * 2 * 2 * FF,
                 O_END = O_CS + 2 * 32 * 2 * FF;

struct Params {
    const float* x_prompt; const float* x_sample; const float* state_a_S; const float* cache_k; const float* cache_v; const float* conv_state;
    const float* norm_mix; const float* norm_ffn; const float* a_w_in; const float* a_gamma; const float* a_norm_o; const float* a_w_o;
    const float* b_w_qkv; const float* b_q_norm; const float* b_k_norm; const float* b_rel_bias; const float* b_w_o;
    const float* f_w_in; const float* f_conv_w; const float* f_conv_b; const float* f_w_down;
    float* out; unsigned char* ws; int ph_lo, ph_hi;
};

DI unsigned pk2(float lo, float hi) { f32x2 v = {lo, hi}; return __builtin_bit_cast(unsigned, __builtin_convertvector(v, bf16x2_t)); }
DI bf16 f2bf(float f) { return (bf16)(pk2(f, 0.f) & 0xffffu); }
DI float bflo(unsigned p) { return __uint_as_float(p << 16); }
DI float bfhi(unsigned p) { return __uint_as_float(p & 0xffff0000u); }
DI float wave_sum(float v) {
#pragma unroll
    for (int o = 1; o < 64; o <<= 1) v += __shfl_xor(v, o);
    return v;
}
DI float fexp(float x) { return __builtin_amdgcn_exp2f(x * 1.4426950408889634f); }
DI float fsigmoid(float z) { return __builtin_amdgcn_rcpf(1.f + fexp(-z)); }
DI float fsilu(float z) { return z * __builtin_amdgcn_rcpf(1.f + fexp(-z)); }
DI float flog(float x) { return __builtin_amdgcn_logf(x) * 0.6931471805599453f; }
DI int crow(int reg, int h) { return (reg & 3) + 8 * (reg >> 2) + 4 * h; }
#define MFMA32(a, b, c) __builtin_amdgcn_mfma_f32_32x32x16_bf16((a), (b), (c), 0, 0, 0)

namespace pg8 {
constexpr int BM = 256, BK = 64, HALF = 128, HTB = HALF * BK * 2, STAGE_BYTES = 8 * HTB, NXCD = 8, WGM = 8;
DI int lds_byte(int r, int c) { const int st = (r >> 4) * 2 + (c >> 5), rr = r & 15, cc = c & 31, ob = rr * 64 + cc * 2; return st * 1024 + (ob ^ (((ob >> 9) & 1) << 5)); }
DI void stage_rc(int b, int& R, int& C) { const int st = b / 1024, sb = b % 1024, swz = sb ^ (((sb >> 9) & 1) << 5); R = (st >> 1) * 16 + swz / 64; C = (st & 1) * 32 + (swz % 64) / 2; }
DI int perm32(int rho) { const int n = rho >> 4, i = rho & 15; return 8 * (i >> 2) + 4 * n + (i & 3); }
struct Unit { int pm, pn, kb0, nkt, slice; };
struct Gemm { const bf16* A; const bf16* Bt; int M, N, K; };
struct StaticOrder {
    int nM, nN, nwg, G, c, tail, nblk, nitems;
    DI void init(int M, int N, int K, int G_, int c_, int tail_) { tail = tail_; nM = tail ? TP / BM : M / BM; nN = N / BM; nwg = nM * nN; G = G_; c = c_; nblk = K / 128; nitems = nwg + (tail ? 256 : 0); }
    DI bool next(int i, Unit& u) const {
        const long L = (long)i * G + c; if (L >= nitems) return false;
        u.slice = -1; u.kb0 = 0; u.nkt = nblk * 2;
        if (L >= nwg) { const int j = (int)L - nwg, uu = j & 31; u.slice = j >> 5; u.pm = TP / BM + (uu >> 3); u.pn = uu & 7;
            const int base = nblk / 8, rem = nblk % 8; u.kb0 = u.slice * base + (u.slice < rem ? u.slice : rem); u.nkt = 2 * (base + (u.slice < rem ? 1 : 0)); return true; }
        int wgid = (int)L; { const int q = nwg / NXCD, r = nwg % NXCD, xcd = wgid % NXCD, off = wgid / NXCD; wgid = (xcd < r ? xcd * (q + 1) : r * (q + 1) + (xcd - r) * q) + off; }
        const int nig = WGM * nN, gid = wgid / nig, fm = gid * WGM, gsz = (nM - fm) < WGM ? (nM - fm) : WGM;
        u.pm = fm + ((wgid % nig) % gsz); u.pn = (wgid % nig) / gsz; return true;
    }
};

struct Epi {
    int mode;
    int ldo;
    bf16* ob;
    float* of; const float* resP; const float* resS;
    const float* lb; float* logf; unsigned char* wsb;
    float* part;
    const float* cw; const float* cbias; bf16* act; float* edge;
    DI bool perm() const { return mode != 2; }
    DI void operator()(const f32x4 (&acc)[2][2][4][2], const Unit& u, int wr, int wc, int fr, int fq) const {
        const int row0 = u.pm * BM + wr * 64 + fr;
        if (mode == 2 && u.slice >= 0) {
            const int col0 = u.pn * BM + wc * 32 + 4 * fq;
#pragma unroll
            for (int ai = 0; ai < 2; ++ai)
#pragma unroll
                for (int m = 0; m < 4; ++m) {
                    float* op = part + ((size_t)u.slice * TS + (row0 + ai * HALF + m * 16 - TP)) * D + col0;
#pragma unroll
                    for (int bj = 0; bj < 2; ++bj)
#pragma unroll
                        for (int n = 0; n < 2; ++n) *(f32x4*)(op + bj * HALF + n * 16) = acc[ai][bj][m][n];
                }
        } else if (mode == 2) {
            const int col0 = u.pn * BM + wc * 32 + 4 * fq;
#pragma unroll
            for (int ai = 0; ai < 2; ++ai) {
                f32x4 rr[4][2][2];
#pragma unroll
                for (int m = 0; m < 4; ++m) {
                    const int row = row0 + ai * HALF + m * 16;
                    const float* rp = (row < TP ? resP + (size_t)row * D : resS + (size_t)(row - TP) * D) + col0;
#pragma unroll
                    for (int bj = 0; bj < 2; ++bj)
#pragma unroll
                        for (int n = 0; n < 2; ++n) rr[m][bj][n] = *(const f32x4*)(rp + bj * HALF + n * 16);
                }
#pragma unroll
                for (int m = 0; m < 4; ++m) {
                    float* op = of + (size_t)(row0 + ai * HALF + m * 16) * D + col0;
#pragma unroll
                    for (int bj = 0; bj < 2; ++bj)
#pragma unroll
                        for (int n = 0; n < 2; ++n) *(f32x4*)(op + bj * HALF + n * 16) = rr[m][bj][n] + acc[ai][bj][m][n];
                }
            }
        } else if (mode == 3) {
            const int cc0 = u.pn * HALF + wc * 32 + 8 * fq;
            float w0[8], w1[8], w2[8], cb[8];
            { const f32x4 a0 = *(const f32x4*)(cw + cc0), a1 = *(const f32x4*)(cw + cc0 + 4), b0 = *(const f32x4*)(cw + FF + cc0), b1 = *(const f32x4*)(cw + FF + cc0 + 4);
              const f32x4 c0 = *(const f32x4*)(cw + 2 * FF + cc0), c1 = *(const f32x4*)(cw + 2 * FF + cc0 + 4), d0 = *(const f32x4*)(cbias + cc0), d1 = *(const f32x4*)(cbias + cc0 + 4);
#pragma unroll
              for (int e = 0; e < 4; ++e) { w0[e] = a0[e]; w0[4 + e] = a1[e]; w1[e] = b0[e]; w1[4 + e] = b1[e]; w2[e] = c0[e]; w2[4 + e] = c1[e]; cb[e] = d0[e]; cb[4 + e] = d1[e]; } }
            float* const eu_first = edge; float* const eg_first = edge + (size_t)(T / 32) * 2 * FF; float* const eu_last = edge + (size_t)(T / 32) * 4 * FF;
            const bool prm_unit = u.pm < TP / BM;
#pragma unroll
            for (int ai = 0; ai < 2; ++ai)
#pragma unroll
                for (int m = 0; m < 4; ++m) {
                    const int row = row0 + ai * HALF + m * 16, hb = row >> 5;
                    float a[8];
#pragma unroll
                    for (int n = 0; n < 2; ++n)
#pragma unroll
                        for (int e = 0; e < 4; ++e) {
                            const float cur = acc[ai][0][m][n][e];
                            const float prv = ((m & 1) || (prm_unit && m == 2)) ? acc[ai][0][m > 0 ? m - 1 : 0][n][e] : 0.f;
                            const int ci = __float_as_int(cur), pi = __float_as_int(prv);
                            const int r1 = __builtin_amdgcn_update_dpp(0, pi, 0x121, 0xf, 0xf, false), r2 = __builtin_amdgcn_update_dpp(0, pi, 0x122, 0xf, 0xf, false);
                            const float p1 = __int_as_float(__builtin_amdgcn_update_dpp(r1, ci, 0x111, 0xf, 0xf, false));
                            const float p2 = __int_as_float(__builtin_amdgcn_update_dpp(r2, ci, 0x112, 0xf, 0xf, false));
                            const int k = 4 * n + e;
                            a[k] = fsilu(cb[k] + p2 * w0[k] + p1 * w1[k] + cur * w2[k]) * acc[ai][1][m][n][e];
                        }
                    const bool first2 = (fr < 2) && (prm_unit ? (m == 0) : ((m & 1) == 0)), last2 = (fr >= 14) && (prm_unit ? (m == 3) : ((m & 1) == 1));
                    if (!first2) { u32x4 o; o.x = pk2(a[0], a[1]); o.y = pk2(a[2], a[3]); o.z = pk2(a[4], a[5]); o.w = pk2(a[6], a[7]); *(u32x4*)(act + (size_t)row * FF + cc0) = o; }
                    else { float* du = eu_first + ((size_t)hb * 2 + fr) * FF + cc0; float* dg = eg_first + ((size_t)hb * 2 + fr) * FF + cc0;
                        *(f32x4*)du = acc[ai][0][m][0]; *(f32x4*)(du + 4) = acc[ai][0][m][1]; *(f32x4*)dg = acc[ai][1][m][0]; *(f32x4*)(dg + 4) = acc[ai][1][m][1]; }
                    if (last2) { float* du = eu_last + ((size_t)hb * 2 + (fr - 14)) * FF + cc0; *(f32x4*)du = acc[ai][0][m][0]; *(f32x4*)(du + 4) = acc[ai][0][m][1]; }
                }
        } else if (mode == 1) {
            const int col0 = u.pn * BM + wc * 32 + 8 * fq;
#pragma unroll
            for (int ai = 0; ai < 2; ++ai)
#pragma unroll
                for (int m = 0; m < 4; ++m) {
                    bf16* op = ob + (size_t)(row0 + ai * HALF + m * 16) * ldo + col0;
#pragma unroll
                    for (int bj = 0; bj < 2; ++bj) { const f32x4 v0 = acc[ai][bj][m][0], v1 = acc[ai][bj][m][1];
                        u32x4 o; o.x = pk2(v0.x, v0.y); o.y = pk2(v0.z, v0.w); o.z = pk2(v1.x, v1.y); o.w = pk2(v1.z, v1.w);
                        *(u32x4*)(op + bj * HALF) = o; }
                }
        } else {
            const int type = u.pn >> 3, col0 = (u.pn & 7) * BM + wc * 32 + 8 * fq;
#pragma unroll
            for (int bj = 0; bj < 2; ++bj) {
                const int col = col0 + bj * HALF;
                f32x4 l0 = {0.f, 0.f, 0.f, 0.f}, l1 = l0;
                if (type == 1) { l0 = *(const f32x4*)(lb + col); l1 = *(const f32x4*)(lb + col + 4); }
#pragma unroll
                for (int ai = 0; ai < 2; ++ai)
#pragma unroll
                    for (int m = 0; m < 4; ++m) {
                        const size_t off = (size_t)(row0 + ai * HALF + m * 16) * D + col;
                        f32x4 v0 = acc[ai][bj][m][0], v1 = acc[ai][bj][m][1];
                        if (type == 1) {
#pragma unroll
                            for (int e = 0; e < 4; ++e) { v0[e] = flog(l0[e] + (1.f - l0[e]) * fsigmoid(v0[e])); v1[e] = flog(l1[e] + (1.f - l1[e]) * fsigmoid(v1[e])); }
                            *(f32x4*)(logf + off) = v0; *(f32x4*)(logf + off + 4) = v1;
                        } else {
                            if (type == 3) {
#pragma unroll
                                for (int e = 0; e < 4; ++e) { v0[e] = fsilu(v0[e]); v1[e] = fsilu(v1[e]); }
                            }
                            u32x4 o; o.x = pk2(v0.x, v0.y); o.y = pk2(v0.z, v0.w); o.z = pk2(v1.x, v1.y); o.w = pk2(v1.z, v1.w);
                            bf16* dst = (bf16*)(wsb + (type == 0 ? WS_QB : (type == 2 ? WS_VB : WS_SG)));
                            *(u32x4*)(dst + off) = o;
                        }
                    }
            }
        }
    }
};

DI void gemm_phase(LAS unsigned char* lds, const Gemm g, const StaticOrder& S, const Epi& E, const int tid) {
    const int wid = __builtin_amdgcn_readfirstlane(tid >> 6), lane = tid & 63, wr = wid >> 2, wc = wid & 3, fr = lane & 15, fq = lane >> 4;
    const int K = g.K;
    const bool PERM = E.perm();
    unsigned voffA[2], voffB[2];
#pragma unroll
    for (int i = 0; i < 2; ++i) { int R, C; stage_rc(tid * 16 + i * 8192, R, C); const int Rb = PERM ? ((R & ~31) + perm32(R & 31)) : R;
        voffA[i] = (unsigned)(R * K + C) * 2u; voffB[i] = (unsigned)(Rb * K + C) * 2u; }
    const size_t kstep = (size_t)(BK * 2);
    const size_t hstep = (size_t)HALF * K * 2;
    const size_t tstep = 2 * hstep;
    const unsigned ldsw = (unsigned)wid * 1024u;
    const int aoff = lds_byte(wr * 64 + fr, fq * 8), boff = lds_byte(wc * 32 + fr, fq * 8);
#define PG8_SA(b, h) (((b) * 2 + (h)) * HTB)
#define PG8_SB(b, h) ((4 + (b) * 2 + (h)) * HTB)
#define PG8_STAGE(bufoff, gbase, voff) do { _Pragma("unroll") for (int _i = 0; _i < 2; ++_i) \
        __builtin_amdgcn_global_load_lds((const unsigned*)((const char*)(gbase) + (voff)[_i]), (LAS unsigned*)(lds + (bufoff) + ldsw + _i * 8192), 16, 0, 0); } while (0)
#define PG8_LDA(dst, b, h) do { _Pragma("unroll") for (int m = 0; m < 4; ++m) _Pragma("unroll") for (int k = 0; k < 2; ++k) dst[m][k] = *(const LAS bf16x8*)(lds + PG8_SA(b, h) + aoff + m * 2048 + k * 1024); } while (0)
#define PG8_LDB(dst, b, h) do { _Pragma("unroll") for (int n = 0; n < 2; ++n) _Pragma("unroll") for (int k = 0; k < 2; ++k) dst[n][k] = *(const LAS bf16x8*)(lds + PG8_SB(b, h) + boff + n * 2048 + k * 1024); } while (0)
#define PG8_MMA(ai, bj, At, Bt) do { __builtin_amdgcn_s_setprio(1); _Pragma("unroll") for (int m = 0; m < 4; ++m) _Pragma("unroll") for (int n = 0; n < 2; ++n) _Pragma("unroll") for (int k = 0; k < 2; ++k) \
        acc[ai][bj][m][n] = __builtin_amdgcn_mfma_f32_16x16x32_bf16(Bt[n][k], At[m][k], acc[ai][bj][m][n], 0, 0, 0); __builtin_amdgcn_s_setprio(0); } while (0)
#define PG8_WAIT_V(n) asm volatile("s_waitcnt vmcnt(" #n ")" ::: "memory")
#define PG8_WAIT_L(n) asm volatile("s_waitcnt lgkmcnt(" #n ")" ::: "memory")
#define PG8_BAR __builtin_amdgcn_s_barrier()
#define PG8_SCHED __builtin_amdgcn_sched_barrier(0)
    Unit cur, nxt; int ui = 0;
    if (!S.next(0, cur)) return;
    f32x4 acc[2][2][4][2];
#pragma unroll
    for (int a = 0; a < 2; ++a)
#pragma unroll
        for (int b = 0; b < 2; ++b)
#pragma unroll
            for (int m = 0; m < 4; ++m)
#pragma unroll
                for (int n = 0; n < 2; ++n) acc[a][b][m][n] = (f32x4){0.f, 0.f, 0.f, 0.f};
    bf16x8 At[4][2], B0[2][2], B1[2][2];
    const char* cA = (const char*)g.A + (size_t)cur.pm * tstep + (size_t)cur.kb0 * 256; const char* cB = (const char*)g.Bt + (size_t)cur.pn * tstep + (size_t)cur.kb0 * 256;
    PG8_STAGE(PG8_SB(0, 0), cB, voffB); PG8_STAGE(PG8_SB(0, 1), cB + hstep, voffB); PG8_STAGE(PG8_SA(0, 0), cA, voffA); PG8_STAGE(PG8_SA(0, 1), cA + hstep, voffA);
    if (wr == 1) PG8_BAR;
    PG8_WAIT_V(2); PG8_BAR;
    PG8_STAGE(PG8_SB(1, 0), cB + kstep, voffB); PG8_STAGE(PG8_SA(1, 0), cA + kstep, voffA); PG8_STAGE(PG8_SB(1, 1), cB + hstep + kstep, voffB);
    PG8_WAIT_V(6); PG8_BAR;
    for (;;) {
        const bool has_next = S.next(ui + 1, nxt);
        const char* nA = has_next ? (const char*)g.A + (size_t)nxt.pm * tstep + (size_t)nxt.kb0 * 256 : cA; const char* nB = has_next ? (const char*)g.Bt + (size_t)nxt.pn * tstep + (size_t)nxt.kb0 * 256 : cB;
        const int nt = cur.nkt;
        for (int t = 0; t < nt; t += 2) {
            const bool last = (t == nt - 2);
            const char* a1 = cA + (size_t)(t + 1) * kstep;
            const char* a2 = last ? nA : cA + (size_t)(t + 2) * kstep; const char* b2 = last ? nB : cB + (size_t)(t + 2) * kstep;
            const char* a3 = a2 + kstep; const char* b3 = b2 + kstep;
            PG8_LDB(B0, 0, 0); PG8_LDB(B1, 0, 1); PG8_SCHED; PG8_LDA(At, 0, 0); PG8_STAGE(PG8_SA(1, 1), a1 + hstep, voffA);
            PG8_WAIT_V(8); PG8_WAIT_L(0); PG8_BAR; PG8_MMA(0, 0, At, B0); PG8_MMA(0, 1, At, B1); PG8_BAR; PG8_SCHED;
            PG8_LDA(At, 0, 1); PG8_STAGE(PG8_SB(0, 0), b2, voffB); PG8_STAGE(PG8_SB(0, 1), b2 + hstep, voffB); PG8_STAGE(PG8_SA(0, 0), a2, voffA);
            PG8_WAIT_V(8); PG8_WAIT_L(0); PG8_BAR; PG8_MMA(1, 0, At, B0); PG8_MMA(1, 1, At, B1); PG8_BAR; PG8_SCHED;
            PG8_LDB(B0, 1, 0); PG8_LDB(B1, 1, 1); PG8_SCHED; PG8_LDA(At, 1, 0); PG8_STAGE(PG8_SA(0, 1), a2 + hstep, voffA);
            PG8_WAIT_V(8); PG8_WAIT_L(0); PG8_BAR; PG8_MMA(0, 0, At, B0); PG8_MMA(0, 1, At, B1); PG8_BAR; PG8_SCHED;
            PG8_LDA(At, 1, 1); PG8_STAGE(PG8_SB(1, 0), b3, voffB); PG8_STAGE(PG8_SB(1, 1), b3 + hstep, voffB); PG8_STAGE(PG8_SA(1, 0), a3, voffA);
            PG8_WAIT_V(8); PG8_WAIT_L(0); PG8_BAR; PG8_MMA(1, 0, At, B0); PG8_MMA(1, 1, At, B1); PG8_BAR; PG8_SCHED;
        }
        if (wr == 0) PG8_BAR;
        E(acc, cur, wr, wc, fr, fq);
        if (!has_next) break;
#pragma unroll
        for (int a = 0; a < 2; ++a)
#pragma unroll
            for (int b = 0; b < 2; ++b)
#pragma unroll
                for (int m = 0; m < 4; ++m)
#pragma unroll
                    for (int n = 0; n < 2; ++n) acc[a][b][m][n] = (f32x4){0.f, 0.f, 0.f, 0.f};
        cur = nxt; cA = nA; cB = nB; ++ui;
        if (wr == 1) PG8_BAR;
    }
    PG8_WAIT_V(0);
    PG8_BAR;
#undef PG8_SA
#undef PG8_SB
#undef PG8_STAGE
#undef PG8_LDA
#undef PG8_LDB
#undef PG8_MMA
#undef PG8_WAIT_V
#undef PG8_WAIT_L
#undef PG8_BAR
#undef PG8_SCHED
}
}

struct Frame {
    Params p; LAS unsigned char* lds; int tid, lane, wave, G, bid;
    bf16 *WinA, *WoA, *Wqkv, *WoB, *Fin0, *Fin1, *Fdn0, *Fdn1;
    float* LB; bf16 *HB, *QB;
    float* LOGF; bf16 *VB, *SG; float *OI, *LOCAL, *DEC;
    bf16 *QKV, *KN, *KS, *VT, *VTS, *UP, *ACT;
};

DI void transpose_item(const float* __restrict__ W, int K, int N, bf16* __restrict__ WT, LAS float* scr, int item, int lane, const bool ilv = false) {
    const int nblk = N / 64, kb = item / nblk, nb = item % nblk, k0 = 64 * kb, n0 = 64 * nb;
    const int lr = lane >> 4, lc = (lane & 15) * 4;
    f32x4 v[16];
    const float* src = W + (size_t)(k0 + lr) * N + n0 + lc;
#pragma unroll
    for (int i = 0; i < 16; ++i) v[i] = __builtin_nontemporal_load((const f32x4*)(src + (size_t)(4 * i) * N));
#pragma unroll
    for (int i = 0; i < 16; ++i) { LAS float* d = scr + (4 * i + lr) * 65 + lc; d[0] = v[i].x; d[1] = v[i].y; d[2] = v[i].z; d[3] = v[i].w; }
    asm volatile("s_waitcnt lgkmcnt(0)" ::: "memory");
    const int c = lane & 7;
#pragma unroll
    for (int j = 0; j < 8; ++j) { const int n = (lane >> 3) + 8 * j; const LAS float* s = scr + (8 * c) * 65 + n;
        u32x4 o; o.x = pk2(s[0 * 65], s[1 * 65]); o.y = pk2(s[2 * 65], s[3 * 65]); o.z = pk2(s[4 * 65], s[5 * 65]); o.w = pk2(s[6 * 65], s[7 * 65]);
        int nd = n0 + n; if (ilv) nd = (nd < FF) ? (((nd >> 7) << 8) + (nd & 127)) : ((((nd - FF) >> 7) << 8) + 128 + ((nd - FF) & 127));
        __builtin_nontemporal_store(o, (u32x4*)(WT + (size_t)nd * K + k0 + 8 * c)); }
    asm volatile("s_waitcnt lgkmcnt(0)" ::: "memory");
}
DI void rms_row(const float* __restrict__ xrow, const float* __restrict__ g, bf16* __restrict__ orow, int lane, const float* __restrict__ part, float* __restrict__ xdst) {
    const f32x4* xr = (const f32x4*)xrow + lane; const f32x4* gr = (const f32x4*)g + lane;
    f32x4 v[8]; float s = 0.f;
#pragma unroll
    for (int j = 0; j < 8; ++j) v[j] = xr[64 * j];
    if (part) {
#pragma unroll
        for (int sl = 0; sl < 8; ++sl) { const f32x4* pr = (const f32x4*)(part + (size_t)sl * TS * D) + lane;
#pragma unroll
            for (int j = 0; j < 8; ++j) v[j] += pr[64 * j]; }
#pragma unroll
        for (int j = 0; j < 8; ++j) ((f32x4*)xdst + lane)[64 * j] = v[j];
    }
#pragma unroll
    for (int j = 0; j < 8; ++j) s += (v[j].x * v[j].x + v[j].y * v[j].y) + (v[j].z * v[j].z + v[j].w * v[j].w);
    const float rstd = rsqrtf(wave_sum(s) * (1.f / D) + EPS);
    u32x2* o8 = (u32x2*)orow + lane;
#pragma unroll
    for (int j = 0; j < 8; ++j) { const f32x4 gg = gr[64 * j]; u32x2 o; o.x = pk2(v[j].x * rstd * gg.x, v[j].y * rstd * gg.y); o.y = pk2(v[j].z * rstd * gg.z, v[j].w * rstd * gg.w); o8[64 * j] = o; }
}
DI void rms_phase(Frame& F, const float* srcP, const float* srcS, const float* g, const float* part, float* xs) {
    const int gw = F.bid * NWAVES + F.wave, NGW = F.G * NWAVES;
    for (int m = gw; m < T; m += NGW) {
        if (m < TP) rms_row(srcP + (size_t)m * D, g, F.HB + (size_t)m * D, F.lane, nullptr, nullptr);
        else rms_row(srcS + (size_t)(m - TP) * D, g, F.HB + (size_t)m * D, F.lane, part ? part + (size_t)(m - TP) * D : nullptr, xs + (size_t)(m - TP) * D);
    }
}
DI void fin_phase(Frame& F, float* xs, const float* part) {
    const int gt = F.bid * NTHR + F.tid, NGT = F.G * NTHR;
    for (int it = gt; it < TS * D / 4; it += NGT) {
        f32x4 v = ((const f32x4*)xs)[it];
#pragma unroll
        for (int sl = 0; sl < 8; ++sl) v += ((const f32x4*)(part + (size_t)sl * TS * D))[it];
        ((f32x4*)xs)[it] = v;
    }
}
constexpr int I_WINA = (D / 64) * (NWIN / 64), I_WO = (D / 64) * (D / 64), I_QKV = (D / 64) * (NQKV / 64), I_FIN = (D / 64) * (NUP / 64), I_FDN = (FF / 64) * (D / 64);
constexpr int WC_EARLY = I_WINA + 2 * I_WO + I_QKV + I_FIN + I_FDN, WC_ALL = WC_EARLY + I_FIN + I_FDN;
DI void wconv_items(Frame& F, int it_lo, int it_hi, int widx, int nw) {
    const Params& p = F.p;
    LAS float* scr = (LAS float*)(F.lds + F.wave * 16640);
    for (int it = it_lo + widx * NWAVES + F.wave; it < it_hi; it += nw * NWAVES) {
        int r = it;
        if (r < I_WINA) { transpose_item(p.a_w_in, D, NWIN, F.WinA, scr, r, F.lane); continue; } r -= I_WINA;
        if (r < I_WO) { transpose_item(p.a_w_o, D, D, F.WoA, scr, r, F.lane); continue; } r -= I_WO;
        if (r < I_QKV) { transpose_item(p.b_w_qkv, D, NQKV, F.Wqkv, scr, r, F.lane); continue; } r -= I_QKV;
        if (r < I_WO) { transpose_item(p.b_w_o, D, D, F.WoB, scr, r, F.lane); continue; } r -= I_WO;
        if (r < I_FIN) { transpose_item(p.f_w_in, D, NUP, F.Fin0, scr, r, F.lane, true); continue; } r -= I_FIN;
        if (r < I_FDN) { transpose_item(p.f_w_down, FF, D, F.Fdn0, scr, r, F.lane); continue; } r -= I_FDN;
        if (r < I_FIN) { transpose_item(p.f_w_in + (size_t)D * NUP, D, NUP, F.Fin1, scr, r, F.lane, true); continue; } r -= I_FIN;
        transpose_item(p.f_w_down + (size_t)FF * D, FF, D, F.Fdn1, scr, r, F.lane);
    }
}
DI void p0_phase(Frame& F) {
    const Params& p = F.p;
    wconv_items(F, 0, WC_EARLY, F.bid, F.G);
    for (int c = F.bid * NTHR + F.tid; c < D; c += F.G * NTHR) {
        const float g0 = p.a_gamma[c], g1 = p.a_gamma[D + c], g2 = p.a_gamma[2 * D + c];
        const float mx = fmaxf(g0, fmaxf(g1, g2));
        const float e0 = __expf(g0 - mx), e1 = __expf(g1 - mx), e2 = __expf(g2 - mx);
        F.LB[c] = e0 / (e0 + e1 + e2);
    }
    rms_phase(F, p.x_prompt, p.x_sample, p.norm_mix, nullptr, nullptr);
}

constexpr int GLA_UNITS = 2048 + 512;
constexpr int QT_STRIDE = 136, TT_STRIDE = 72;
constexpr int L_BCUM = 0, L_QT = 32768, L_KT = L_QT + 64 * QT_STRIDE * 2, L_KHT = L_KT + 64 * QT_STRIDE * 2, L_VT = L_KHT + 128 * TT_STRIDE * 2, L_PM = L_VT + 128 * TT_STRIDE * 2, L_GLA_END = L_PM + 64 * TT_STRIDE * 2;
static_assert(L_GLA_END <= LDS_BYTES, "gla lds");

DI f32x16 mma_lds(const LAS bf16* A, int astride, int arow0, const LAS bf16* B, int bstride, int brow0, int nks, int lane) {
    f32x16 acc; for (int i = 0; i < 16; ++i) acc[i] = 0.f;
    const int r = lane & 31, hf = lane >> 5;
    const LAS bf16* ap = A + (arow0 + r) * astride + 8 * hf; const LAS bf16* bp = B + (brow0 + r) * bstride + 8 * hf;
    for (int ks = 0; ks < nks; ++ks) { const bf16x8 a = *(const LAS bf16x8*)(ap + 16 * ks), b = *(const LAS bf16x8*)(bp + 16 * ks); acc = MFMA32(a, b, acc); }
    return acc;
}

template <int BLK>
DI void gla_a_unit(Frame& F, int u, int row0, int h) {
    LAS float* bcum = (LAS float*)(F.lds + L_BCUM);
    LAS bf16* qt = (LAS bf16*)(F.lds + L_QT); LAS bf16* kt = (LAS bf16*)(F.lds + L_KT); LAS bf16* khT = (LAS bf16*)(F.lds + L_KHT);
    LAS bf16* vT = (LAS bf16*)(F.lds + L_VT); LAS bf16* Pm = (LAS bf16*)(F.lds + L_PM);
    const int tid = F.tid, lane = F.lane, w = F.wave;
    const size_t hoff = (size_t)h * HD;
    constexpr int SEG = BLK / 4;
    { const int seg = tid >> 7, kc = tid & 127; float a = 0.f;
      const float* lp = F.LOGF + (size_t)(row0 + seg * SEG) * D + hoff + kc;
#pragma unroll
      for (int t = 0; t < SEG; ++t) { a += lp[(size_t)t * D]; bcum[(seg * SEG + t) * 128 + kc] = a; }
      __syncthreads();
      float off = 0.f;
      for (int s = 0; s < seg; ++s) off += bcum[(s * SEG + SEG - 1) * 128 + kc];
      __syncthreads();
      if (seg > 0) {
#pragma unroll
          for (int t = 0; t < SEG; ++t) bcum[(seg * SEG + t) * 128 + kc] += off;
      }
      __syncthreads(); }
    for (int i = tid; i < BLK * 16; i += NTHR) {
        const int t = i >> 4, c0 = (i & 15) * 8;
        const size_t goff = (size_t)(row0 + t) * D + hoff + c0;
        const u32x4 qv = *(const u32x4*)(F.QB + goff);
        const u32x4 vv = *(const u32x4*)(F.VB + goff);
        const f32x4 lf0 = *(const f32x4*)(F.LOGF + goff), lf1 = *(const f32x4*)(F.LOGF + goff + 4);
        float q[8] = {bflo(qv.x), bfhi(qv.x), bflo(qv.y), bfhi(qv.y), bflo(qv.z), bfhi(qv.z), bflo(qv.w), bfhi(qv.w)};
        float lf[8] = {lf0.x, lf0.y, lf0.z, lf0.w, lf1.x, lf1.y, lf1.z, lf1.w};
        float qtv[8], ktv[8], qhv[8], khv[8];
#pragma unroll
        for (int e = 0; e < 8; ++e) {
            const float b = bcum[t * 128 + c0 + e], bmid = bcum[(BLK / 2 - 1) * 128 + c0 + e], bend = bcum[(BLK - 1) * 128 + c0 + e];
            const float kk = 1.f - __expf(lf[e]);
            qtv[e] = q[e] * __expf(b - bmid); ktv[e] = kk * __expf(bmid - b); qhv[e] = q[e] * __expf(b); khv[e] = kk * __expf(bend - b);
            if (t == BLK - 1) F.DEC[(size_t)u * 128 + c0 + e] = __expf(bend);
        }
        u32x4 o; o.x = pk2(qtv[0], qtv[1]); o.y = pk2(qtv[2], qtv[3]); o.z = pk2(qtv[4], qtv[5]); o.w = pk2(qtv[6], qtv[7]);
        *(LAS u32x4*)(qt + t * QT_STRIDE + c0) = o;
        o.x = pk2(ktv[0], ktv[1]); o.y = pk2(ktv[2], ktv[3]); o.z = pk2(ktv[4], ktv[5]); o.w = pk2(ktv[6], ktv[7]);
        *(LAS u32x4*)(kt + t * QT_STRIDE + c0) = o;
        o.x = pk2(qhv[0], qhv[1]); o.y = pk2(qhv[2], qhv[3]); o.z = pk2(qhv[4], qhv[5]); o.w = pk2(qhv[6], qhv[7]);
        *(u32x4*)(F.QB + goff) = o;
        const unsigned vw[4] = {vv.x, vv.y, vv.z, vv.w};
#pragma unroll
        for (int e = 0; e < 8; ++e) {
            khT[(c0 + e) * TT_STRIDE + t] = f2bf(khv[e]);
            vT[(c0 + e) * TT_STRIDE + t] = (bf16)((e & 1) ? (vw[e >> 1] >> 16) : (vw[e >> 1] & 0xffffu));
        }
    }
    __syncthreads();
    const int r = lane & 31, hf = lane >> 5;
#pragma unroll
    for (int q2 = 0; q2 < 2; ++q2) {
        const int tl = w * 2 + q2, mt = tl >> 2, nt = tl & 3;
        const f32x16 acc = mma_lds(khT, TT_STRIDE, 32 * mt, vT, TT_STRIDE, 32 * nt, BLK / 16, lane);
        if (BLK == 64) {
            float* lp = F.LOCAL + (size_t)u * 16384 + 32 * nt + r;
#pragma unroll
            for (int i = 0; i < 16; ++i) lp[(size_t)(32 * mt + crow(i, hf)) * 128] = acc[i];
        } else {
            const size_t so = (size_t)(u - 2048) * 16384 + 32 * nt + r;
            float s0v[16];
#pragma unroll
            for (int i = 0; i < 16; ++i) s0v[i] = F.p.state_a_S[so + (size_t)(32 * mt + crow(i, hf)) * 128];
#pragma unroll
            for (int i = 0; i < 16; ++i) { const int kc = 32 * mt + crow(i, hf); F.p.out[O_SS + so + (size_t)kc * 128] = __expf(bcum[(BLK - 1) * 128 + kc]) * s0v[i] + acc[i]; }
        }
    }
    constexpr int NT2 = BLK / 32;
    if (w < NT2 * NT2) {
        const int mt = w / NT2, nt = w % NT2;
        if (nt > mt) {
#pragma unroll
            for (int i = 0; i < 16; ++i) Pm[(32 * mt + crow(i, hf)) * TT_STRIDE + 32 * nt + r] = 0;
        } else {
            const f32x16 acc = mma_lds(qt, QT_STRIDE, 32 * mt, kt, QT_STRIDE, 32 * nt, 8, lane);
#pragma unroll
            for (int i = 0; i < 16; ++i) { const int t = 32 * mt + crow(i, hf), s = 32 * nt + r; Pm[t * TT_STRIDE + s] = (s <= t) ? f2bf(acc[i]) : (bf16)0; }
        }
    }
    __syncthreads();
    if (w < NT2 * 4) {
        const int mt = w >> 2, nt = w & 3;
        const f32x16 acc = mma_lds(Pm, TT_STRIDE, 32 * mt, vT, TT_STRIDE, 32 * nt, BLK / 16, lane);
        float* op = F.OI + (size_t)(row0 + 32 * mt) * D + hoff + 32 * nt + r;
#pragma unroll
        for (int i = 0; i < 16; ++i) op[(size_t)crow(i, hf) * D] = acc[i];
    }
    __syncthreads();
}
DI void gla_a_phase(Frame& F) {
    for (int u = F.bid; u < GLA_UNITS; u += F.G) {
        if (u < 2048) { const int b = u >> 10, h = (u >> 6) & 15, c = u & 63; gla_a_unit<64>(F, u, b * SEQ + c * 64, h); }
        else { const int su = u - 2048, b = su >> 4, h = su & 15; gla_a_unit<32>(F, u, TP + b * 32, h); }
    }
}
DI void scan_phase(Frame& F) {
    const int gt = F.bid * NTHR + F.tid, NGT = F.G * NTHR;
    for (int it = gt; it < 32 * 4096; it += NGT) {
        const int bh = it >> 12, e = (it & 4095) * 4, kc = e >> 7;
        f32x4 S = {0.f, 0.f, 0.f, 0.f};
        float* __restrict__ lp = F.LOCAL + (size_t)(bh * 64) * 16384 + e; const float* __restrict__ dp = F.DEC + (size_t)(bh * 64) * 128 + kc;
        for (int c0 = 0; c0 < 64; c0 += 8) {
            f32x4 loc[8]; float d[8];
#pragma unroll
            for (int j = 0; j < 8; ++j) { loc[j] = *(const f32x4*)(lp + (size_t)(c0 + j) * 16384); d[j] = dp[(c0 + j) * 128]; }
#pragma unroll
            for (int j = 0; j < 8; ++j) { *(f32x4*)(lp + (size_t)(c0 + j) * 16384) = S; S = S * d[j] + loc[j]; }
        }
        *(f32x4*)(F.p.out + O_SP + (size_t)bh * 16384 + e) = S;
    }
}
constexpr int OB_STRIDE = 132;
template <int BLK>
DI void gla_c_unit(Frame& F, const float* __restrict__ S, int row0, int h) {
    LAS float* ob = (LAS float*)F.lds;
    const int tid = F.tid, lane = F.lane, w = F.wave, r = lane & 31, hf = lane >> 5;
    const size_t hoff = (size_t)h * HD;
    constexpr int TPR_ = NTHR / BLK, CPT_ = 128 / TPR_;
    u32x4 sgv[CPT_ / 8];
    { const int t = tid / TPR_, c0 = (tid % TPR_) * CPT_;
#pragma unroll
      for (int e8 = 0; e8 < CPT_ / 8; ++e8) sgv[e8] = *(const u32x4*)(F.SG + (size_t)(row0 + t) * D + hoff + c0 + 8 * e8); }
    if (w < (BLK / 32) * 4) {
        const int mt = w >> 2, nt = w & 3;
        f32x16 acc; for (int i = 0; i < 16; ++i) acc[i] = 0.f;
        float oiv[16];
        { const float* oi = F.OI + (size_t)(row0 + 32 * mt) * D + hoff + 32 * nt + r;
#pragma unroll
          for (int i = 0; i < 16; ++i) oiv[i] = oi[(size_t)crow(i, hf) * D]; }
        const bf16* ap = F.QB + (size_t)(row0 + 32 * mt + r) * D + hoff + 8 * hf;
        const float* sp = S + (size_t)(8 * hf) * 128 + 32 * nt + r;
#pragma unroll
        for (int ks = 0; ks < 8; ++ks) {
            const bf16x8 a = *(const bf16x8*)(ap + 16 * ks);
            float sv[8];
#pragma unroll
            for (int e = 0; e < 8; ++e) sv[e] = sp[(size_t)(16 * ks + e) * 128];
            u32x4 bb; bb.x = pk2(sv[0], sv[1]); bb.y = pk2(sv[2], sv[3]); bb.z = pk2(sv[4], sv[5]); bb.w = pk2(sv[6], sv[7]);
            acc = MFMA32(a, __builtin_bit_cast(bf16x8, bb), acc);
        }
#pragma unroll
        for (int i = 0; i < 16; ++i) { const int t = crow(i, hf); ob[(32 * mt + t) * OB_STRIDE + 32 * nt + r] = acc[i] + oiv[i]; }
    }
    __syncthreads();
    {
        constexpr int TPR = NTHR / BLK;
        constexpr int CPT = 128 / TPR;
        const int t = tid / TPR, j = tid % TPR, c0 = j * CPT;
        float v[CPT]; float ss = 0.f;
#pragma unroll
        for (int e = 0; e < CPT; ++e) { v[e] = ob[t * OB_STRIDE + c0 + e]; ss += v[e] * v[e]; }
#pragma unroll
        for (int o = 1; o < TPR; o <<= 1) ss += __shfl_xor(ss, o);
        const float rstd = rsqrtf(ss * (1.f / HD) + EPS);
        const size_t goff = (size_t)(row0 + t) * D + hoff + c0;
#pragma unroll
        for (int e8 = 0; e8 < CPT / 8; ++e8) {
            const u32x4 sg = sgv[e8];
            const f32x4 n0 = *(const f32x4*)(F.p.a_norm_o + c0 + 8 * e8), n1 = *(const f32x4*)(F.p.a_norm_o + c0 + 8 * e8 + 4);
            const float* vv = v + 8 * e8;
            u32x4 o;
            o.x = pk2(vv[0] * rstd * n0.x * bflo(sg.x), vv[1] * rstd * n0.y * bfhi(sg.x));
            o.y = pk2(vv[2] * rstd * n0.z * bflo(sg.y), vv[3] * rstd * n0.w * bfhi(sg.y));
            o.z = pk2(vv[4] * rstd * n1.x * bflo(sg.z), vv[5] * rstd * n1.y * bfhi(sg.z));
            o.w = pk2(vv[6] * rstd * n1.z * bflo(sg.w), vv[7] * rstd * n1.w * bfhi(sg.w));
            *(u32x4*)(F.HB + goff + 8 * e8) = o;
        }
    }
    __syncthreads();
}
DI void gla_c_phase(Frame& F) {
    for (int u = F.bid; u < GLA_UNITS; u += F.G) {
        if (u < 2048) { const int b = u >> 10, h = (u >> 6) & 15, c = u & 63; gla_c_unit<64>(F, F.LOCAL + (size_t)u * 16384, b * SEQ + c * 64, h); }
        else { const int su = u - 2048, b = su >> 4, h = su & 15; gla_c_unit<32>(F, F.p.state_a_S + (size_t)su * 16384, TP + b * 32, h); }
    }
}
DI void convfix_phase(Frame& F, int layer, const float* edge) {
    const Params& p = F.p;
    const int gt = F.bid * NTHR + F.tid, NGT = F.G * NTHR;
    constexpr int NCG = FF / 8, NHB = T / 32;
    const float* cw = p.f_conv_w + (size_t)layer * 3 * FF; const float* cbp = p.f_conv_b + (size_t)layer * FF;
    const float* eu_first = edge; const float* eg_first = edge + (size_t)NHB * 2 * FF; const float* eu_last = edge + (size_t)NHB * 4 * FF;
    for (int it = gt; it < (128 + 32) * NCG; it += NGT) {
        const int blk = it / NCG, c0 = (it % NCG) * 8, hb = blk < 128 ? 2 * blk : 256 + (blk - 128);
        const bool smp = hb >= 256; const bool first = smp || ((hb & 127) == 0), lastb = smp || ((hb & 127) == 126);
        const int hbl = smp ? hb : hb + 1;
        float um2[8], um1[8], u0[8], u1[8], g0[8], g1[8], w0[8], w1[8], w2[8], bb[8];
#pragma unroll
        for (int e = 0; e < 8; ++e) { w0[e] = cw[c0 + e]; w1[e] = cw[FF + c0 + e]; w2[e] = cw[2 * FF + c0 + e]; bb[e] = cbp[c0 + e]; um2[e] = 0.f; um1[e] = 0.f;
            u0[e] = eu_first[((size_t)hb * 2) * FF + c0 + e]; u1[e] = eu_first[((size_t)hb * 2 + 1) * FF + c0 + e];
            g0[e] = eg_first[((size_t)hb * 2) * FF + c0 + e]; g1[e] = eg_first[((size_t)hb * 2 + 1) * FF + c0 + e]; }
        if (first) {
            if (smp) { const float* st = p.conv_state + ((size_t)(layer * 32 + (hb - 256)) * 2) * FF + c0;
#pragma unroll
                for (int e = 0; e < 8; ++e) { um2[e] = st[e]; um1[e] = st[FF + e]; } }
        } else {
#pragma unroll
            for (int e = 0; e < 8; ++e) { um2[e] = eu_last[((size_t)(hb - 1) * 2) * FF + c0 + e]; um1[e] = eu_last[((size_t)(hb - 1) * 2 + 1) * FF + c0 + e]; }
        }
        float a0[8], a1[8];
#pragma unroll
        for (int e = 0; e < 8; ++e) { a0[e] = fsilu(bb[e] + um2[e] * w0[e] + um1[e] * w1[e] + u0[e] * w2[e]) * g0[e]; a1[e] = fsilu(bb[e] + um1[e] * w0[e] + u0[e] * w1[e] + u1[e] * w2[e]) * g1[e]; }
        u32x4 o; o.x = pk2(a0[0], a0[1]); o.y = pk2(a0[2], a0[3]); o.z = pk2(a0[4], a0[5]); o.w = pk2(a0[6], a0[7]);
        *(u32x4*)(F.ACT + (size_t)(hb * 32) * FF + c0) = o;
        o.x = pk2(a1[0], a1[1]); o.y = pk2(a1[2], a1[3]); o.z = pk2(a1[4], a1[5]); o.w = pk2(a1[6], a1[7]);
        *(u32x4*)(F.ACT + (size_t)(hb * 32 + 1) * FF + c0) = o;
        if (lastb) {
            float* dst = smp ? p.out + O_CS + ((size_t)(layer * 32 + (hb - 256)) * 2) * FF + c0 : p.out + O_CP + ((size_t)(layer * 2 + (hb >> 7)) * 2) * FF + c0;
#pragma unroll
            for (int e = 0; e < 8; ++e) { dst[e] = eu_last[((size_t)hbl * 2) * FF + c0 + e]; dst[FF + e] = eu_last[((size_t)hbl * 2 + 1) * FF + c0 + e]; }
        }
    }
}
DI void cacheK_fill(Frame& F, int widx, int nw) {
    const Params& p = F.p;
    const int gt = widx * NTHR + F.tid, NGT = nw * NTHR;
    for (int it0 = gt; it0 < 32 * 512 * (D / 8); it0 += 4 * NGT) {
        f32x4 a[4], c[4];
#pragma unroll
        for (int j = 0; j < 4; ++j) { const int it = it0 + j * NGT; if (it < 32 * 512 * (D / 8)) { const int row = it >> 8, cc = (it & 255) * 8;
            a[j] = __builtin_nontemporal_load((const f32x4*)(p.cache_k + (size_t)row * D + cc)); c[j] = __builtin_nontemporal_load((const f32x4*)(p.cache_k + (size_t)row * D + cc + 4)); } }
#pragma unroll
        for (int j = 0; j < 4; ++j) { const int it = it0 + j * NGT; if (it < 32 * 512 * (D / 8)) { const int row = it >> 8, cc = (it & 255) * 8, b = row >> 9, jj = row & 511;
            u32x4 o; o.x = pk2(a[j].x, a[j].y); o.y = pk2(a[j].z, a[j].w); o.z = pk2(c[j].x, c[j].y); o.w = pk2(c[j].z, c[j].w);
            __builtin_nontemporal_store(o, (u32x4*)(F.KS + ((size_t)b * SROWS + jj) * D + cc)); } }
    }
}
constexpr int VT_NP = 2 * 64 * 16, VT_NN = 32 * 16, VT_NC = 32 * 16 * 8;
DI void vtrans_items(Frame& F, int it_lo, int it_hi, int widx, int nw) {
    const Params& p = F.p; const int lane = F.lane;
    LAS bf16* tile = (LAS bf16*)(F.lds + F.wave * 16640);
    for (int it = it_lo + widx * NWAVES + F.wave; it < it_hi; it += nw * NWAVES) {
        int nrows = 64; bf16* dst; int dstride;
        if (it < VT_NP) {
            const int h = it & 15, tb = (it >> 4) & 63, b = it >> 10;
            const bf16* src = F.QKV + (size_t)(b * SEQ + tb * 64) * NQKV + 2 * D + h * HD + 2 * lane;
            unsigned u[64];
#pragma unroll
            for (int i = 0; i < 64; ++i) u[i] = *(const unsigned*)(src + (size_t)i * NQKV);
#pragma unroll
            for (int i = 0; i < 64; ++i) *(LAS unsigned*)(tile + i * 130 + 2 * lane) = u[i];
            dst = F.VT + ((size_t)(b * 16 + h) * HD) * SEQ + tb * 64; dstride = SEQ;
        } else if (it < VT_NP + VT_NN) {
            const int r = it - VT_NP, h = r & 15, b = r >> 4;
            nrows = 32;
            const bf16* src = F.QKV + (size_t)(TP + b * 32) * NQKV + 2 * D + h * HD + 2 * lane;
            unsigned u[32];
#pragma unroll
            for (int i = 0; i < 32; ++i) u[i] = *(const unsigned*)(src + (size_t)i * NQKV);
#pragma unroll
            for (int i = 0; i < 32; ++i) *(LAS unsigned*)(tile + i * 130 + 2 * lane) = u[i];
            dst = F.VTS + ((size_t)(b * 16 + h) * HD) * SROWS + 512; dstride = SROWS;
        } else {
            const int r = it - VT_NP - VT_NN, h = r & 15, jb = (r >> 4) & 7, b = r >> 7;
            const float* src = p.cache_v + ((size_t)(b * 512 + jb * 64) * NH + h) * HD + 2 * lane;
#pragma unroll
            for (int hh = 0; hh < 2; ++hh) {
                f32x2 x[32];
#pragma unroll
                for (int i = 0; i < 32; ++i) x[i] = __builtin_nontemporal_load((const f32x2*)(src + (size_t)(32 * hh + i) * D));
#pragma unroll
                for (int i = 0; i < 32; ++i) *(LAS unsigned*)(tile + (32 * hh + i) * 130 + 2 * lane) = pk2(x[i].x, x[i].y);
            }
            dst = F.VTS + ((size_t)(b * 16 + h) * HD) * SROWS + jb * 64; dstride = SROWS;
        }
        asm volatile("s_waitcnt lgkmcnt(0)" ::: "memory");
        const int tp = lane & 31, dh = lane >> 5;
        if (2 * tp < nrows) {
#pragma unroll 8
            for (int pp = 0; pp < 64; ++pp) { const int dv = 2 * pp + dh;
                const unsigned lo = tile[(2 * tp) * 130 + dv], hi = tile[(2 * tp + 1) * 130 + dv];
                *(unsigned*)(dst + (size_t)dv * dstride + 2 * tp) = lo | (hi << 16); }
        }
        asm volatile("s_waitcnt lgkmcnt(0)" ::: "memory");
    }
}
DI void prep_phase(Frame& F) {
    const Params& p = F.p;
    const int gw = F.bid * NWAVES + F.wave, NGW = F.G * NWAVES, lane = F.lane;
    const float qscale = 0.08838834764831845f * 1.4426950408889634f;
    for (int m = gw; m < T; m += NGW) {
        const bf16* src = F.QKV + (size_t)m * NQKV + lane * 8;
        const bool smp = m >= TP; const int b = smp ? (m - TP) >> 5 : m >> 12, t = smp ? (m - TP) & 31 : m & 4095;
        const int hc = (lane & 15) * 8;
        u32x4 xq[4], xk[4], xv[4];
#pragma unroll
        for (int j = 0; j < 4; ++j) { xq[j] = *(const u32x4*)(src + j * 512); xk[j] = *(const u32x4*)(src + D + j * 512); xv[j] = *(const u32x4*)(src + 2 * D + j * 512); }
        float* ko = nullptr; float* vo = nullptr;
        if (smp) { ko = p.out + O_KSM + (size_t)(m - TP) * D + lane * 8; vo = p.out + O_VSM + (size_t)(m - TP) * D + lane * 8; }
        else if (t >= SEQ - 512) { ko = p.out + O_KP + ((size_t)b * 512 + (t - (SEQ - 512))) * D + lane * 8; vo = p.out + O_VP + ((size_t)b * 512 + (t - (SEQ - 512))) * D + lane * 8; }
        const f32x4 gq0 = *(const f32x4*)(p.b_q_norm + hc), gq1 = *(const f32x4*)(p.b_q_norm + hc + 4);
        const f32x4 gk0 = *(const f32x4*)(p.b_k_norm + hc), gk1 = *(const f32x4*)(p.b_k_norm + hc + 4);
        bf16* qdst = F.QB + (size_t)m * D + lane * 8;
        bf16* kdst = smp ? F.KS + ((size_t)b * SROWS + 512 + t) * D + lane * 8 : F.KN + (size_t)m * D + lane * 8;
#pragma unroll
        for (int j = 0; j < 4; ++j) {
            { const u32x4 x = xq[j]; const float v[8] = {bflo(x.x), bfhi(x.x), bflo(x.y), bfhi(x.y), bflo(x.z), bfhi(x.z), bflo(x.w), bfhi(x.w)};
              float ss = 0.f;
#pragma unroll
              for (int e = 0; e < 8; ++e) ss += v[e] * v[e];
              ss += __shfl_xor(ss, 1); ss += __shfl_xor(ss, 2); ss += __shfl_xor(ss, 4); ss += __shfl_xor(ss, 8);
              const float rstd = rsqrtf(ss * (1.f / HD) + EPS) * qscale;
              u32x4 o; o.x = pk2(v[0] * rstd * gq0.x, v[1] * rstd * gq0.y); o.y = pk2(v[2] * rstd * gq0.z, v[3] * rstd * gq0.w);
              o.z = pk2(v[4] * rstd * gq1.x, v[5] * rstd * gq1.y); o.w = pk2(v[6] * rstd * gq1.z, v[7] * rstd * gq1.w);
              *(u32x4*)(qdst + j * 512) = o; }
            { const u32x4 x = xk[j]; const float v[8] = {bflo(x.x), bfhi(x.x), bflo(x.y), bfhi(x.y), bflo(x.z), bfhi(x.z), bflo(x.w), bfhi(x.w)};
              float ss = 0.f;
#pragma unroll
              for (int e = 0; e < 8; ++e) ss += v[e] * v[e];
              ss += __shfl_xor(ss, 1); ss += __shfl_xor(ss, 2); ss += __shfl_xor(ss, 4); ss += __shfl_xor(ss, 8);
              const float rstd = rsqrtf(ss * (1.f / HD) + EPS);
              const f32x4 a = {v[0] * rstd * gk0.x, v[1] * rstd * gk0.y, v[2] * rstd * gk0.z, v[3] * rstd * gk0.w};
              const f32x4 c = {v[4] * rstd * gk1.x, v[5] * rstd * gk1.y, v[6] * rstd * gk1.z, v[7] * rstd * gk1.w};
              u32x4 o; o.x = pk2(a.x, a.y); o.y = pk2(a.z, a.w); o.z = pk2(c.x, c.y); o.w = pk2(c.z, c.w);
              *(u32x4*)(kdst + j * 512) = o;
              if (ko) { *(f32x4*)(ko + j * 512) = a; *(f32x4*)(ko + j * 512 + 4) = c; } }
            if (vo) { const u32x4 x = xv[j];
              const f32x4 a = {bflo(x.x), bfhi(x.x), bflo(x.y), bfhi(x.y)}, c = {bflo(x.z), bfhi(x.z), bflo(x.w), bfhi(x.w)};
              *(f32x4*)(vo + j * 512) = a; *(f32x4*)(vo + j * 512 + 4) = c; }
        }
    }
    vtrans_items(F, 0, VT_NP + VT_NN, F.bid, F.G);
}
DI void attn_scores(f32x16 (&oacc)[4], float& mrun, float& lsum, const bf16x8 (&qf)[8], const bf16x8 (&kf)[8], bf16x8 (&pfr)[2], int relb, const LAS float* bias, float bias0, int hf) {
    f32x16 s; for (int i = 0; i < 16; ++i) s[i] = 0.f;
#pragma unroll
    for (int kk = 0; kk < 8; ++kk) s = MFMA32(kf[kk], qf[kk], s);
    const bool farb = relb + 31 <= -128;
    const float boff = farb ? bias0 : 0.f;
    if (!farb) {
#pragma unroll
        for (int i = 0; i < 16; ++i) { int rel = relb + crow(i, hf); rel = rel < -128 ? -128 : (rel > 63 ? 63 : rel); s[i] += bias[rel + 128]; }
    }
    float mt = s[0];
#pragma unroll
    for (int i = 1; i < 16; ++i) mt = fmaxf(mt, s[i]);
    mt += boff;
    mt = fmaxf(mt, __shfl_xor(mt, 32));
    constexpr float DEFER_THR = 8.f;
    if (__any(mt - mrun > DEFER_THR)) {
        const float mnew = fmaxf(mrun, mt), alpha = __builtin_amdgcn_exp2f(mrun - mnew);
        mrun = mnew; lsum *= alpha;
#pragma unroll
        for (int bl = 0; bl < 4; ++bl)
#pragma unroll
            for (int i = 0; i < 16; ++i) oacc[bl][i] *= alpha;
    }
    float ps = 0.f; float pv[16];
    const float eoff = boff - mrun;
#pragma unroll
    for (int i = 0; i < 16; ++i) { pv[i] = __builtin_amdgcn_exp2f(s[i] + eoff); ps += pv[i]; }
    lsum += ps;
#pragma unroll
    for (int kb = 0; kb < 2; ++kb) {
        u32x4 pb; pb.x = pk2(pv[8 * kb], pv[8 * kb + 1]); pb.y = pk2(pv[8 * kb + 2], pv[8 * kb + 3]); pb.z = pk2(pv[8 * kb + 4], pv[8 * kb + 5]); pb.w = pk2(pv[8 * kb + 6], pv[8 * kb + 7]);
        pfr[kb] = __builtin_bit_cast(bf16x8, pb);
    }
}
DI void attn_pv(f32x16 (&oacc)[4], const bf16x8 (&pfr)[2], const bf16x8 (&vf)[2][4]) {
#pragma unroll
    for (int kb = 0; kb < 2; ++kb)
#pragma unroll
        for (int bl = 0; bl < 4; ++bl) oacc[bl] = MFMA32(vf[kb][bl], pfr[kb], oacc[bl]);
}
DI void attn_step(f32x16 (&oacc)[4], float& mrun, float& lsum, const bf16x8 (&qf)[8], const bf16x8 (&kf)[8], const bf16x8 (&vf)[2][4], int relb, const LAS float* bias, float bias0, int hf) {
    bf16x8 pfr[2];
    attn_scores(oacc, mrun, lsum, qf, kf, pfr, relb, bias, bias0, hf);
    attn_pv(oacc, pfr, vf);
}
constexpr int AK_STRIDE = 136, AV_STRIDE = 72, A_KBYTES = 64 * AK_STRIDE * 2, A_VBYTES = 128 * AV_STRIDE * 2, A_BUF = A_KBYTES + A_VBYTES;
constexpr int A_BIAS_OFF = 135168;
static_assert(2 * A_BUF <= A_BIAS_OFF && 8 * 16384 + 8 * 256 <= A_BIAS_OFF && A_BIAS_OFF + 768 <= LDS_BYTES - 16, "attention lds");

DI void attn_phase(Frame& F) {
    const Params& p = F.p;
    const int lane = F.lane, w = F.wave, tid = F.tid, r = lane & 31, hf = lane >> 5;
    constexpr float L2E = 1.4426950408889634f;
    for (int su = F.bid; su < 512; su += F.G) {
        const int h = su & 15, b = su >> 4, qrow0 = TP + b * 32;
        const bf16* kbase = F.KS + (size_t)(b * SROWS) * D + h * HD; const bf16* vbase = F.VTS + ((size_t)(b * 16 + h) * HD) * SROWS;
        LAS float* bias = (LAS float*)(F.lds + A_BIAS_OFF);
        if (tid < 192) bias[tid] = p.b_rel_bias[tid * NH + h] * L2E;
        bf16x8 qf[8];
        { const bf16* qp = F.QB + (size_t)(qrow0 + r) * D + h * HD + 8 * hf;
#pragma unroll
          for (int kk = 0; kk < 8; ++kk) qf[kk] = *(const bf16x8*)(qp + 16 * kk); }
        f32x16 oacc[4];
#pragma unroll
        for (int bl = 0; bl < 4; ++bl) for (int i = 0; i < 16; ++i) oacc[bl][i] = 0.f;
        float mrun = -1e30f, lsum = 0.f;
        __syncthreads();
        const float bias0 = bias[0];
        for (int kt = w; kt < 17; kt += 8) {
            bf16x8 kf[8], vf[2][4];
            { const bf16* kp = kbase + (size_t)(32 * kt + r) * D + 8 * hf;
#pragma unroll
              for (int kk = 0; kk < 8; ++kk) kf[kk] = *(const bf16x8*)(kp + 16 * kk); }
#pragma unroll
            for (int kb = 0; kb < 2; ++kb)
#pragma unroll
                for (int bl = 0; bl < 4; ++bl) { const bf16* vp = vbase + (size_t)(32 * bl + r) * SROWS + 32 * kt + 16 * kb + 4 * hf;
                    const u32x2 v0 = *(const u32x2*)vp, v1 = *(const u32x2*)(vp + 8); u32x4 vv; vv.x = v0.x; vv.y = v0.y; vv.z = v1.x; vv.w = v1.y; vf[kb][bl] = __builtin_bit_cast(bf16x8, vv); }
            attn_step(oacc, mrun, lsum, qf, kf, vf, -512 + 32 * kt - r, bias, bias0, hf);
        }
        lsum += __shfl_xor(lsum, 32);
        LAS float* op = (LAS float*)(F.lds + w * 16384); LAS float* ml = (LAS float*)(F.lds + 8 * 16384 + w * 256);
#pragma unroll
        for (int bl = 0; bl < 4; ++bl)
#pragma unroll
            for (int i = 0; i < 16; ++i) op[(32 * bl + crow(i, hf)) * 32 + r] = oacc[bl][i];
        if (hf == 0) { ml[2 * r] = mrun; ml[2 * r + 1] = lsum; }
        __syncthreads();
        { const int q = tid & 31, dv0 = (tid >> 5) * 8;
          float mw[8], M = -1e30f;
#pragma unroll
          for (int ww = 0; ww < 8; ++ww) { mw[ww] = ((LAS float*)(F.lds + 8 * 16384 + ww * 256))[2 * q]; M = fmaxf(M, mw[ww]); }
          float o[8] = {0.f, 0.f, 0.f, 0.f, 0.f, 0.f, 0.f, 0.f}, L = 0.f;
#pragma unroll
          for (int ww = 0; ww < 8; ++ww) { const float sc = __builtin_amdgcn_exp2f(mw[ww] - M); L += sc * ((LAS float*)(F.lds + 8 * 16384 + ww * 256))[2 * q + 1];
              const LAS float* pp = (LAS float*)(F.lds + ww * 16384) + dv0 * 32 + q;
#pragma unroll
              for (int e = 0; e < 8; ++e) o[e] += sc * pp[e * 32]; }
          const float inv = 1.f / L;
          u32x4 ov; ov.x = pk2(o[0] * inv, o[1] * inv); ov.y = pk2(o[2] * inv, o[3] * inv); ov.z = pk2(o[4] * inv, o[5] * inv); ov.w = pk2(o[6] * inv, o[7] * inv);
          *(u32x4*)(F.HB + (size_t)(qrow0 + q) * D + h * HD + dv0) = ov; }
        __syncthreads();
    }
    const int vbid = (F.G % 8 == 0) ? (F.bid & 7) * (F.G >> 3) + (F.bid >> 3) : F.bid;
    for (int unit = vbid; unit < 512; unit += F.G) {
        const int cq = unit & 15, h = (unit >> 4) & 15, b = unit >> 8;
        const int cw = 4 * cq + (w >> 1), qrow0 = b * SEQ + cw * 64 + (w & 1) * 32;
        const int kc_lo = (4 * cq - 8) > 0 ? 4 * cq - 8 : 0, kc_hi = 4 * cq + 3;
        LAS float* bias = (LAS float*)(F.lds + A_BIAS_OFF);
        if (tid < 192) bias[tid] = p.b_rel_bias[tid * NH + h] * L2E;
        const bf16* kg = F.KN + (size_t)(b * SEQ) * D + h * HD;
        const bf16* vg = F.VT + ((size_t)(b * 16 + h) * HD) * SEQ;
        const int kr0 = tid >> 4, ks0 = tid & 15, vr0 = tid >> 3, vs0 = tid & 7;
        u32x4 stA[4], stB[4];
#define A_GLOAD(kc, st) do { st[0] = *(const u32x4*)(kg + (size_t)((kc) * 64 + kr0) * D + ks0 * 8); st[1] = *(const u32x4*)(kg + (size_t)((kc) * 64 + kr0 + 32) * D + ks0 * 8); \
                         st[2] = *(const u32x4*)(vg + (size_t)vr0 * SEQ + (kc) * 64 + vs0 * 8); st[3] = *(const u32x4*)(vg + (size_t)(vr0 + 64) * SEQ + (kc) * 64 + vs0 * 8); } while (0)
#define A_LWRITE(buf, st) do { LAS bf16* kb_ = (LAS bf16*)(F.lds + (buf) * A_BUF); LAS bf16* vb_ = (LAS bf16*)(F.lds + (buf) * A_BUF + A_KBYTES); \
                         *(LAS u32x4*)(kb_ + kr0 * AK_STRIDE + ks0 * 8) = st[0]; *(LAS u32x4*)(kb_ + (kr0 + 32) * AK_STRIDE + ks0 * 8) = st[1]; \
                         *(LAS u32x4*)(vb_ + vr0 * AV_STRIDE + vs0 * 8) = st[2]; *(LAS u32x4*)(vb_ + (vr0 + 64) * AV_STRIDE + vs0 * 8) = st[3]; } while (0)
#define A_COMPUTE(kc, cur) do { if ((kc) >= cw - 8 && (kc) <= cw) { \
                const LAS bf16* Kb = (const LAS bf16*)(F.lds + (cur) * A_BUF); const LAS bf16* Vb = (const LAS bf16*)(F.lds + (cur) * A_BUF + A_KBYTES); \
                _Pragma("unroll 1") for (int t = 0; t < 2; ++t) { \
                    bf16x8 pfr[2]; \
                    { bf16x8 kf[8]; \
                      _Pragma("unroll") for (int kk = 0; kk < 8; ++kk) kf[kk] = *(const LAS bf16x8*)(Kb + (32 * t + r) * AK_STRIDE + 16 * kk + 8 * hf); \
                      attn_scores(oacc, mrun, lsum, qf, kf, pfr, ((kc) * 64 + 32 * t) - (cw * 64 + (w & 1) * 32) - r, bias, bias0, hf); } \
                    { bf16x8 vf[2][4]; \
                      _Pragma("unroll") for (int kb = 0; kb < 2; ++kb) _Pragma("unroll") for (int bl = 0; bl < 4; ++bl) { const LAS bf16* vp = Vb + (32 * bl + r) * AV_STRIDE + 32 * t + 16 * kb + 4 * hf; \
                            const u32x2 v0 = *(const LAS u32x2*)vp, v1 = *(const LAS u32x2*)(vp + 8); u32x4 vv; vv.x = v0.x; vv.y = v0.y; vv.z = v1.x; vv.w = v1.y; vf[kb][bl] = __builtin_bit_cast(bf16x8, vv); } \
                      attn_pv(oacc, pfr, vf); } } } } while (0)
        A_GLOAD(kc_lo, stA);
        A_GLOAD(kc_lo + 1, stB);
        bf16x8 qf[8];
        { const bf16* qp = F.QB + (size_t)(qrow0 + r) * D + h * HD + 8 * hf;
#pragma unroll
          for (int kk = 0; kk < 8; ++kk) qf[kk] = *(const bf16x8*)(qp + 16 * kk); }
        f32x16 oacc[4];
#pragma unroll
        for (int bl = 0; bl < 4; ++bl) for (int i = 0; i < 16; ++i) oacc[bl][i] = 0.f;
        float mrun = -1e30f, lsum = 0.f;
        A_LWRITE(0, stA);
        __syncthreads();
        const float bias0 = bias[0];
        for (int kc = kc_lo; kc <= kc_hi; kc += 2) {
            if (kc + 2 <= kc_hi) A_GLOAD(kc + 2, stA);
            A_COMPUTE(kc, 0);
            A_LWRITE(1, stB);
            __syncthreads();
            if (kc + 3 <= kc_hi) A_GLOAD(kc + 3, stB);
            A_COMPUTE(kc + 1, 1);
            if (kc + 2 <= kc_hi) A_LWRITE(0, stA);
            __syncthreads();
        }
#undef A_GLOAD
#undef A_LWRITE
#undef A_COMPUTE
        lsum += __shfl_xor(lsum, 32);
        const float inv = 1.f / lsum;
        bf16* op = F.HB + (size_t)(qrow0 + r) * D + h * HD;
#pragma unroll
        for (int bl = 0; bl < 4; ++bl)
#pragma unroll
            for (int g4 = 0; g4 < 4; ++g4) {
                u32x2 o; o.x = pk2(oacc[bl][4 * g4] * inv, oacc[bl][4 * g4 + 1] * inv); o.y = pk2(oacc[bl][4 * g4 + 2] * inv, oacc[bl][4 * g4 + 3] * inv);
                *(u32x2*)(op + 32 * bl + 8 * g4 + 4 * hf) = o;
            }
    }
}

#define XB_TMO      128
#define XB_XCNT(j)  (256  + 64 * (j))
#define XB_XSUB(j)  (1280 + 64 * (j))
#define XB_XGEN(j)  (2304 + 64 * (j))
#define XB_TOP      3328
#define XB_TOPGEN   3392
#define XCD_BAR_WORDS 3456
#define XB_SPIN_CAP (1u << 18)
DI unsigned xb_ld(unsigned* p)              { return __hip_atomic_load(p, __ATOMIC_RELAXED, __HIP_MEMORY_SCOPE_AGENT); }
DI unsigned xb_add(unsigned* p, unsigned v) { return __hip_atomic_fetch_add(p, v, __ATOMIC_RELAXED, __HIP_MEMORY_SCOPE_AGENT); }
DI unsigned xb_xcc_id() { return (unsigned)__builtin_amdgcn_s_getreg((3 << 11) | 20) & 0xFu; }
#define XB_SPIN(cond, bar) do { unsigned _sp = 0; while (cond) { __builtin_amdgcn_s_sleep(1); \
    if ((++_sp & 255u) == 0u) { if (xb_ld(&(bar)[XB_TMO])) break; if (_sp > XB_SPIN_CAP) { atomicAdd(&(bar)[XB_TMO], 1u); break; } } } } while (0)
struct XcdBarrier { unsigned* bar; unsigned x; volatile LAS unsigned* st; };
DI XcdBarrier xcd_barrier_post(unsigned* bar, volatile LAS unsigned* st) {
    XcdBarrier b; b.bar = bar; b.x = xb_xcc_id(); b.st = st;
    if (threadIdx.x == 0) (void)xb_add(&bar[XB_XCNT(b.x)], 1u);
    return b;
}
DI void xcd_barrier_complete(unsigned* bar, unsigned x, unsigned& nloc, unsigned& nx) {
    const unsigned G = gridDim.x * gridDim.y * gridDim.z;
    unsigned sum, cnt, mine, sp = 0u;
    for (;;) {
        sum = 0u; cnt = 0u; mine = 0u;
#pragma unroll
        for (unsigned j = 0; j < 16; ++j) { const unsigned c = xb_ld(&bar[XB_XCNT(j)]); sum += c; cnt += (c > 0u) ? 1u : 0u; mine = (j == x) ? c : mine; }
        if (sum == G) break;
        __builtin_amdgcn_s_sleep(1);
        if ((++sp & 255u) == 0u) { if (xb_ld(&bar[XB_TMO])) break; if (sp > XB_SPIN_CAP) { atomicAdd(&bar[XB_TMO], 1u); break; } }
    }
    nloc = mine > 0u ? mine : 1u; nx = cnt > 0u ? cnt : 1u;
}
DI void xcd_barrier(const XcdBarrier& b) {
    asm volatile("s_waitcnt vmcnt(0)" ::: "memory");
    __syncthreads();
    if (threadIdx.x == 0) {
        unsigned* bar = b.bar;
        __builtin_amdgcn_s_waitcnt(0);
        unsigned nloc = b.st[0], nx = b.st[1];
        if (nloc == 0u) { xcd_barrier_complete(bar, b.x, nloc, nx); b.st[0] = nloc; b.st[1] = nx; }
        const unsigned old = xb_add(&bar[XB_XSUB(b.x)], 1u);
        const unsigned gen = old / nloc;
        if (old + 1u == (gen + 1u) * nloc) {
            __builtin_amdgcn_fence(__ATOMIC_RELEASE, "agent");
            asm volatile("s_waitcnt vmcnt(0)" ::: "memory");
            const unsigned og = xb_add(&bar[XB_TOP], 1u);
            const unsigned tg = og / nx;
            if (og + 1u == (tg + 1u) * nx) xb_add(&bar[XB_TOPGEN], 1u);
            else XB_SPIN(xb_ld(&bar[XB_TOPGEN]) == tg, bar);
            __builtin_amdgcn_fence(__ATOMIC_ACQUIRE, "agent");
            xb_add(&bar[XB_XGEN(b.x)], 1u);
            asm volatile("s_waitcnt vmcnt(0)" ::: "memory");
        } else {
            XB_SPIN(xb_ld(&bar[XB_XGEN(b.x)]) == gen, bar);
            __builtin_amdgcn_fence(__ATOMIC_ACQUIRE, "agent");
            asm volatile("s_waitcnt vmcnt(0)" ::: "memory");
        }
    }
    __syncthreads();
}

enum { PH_P0, PH_G1, PH_GLA_A, PH_SCAN, PH_GLA_C, PH_G2, PH_RMS_F0, PH_G3_0, PH_CONV0, PH_G4_0, PH_RMS_M1, PH_G5, PH_PREP, PH_ATTN, PH_G6, PH_RMS_F1, PH_G3_1, PH_CONV1, PH_G4_1, PH_FIN, NPH };

__global__ void __launch_bounds__(NTHR, 2) fwd_megakernel(Params prm) {
    extern __shared__ __attribute__((aligned(16))) unsigned char lds_raw[];
    cg::grid_group grid = cg::this_grid();
    float* const X0 = prm.out;
    volatile LAS unsigned* bst = (volatile LAS unsigned*)((LAS unsigned char*)lds_raw + (LDS_BYTES - 16));
    if (threadIdx.x < 4) bst[threadIdx.x] = 0u;
    __syncthreads();
    XcdBarrier xbar = xcd_barrier_post((unsigned*)(prm.ws + WS_BAR), bst);
    for (int ph = prm.ph_lo; ph < prm.ph_hi; ++ph) {
      for (int rep = 0, nrep = 1 + ((REP_MASK >> ph) & 1); rep < nrep; ++rep) {
        int tid_ = threadIdx.x; asm volatile("" : "+v"(tid_));
        size_t zoff = 0; asm volatile("" : "+s"(zoff));
        unsigned char* ws = prm.ws + zoff;
        float* X = X0 + zoff;
        Frame F;
        F.p = prm; F.lds = (LAS unsigned char*)lds_raw;
        F.tid = tid_; F.lane = F.tid & 63; F.wave = __builtin_amdgcn_readfirstlane(F.tid >> 6); F.G = gridDim.x; F.bid = blockIdx.x;
        F.WinA = (bf16*)(ws + WS_WINA); F.WoA = (bf16*)(ws + WS_WOA); F.Wqkv = (bf16*)(ws + WS_WQKV); F.WoB = (bf16*)(ws + WS_WOB);
        F.Fin0 = (bf16*)(ws + WS_FIN0); F.Fin1 = (bf16*)(ws + WS_FIN1); F.Fdn0 = (bf16*)(ws + WS_FDN0); F.Fdn1 = (bf16*)(ws + WS_FDN1);
        F.LB = (float*)(ws + WS_LB); F.HB = (bf16*)(ws + WS_HB); F.QB = (bf16*)(ws + WS_QB);
        F.LOGF = (float*)(ws + WS_LOGF); F.VB = (bf16*)(ws + WS_VB); F.SG = (bf16*)(ws + WS_SG); F.OI = (float*)(ws + WS_OI); F.LOCAL = (float*)(ws + WS_LOCAL); F.DEC = (float*)(ws + WS_DEC);
        F.QKV = (bf16*)(ws + WS_QKV); F.KN = (bf16*)(ws + WS_KN); F.KS = (bf16*)(ws + WS_KS); F.VT = (bf16*)(ws + WS_VT); F.VTS = (bf16*)(ws + WS_VTS);
        F.UP = (bf16*)(ws + WS_UP); F.ACT = (bf16*)(ws + WS_ACT);
        switch (ph) {
        case PH_P0: if (EN_MASK & 1) p0_phase(F); break;
        case PH_GLA_A: if (EN_MASK & 2) gla_a_phase(F); break;
        case PH_SCAN: if (EN_MASK & 4) scan_phase(F); break;
        case PH_GLA_C: if (EN_MASK & 8) gla_c_phase(F); break;
        case PH_RMS_F0: if (EN_MASK & 16) rms_phase(F, X, prm.x_sample, prm.norm_ffn, (const float*)(ws + WS_PART), X + (size_t)TP * D); break;
        case PH_RMS_M1: if (EN_MASK & 16) rms_phase(F, X, X + (size_t)TP * D, prm.norm_mix + D, (const float*)(ws + WS_PART), X + (size_t)TP * D); break;
        case PH_RMS_F1: if (EN_MASK & 16) rms_phase(F, X, X + (size_t)TP * D, prm.norm_ffn + D, (const float*)(ws + WS_PART), X + (size_t)TP * D); break;
        case PH_FIN: fin_phase(F, X + (size_t)TP * D, (const float*)(ws + WS_PART)); break;
        case PH_CONV0: if (EN_MASK & 32) convfix_phase(F, 0, (const float*)(ws + WS_PART)); break;
        case PH_CONV1: if (EN_MASK & 32) convfix_phase(F, 1, (const float*)(ws + WS_PART)); break;
        case PH_PREP: if (EN_MASK & 64) prep_phase(F); break;
        case PH_ATTN: if (EN_MASK & 128) attn_phase(F); break;
        default: if (EN_MASK & 256) {
            pg8::Gemm g; pg8::Epi E; E.mode = 2; E.cw = nullptr; E.cbias = nullptr; E.ldo = D; E.ob = nullptr; E.of = X; E.resP = X; E.resS = X + (size_t)TP * D;
            E.lb = F.LB; E.logf = F.LOGF; E.wsb = ws;
            g.A = F.HB; g.M = T; g.K = D; g.N = D; g.Bt = F.WoA;
            if (ph == PH_G1) { g.Bt = F.WinA; g.N = NWIN; E.mode = 0; }
            else if (ph == PH_G2) { g.Bt = F.WoA; E.resP = prm.x_prompt; E.resS = prm.x_sample; }
            else if (ph == PH_G3_0 || ph == PH_G3_1) { const int l = (ph == PH_G3_1); g.Bt = l ? F.Fin1 : F.Fin0; g.N = NUP; E.mode = 3; E.cw = prm.f_conv_w + (size_t)l * 3 * FF; E.cbias = prm.f_conv_b + (size_t)l * FF; }
            else if (ph == PH_G4_0 || ph == PH_G4_1) { g.A = F.ACT; g.Bt = (ph == PH_G4_1) ? F.Fdn1 : F.Fdn0; g.K = FF; }
            else if (ph == PH_G5) { g.Bt = F.Wqkv; g.N = NQKV; E.mode = 1; E.ob = F.QKV; E.ldo = NQKV; }
            else { g.Bt = F.WoB; }
            E.part = (float*)(ws + WS_PART); E.act = F.ACT; E.edge = (float*)(ws + WS_PART);
            pg8::StaticOrder S; S.init(g.M, g.N, g.K, F.G, F.bid, E.mode == 2);
            pg8::gemm_phase(F.lds, g, S, E, F.tid);
            if (ph == PH_G1 || ph == PH_G3_0 || ph == PH_G5) {
                const int rem = S.nitems % F.G;
                if (rem == 0 || F.bid >= rem) {
                    const int widx = rem ? F.bid - rem : F.bid, nw = rem ? F.G - rem : F.G;
                    if (ph == PH_G1) wconv_items(F, WC_EARLY, WC_ALL, widx, nw);
                    else if (ph == PH_G3_0) cacheK_fill(F, widx, nw);
                    else vtrans_items(F, VT_NP + VT_NN, VT_NP + VT_NN + VT_NC, widx, nw);
                }
            }
        } break;
        }
      }
        if (prm.ph_hi > 1000) grid.sync();
        if (ph + 1 < prm.ph_hi) xcd_barrier(xbar);
    }
}

extern "C" void kernel_launch(void* const* d_in, const int* in_sizes, int n_in, void* d_out, int out_size, void* d_ws, size_t ws_size, hipStream_t stream) {
    static int grid_blocks = 0;
    if (!grid_blocks) {
        int dev = 0, cus = 0, per_cu = 0;
        hipGetDevice(&dev);
        hipDeviceGetAttribute(&cus, hipDeviceAttributeMultiprocessorCount, dev);
        if (hipFuncSetAttribute((const void*)fwd_megakernel, hipFuncAttributeMaxDynamicSharedMemorySize, LDS_BYTES) != hipSuccess) fprintf(stderr, "kernel_launch: hipFuncSetAttribute failed\n");
        hipOccupancyMaxActiveBlocksPerMultiprocessor(&per_cu, (const void*)fwd_megakernel, NTHR, LDS_BYTES);
        if (per_cu < 1) per_cu = 1;
        if (per_cu > 1) per_cu = 1;
        grid_blocks = cus * per_cu;
        if (n_in != 21 || (size_t)out_size != O_END || ws_size < WS_END) fprintf(stderr, "kernel_launch: unexpected sizes n_in %d out %d ws %zu (need %zu)\n", n_in, out_size, ws_size, (size_t)WS_END);
    }
    Params p{};
    p.x_prompt = (const float*)d_in[0]; p.x_sample = (const float*)d_in[1]; p.state_a_S = (const float*)d_in[2]; p.cache_k = (const float*)d_in[3]; p.cache_v = (const float*)d_in[4];
    p.conv_state = (const float*)d_in[5]; p.norm_mix = (const float*)d_in[6]; p.norm_ffn = (const float*)d_in[7]; p.a_w_in = (const float*)d_in[8]; p.a_gamma = (const float*)d_in[9];
    p.a_norm_o = (const float*)d_in[10]; p.a_w_o = (const float*)d_in[11]; p.b_w_qkv = (const float*)d_in[12]; p.b_q_norm = (const float*)d_in[13]; p.b_k_norm = (const float*)d_in[14];
    p.b_rel_bias = (const float*)d_in[15]; p.b_w_o = (const float*)d_in[16]; p.f_w_in = (const float*)d_in[17]; p.f_conv_w = (const float*)d_in[18]; p.f_conv_b = (const float*)d_in[19];
    p.f_w_down = (const float*)d_in[20];
    p.out = (float*)d_out; p.ws = (unsigned char*)d_ws;
#if MK_N_LAUNCHES == 1
    p.ph_lo = 0; p.ph_hi = NPH;
    if (hipMemsetAsync((char*)d_ws + WS_BAR, 0, 16384, stream) != hipSuccess) fprintf(stderr, "kernel_launch: memset of barrier words failed\n");
    void* args[] = {&p};
    hipError_t e = hipLaunchCooperativeKernel((const void*)fwd_megakernel, dim3(grid_blocks), dim3(NTHR), args, LDS_BYTES, stream);
    if (e != hipSuccess) fprintf(stderr, "cooperative launch failed: %s (grid %d)\n", hipGetErrorString(e), grid_blocks);
#else
    for (int ph = 0; ph < NPH; ++ph) {
        p.ph_lo = ph; p.ph_hi = ph + 1;
        hipLaunchKernelGGL(fwd_megakernel, dim3(grid_blocks), dim3(NTHR), LDS_BYTES, stream, p);
    }
#endif
}
```

```cpp
#include <hip/hip_runtime.h>
#include <hip/hip_cooperative_groups.h>
#include <cstdio>
#include <cstdint>
namespace cg = cooperative_groups;

#define DI __device__ __forceinline__
#define LAS __attribute__((address_space(3)))
#define GAS __attribute__((address_space(1)))
typedef unsigned short bf16;
typedef short bf16x8 __attribute__((ext_vector_type(8)));
typedef float f32x2 __attribute__((ext_vector_type(2)));
typedef float f32x4 __attribute__((ext_vector_type(4)));
typedef float f32x16 __attribute__((ext_vector_type(16)));
typedef unsigned u32x2 __attribute__((ext_vector_type(2)));
typedef unsigned u32x4 __attribute__((ext_vector_type(4)));
typedef __bf16 bf16x2_t __attribute__((ext_vector_type(2)));

#ifndef EN_MASK
#define EN_MASK 0xffffu
#endif
#ifndef REP_MASK
#define REP_MASK 0
#endif
#ifndef MK_N_LAUNCHES
#define MK_N_LAUNCHES 1
#endif

constexpr int D = 2048, TP = 8192, TS = 1024, T = TP + TS, SEQ = 4096, NH = 16, HD = 128, FF = 5632;
constexpr int NQKV = 3 * D, NWIN = 4 * D, NUP = 2 * FF;
constexpr int SROWS = 544;
constexpr float EPS = 1e-6f;
constexpr int NWAVES = 8, NTHR = 512;
constexpr int LDS_BYTES = 147456;

constexpr size_t MiB = 1u << 20;
constexpr size_t WS_WINA = 0, WS_WOA = 32 * MiB, WS_WQKV = 40 * MiB, WS_WOB = 64 * MiB, WS_FIN0 = 72 * MiB, WS_FIN1 = 116 * MiB, WS_FDN0 = 160 * MiB, WS_FDN1 = 182 * MiB;
constexpr size_t WS_LB = 204 * MiB, WS_HB = 205 * MiB, WS_QB = 241 * MiB, WS_MIX = 277 * MiB;
constexpr size_t WS_LOGF = WS_MIX, WS_VB = WS_MIX + 72 * MiB, WS_SG = WS_MIX + 108 * MiB, WS_OI = WS_MIX + 144 * MiB, WS_LOCAL = WS_MIX + 216 * MiB, WS_DEC = WS_MIX + 376 * MiB;
constexpr size_t WS_KS = WS_MIX, WS_VTS = WS_MIX + 68 * MiB, WS_QKV = WS_MIX + 136 * MiB, WS_KN = WS_MIX + 244 * MiB, WS_VT = WS_MIX + 276 * MiB;
constexpr size_t WS_UP = WS_MIX + 136 * MiB, WS_ACT = WS_MIX + 136 * MiB;
constexpr size_t WS_PART = WS_MIX + 236 * MiB;
constexpr size_t WS_BAR = WS_LB + 64 * 1024;
constexpr size_t WS_END = WS_MIX + 378 * MiB;

constexpr size_t O_YP = 0, O_YS = O_YP + (size_t)TP * D, O_SP = O_YS + (size_t)TS * D, O_SS = O_SP + 2 * 16 * 128 * 128, O_KP = O_SS + 32 * 16 * 128 * 128,
                 O_VP = O_KP + 2 * 512 * 2048, O_KSM = O_VP + 2 * 512 * 2048, O_VSM = O_KSM + 32 * 32 * 2048, O_CP = O_VSM + 32 * 32 * 2048, O_CS = O_CP + 2 * 2 * 2 * FF,
                 O_END = O_CS + 2 * 32 * 2 * FF;

struct Params {
    const float* x_prompt; const float* x_sample; const float* state_a_S; const float* cache_k; const float* cache_v; const float* conv_state;
    const float* norm_mix; const float* norm_ffn; const float* a_w_in; const float* a_gamma; const float* a_norm_o; const float* a_w_o;
    const float* b_w_qkv; const float* b_q_norm; const float* b_k_norm; const float* b_rel_bias; const float* b_w_o;
    const float* f_w_in; const float* f_conv_w; const float* f_conv_b; const float* f_w_down;
    float* out; unsigned char* ws; int ph_lo, ph_hi;
};

DI unsigned pk2(float lo, float hi) { f32x2 v = {lo, hi}; return __builtin_bit_cast(unsigned, __builtin_convertvector(v, bf16x2_t)); }
DI bf16 f2bf(float f) { return (bf16)(pk2(f, 0.f) & 0xffffu); }
DI float bflo(unsigned p) { return __uint_as_float(p << 16); }
DI float bfhi(unsigned p) { return __uint_as_float(p & 0xffff0000u); }
DI float wave_sum(float v) {
#pragma unroll
    for (int o = 1; o < 64; o <<= 1) v += __shfl_xor(v, o);
    return v;
}
DI float fexp(float x) { return __builtin_amdgcn_exp2f(x * 1.4426950408889634f); }
DI float fsigmoid(float z) { return __builtin_amdgcn_rcpf(1.f + fexp(-z)); }
DI float fsilu(float z) { return z * __builtin_amdgcn_rcpf(1.f + fexp(-z)); }
DI float flog(float x) { return __builtin_amdgcn_logf(x) * 0.6931471805599453f; }
DI int crow(int reg, int h) { return (reg & 3) + 8 * (reg >> 2) + 4 * h; }
#define MFMA32(a, b, c) __builtin_amdgcn_mfma_f32_32x32x16_bf16((a), (b), (c), 0, 0, 0)

namespace pg8 {
constexpr int BM = 256, BK = 64, HALF = 128, HTB = HALF * BK * 2, STAGE_BYTES = 8 * HTB, NXCD = 8, WGM = 8;
DI int lds_byte(int r, int c) { const int st = (r >> 4) * 2 + (c >> 5), rr = r & 15, cc = c & 31, ob = rr * 64 + cc * 2; return st * 1024 + (ob ^ (((ob >> 9) & 1) << 5)); }
DI void stage_rc(int b, int& R, int& C) { const int st = b / 1024, sb = b % 1024, swz = sb ^ (((sb >> 9) & 1) << 5); R = (st >> 1) * 16 + swz / 64; C = (st & 1) * 32 + (swz % 64) / 2; }
DI int perm32(int rho) { const int n = rho >> 4, i = rho & 15; return 8 * (i >> 2) + 4 * n + (i & 3); }
struct Unit { int pm, pn, kb0, nkt, slice; };
struct Gemm { const bf16* A; const bf16* Bt; int M, N, K; };
struct StaticOrder {
    int nM, nN, nwg, G, c, tail, nblk, nitems;
    DI void init(int M, int N, int K, int G_, int c_, int tail_) { tail = tail_; nM = tail ? TP / BM : M / BM; nN = N / BM; nwg = nM * nN; G = G_; c = c_; nblk = K / 128; nitems = nwg + (tail ? 256 : 0); }
    DI bool next(int i, Unit& u) const {
        const long L = (long)i * G + c; if (L >= nitems) return false;
        u.slice = -1; u.kb0 = 0; u.nkt = nblk * 2;
        if (L >= nwg) { const int j = (int)L - nwg, uu = j & 31; u.slice = j >> 5; u.pm = TP / BM + (uu >> 3); u.pn = uu & 7;
            const int base = nblk / 8, rem = nblk % 8; u.kb0 = u.slice * base + (u.slice < rem ? u.slice : rem); u.nkt = 2 * (base + (u.slice < rem ? 1 : 0)); return true; }
        int wgid = (int)L; { const int q = nwg / NXCD, r = nwg % NXCD, xcd = wgid % NXCD, off = wgid / NXCD; wgid = (xcd < r ? xcd * (q + 1) : r * (q + 1) + (xcd - r) * q) + off; }
        const int nig = WGM * nN, gid = wgid / nig, fm = gid * WGM, gsz = (nM - fm) < WGM ? (nM - fm) : WGM;
        u.pm = fm + ((wgid % nig) % gsz); u.pn = (wgid % nig) / gsz; return true;
    }
};

struct Epi {
    int mode;
    int ldo;
    bf16* ob;
    float* of; const float* resP; const float* resS;
    const float* lb; float* logf; unsigned char* wsb;
    float* part;
    const float* cw; const float* cbias; bf16* act; float* edge;
    DI bool perm() const { return mode != 2; }
    DI void operator()(const f32x4 (&acc)[2][2][4][2], const Unit& u, int wr, int wc, int fr, int fq) const {
        const int row0 = u.pm * BM + wr * 64 + fr;
        if (mode == 2 && u.slice >= 0) {
            const int col0 = u.pn * BM + wc * 32 + 4 * fq;
#pragma unroll
            for (int ai = 0; ai < 2; ++ai)
#pragma unroll
                for (int m = 0; m < 4; ++m) {
                    float* op = part + ((size_t)u.slice * TS + (row0 + ai * HALF + m * 16 - TP)) * D + col0;
#pragma unroll
                    for (int bj = 0; bj < 2; ++bj)
#pragma unroll
                        for (int n = 0; n < 2; ++n) *(f32x4*)(op + bj * HALF + n * 16) = acc[ai][bj][m][n];
                }
        } else if (mode == 2) {
            const int col0 = u.pn * BM + wc * 32 + 4 * fq;
#pragma unroll
            for (int ai = 0; ai < 2; ++ai) {
                f32x4 rr[4][2][2];
#pragma unroll
                for (int m = 0; m < 4; ++m) {
                    const int row = row0 + ai * HALF + m * 16;
                    const float* rp = (row < TP ? resP + (size_t)row * D : resS + (size_t)(row - TP) * D) + col0;
#pragma unroll
                    for (int bj = 0; bj < 2; ++bj)
#pragma unroll
                        for (int n = 0; n < 2; ++n) rr[m][bj][n] = *(const f32x4*)(rp + bj * HALF + n * 16);
                }
#pragma unroll
                for (int m = 0; m < 4; ++m) {
                    float* op = of + (size_t)(row0 + ai * HALF + m * 16) * D + col0;
#pragma unroll
                    for (int bj = 0; bj < 2; ++bj)
#pragma unroll
                        for (int n = 0; n < 2; ++n) *(f32x4*)(op + bj * HALF + n * 16) = rr[m][bj][n] + acc[ai][bj][m][n];
                }
            }
        } else if (mode == 3) {
            const int cc0 = u.pn * HALF + wc * 32 + 8 * fq;
            float w0[8], w1[8], w2[8], cb[8];
            { const f32x4 a0 = *(const f32x4*)(cw + cc0), a1 = *(const f32x4*)(cw + cc0 + 4), b0 = *(const f32x4*)(cw + FF + cc0), b1 = *(const f32x4*)(cw + FF + cc0 + 4);
              const f32x4 c0 = *(const f32x4*)(cw + 2 * FF + cc0), c1 = *(const f32x4*)(cw + 2 * FF + cc0 + 4), d0 = *(const f32x4*)(cbias + cc0), d1 = *(const f32x4*)(cbias + cc0 + 4);
#pragma unroll
              for (int e = 0; e < 4; ++e) { w0[e] = a0[e]; w0[4 + e] = a1[e]; w1[e] = b0[e]; w1[4 + e] = b1[e]; w2[e] = c0[e]; w2[4 + e] = c1[e]; cb[e] = d0[e]; cb[4 + e] = d1[e]; } }
            float* const eu_first = edge; float* const eg_first = edge + (size_t)(T / 32) * 2 * FF; float* const eu_last = edge + (size_t)(T / 32) * 4 * FF;
            const bool prm_unit = u.pm < TP / BM;
#pragma unroll
            for (int ai = 0; ai < 2; ++ai)
#pragma unroll
                for (int m = 0; m < 4; ++m) {
                    const int row = row0 + ai * HALF + m * 16, hb = row >> 5;
                    float a[8];
#pragma unroll
                    for (int n = 0; n < 2; ++n)
#pragma unroll
                        for (int e = 0; e < 4; ++e) {
                            const float cur = acc[ai][0][m][n][e];
                            const float prv = ((m & 1) || (prm_unit && m == 2)) ? acc[ai][0][m > 0 ? m - 1 : 0][n][e] : 0.f;
                            const int ci = __float_as_int(cur), pi = __float_as_int(prv);
                            const int r1 = __builtin_amdgcn_update_dpp(0, pi, 0x121, 0xf, 0xf, false), r2 = __builtin_amdgcn_update_dpp(0, pi, 0x122, 0xf, 0xf, false);
                            const float p1 = __int_as_float(__builtin_amdgcn_update_dpp(r1, ci, 0x111, 0xf, 0xf, false));
                            const float p2 = __int_as_float(__builtin_amdgcn_update_dpp(r2, ci, 0x112, 0xf, 0xf, false));
                            const int k = 4 * n + e;
                            a[k] = fsilu(cb[k] + p2 * w0[k] + p1 * w1[k] + cur * w2[k]) * acc[ai][1][m][n][e];
                        }
                    const bool first2 = (fr < 2) && (prm_unit ? (m == 0) : ((m & 1) == 0)), last2 = (fr >= 14) && (prm_unit ? (m == 3) : ((m & 1) == 1));
                    if (!first2) { u32x4 o; o.x = pk2(a[0], a[1]); o.y = pk2(a[2], a[3]); o.z = pk2(a[4], a[5]); o.w = pk2(a[6], a[7]); *(u32x4*)(act + (size_t)row * FF + cc0) = o; }
                    else { float* du = eu_first + ((size_t)hb * 2 + fr) * FF + cc0; float* dg = eg_first + ((size_t)hb * 2 + fr) * FF + cc0;
                        *(f32x4*)du = acc[ai][0][m][0]; *(f32x4*)(du + 4) = acc[ai][0][m][1]; *(f32x4*)dg = acc[ai][1][m][0]; *(f32x4*)(dg + 4) = acc[ai][1][m][1]; }
                    if (last2) { float* du = eu_last + ((size_t)hb * 2 + (fr - 14)) * FF + cc0; *(f32x4*)du = acc[ai][0][m][0]; *(f32x4*)(du + 4) = acc[ai][0][m][1]; }
                }
        } else if (mode == 1) {
            const int col0 = u.pn * BM + wc * 32 + 8 * fq;
#pragma unroll
            for (int ai = 0; ai < 2; ++ai)
#pragma unroll
                for (int m = 0; m < 4; ++m) {
                    bf16* op = ob + (size_t)(row0 + ai * HALF + m * 16) * ldo + col0;
#pragma unroll
                    for (int bj = 0; bj < 2; ++bj) { const f32x4 v0 = acc[ai][bj][m][0], v1 = acc[ai][bj][m][1];
                        u32x4 o; o.x = pk2(v0.x, v0.y); o.y = pk2(v0.z, v0.w); o.z = pk2(v1.x, v1.y); o.w = pk2(v1.z, v1.w);
                        *(u32x4*)(op + bj * HALF) = o; }
                }
        } else {
            const int type = u.pn >> 3, col0 = (u.pn & 7) * BM + wc * 32 + 8 * fq;
#pragma unroll
            for (int bj = 0; bj < 2; ++bj) {
                const int col = col0 + bj * HALF;
                f32x4 l0 = {0.f, 0.f, 0.f, 0.f}, l1 = l0;
                if (type == 1) { l0 = *(const f32x4*)(lb + col); l1 = *(const f32x4*)(lb + col + 4); }
#pragma unroll
                for (int ai = 0; ai < 2; ++ai)
#pragma unroll
                    for (int m = 0; m < 4; ++m) {
                        const size_t off = (size_t)(row0 + ai * HALF + m * 16) * D + col;
                        f32x4 v0 = acc[ai][bj][m][0], v1 = acc[ai][bj][m][1];
                        if (type == 1) {
#pragma unroll
                            for (int e = 0; e < 4; ++e) { v0[e] = flog(l0[e] + (1.f - l0[e]) * fsigmoid(v0[e])); v1[e] = flog(l1[e] + (1.f - l1[e]) * fsigmoid(v1[e])); }
                            *(f32x4*)(logf + off) = v0; *(f32x4*)(logf + off + 4) = v1;
                        } else {
                            if (type == 3) {
#pragma unroll
                                for (int e = 0; e < 4; ++e) { v0[e] = fsilu(v0[e]); v1[e] = fsilu(v1[e]); }
                            }
                            u32x4 o; o.x = pk2(v0.x, v0.y); o.y = pk2(v0.z, v0.w); o.z = pk2(v1.x, v1.y); o.w = pk2(v1.z, v1.w);
                            bf16* dst = (bf16*)(wsb + (type == 0 ? WS_QB : (type == 2 ? WS_VB : WS_SG)));
                            *(u32x4*)(dst + off) = o;
                        }
                    }
            }
        }
    }
};

DI void gemm_phase(LAS unsigned char* lds, const Gemm g, const StaticOrder& S, const Epi& E, const int tid) {
    const int wid = __builtin_amdgcn_readfirstlane(tid >> 6), lane = tid & 63, wr = wid >> 2, wc = wid & 3, fr = lane & 15, fq = lane >> 4;
    const int K = g.K;
    const bool PERM = E.perm();
    unsigned voffA[2], voffB[2];
#pragma unroll
    for (int i = 0; i < 2; ++i) { int R, C; stage_rc(tid * 16 + i * 8192, R, C); const int Rb = PERM ? ((R & ~31) + perm32(R & 31)) : R;
        voffA[i] = (unsigned)(R * K + C) * 2u; voffB[i] = (unsigned)(Rb * K + C) * 2u; }
    const size_t kstep = (size_t)(BK * 2);
    const size_t hstep = (size_t)HALF * K * 2;
    const size_t tstep = 2 * hstep;
    const unsigned ldsw = (unsigned)wid * 1024u;
    const int aoff = lds_byte(wr * 64 + fr, fq * 8), boff = lds_byte(wc * 32 + fr, fq * 8);
#define PG8_SA(b, h) (((b) * 2 + (h)) * HTB)
#define PG8_SB(b, h) ((4 + (b) * 2 + (h)) * HTB)
#define PG8_STAGE(bufoff, gbase, voff) do { _Pragma("unroll") for (int _i = 0; _i < 2; ++_i) \
        __builtin_amdgcn_global_load_lds((const unsigned*)((const char*)(gbase) + (voff)[_i]), (LAS unsigned*)(lds + (bufoff) + ldsw + _i * 8192), 16, 0, 0); } while (0)
#define PG8_LDA(dst, b, h) do { _Pragma("unroll") for (int m = 0; m < 4; ++m) _Pragma("unroll") for (int k = 0; k < 2; ++k) dst[m][k] = *(const LAS bf16x8*)(lds + PG8_SA(b, h) + aoff + m * 2048 + k * 1024); } while (0)
#define PG8_LDB(dst, b, h) do { _Pragma("unroll") for (int n = 0; n < 2; ++n) _Pragma("unroll") for (int k = 0; k < 2; ++k) dst[n][k] = *(const LAS bf16x8*)(lds + PG8_SB(b, h) + boff + n * 2048 + k * 1024); } while (0)
#define PG8_MMA(ai, bj, At, Bt) do { __builtin_amdgcn_s_setprio(1); _Pragma("unroll") for (int m = 0; m < 4; ++m) _Pragma("unroll") for (int n = 0; n < 2; ++n) _Pragma("unroll") for (int k = 0; k < 2; ++k) \
        acc[ai][bj][m][n] = __builtin_amdgcn_mfma_f32_16x16x32_bf16(Bt[n][k], At[m][k], acc[ai][bj][m][n], 0, 0, 0); __builtin_amdgcn_s_setprio(0); } while (0)
#define PG8_WAIT_V(n) asm volatile("s_waitcnt vmcnt(" #n ")" ::: "memory")
#define PG8_WAIT_L(n) asm volatile("s_waitcnt lgkmcnt(" #n ")" ::: "memory")
#define PG8_BAR __builtin_amdgcn_s_barrier()
#define PG8_SCHED __builtin_amdgcn_sched_barrier(0)
    Unit cur, nxt; int ui = 0;
    if (!S.next(0, cur)) return;
    f32x4 acc[2][2][4][2];
#pragma unroll
    for (int a = 0; a < 2; ++a)
#pragma unroll
        for (int b = 0; b < 2; ++b)
#pragma unroll
            for (int m = 0; m < 4; ++m)
#pragma unroll
                for (int n = 0; n < 2; ++n) acc[a][b][m][n] = (f32x4){0.f, 0.f, 0.f, 0.f};
    bf16x8 At[4][2], B0[2][2], B1[2][2];
    const char* cA = (const char*)g.A + (size_t)cur.pm * tstep + (size_t)cur.kb0 * 256; const char* cB = (const char*)g.Bt + (size_t)cur.pn * tstep + (size_t)cur.kb0 * 256;
    PG8_STAGE(PG8_SB(0, 0), cB, voffB); PG8_STAGE(PG8_SB(0, 1), cB + hstep, voffB); PG8_STAGE(PG8_SA(0, 0), cA, voffA); PG8_STAGE(PG8_SA(0, 1), cA + hstep, voffA);
    if (wr == 1) PG8_BAR;
    PG8_WAIT_V(2); PG8_BAR;
    PG8_STAGE(PG8_SB(1, 0), cB + kstep, voffB); PG8_STAGE(PG8_SA(1, 0), cA + kstep, voffA); PG8_STAGE(PG8_SB(1, 1), cB + hstep + kstep, voffB);
    PG8_WAIT_V(6); PG8_BAR;
    for (;;) {
        const bool has_next = S.next(ui + 1, nxt);
        const char* nA = has_next ? (const char*)g.A + (size_t)nxt.pm * tstep + (size_t)nxt.kb0 * 256 : cA; const char* nB = has_next ? (const char*)g.Bt + (size_t)nxt.pn * tstep + (size_t)nxt.kb0 * 256 : cB;
        const int nt = cur.nkt;
        for (int t = 0; t < nt; t += 2) {
            const bool last = (t == nt - 2);
            const char* a1 = cA + (size_t)(t + 1) * kstep;
            const char* a2 = last ? nA : cA + (size_t)(t + 2) * kstep; const char* b2 = last ? nB : cB + (size_t)(t + 2) * kstep;
            const char* a3 = a2 + kstep; const char* b3 = b2 + kstep;
            PG8_LDB(B0, 0, 0); PG8_LDB(B1, 0, 1); PG8_SCHED; PG8_LDA(At, 0, 0); PG8_STAGE(PG8_SA(1, 1), a1 + hstep, voffA);
            PG8_WAIT_V(8); PG8_WAIT_L(0); PG8_BAR; PG8_MMA(0, 0, At, B0); PG8_MMA(0, 1, At, B1); PG8_BAR; PG8_SCHED;
            PG8_LDA(At, 0, 1); PG8_STAGE(PG8_SB(0, 0), b2, voffB); PG8_STAGE(PG8_SB(0, 1), b2 + hstep, voffB); PG8_STAGE(PG8_SA(0, 0), a2, voffA);
            PG8_WAIT_V(8); PG8_WAIT_L(0); PG8_BAR; PG8_MMA(1, 0, At, B0); PG8_MMA(1, 1, At, B1); PG8_BAR; PG8_SCHED;
            PG8_LDB(B0, 1, 0); PG8_LDB(B1, 1, 1); PG8_SCHED; PG8_LDA(At, 1, 0); PG8_STAGE(PG8_SA(0, 1), a2 + hstep, voffA);
            PG8_WAIT_V(8); PG8_WAIT_L(0); PG8_BAR; PG8_MMA(0, 0, At, B0); PG8_MMA(0, 1, At, B1); PG8_BAR; PG8_SCHED;
            PG8_LDA(At, 1, 1); PG8_STAGE(PG8_SB(1, 0), b3, voffB); PG8_STAGE(PG8_SB(1, 1), b3 + hstep, voffB); PG8_STAGE(PG8_SA(1, 0), a3, voffA);
            PG8_WAIT_V(8); PG8_WAIT_L(0); PG8_BAR; PG8_MMA(1, 0, At, B0); PG8_MMA(1, 1, At, B1); PG8_BAR; PG8_SCHED;
        }
        if (wr == 0) PG8_BAR;
        E(acc, cur, wr, wc, fr, fq);
        if (!has_next) break;
#pragma unroll
        for (int a = 0; a < 2; ++a)
#pragma unroll
            for (int b = 0; b < 2; ++b)
#pragma unroll
                for (int m = 0; m < 4; ++m)
#pragma unroll
                    for (int n = 0; n < 2; ++n) acc[a][b][m][n] = (f32x4){0.f, 0.f, 0.f, 0.f};
        cur = nxt; cA = nA; cB = nB; ++ui;
        if (wr == 1) PG8_BAR;
    }
    PG8_WAIT_V(0);
    PG8_BAR;
#undef PG8_SA
#undef PG8_SB
#undef PG8_STAGE
#undef PG8_LDA
#undef PG8_LDB
#undef PG8_MMA
#undef PG8_WAIT_V
#undef PG8_WAIT_L
#undef PG8_BAR
#undef PG8_SCHED
}
}

struct Frame {
    Params p; LAS unsigned char* lds; int tid, lane, wave, G, bid;
    bf16 *WinA, *WoA, *Wqkv, *WoB, *Fin0, *Fin1, *Fdn0, *Fdn1;
    float* LB; bf16 *HB, *QB;
    float* LOGF; bf16 *VB, *SG; float *OI, *LOCAL, *DEC;
    bf16 *QKV, *KN, *KS, *VT, *VTS, *UP, *ACT;
};

DI void transpose_item(const float* __restrict__ W, int K, int N, bf16* __restrict__ WT, LAS float* scr, int item, int lane, const bool ilv = false) {
    const int nblk = N / 64, kb = item / nblk, nb = item % nblk, k0 = 64 * kb, n0 = 64 * nb;
    const int lr = lane >> 4, lc = (lane & 15) * 4;
    f32x4 v[16];
    const float* src = W + (size_t)(k0 + lr) * N + n0 + lc;
#pragma unroll
    for (int i = 0; i < 16; ++i) v[i] = __builtin_nontemporal_load((const f32x4*)(src + (size_t)(4 * i) * N));
#pragma unroll
    for (int i = 0; i < 16; ++i) { LAS float* d = scr + (4 * i + lr) * 65 + lc; d[0] = v[i].x; d[1] = v[i].y; d[2] = v[i].z; d[3] = v[i].w; }
    asm volatile("s_waitcnt lgkmcnt(0)" ::: "memory");
    const int c = lane & 7;
#pragma unroll
    for (int j = 0; j < 8; ++j) { const int n = (lane >> 3) + 8 * j; const LAS float* s = scr + (8 * c) * 65 + n;
        u32x4 o; o.x = pk2(s[0 * 65], s[1 * 65]); o.y = pk2(s[2 * 65], s[3 * 65]); o.z = pk2(s[4 * 65], s[5 * 65]); o.w = pk2(s[6 * 65], s[7 * 65]);
        int nd = n0 + n; if (ilv) nd = (nd < FF) ? (((nd >> 7) << 8) + (nd & 127)) : ((((nd - FF) >> 7) << 8) + 128 + ((nd - FF) & 127));
        __builtin_nontemporal_store(o, (u32x4*)(WT + (size_t)nd * K + k0 + 8 * c)); }
    asm volatile("s_waitcnt lgkmcnt(0)" ::: "memory");
}
DI void rms_row(const float* __restrict__ xrow, const float* __restrict__ g, bf16* __restrict__ orow, int lane, const float* __restrict__ part, float* __restrict__ xdst) {
    const f32x4* xr = (const f32x4*)xrow + lane; const f32x4* gr = (const f32x4*)g + lane;
    f32x4 v[8]; float s = 0.f;
#pragma unroll
    for (int j = 0; j < 8; ++j) v[j] = xr[64 * j];
    if (part) {
#pragma unroll
        for (int sl = 0; sl < 8; ++sl) { const f32x4* pr = (const f32x4*)(part + (size_t)sl * TS * D) + lane;
#pragma unroll
            for (int j = 0; j < 8; ++j) v[j] += pr[64 * j]; }
#pragma unroll
        for (int j = 0; j < 8; ++j) ((f32x4*)xdst + lane)[64 * j] = v[j];
    }
#pragma unroll
    for (int j = 0; j < 8; ++j) s += (v[j].x * v[j].x + v[j].y * v[j].y) + (v[j].z * v[j].z + v[j].w * v[j].w);
    const float rstd = rsqrtf(wave_sum(s) * (1.f / D) + EPS);
    u32x2* o8 = (u32x2*)orow + lane;
#pragma unroll
    for (int j = 0; j < 8; ++j) { const f32x4 gg = gr[64 * j]; u32x2 o; o.x = pk2(v[j].x * rstd * gg.x, v[j].y * rstd * gg.y); o.y = pk2(v[j].z * rstd * gg.z, v[j].w * rstd * gg.w); o8[64 * j] = o; }
}
DI void rms_row2(const float* __restrict__ x0, const float* __restrict__ x1, const float* __restrict__ g, bf16* __restrict__ o0, bf16* __restrict__ o1, int lane) {
    const f32x4* xr0 = (const f32x4*)x0 + lane; const f32x4* xr1 = (const f32x4*)x1 + lane; const f32x4* gr = (const f32x4*)g + lane;
    f32x4 v0[8], v1[8], gg[8]; float s0 = 0.f, s1 = 0.f;
#pragma unroll
    for (int j = 0; j < 8; ++j) { v0[j] = xr0[64 * j]; v1[j] = xr1[64 * j]; gg[j] = gr[64 * j]; }
#pragma unroll
    for (int j = 0; j < 8; ++j) { s0 += (v0[j].x * v0[j].x + v0[j].y * v0[j].y) + (v0[j].z * v0[j].z + v0[j].w * v0[j].w); s1 += (v1[j].x * v1[j].x + v1[j].y * v1[j].y) + (v1[j].z * v1[j].z + v1[j].w * v1[j].w); }
    const float r0 = rsqrtf(wave_sum(s0) * (1.f / D) + EPS), r1 = rsqrtf(wave_sum(s1) * (1.f / D) + EPS);
    u32x2* p0 = (u32x2*)o0 + lane; u32x2* p1 = (u32x2*)o1 + lane;
#pragma unroll
    for (int j = 0; j < 8; ++j) { u32x2 a, b;
        a.x = pk2(v0[j].x * r0 * gg[j].x, v0[j].y * r0 * gg[j].y); a.y = pk2(v0[j].z * r0 * gg[j].z, v0[j].w * r0 * gg[j].w);
        b.x = pk2(v1[j].x * r1 * gg[j].x, v1[j].y * r1 * gg[j].y); b.y = pk2(v1[j].z * r1 * gg[j].z, v1[j].w * r1 * gg[j].w);
        p0[64 * j] = a; p1[64 * j] = b; }
}
DI void rms_phase(Frame& F, const float* srcP, const float* srcS, const float* g, const float* part, float* xs) {
    const int gw = F.bid * NWAVES + F.wave, NGW = F.G * NWAVES;
    int m = gw;
    for (; m + NGW < TP; m += 2 * NGW) rms_row2(srcP + (size_t)m * D, srcP + (size_t)(m + NGW) * D, g, F.HB + (size_t)m * D, F.HB + (size_t)(m + NGW) * D, F.lane);
    for (; m < T; m += NGW) {
        if (m < TP) rms_row(srcP + (size_t)m * D, g, F.HB + (size_t)m * D, F.lane, nullptr, nullptr);
        else rms_row(srcS + (size_t)(m - TP) * D, g, F.HB + (size_t)m * D, F.lane, part ? part + (size_t)(m - TP) * D : nullptr, xs + (size_t)(m - TP) * D);
    }
}
DI void fin_phase(Frame& F, float* xs, const float* part) {
    const int gt = F.bid * NTHR + F.tid, NGT = F.G * NTHR;
    for (int it = gt; it < TS * D / 4; it += NGT) {
        f32x4 v = ((const f32x4*)xs)[it];
#pragma unroll
        for (int sl = 0; sl < 8; ++sl) v += ((const f32x4*)(part + (size_t)sl * TS * D))[it];
        ((f32x4*)xs)[it] = v;
    }
}
constexpr int I_WINA = (D / 64) * (NWIN / 64), I_WO = (D / 64) * (D / 64), I_QKV = (D / 64) * (NQKV / 64), I_FIN = (D / 64) * (NUP / 64), I_FDN = (FF / 64) * (D / 64);
constexpr int WC_EARLY = I_WINA + 2 * I_WO + I_QKV + I_FIN + I_FDN, WC_ALL = WC_EARLY + I_FIN + I_FDN;
DI void wconv_items(Frame& F, int it_lo, int it_hi, int widx, int nw) {
    const Params& p = F.p;
    LAS float* scr = (LAS float*)(F.lds + F.wave * 16640);
    for (int it = it_lo + widx * NWAVES + F.wave; it < it_hi; it += nw * NWAVES) {
        int r = it;
        if (r < I_WINA) { transpose_item(p.a_w_in, D, NWIN, F.WinA, scr, r, F.lane); continue; } r -= I_WINA;
        if (r < I_WO) { transpose_item(p.a_w_o, D, D, F.WoA, scr, r, F.lane); continue; } r -= I_WO;
        if (r < I_QKV) { transpose_item(p.b_w_qkv, D, NQKV, F.Wqkv, scr, r, F.lane); continue; } r -= I_QKV;
        if (r < I_WO) { transpose_item(p.b_w_o, D, D, F.WoB, scr, r, F.lane); continue; } r -= I_WO;
        if (r < I_FIN) { transpose_item(p.f_w_in, D, NUP, F.Fin0, scr, r, F.lane, true); continue; } r -= I_FIN;
        if (r < I_FDN) { transpose_item(p.f_w_down, FF, D, F.Fdn0, scr, r, F.lane); continue; } r -= I_FDN;
        if (r < I_FIN) { transpose_item(p.f_w_in + (size_t)D * NUP, D, NUP, F.Fin1, scr, r, F.lane, true); continue; } r -= I_FIN;
        transpose_item(p.f_w_down + (size_t)FF * D, FF, D, F.Fdn1, scr, r, F.lane);
    }
}
DI void p0_phase(Frame& F) {
    const Params& p = F.p;
    wconv_items(F, 0, WC_EARLY, F.bid, F.G);
    for (int c = F.bid * NTHR + F.tid; c < D; c += F.G * NTHR) {
        const float g0 = p.a_gamma[c], g1 = p.a_gamma[D + c], g2 = p.a_gamma[2 * D + c];
        const float mx = fmaxf(g0, fmaxf(g1, g2));
        const float e0 = __expf(g0 - mx), e1 = __expf(g1 - mx), e2 = __expf(g2 - mx);
        F.LB[c] = e0 / (e0 + e1 + e2);
    }
    rms_phase(F, p.x_prompt, p.x_sample, p.norm_mix, nullptr, nullptr);
}

constexpr int GLA_UNITS = 2048 + 512;
constexpr int QT_STRIDE = 136, TT_STRIDE = 72;
constexpr int L_BCUM = 0, L_QT = 32768, L_KT = L_QT + 64 * QT_STRIDE * 2, L_KHT = L_KT + 64 * QT_STRIDE * 2, L_VT = L_KHT + 128 * TT_STRIDE * 2, L_PM = L_VT + 128 * TT_STRIDE * 2, L_GLA_END = L_PM + 64 * TT_STRIDE * 2;
static_assert(L_GLA_END <= LDS_BYTES, "gla lds");

DI f32x16 mma_lds(const LAS bf16* A, int astride, int arow0, const LAS bf16* B, int bstride, int brow0, int nks, int lane) {
    f32x16 acc; for (int i = 0; i < 16; ++i) acc[i] = 0.f;
    const int r = lane & 31, hf = lane >> 5;
    const LAS bf16* ap = A + (arow0 + r) * astride + 8 * hf; const LAS bf16* bp = B + (brow0 + r) * bstride + 8 * hf;
    for (int ks = 0; ks < nks; ++ks) { const bf16x8 a = *(const LAS bf16x8*)(ap + 16 * ks), b = *(const LAS bf16x8*)(bp + 16 * ks); acc = MFMA32(a, b, acc); }
    return acc;
}

template <int BLK>
DI void gla_a_unit(Frame& F, int u, int row0, int h) {
    LAS float* bcum = (LAS float*)(F.lds + L_BCUM);
    LAS bf16* qt = (LAS bf16*)(F.lds + L_QT); LAS bf16* kt = (LAS bf16*)(F.lds + L_KT); LAS bf16* khT = (LAS bf16*)(F.lds + L_KHT);
    LAS bf16* vT = (LAS bf16*)(F.lds + L_VT); LAS bf16* Pm = (LAS bf16*)(F.lds + L_PM);
    const int tid = F.tid, lane = F.lane, w = F.wave;
    const size_t hoff = (size_t)h * HD;
    constexpr int SEG = BLK / 4;
    { const int seg = tid >> 7, kc = tid & 127; float a = 0.f;
      const float* lp = F.LOGF + (size_t)(row0 + seg * SEG) * D + hoff + kc;
#pragma unroll
      for (int t = 0; t < SEG; ++t) { a += lp[(size_t)t * D]; bcum[(seg * SEG + t) * 128 + kc] = a; }
      __syncthreads();
      float off = 0.f;
      for (int s = 0; s < seg; ++s) off += bcum[(s * SEG + SEG - 1) * 128 + kc];
      __syncthreads();
      if (seg > 0) {
#pragma unroll
          for (int t = 0; t < SEG; ++t) bcum[(seg * SEG + t) * 128 + kc] += off;
      }
      __syncthreads(); }
    for (int i = tid; i < BLK * 16; i += NTHR) {
        const int t = i >> 4, c0 = (i & 15) * 8;
        const size_t goff = (size_t)(row0 + t) * D + hoff + c0;
        const u32x4 qv = *(const u32x4*)(F.QB + goff);
        const u32x4 vv = *(const u32x4*)(F.VB + goff);
        const f32x4 lf0 = *(const f32x4*)(F.LOGF + goff), lf1 = *(const f32x4*)(F.LOGF + goff + 4);
        float q[8] = {bflo(qv.x), bfhi(qv.x), bflo(qv.y), bfhi(qv.y), bflo(qv.z), bfhi(qv.z), bflo(qv.w), bfhi(qv.w)};
        float lf[8] = {lf0.x, lf0.y, lf0.z, lf0.w, lf1.x, lf1.y, lf1.z, lf1.w};
        float qtv[8], ktv[8], qhv[8], khv[8];
#pragma unroll
        for (int e = 0; e < 8; ++e) {
            const float b = bcum[t * 128 + c0 + e], bmid = bcum[(BLK / 2 - 1) * 128 + c0 + e], bend = bcum[(BLK - 1) * 128 + c0 + e];
            const float kk = 1.f - __expf(lf[e]);
            qtv[e] = q[e] * __expf(b - bmid); ktv[e] = kk * __expf(bmid - b); qhv[e] = q[e] * __expf(b); khv[e] = kk * __expf(bend - b);
            if (t == BLK - 1) F.DEC[(size_t)u * 128 + c0 + e] = __expf(bend);
        }
        u32x4 o; o.x = pk2(qtv[0], qtv[1]); o.y = pk2(qtv[2], qtv[3]); o.z = pk2(qtv[4], qtv[5]); o.w = pk2(qtv[6], qtv[7]);
        *(LAS u32x4*)(qt + t * QT_STRIDE + c0) = o;
        o.x = pk2(ktv[0], ktv[1]); o.y = pk2(ktv[2], ktv[3]); o.z = pk2(ktv[4], ktv[5]); o.w = pk2(ktv[6], ktv[7]);
        *(LAS u32x4*)(kt + t * QT_STRIDE + c0) = o;
        o.x = pk2(qhv[0], qhv[1]); o.y = pk2(qhv[2], qhv[3]); o.z = pk2(qhv[4], qhv[5]); o.w = pk2(qhv[6], qhv[7]);
        *(u32x4*)(F.QB + goff) = o;
        const unsigned vw[4] = {vv.x, vv.y, vv.z, vv.w};
#pragma unroll
        for (int e = 0; e < 8; ++e) {
            khT[(c0 + e) * TT_STRIDE + t] = f2bf(khv[e]);
            vT[(c0 + e) * TT_STRIDE + t] = (bf16)((e & 1) ? (vw[e >> 1] >> 16) : (vw[e >> 1] & 0xffffu));
        }
    }
    __syncthreads();
    const int r = lane & 31, hf = lane >> 5;
#pragma unroll
    for (int q2 = 0; q2 < 2; ++q2) {
        const int tl = w * 2 + q2, mt = tl >> 2, nt = tl & 3;
        const f32x16 acc = mma_lds(khT, TT_STRIDE, 32 * mt, vT, TT_STRIDE, 32 * nt, BLK / 16, lane);
        if (BLK == 64) {
            float* lp = F.LOCAL + (size_t)u * 16384 + 32 * nt + r;
#pragma unroll
            for (int i = 0; i < 16; ++i) lp[(size_t)(32 * mt + crow(i, hf)) * 128] = acc[i];
        } else {
            const size_t so = (size_t)(u - 2048) * 16384 + 32 * nt + r;
            float s0v[16];
#pragma unroll
            for (int i = 0; i < 16; ++i) s0v[i] = F.p.state_a_S[so + (size_t)(32 * mt + crow(i, hf)) * 128];
#pragma unroll
            for (int i = 0; i < 16; ++i) { const int kc = 32 * mt + crow(i, hf); F.p.out[O_SS + so + (size_t)kc * 128] = __expf(bcum[(BLK - 1) * 128 + kc]) * s0v[i] + acc[i]; }
        }
    }
    constexpr int NT2 = BLK / 32;
    if (w < NT2 * NT2) {
        const int mt = w / NT2, nt = w % NT2;
        if (nt > mt) {
#pragma unroll
            for (int i = 0; i < 16; ++i) Pm[(32 * mt + crow(i, hf)) * TT_STRIDE + 32 * nt + r] = 0;
        } else {
            const f32x16 acc = mma_lds(qt, QT_STRIDE, 32 * mt, kt, QT_STRIDE, 32 * nt, 8, lane);
#pragma unroll
            for (int i = 0; i < 16; ++i) { const int t = 32 * mt + crow(i, hf), s = 32 * nt + r; Pm[t * TT_STRIDE + s] = (s <= t) ? f2bf(acc[i]) : (bf16)0; }
        }
    }
    __syncthreads();
    if (w < NT2 * 4) {
        const int mt = w >> 2, nt = w & 3;
        const f32x16 acc = mma_lds(Pm, TT_STRIDE, 32 * mt, vT, TT_STRIDE, 32 * nt, BLK / 16, lane);
        float* op = F.OI + (size_t)(row0 + 32 * mt) * D + hoff + 32 * nt + r;
#pragma unroll
        for (int i = 0; i < 16; ++i) op[(size_t)crow(i, hf) * D] = acc[i];
    }
    __syncthreads();
}
DI void gla_a_phase(Frame& F) {
    for (int u = F.bid; u < GLA_UNITS; u += F.G) {
        if (u < 2048) { const int b = u >> 10, h = (u >> 6) & 15, c = u & 63; gla_a_unit<64>(F, u, b * SEQ + c * 64, h); }
        else { const int su = u - 2048, b = su >> 4, h = su & 15; gla_a_unit<32>(F, u, TP + b * 32, h); }
    }
}
DI void scan_phase(Frame& F) {
    const int gt = F.bid * NTHR + F.tid, NGT = F.G * NTHR;
    for (int it = gt; it < 32 * 4096; it += NGT) {
        const int bh = it >> 12, e = (it & 4095) * 4, kc = e >> 7;
        f32x4 S = {0.f, 0.f, 0.f, 0.f};
        float* __restrict__ lp = F.LOCAL + (size_t)(bh * 64) * 16384 + e; const float* __restrict__ dp = F.DEC + (size_t)(bh * 64) * 128 + kc;
        for (int c0 = 0; c0 < 64; c0 += 8) {
            f32x4 loc[8]; float d[8];
#pragma unroll
            for (int j = 0; j < 8; ++j) { loc[j] = *(const f32x4*)(lp + (size_t)(c0 + j) * 16384); d[j] = dp[(c0 + j) * 128]; }
#pragma unroll
            for (int j = 0; j < 8; ++j) { *(f32x4*)(lp + (size_t)(c0 + j) * 16384) = S; S = S * d[j] + loc[j]; }
        }
        *(f32x4*)(F.p.out + O_SP + (size_t)bh * 16384 + e) = S;
    }
}
constexpr int OB_STRIDE = 132;
template <int BLK>
DI void gla_c_unit(Frame& F, const float* __restrict__ S, int row0, int h) {
    LAS float* ob = (LAS float*)F.lds;
    const int tid = F.tid, lane = F.lane, w = F.wave, r = lane & 31, hf = lane >> 5;
    const size_t hoff = (size_t)h * HD;
    constexpr int TPR_ = NTHR / BLK, CPT_ = 128 / TPR_;
    u32x4 sgv[CPT_ / 8];
    { const int t = tid / TPR_, c0 = (tid % TPR_) * CPT_;
#pragma unroll
      for (int e8 = 0; e8 < CPT_ / 8; ++e8) sgv[e8] = *(const u32x4*)(F.SG + (size_t)(row0 + t) * D + hoff + c0 + 8 * e8); }
    if (w < (BLK / 32) * 4) {
        const int mt = w >> 2, nt = w & 3;
        f32x16 acc; for (int i = 0; i < 16; ++i) acc[i] = 0.f;
        float oiv[16];
        { const float* oi = F.OI + (size_t)(row0 + 32 * mt) * D + hoff + 32 * nt + r;
#pragma unroll
          for (int i = 0; i < 16; ++i) oiv[i] = oi[(size_t)crow(i, hf) * D]; }
        const bf16* ap = F.QB + (size_t)(row0 + 32 * mt + r) * D + hoff + 8 * hf;
        const float* sp = S + (size_t)(8 * hf) * 128 + 32 * nt + r;
#pragma unroll
        for (int ks = 0; ks < 8; ++ks) {
            const bf16x8 a = *(const bf16x8*)(ap + 16 * ks);
            float sv[8];
#pragma unroll
            for (int e = 0; e < 8; ++e) sv[e] = sp[(size_t)(16 * ks + e) * 128];
            u32x4 bb; bb.x = pk2(sv[0], sv[1]); bb.y = pk2(sv[2], sv[3]); bb.z = pk2(sv[4], sv[5]); bb.w = pk2(sv[6], sv[7]);
            acc = MFMA32(a, __builtin_bit_cast(bf16x8, bb), acc);
        }
#pragma unroll
        for (int i = 0; i < 16; ++i) { const int t = crow(i, hf); ob[(32 * mt + t) * OB_STRIDE + 32 * nt + r] = acc[i] + oiv[i]; }
    }
    __syncthreads();
    {
        constexpr int TPR = NTHR / BLK;
        constexpr int CPT = 128 / TPR;
        const int t = tid / TPR, j = tid % TPR, c0 = j * CPT;
        float v[CPT]; float ss = 0.f;
#pragma unroll
        for (int e = 0; e < CPT; ++e) { v[e] = ob[t * OB_STRIDE + c0 + e]; ss += v[e] * v[e]; }
#pragma unroll
        for (int o = 1; o < TPR; o <<= 1) ss += __shfl_xor(ss, o);
        const float rstd = rsqrtf(ss * (1.f / HD) + EPS);
        const size_t goff = (size_t)(row0 + t) * D + hoff + c0;
#pragma unroll
        for (int e8 = 0; e8 < CPT / 8; ++e8) {
            const u32x4 sg = sgv[e8];
            const f32x4 n0 = *(const f32x4*)(F.p.a_norm_o + c0 + 8 * e8), n1 = *(const f32x4*)(F.p.a_norm_o + c0 + 8 * e8 + 4);
            const float* vv = v + 8 * e8;
            u32x4 o;
            o.x = pk2(vv[0] * rstd * n0.x * bflo(sg.x), vv[1] * rstd * n0.y * bfhi(sg.x));
            o.y = pk2(vv[2] * rstd * n0.z * bflo(sg.y), vv[3] * rstd * n0.w * bfhi(sg.y));
            o.z = pk2(vv[4] * rstd * n1.x * bflo(sg.z), vv[5] * rstd * n1.y * bfhi(sg.z));
            o.w = pk2(vv[6] * rstd * n1.z * bflo(sg.w), vv[7] * rstd * n1.w * bfhi(sg.w));
            *(u32x4*)(F.HB + goff + 8 * e8) = o;
        }
    }
    __syncthreads();
}
DI void gla_c_phase(Frame& F) {
    for (int u = F.bid; u < GLA_UNITS; u += F.G) {
        if (u < 2048) { const int b = u >> 10, h = (u >> 6) & 15, c = u & 63; gla_c_unit<64>(F, F.LOCAL + (size_t)u * 16384, b * SEQ + c * 64, h); }
        else { const int su = u - 2048, b = su >> 4, h = su & 15; gla_c_unit<32>(F, F.p.state_a_S + (size_t)su * 16384, TP + b * 32, h); }
    }
}
DI void convfix_phase(Frame& F, int layer, const float* edge) {
    const Params& p = F.p;
    const int gt = F.bid * NTHR + F.tid, NGT = F.G * NTHR;
    constexpr int NCG = FF / 8, NHB = T / 32;
    const float* cw = p.f_conv_w + (size_t)layer * 3 * FF; const float* cbp = p.f_conv_b + (size_t)layer * FF;
    const float* eu_first = edge; const float* eg_first = edge + (size_t)NHB * 2 * FF; const float* eu_last = edge + (size_t)NHB * 4 * FF;
    for (int it = gt; it < (128 + 32) * NCG; it += NGT) {
        const int blk = it / NCG, c0 = (it % NCG) * 8, hb = blk < 128 ? 2 * blk : 256 + (blk - 128);
        const bool smp = hb >= 256; const bool first = smp || ((hb & 127) == 0), lastb = smp || ((hb & 127) == 126);
        const int hbl = smp ? hb : hb + 1;
        float um2[8], um1[8], u0[8], u1[8], g0[8], g1[8], w0[8], w1[8], w2[8], bb[8];
#pragma unroll
        for (int e = 0; e < 8; ++e) { w0[e] = cw[c0 + e]; w1[e] = cw[FF + c0 + e]; w2[e] = cw[2 * FF + c0 + e]; bb[e] = cbp[c0 + e]; um2[e] = 0.f; um1[e] = 0.f;
            u0[e] = eu_first[((size_t)hb * 2) * FF + c0 + e]; u1[e] = eu_first[((size_t)hb * 2 + 1) * FF + c0 + e];
            g0[e] = eg_first[((size_t)hb * 2) * FF + c0 + e]; g1[e] = eg_first[((size_t)hb * 2 + 1) * FF + c0 + e]; }
        if (first) {
            if (smp) { const float* st = p.conv_state + ((size_t)(layer * 32 + (hb - 256)) * 2) * FF + c0;
#pragma unroll
                for (int e = 0; e < 8; ++e) { um2[e] = st[e]; um1[e] = st[FF + e]; } }
        } else {
#pragma unroll
            for (int e = 0; e < 8; ++e) { um2[e] = eu_last[((size_t)(hb - 1) * 2) * FF + c0 + e]; um1[e] = eu_last[((size_t)(hb - 1) * 2 + 1) * FF + c0 + e]; }
        }
        float a0[8], a1[8];
#pragma unroll
        for (int e = 0; e < 8; ++e) { a0[e] = fsilu(bb[e] + um2[e] * w0[e] + um1[e] * w1[e] + u0[e] * w2[e]) * g0[e]; a1[e] = fsilu(bb[e] + um1[e] * w0[e] + u0[e] * w1[e] + u1[e] * w2[e]) * g1[e]; }
        u32x4 o; o.x = pk2(a0[0], a0[1]); o.y = pk2(a0[2], a0[3]); o.z = pk2(a0[4], a0[5]); o.w = pk2(a0[6], a0[7]);
        *(u32x4*)(F.ACT + (size_t)(hb * 32) * FF + c0) = o;
        o.x = pk2(a1[0], a1[1]); o.y = pk2(a1[2], a1[3]); o.z = pk2(a1[4], a1[5]); o.w = pk2(a1[6], a1[7]);
        *(u32x4*)(F.ACT + (size_t)(hb * 32 + 1) * FF + c0) = o;
        if (lastb) {
            float* dst = smp ? p.out + O_CS + ((size_t)(layer * 32 + (hb - 256)) * 2) * FF + c0 : p.out + O_CP + ((size_t)(layer * 2 + (hb >> 7)) * 2) * FF + c0;
#pragma unroll
            for (int e = 0; e < 8; ++e) { dst[e] = eu_last[((size_t)hbl * 2) * FF + c0 + e]; dst[FF + e] = eu_last[((size_t)hbl * 2 + 1) * FF + c0 + e]; }
        }
    }
}
DI void cacheK_fill(Frame& F, int widx, int nw) {
    const Params& p = F.p;
    const int gt = widx * NTHR + F.tid, NGT = nw * NTHR;
    for (int it0 = gt; it0 < 32 * 512 * (D / 8); it0 += 4 * NGT) {
        f32x4 a[4], c[4];
#pragma unroll
        for (int j = 0; j < 4; ++j) { const int it = it0 + j * NGT; if (it < 32 * 512 * (D / 8)) { const int row = it >> 8, cc = (it & 255) * 8;
            a[j] = __builtin_nontemporal_load((const f32x4*)(p.cache_k + (size_t)row * D + cc)); c[j] = __builtin_nontemporal_load((const f32x4*)(p.cache_k + (size_t)row * D + cc + 4)); } }
#pragma unroll
        for (int j = 0; j < 4; ++j) { const int it = it0 + j * NGT; if (it < 32 * 512 * (D / 8)) { const int row = it >> 8, cc = (it & 255) * 8, b = row >> 9, jj = row & 511;
            u32x4 o; o.x = pk2(a[j].x, a[j].y); o.y = pk2(a[j].z, a[j].w); o.z = pk2(c[j].x, c[j].y); o.w = pk2(c[j].z, c[j].w);
            __builtin_nontemporal_store(o, (u32x4*)(F.KS + ((size_t)b * SROWS + jj) * D + cc)); } }
    }
}
constexpr int VT_NP = 2 * 64 * 16, VT_NN = 32 * 16, VT_NC = 32 * 16 * 8;
DI void vtrans_items(Frame& F, int it_lo, int it_hi, int widx, int nw) {
    const Params& p = F.p; const int lane = F.lane;
    LAS bf16* tile = (LAS bf16*)(F.lds + F.wave * 16640);
    for (int it = it_lo + widx * NWAVES + F.wave; it < it_hi; it += nw * NWAVES) {
        int nrows = 64; bf16* dst; int dstride;
        if (it < VT_NP) {
            const int h = it & 15, tb = (it >> 4) & 63, b = it >> 10;
            const bf16* src = F.QKV + (size_t)(b * SEQ + tb * 64) * NQKV + 2 * D + h * HD + 2 * lane;
            unsigned u[64];
#pragma unroll
            for (int i = 0; i < 64; ++i) u[i] = *(const unsigned*)(src + (size_t)i * NQKV);
#pragma unroll
            for (int i = 0; i < 64; ++i) *(LAS unsigned*)(tile + i * 130 + 2 * lane) = u[i];
            dst = F.VT + ((size_t)(b * 16 + h) * HD) * SEQ + tb * 64; dstride = SEQ;
        } else if (it < VT_NP + VT_NN) {
            const int r = it - VT_NP, h = r & 15, b = r >> 4;
            nrows = 32;
            const bf16* src = F.QKV + (size_t)(TP + b * 32) * NQKV + 2 * D + h * HD + 2 * lane;
            unsigned u[32];
#pragma unroll
            for (int i = 0; i < 32; ++i) u[i] = *(const unsigned*)(src + (size_t)i * NQKV);
#pragma unroll
            for (int i = 0; i < 32; ++i) *(LAS unsigned*)(tile + i * 130 + 2 * lane) = u[i];
            dst = F.VTS + ((size_t)(b * 16 + h) * HD) * SROWS + 512; dstride = SROWS;
        } else {
            const int r = it - VT_NP - VT_NN, h = r & 15, jb = (r >> 4) & 7, b = r >> 7;
            const float* src = p.cache_v + ((size_t)(b * 512 + jb * 64) * NH + h) * HD + 2 * lane;
#pragma unroll
            for (int hh = 0; hh < 2; ++hh) {
                f32x2 x[32];
#pragma unroll
                for (int i = 0; i < 32; ++i) x[i] = __builtin_nontemporal_load((const f32x2*)(src + (size_t)(32 * hh + i) * D));
#pragma unroll
                for (int i = 0; i < 32; ++i) *(LAS unsigned*)(tile + (32 * hh + i) * 130 + 2 * lane) = pk2(x[i].x, x[i].y);
            }
            dst = F.VTS + ((size_t)(b * 16 + h) * HD) * SROWS + jb * 64; dstride = SROWS;
        }
        asm volatile("s_waitcnt lgkmcnt(0)" ::: "memory");
        const int tp = lane & 31, dh = lane >> 5;
        if (2 * tp < nrows) {
#pragma unroll 8
            for (int pp = 0; pp < 64; ++pp) { const int dv = 2 * pp + dh;
                const unsigned lo = tile[(2 * tp) * 130 + dv], hi = tile[(2 * tp + 1) * 130 + dv];
                *(unsigned*)(dst + (size_t)dv * dstride + 2 * tp) = lo | (hi << 16); }
        }
        asm volatile("s_waitcnt lgkmcnt(0)" ::: "memory");
    }
}
DI void prep_phase(Frame& F) {
    const Params& p = F.p;
    const int gw = F.bid * NWAVES + F.wave, NGW = F.G * NWAVES, lane = F.lane;
    const float qscale = 0.08838834764831845f * 1.4426950408889634f;
    for (int m = gw; m < T; m += NGW) {
        const bf16* src = F.QKV + (size_t)m * NQKV + lane * 8;
        const bool smp = m >= TP; const int b = smp ? (m - TP) >> 5 : m >> 12, t = smp ? (m - TP) & 31 : m & 4095;
        const int hc = (lane & 15) * 8;
        u32x4 xq[4], xk[4], xv[4];
#pragma unroll
        for (int j = 0; j < 4; ++j) { xq[j] = *(const u32x4*)(src + j * 512); xk[j] = *(const u32x4*)(src + D + j * 512); xv[j] = *(const u32x4*)(src + 2 * D + j * 512); }
        float* ko = nullptr; float* vo = nullptr;
        if (smp) { ko = p.out + O_KSM + (size_t)(m - TP) * D + lane * 8; vo = p.out + O_VSM + (size_t)(m - TP) * D + lane * 8; }
        else if (t >= SEQ - 512) { ko = p.out + O_KP + ((size_t)b * 512 + (t - (SEQ - 512))) * D + lane * 8; vo = p.out + O_VP + ((size_t)b * 512 + (t - (SEQ - 512))) * D + lane * 8; }
        const f32x4 gq0 = *(const f32x4*)(p.b_q_norm + hc), gq1 = *(const f32x4*)(p.b_q_norm + hc + 4);
        const f32x4 gk0 = *(const f32x4*)(p.b_k_norm + hc), gk1 = *(const f32x4*)(p.b_k_norm + hc + 4);
        bf16* qdst = F.QB + (size_t)m * D + lane * 8;
        bf16* kdst = smp ? F.KS + ((size_t)b * SROWS + 512 + t) * D + lane * 8 : F.KN + (size_t)m * D + lane * 8;
#pragma unroll
        for (int j = 0; j < 4; ++j) {
            { const u32x4 x = xq[j]; const float v[8] = {bflo(x.x), bfhi(x.x), bflo(x.y), bfhi(x.y), bflo(x.z), bfhi(x.z), bflo(x.w), bfhi(x.w)};
              float ss = 0.f;
#pragma unroll
              for (int e = 0; e < 8; ++e) ss += v[e] * v[e];
              ss += __shfl_xor(ss, 1); ss += __shfl_xor(ss, 2); ss += __shfl_xor(ss, 4); ss += __shfl_xor(ss, 8);
              const float rstd = rsqrtf(ss * (1.f / HD) + EPS) * qscale;
              u32x4 o; o.x = pk2(v[0] * rstd * gq0.x, v[1] * rstd * gq0.y); o.y = pk2(v[2] * rstd * gq0.z, v[3] * rstd * gq0.w);
              o.z = pk2(v[4] * rstd * gq1.x, v[5] * rstd * gq1.y); o.w = pk2(v[6] * rstd * gq1.z, v[7] * rstd * gq1.w);
              *(u32x4*)(qdst + j * 512) = o; }
            { const u32x4 x = xk[j]; const float v[8] = {bflo(x.x), bfhi(x.x), bflo(x.y), bfhi(x.y), bflo(x.z), bfhi(x.z), bflo(x.w), bfhi(x.w)};
              float ss = 0.f;
#pragma unroll
              for (int e = 0; e < 8; ++e) ss += v[e] * v[e];
              ss += __shfl_xor(ss, 1); ss += __shfl_xor(ss, 2); ss += __shfl_xor(ss, 4); ss += __shfl_xor(ss, 8);
              const float rstd = rsqrtf(ss * (1.f / HD) + EPS);
              const f32x4 a = {v[0] * rstd * gk0.x, v[1] * rstd * gk0.y, v[2] * rstd * gk0.z, v[3] * rstd * gk0.w};
              const f32x4 c = {v[4] * rstd * gk1.x, v[5] * rstd * gk1.y, v[6] * rstd * gk1.z, v[7] * rstd * gk1.w};
              u32x4 o; o.x = pk2(a.x, a.y); o.y = pk2(a.z, a.w); o.z = pk2(c.x, c.y); o.w = pk2(c.z, c.w);
              *(u32x4*)(kdst + j * 512) = o;
              if (ko) { *(f32x4*)(ko + j * 512) = a; *(f32x4*)(ko + j * 512 + 4) = c; } }
            if (vo) { const u32x4 x = xv[j];
              const f32x4 a = {bflo(x.x), bfhi(x.x), bflo(x.y), bfhi(x.y)}, c = {bflo(x.z), bfhi(x.z), bflo(x.w), bfhi(x.w)};
              *(f32x4*)(vo + j * 512) = a; *(f32x4*)(vo + j * 512 + 4) = c; }
        }
    }
    vtrans_items(F, 0, VT_NP + VT_NN, F.bid, F.G);
}
DI void attn_scores(f32x16 (&oacc)[4], float& mrun, float& lsum, const bf16x8 (&qf)[8], const bf16x8 (&kf)[8], bf16x8 (&pfr)[2], int relb, const LAS float* bias, float bias0, int hf) {
    f32x16 s; for (int i = 0; i < 16; ++i) s[i] = 0.f;
#pragma unroll
    for (int kk = 0; kk < 8; ++kk) s = MFMA32(kf[kk], qf[kk], s);
    const bool farb = relb + 31 <= -128;
    const float boff = farb ? bias0 : 0.f;
    if (!farb) {
#pragma unroll
        for (int i = 0; i < 16; ++i) { int rel = relb + crow(i, hf); rel = rel < -128 ? -128 : (rel > 63 ? 63 : rel); s[i] += bias[rel + 128]; }
    }
    float mt = s[0];
#pragma unroll
    for (int i = 1; i < 16; ++i) mt = fmaxf(mt, s[i]);
    mt += boff;
    mt = fmaxf(mt, __shfl_xor(mt, 32));
    constexpr float DEFER_THR = 8.f;
    if (__any(mt - mrun > DEFER_THR)) {
        const float mnew = fmaxf(mrun, mt), alpha = __builtin_amdgcn_exp2f(mrun - mnew);
        mrun = mnew; lsum *= alpha;
#pragma unroll
        for (int bl = 0; bl < 4; ++bl)
#pragma unroll
            for (int i = 0; i < 16; ++i) oacc[bl][i] *= alpha;
    }
    float ps = 0.f; float pv[16];
    const float eoff = boff - mrun;
#pragma unroll
    for (int i = 0; i < 16; ++i) { pv[i] = __builtin_amdgcn_exp2f(s[i] + eoff); ps += pv[i]; }
    lsum += ps;
#pragma unroll
    for (int kb = 0; kb < 2; ++kb) {
        u32x4 pb; pb.x = pk2(pv[8 * kb], pv[8 * kb + 1]); pb.y = pk2(pv[8 * kb + 2], pv[8 * kb + 3]); pb.z = pk2(pv[8 * kb + 4], pv[8 * kb + 5]); pb.w = pk2(pv[8 * kb + 6], pv[8 * kb + 7]);
        pfr[kb] = __builtin_bit_cast(bf16x8, pb);
    }
}
DI void attn_pv(f32x16 (&oacc)[4], const bf16x8 (&pfr)[2], const bf16x8 (&vf)[2][4]) {
#pragma unroll
    for (int kb = 0; kb < 2; ++kb)
#pragma unroll
        for (int bl = 0; bl < 4; ++bl) oacc[bl] = MFMA32(vf[kb][bl], pfr[kb], oacc[bl]);
}
DI void attn_step(f32x16 (&oacc)[4], float& mrun, float& lsum, const bf16x8 (&qf)[8], const bf16x8 (&kf)[8], const bf16x8 (&vf)[2][4], int relb, const LAS float* bias, float bias0, int hf) {
    bf16x8 pfr[2];
    attn_scores(oacc, mrun, lsum, qf, kf, pfr, relb, bias, bias0, hf);
    attn_pv(oacc, pfr, vf);
}
constexpr int AK_STRIDE = 136, AV_STRIDE = 72, A_KBYTES = 64 * AK_STRIDE * 2, A_VBYTES = 128 * AV_STRIDE * 2, A_BUF = A_KBYTES + A_VBYTES;
constexpr int A_BIAS_OFF = 135168;
static_assert(2 * A_BUF <= A_BIAS_OFF && 8 * 16384 + 8 * 256 <= A_BIAS_OFF && A_BIAS_OFF + 768 <= LDS_BYTES - 16, "attention lds");

DI void attn_phase(Frame& F) {
    const Params& p = F.p;
    const int lane = F.lane, w = F.wave, tid = F.tid, r = lane & 31, hf = lane >> 5;
    constexpr float L2E = 1.4426950408889634f;
    for (int su = F.bid; su < 512; su += F.G) {
        const int h = su & 15, b = su >> 4, qrow0 = TP + b * 32;
        const bf16* kbase = F.KS + (size_t)(b * SROWS) * D + h * HD; const bf16* vbase = F.VTS + ((size_t)(b * 16 + h) * HD) * SROWS;
        LAS float* bias = (LAS float*)(F.lds + A_BIAS_OFF);
        if (tid < 192) bias[tid] = p.b_rel_bias[tid * NH + h] * L2E;
        bf16x8 qf[8];
        { const bf16* qp = F.QB + (size_t)(qrow0 + r) * D + h * HD + 8 * hf;
#pragma unroll
          for (int kk = 0; kk < 8; ++kk) qf[kk] = *(const bf16x8*)(qp + 16 * kk); }
        f32x16 oacc[4];
#pragma unroll
        for (int bl = 0; bl < 4; ++bl) for (int i = 0; i < 16; ++i) oacc[bl][i] = 0.f;
        float mrun = -1e30f, lsum = 0.f;
        __syncthreads();
        const float bias0 = bias[0];
        for (int kt = w; kt < 17; kt += 8) {
            bf16x8 kf[8], vf[2][4];
            { const bf16* kp = kbase + (size_t)(32 * kt + r) * D + 8 * hf;
#pragma unroll
              for (int kk = 0; kk < 8; ++kk) kf[kk] = *(const bf16x8*)(kp + 16 * kk); }
#pragma unroll
            for (int kb = 0; kb < 2; ++kb)
#pragma unroll
                for (int bl = 0; bl < 4; ++bl) { const bf16* vp = vbase + (size_t)(32 * bl + r) * SROWS + 32 * kt + 16 * kb + 4 * hf;
                    const u32x2 v0 = *(const u32x2*)vp, v1 = *(const u32x2*)(vp + 8); u32x4 vv; vv.x = v0.x; vv.y = v0.y; vv.z = v1.x; vv.w = v1.y; vf[kb][bl] = __builtin_bit_cast(bf16x8, vv); }
            attn_step(oacc, mrun, lsum, qf, kf, vf, -512 + 32 * kt - r, bias, bias0, hf);
        }
        lsum += __shfl_xor(lsum, 32);
        LAS float* op = (LAS float*)(F.lds + w * 16384); LAS float* ml = (LAS float*)(F.lds + 8 * 16384 + w * 256);
#pragma unroll
        for (int bl = 0; bl < 4; ++bl)
#pragma unroll
            for (int i = 0; i < 16; ++i) op[(32 * bl + crow(i, hf)) * 32 + r] = oacc[bl][i];
        if (hf == 0) { ml[2 * r] = mrun; ml[2 * r + 1] = lsum; }
        __syncthreads();
        { const int q = tid & 31, dv0 = (tid >> 5) * 8;
          float mw[8], M = -1e30f;
#pragma unroll
          for (int ww = 0; ww < 8; ++ww) { mw[ww] = ((LAS float*)(F.lds + 8 * 16384 + ww * 256))[2 * q]; M = fmaxf(M, mw[ww]); }
          float o[8] = {0.f, 0.f, 0.f, 0.f, 0.f, 0.f, 0.f, 0.f}, L = 0.f;
#pragma unroll
          for (int ww = 0; ww < 8; ++ww) { const float sc = __builtin_amdgcn_exp2f(mw[ww] - M); L += sc * ((LAS float*)(F.lds + 8 * 16384 + ww * 256))[2 * q + 1];
              const LAS float* pp = (LAS float*)(F.lds + ww * 16384) + dv0 * 32 + q;
#pragma unroll
              for (int e = 0; e < 8; ++e) o[e] += sc * pp[e * 32]; }
          const float inv = 1.f / L;
          u32x4 ov; ov.x = pk2(o[0] * inv, o[1] * inv); ov.y = pk2(o[2] * inv, o[3] * inv); ov.z = pk2(o[4] * inv, o[5] * inv); ov.w = pk2(o[6] * inv, o[7] * inv);
          *(u32x4*)(F.HB + (size_t)(qrow0 + q) * D + h * HD + dv0) = ov; }
        __syncthreads();
    }
    const int vbid = (F.G % 8 == 0) ? (F.bid & 7) * (F.G >> 3) + (F.bid >> 3) : F.bid;
    for (int unit = vbid; unit < 512; unit += F.G) {
        const int cq = unit & 15, h = (unit >> 4) & 15, b = unit >> 8;
        const int cw = 4 * cq + (w >> 1), qrow0 = b * SEQ + cw * 64 + (w & 1) * 32;
        const int kc_lo = (4 * cq - 8) > 0 ? 4 * cq - 8 : 0, kc_hi = 4 * cq + 3;
        LAS float* bias = (LAS float*)(F.lds + A_BIAS_OFF);
        if (tid < 192) bias[tid] = p.b_rel_bias[tid * NH + h] * L2E;
        const bf16* kg = F.KN + (size_t)(b * SEQ) * D + h * HD;
        const bf16* vg = F.VT + ((size_t)(b * 16 + h) * HD) * SEQ;
        const int kr0 = tid >> 4, ks0 = tid & 15, vr0 = tid >> 3, vs0 = tid & 7;
        u32x4 stA[4], stB[4];
#define A_GLOAD(kc, st) do { st[0] = *(const u32x4*)(kg + (size_t)((kc) * 64 + kr0) * D + ks0 * 8); st[1] = *(const u32x4*)(kg + (size_t)((kc) * 64 + kr0 + 32) * D + ks0 * 8); \
                         st[2] = *(const u32x4*)(vg + (size_t)vr0 * SEQ + (kc) * 64 + vs0 * 8); st[3] = *(const u32x4*)(vg + (size_t)(vr0 + 64) * SEQ + (kc) * 64 + vs0 * 8); } while (0)
#define A_LWRITE(buf, st) do { LAS bf16* kb_ = (LAS bf16*)(F.lds + (buf) * A_BUF); LAS bf16* vb_ = (LAS bf16*)(F.lds + (buf) * A_BUF + A_KBYTES); \
                         *(LAS u32x4*)(kb_ + kr0 * AK_STRIDE + ks0 * 8) = st[0]; *(LAS u32x4*)(kb_ + (kr0 + 32) * AK_STRIDE + ks0 * 8) = st[1]; \
                         *(LAS u32x4*)(vb_ + vr0 * AV_STRIDE + vs0 * 8) = st[2]; *(LAS u32x4*)(vb_ + (vr0 + 64) * AV_STRIDE + vs0 * 8) = st[3]; } while (0)
#define A_COMPUTE(kc, cur) do { if ((kc) >= cw - 8 && (kc) <= cw) { \
                const LAS bf16* Kb = (const LAS bf16*)(F.lds + (cur) * A_BUF); const LAS bf16* Vb = (const LAS bf16*)(F.lds + (cur) * A_BUF + A_KBYTES); \
                _Pragma("unroll 1") for (int t = 0; t < 2; ++t) { \
                    bf16x8 pfr[2]; \
                    { bf16x8 kf[8]; \
                      _Pragma("unroll") for (int kk = 0; kk < 8; ++kk) kf[kk] = *(const LAS bf16x8*)(Kb + (32 * t + r) * AK_STRIDE + 16 * kk + 8 * hf); \
                      attn_scores(oacc, mrun, lsum, qf, kf, pfr, ((kc) * 64 + 32 * t) - (cw * 64 + (w & 1) * 32) - r, bias, bias0, hf); } \
                    { bf16x8 vf[2][4]; \
                      _Pragma("unroll") for (int kb = 0; kb < 2; ++kb) _Pragma("unroll") for (int bl = 0; bl < 4; ++bl) { const LAS bf16* vp = Vb + (32 * bl + r) * AV_STRIDE + 32 * t + 16 * kb + 4 * hf; \
                            const u32x2 v0 = *(const LAS u32x2*)vp, v1 = *(const LAS u32x2*)(vp + 8); u32x4 vv; vv.x = v0.x; vv.y = v0.y; vv.z = v1.x; vv.w = v1.y; vf[kb][bl] = __builtin_bit_cast(bf16x8, vv); } \
                      attn_pv(oacc, pfr, vf); } } } } while (0)
        A_GLOAD(kc_lo, stA);
        A_GLOAD(kc_lo + 1, stB);
        bf16x8 qf[8];
        { const bf16* qp = F.QB + (size_t)(qrow0 + r) * D + h * HD + 8 * hf;
#pragma unroll
          for (int kk = 0; kk < 8; ++kk) qf[kk] = *(const bf16x8*)(qp + 16 * kk); }
        f32x16 oacc[4];
#pragma unroll
        for (int bl = 0; bl < 4; ++bl) for (int i = 0; i < 16; ++i) oacc[bl][i] = 0.f;
        float mrun = -1e30f, lsum = 0.f;
        A_LWRITE(0, stA);
        __syncthreads();
        const float bias0 = bias[0];
        for (int kc = kc_lo; kc <= kc_hi; kc += 2) {
            if (kc + 2 <= kc_hi) A_GLOAD(kc + 2, stA);
            A_COMPUTE(kc, 0);
            A_LWRITE(1, stB);
            __syncthreads();
            if (kc + 3 <= kc_hi) A_GLOAD(kc + 3, stB);
            A_COMPUTE(kc + 1, 1);
            if (kc + 2 <= kc_hi) A_LWRITE(0, stA);
            __syncthreads();
        }
#undef A_GLOAD
#undef A_LWRITE
#undef A_COMPUTE
        lsum += __shfl_xor(lsum, 32);
        const float inv = 1.f / lsum;
        bf16* op = F.HB + (size_t)(qrow0 + r) * D + h * HD;
#pragma unroll
        for (int bl = 0; bl < 4; ++bl)
#pragma unroll
            for (int g4 = 0; g4 < 4; ++g4) {
                u32x2 o; o.x = pk2(oacc[bl][4 * g4] * inv, oacc[bl][4 * g4 + 1] * inv); o.y = pk2(oacc[bl][4 * g4 + 2] * inv, oacc[bl][4 * g4 + 3] * inv);
                *(u32x2*)(op + 32 * bl + 8 * g4 + 4 * hf) = o;
            }
    }
}

#define XB_TMO      128
#define XB_XCNT(j)  (256  + 64 * (j))
#define XB_XSUB(j)  (1280 + 64 * (j))
#define XB_XGEN(j)  (2304 + 64 * (j))
#define XB_TOP      3328
#define XB_TOPGEN   3392
#define XCD_BAR_WORDS 3456
#define XB_SPIN_CAP (1u << 18)
DI unsigned xb_ld(unsigned* p)              { return __hip_atomic_load(p, __ATOMIC_RELAXED, __HIP_MEMORY_SCOPE_AGENT); }
DI unsigned xb_add(unsigned* p, unsigned v) { return __hip_atomic_fetch_add(p, v, __ATOMIC_RELAXED, __HIP_MEMORY_SCOPE_AGENT); }
DI unsigned xb_xcc_id() { return (unsigned)__builtin_amdgcn_s_getreg((3 << 11) | 20) & 0xFu; }
#define XB_SPIN(cond, bar) do { unsigned _sp = 0; while (cond) { __builtin_amdgcn_s_sleep(1); \
    if ((++_sp & 255u) == 0u) { if (xb_ld(&(bar)[XB_TMO])) break; if (_sp > XB_SPIN_CAP) { atomicAdd(&(bar)[XB_TMO], 1u); break; } } } } while (0)
struct XcdBarrier { unsigned* bar; unsigned x; volatile LAS unsigned* st; };
DI XcdBarrier xcd_barrier_post(unsigned* bar, volatile LAS unsigned* st) {
    XcdBarrier b; b.bar = bar; b.x = xb_xcc_id(); b.st = st;
    if (threadIdx.x == 0) (void)xb_add(&bar[XB_XCNT(b.x)], 1u);
    return b;
}
DI void xcd_barrier_complete(unsigned* bar, unsigned x, unsigned& nloc, unsigned& nx) {
    const unsigned G = gridDim.x * gridDim.y * gridDim.z;
    unsigned sum, cnt, mine, sp = 0u;
    for (;;) {
        sum = 0u; cnt = 0u; mine = 0u;
#pragma unroll
        for (unsigned j = 0; j < 16; ++j) { const unsigned c = xb_ld(&bar[XB_XCNT(j)]); sum += c; cnt += (c > 0u) ? 1u : 0u; mine = (j == x) ? c : mine; }
        if (sum == G) break;
        __builtin_amdgcn_s_sleep(1);
        if ((++sp & 255u) == 0u) { if (xb_ld(&bar[XB_TMO])) break; if (sp > XB_SPIN_CAP) { atomicAdd(&bar[XB_TMO], 1u); break; } }
    }
    nloc = mine > 0u ? mine : 1u; nx = cnt > 0u ? cnt : 1u;
}
DI void xcd_barrier(const XcdBarrier& b) {
    asm volatile("s_waitcnt vmcnt(0)" ::: "memory");
    __syncthreads();
    if (threadIdx.x == 0) {
        unsigned* bar = b.bar;
        __builtin_amdgcn_s_waitcnt(0);
        unsigned nloc = b.st[0], nx = b.st[1];
        if (nloc == 0u) { xcd_barrier_complete(bar, b.x, nloc, nx); b.st[0] = nloc; b.st[1] = nx; }
        const unsigned old = xb_add(&bar[XB_XSUB(b.x)], 1u);
        const unsigned gen = old / nloc;
        if (old + 1u == (gen + 1u) * nloc) {
            __builtin_amdgcn_fence(__ATOMIC_RELEASE, "agent");
            asm volatile("s_waitcnt vmcnt(0)" ::: "memory");
            const unsigned og = xb_add(&bar[XB_TOP], 1u);
            const unsigned tg = og / nx;
            if (og + 1u == (tg + 1u) * nx) xb_add(&bar[XB_TOPGEN], 1u);
            else XB_SPIN(xb_ld(&bar[XB_TOPGEN]) == tg, bar);
            __builtin_amdgcn_fence(__ATOMIC_ACQUIRE, "agent");
            xb_add(&bar[XB_XGEN(b.x)], 1u);
            asm volatile("s_waitcnt vmcnt(0)" ::: "memory");
        } else {
            XB_SPIN(xb_ld(&bar[XB_XGEN(b.x)]) == gen, bar);
            __builtin_amdgcn_fence(__ATOMIC_ACQUIRE, "agent");
            asm volatile("s_waitcnt vmcnt(0)" ::: "memory");
        }
    }
    __syncthreads();
}

enum { PH_P0, PH_G1, PH_GLA_A, PH_SCAN, PH_GLA_C, PH_G2, PH_RMS_F0, PH_G3_0, PH_CONV0, PH_G4_0, PH_RMS_M1, PH_G5, PH_PREP, PH_ATTN, PH_G6, PH_RMS_F1, PH_G3_1, PH_CONV1, PH_G4_1, PH_FIN, NPH };

__global__ void __launch_bounds__(NTHR, 2) fwd_megakernel(Params prm) {
    extern __shared__ __attribute__((aligned(16))) unsigned char lds_raw[];
    cg::grid_group grid = cg::this_grid();
    float* const X0 = prm.out;
    volatile LAS unsigned* bst = (volatile LAS unsigned*)((LAS unsigned char*)lds_raw + (LDS_BYTES - 16));
    if (threadIdx.x < 4) bst[threadIdx.x] = 0u;
    __syncthreads();
    XcdBarrier xbar = xcd_barrier_post((unsigned*)(prm.ws + WS_BAR), bst);
    for (int ph = prm.ph_lo; ph < prm.ph_hi; ++ph) {
      for (int rep = 0, nrep = 1 + ((REP_MASK >> ph) & 1); rep < nrep; ++rep) {
        int tid_ = threadIdx.x; asm volatile("" : "+v"(tid_));
        size_t zoff = 0; asm volatile("" : "+s"(zoff));
        unsigned char* ws = prm.ws + zoff;
        float* X = X0 + zoff;
        Frame F;
        F.p = prm; F.lds = (LAS unsigned char*)lds_raw;
        F.tid = tid_; F.lane = F.tid & 63; F.wave = __builtin_amdgcn_readfirstlane(F.tid >> 6); F.G = gridDim.x; F.bid = blockIdx.x;
        F.WinA = (bf16*)(ws + WS_WINA); F.WoA = (bf16*)(ws + WS_WOA); F.Wqkv = (bf16*)(ws + WS_WQKV); F.WoB = (bf16*)(ws + WS_WOB);
        F.Fin0 = (bf16*)(ws + WS_FIN0); F.Fin1 = (bf16*)(ws + WS_FIN1); F.Fdn0 = (bf16*)(ws + WS_FDN0); F.Fdn1 = (bf16*)(ws + WS_FDN1);
        F.LB = (float*)(ws + WS_LB); F.HB = (bf16*)(ws + WS_HB); F.QB = (bf16*)(ws + WS_QB);
        F.LOGF = (float*)(ws + WS_LOGF); F.VB = (bf16*)(ws + WS_VB); F.SG = (bf16*)(ws + WS_SG); F.OI = (float*)(ws + WS_OI); F.LOCAL = (float*)(ws + WS_LOCAL); F.DEC = (float*)(ws + WS_DEC);
        F.QKV = (bf16*)(ws + WS_QKV); F.KN = (bf16*)(ws + WS_KN); F.KS = (bf16*)(ws + WS_KS); F.VT = (bf16*)(ws + WS_VT); F.VTS = (bf16*)(ws + WS_VTS);
        F.UP = (bf16*)(ws + WS_UP); F.ACT = (bf16*)(ws + WS_ACT);
        switch (ph) {
        case PH_P0: if (EN_MASK & 1) p0_phase(F); break;
        case PH_GLA_A: if (EN_MASK & 2) gla_a_phase(F); break;
        case PH_SCAN: if (EN_MASK & 4) scan_phase(F); break;
        case PH_GLA_C: if (EN_MASK & 8) gla_c_phase(F); break;
        case PH_RMS_F0: if (EN_MASK & 16) rms_phase(F, X, prm.x_sample, prm.norm_ffn, (const float*)(ws + WS_PART), X + (size_t)TP * D); break;
        case PH_RMS_M1: if (EN_MASK & 16) rms_phase(F, X, X + (size_t)TP * D, prm.norm_mix + D, (const float*)(ws + WS_PART), X + (size_t)TP * D); break;
        case PH_RMS_F1: if (EN_MASK & 16) rms_phase(F, X, X + (size_t)TP * D, prm.norm_ffn + D, (const float*)(ws + WS_PART), X + (size_t)TP * D); break;
        case PH_FIN: fin_phase(F, X + (size_t)TP * D, (const float*)(ws + WS_PART)); break;
        case PH_CONV0: if (EN_MASK & 32) convfix_phase(F, 0, (const float*)(ws + WS_PART)); break;
        case PH_CONV1: if (EN_MASK & 32) convfix_phase(F, 1, (const float*)(ws + WS_PART)); break;
        case PH_PREP: if (EN_MASK & 64) prep_phase(F); break;
        case PH_ATTN: if (EN_MASK & 128) attn_phase(F); break;
        default: if (EN_MASK & 256) {
            pg8::Gemm g; pg8::Epi E; E.mode = 2; E.cw = nullptr; E.cbias = nullptr; E.ldo = D; E.ob = nullptr; E.of = X; E.resP = X; E.resS = X + (size_t)TP * D;
            E.lb = F.LB; E.logf = F.LOGF; E.wsb = ws;
            g.A = F.HB; g.M = T; g.K = D; g.N = D; g.Bt = F.WoA;
            if (ph == PH_G1) { g.Bt = F.WinA; g.N = NWIN; E.mode = 0; }
            else if (ph == PH_G2) { g.Bt = F.WoA; E.resP = prm.x_prompt; E.resS = prm.x_sample; }
            else if (ph == PH_G3_0 || ph == PH_G3_1) { const int l = (ph == PH_G3_1); g.Bt = l ? F.Fin1 : F.Fin0; g.N = NUP; E.mode = 3; E.cw = prm.f_conv_w + (size_t)l * 3 * FF; E.cbias = prm.f_conv_b + (size_t)l * FF; }
            else if (ph == PH_G4_0 || ph == PH_G4_1) { g.A = F.ACT; g.Bt = (ph == PH_G4_1) ? F.Fdn1 : F.Fdn0; g.K = FF; }
            else if (ph == PH_G5) { g.Bt = F.Wqkv; g.N = NQKV; E.mode = 1; E.ob = F.QKV; E.ldo = NQKV; }
            else { g.Bt = F.WoB; }
            E.part = (float*)(ws + WS_PART); E.act = F.ACT; E.edge = (float*)(ws + WS_PART);
            pg8::StaticOrder S; S.init(g.M, g.N, g.K, F.G, F.bid, E.mode == 2);
            pg8::gemm_phase(F.lds, g, S, E, F.tid);
            if (ph == PH_G1 || ph == PH_G3_0 || ph == PH_G5) {
                const int rem = S.nitems % F.G;
                if (rem == 0 || F.bid >= rem) {
                    const int widx = rem ? F.bid - rem : F.bid, nw = rem ? F.G - rem : F.G;
                    if (ph == PH_G1) wconv_items(F, WC_EARLY, WC_ALL, widx, nw);
                    else if (ph == PH_G3_0) cacheK_fill(F, widx, nw);
                    else vtrans_items(F, VT_NP + VT_NN, VT_NP + VT_NN + VT_NC, widx, nw);
                }
            }
        } break;
        }
      }
        if (prm.ph_hi > 1000) grid.sync();
        if (ph + 1 < prm.ph_hi) xcd_barrier(xbar);
    }
}

extern "C" void kernel_launch(void* const* d_in, const int* in_sizes, int n_in, void* d_out, int out_size, void* d_ws, size_t ws_size, hipStream_t stream) {
    static int grid_blocks = 0;
    if (!grid_blocks) {
        int dev = 0, cus = 0, per_cu = 0;
        hipGetDevice(&dev);
        hipDeviceGetAttribute(&cus, hipDeviceAttributeMultiprocessorCount, dev);
        if (hipFuncSetAttribute((const void*)fwd_megakernel, hipFuncAttributeMaxDynamicSharedMemorySize, LDS_BYTES) != hipSuccess) fprintf(stderr, "kernel_launch: hipFuncSetAttribute failed\n");
        hipOccupancyMaxActiveBlocksPerMultiprocessor(&per_cu, (const void*)fwd_megakernel, NTHR, LDS_BYTES);
        if (per_cu < 1) per_cu = 1;
        if (per_cu > 1) per_cu = 1;
        grid_blocks = cus * per_cu;
        if (n_in != 21 || (size_t)out_size != O_END || ws_size < WS_END) fprintf(stderr, "kernel_launch: unexpected sizes n_in %d out %d ws %zu (need %zu)\n", n_in, out_size, ws_size, (size_t)WS_END);
    }
    Params p{};
    p.x_prompt = (const float*)d_in[0]; p.x_sample = (const float*)d_in[1]; p.state_a_S = (const float*)d_in[2]; p.cache_k = (const float*)d_in[3]; p.cache_v = (const float*)d_in[4];
    p.conv_state = (const float*)d_in[5]; p.norm_mix = (const float*)d_in[6]; p.norm_ffn = (const float*)d_in[7]; p.a_w_in = (const float*)d_in[8]; p.a_gamma = (const float*)d_in[9];
    p.a_norm_o = (const float*)d_in[10]; p.a_w_o = (const float*)d_in[11]; p.b_w_qkv = (const float*)d_in[12]; p.b_q_norm = (const float*)d_in[13]; p.b_k_norm = (const float*)d_in[14];
    p.b_rel_bias = (const float*)d_in[15]; p.b_w_o = (const float*)d_in[16]; p.f_w_in = (const float*)d_in[17]; p.f_conv_w = (const float*)d_in[18]; p.f_conv_b = (const float*)d_in[19];
    p.f_w_down = (const float*)d_in[20];
    p.out = (float*)d_out; p.ws = (unsigned char*)d_ws;
#if MK_N_LAUNCHES == 1
    p.ph_lo = 0; p.ph_hi = NPH;
    if (hipMemsetAsync((char*)d_ws + WS_BAR, 0, 16384, stream) != hipSuccess) fprintf(stderr, "kernel_launch: memset of barrier words failed\n");
    void* args[] = {&p};
    hipError_t e = hipLaunchCooperativeKernel((const void*)fwd_megakernel, dim3(grid_blocks), dim3(NTHR), args, LDS_BYTES, stream);
    if (e != hipSuccess) fprintf(stderr, "cooperative launch failed: %s (grid %d)\n", hipGetErrorString(e), grid_blocks);
#else
    for (int ph = 0; ph < NPH; ++ph) {
        p.ph_lo = ph; p.ph_hi = ph + 1;
        hipLaunchKernelGGL(fwd_megakernel, dim3(grid_blocks), dim3(NTHR), LDS_BYTES, stream, p);
    }
#endif
}
```
